# Optimizing an MI355X kernel written in HIP

```python
import jax
import jax.numpy as jnp
from jax import lax
import numpy as np
import math

D_MODEL = 1024
BATCH = 4
SEQ = 8192
DEPTH = 2

HEAD_DIM = 64
ROT_DIM = HEAD_DIM // 4
ROPE_THETA = 500000.0
NORM_EPS = 1e-6
MIX_WIDTH = D_MODEL

S5_WIDTH = MIX_WIDTH // 2
S5_GROUP = 16
S5_GROUPS = S5_WIDTH // S5_GROUP
S5_STATE = 64
MOBA_WIDTH = MIX_WIDTH - S5_WIDTH
MOBA_HEADS = MOBA_WIDTH // HEAD_DIM
MOBA_BLOCK = 256
MOBA_TOPK = 3
MOBA_QCHUNK = 32
EVEN_SPLITS = (S5_WIDTH, MOBA_WIDTH, MOBA_WIDTH, MOBA_WIDTH)
EVEN_PROJ = sum(EVEN_SPLITS)

RWKV_WIDTH = MIX_WIDTH // 2
RWKV_HEADS = RWKV_WIDTH // HEAD_DIM
RWKV_W_LORA = 64
RWKV_A_LORA = 64
RWKV_G_LORA = 128
RWKV_GN_EPS = 64e-5
RWKV_SPLITS = (RWKV_WIDTH, RWKV_WIDTH, RWKV_WIDTH, RWKV_W_LORA, RWKV_A_LORA, RWKV_G_LORA)
RWKV_PROJ = sum(RWKV_SPLITS)
DSA_WIDTH = MIX_WIDTH - RWKV_WIDTH
DSA_HEADS = DSA_WIDTH // HEAD_DIM
DSA_IDX_HEADS = 4
DSA_IDX_DIM = HEAD_DIM
DSA_TOPK = 256
DSA_QBLOCK = 128
DSA_SPLITS = (DSA_WIDTH, HEAD_DIM, HEAD_DIM, DSA_IDX_HEADS * DSA_IDX_DIM, DSA_IDX_DIM, DSA_IDX_HEADS)
ODD_PROJ = RWKV_PROJ + sum(DSA_SPLITS)

FFN_DENSE = 2816
N_EXPERTS = 8
TOP_K = 2
FFN_EXPERT = 3584
MOE_BLOCK = 256

N_EVEN = (DEPTH + 1) // 2
N_ODD = DEPTH // 2

kernel_name = 'hybrid_s5_moba_rwkv7_dsa_moe'


def split_cols(t, sizes):
    return jnp.split(t, [int(c) for c in np.cumsum(sizes)[:-1]], axis=-1)


def rms_norm(x, g):
    xf = x.astype(jnp.float32)
    y = xf * lax.rsqrt(jnp.mean(xf * xf, axis=-1, keepdims=True) + NORM_EPS)
    return (y * g.astype(jnp.float32)).astype(x.dtype)


def partial_rope(x, pos):
    half = ROT_DIM // 2
    inv_freq = ROPE_THETA ** (-jnp.arange(half, dtype=jnp.float32) / half)
    ang = pos.astype(jnp.float32)[:, None] * inv_freq[None, :]
    cos = jnp.cos(ang)[None, :, None, :]
    sin = jnp.sin(ang)[None, :, None, :]
    x1 = x[..., :half].astype(jnp.float32)
    x2 = x[..., half:ROT_DIM].astype(jnp.float32)
    rot = jnp.concatenate([x1 * cos - x2 * sin, x2 * cos + x1 * sin], axis=-1).astype(x.dtype)
    return jnp.concatenate([rot, x[..., ROT_DIM:]], axis=-1)


def swiglu(x, w_gate, w_up, w_down):
    return (jax.nn.silu(x @ w_gate) * (x @ w_up)) @ w_down


def s5_mixer(u, a_re, a_im, log_dt, b_re, b_im, c_re, c_im, d, glu_w, glu_b):
    f32 = jnp.float32
    Bsz, S, _ = u.shape
    uf = u.astype(f32)
    ug = uf.reshape(Bsz, S, S5_GROUPS, S5_GROUP)
    ar, ai = a_re.astype(f32), a_im.astype(f32)
    dt = jnp.exp(log_dt.astype(f32))[:, None]
    mag = jnp.exp(dt * ar)
    abar_re = mag * jnp.cos(dt * ai)
    abar_im = mag * jnp.sin(dt * ai)
    den = ar * ar + ai * ai
    xr, xi = abar_re - 1.0, abar_im
    f_re = (xr * ar + xi * ai) / den
    f_im = (xi * ar - xr * ai) / den
    br, bi = b_re.astype(f32), b_im.astype(f32)
    bbar_re = f_re[..., None] * br - f_im[..., None] * bi
    bbar_im = f_re[..., None] * bi + f_im[..., None] * br
    bu_re = jnp.einsum('gpc,bsgc->bsgp', bbar_re, ug)
    bu_im = jnp.einsum('gpc,bsgc->bsgp', bbar_im, ug)
    a_re_t = jnp.broadcast_to(abar_re, bu_re.shape)
    a_im_t = jnp.broadcast_to(abar_im, bu_re.shape)

    def combine(e1, e2):
        a1r, a1i, b1r, b1i = e1
        a2r, a2i, b2r, b2i = e2
        return (a1r * a2r - a1i * a2i, a1r * a2i + a1i * a2r,
                a2r * b1r - a2i * b1i + b2r, a2r * b1i + a2i * b1r + b2i)

    _, _, st_re, st_im = lax.associative_scan(combine, (a_re_t, a_im_t, bu_re, bu_im), axis=1)
    y = (jnp.einsum('gcp,bsgp->bsgc', c_re.astype(f32), st_re)
         - jnp.einsum('gcp,bsgp->bsgc', c_im.astype(f32), st_im))
    y = y.reshape(Bsz, S, S5_WIDTH) + d.astype(f32) * uf
    y = jax.nn.gelu(y)
    y = y * jax.nn.sigmoid(y @ glu_w.astype(f32) + glu_b.astype(f32))
    return y.astype(u.dtype)


def moba_attention(q, k, v):
    f32 = jnp.float32
    Bsz, S, H, hd = q.shape
    nb = -(-S // MOBA_BLOCK)
    pad = nb * MOBA_BLOCK - S
    kp = jnp.pad(k, ((0, 0), (0, pad), (0, 0), (0, 0)))
    vp = jnp.pad(v, ((0, 0), (0, pad), (0, 0), (0, 0)))
    kb = kp.reshape(Bsz, nb, MOBA_BLOCK, H, hd).transpose(0, 3, 1, 2, 4)
    vb = vp.reshape(Bsz, nb, MOBA_BLOCK, H, hd).transpose(0, 3, 1, 2, 4)
    qh = q.transpose(0, 2, 1, 3)
    pos = jnp.arange(S, dtype=jnp.int32)
    qblk = pos // MOBA_BLOCK
    own = jnp.broadcast_to(qblk[None, None, :, None], (Bsz, H, S, 1))
    n_sel = min(MOBA_TOPK, nb - 1)
    if n_sel > 0:
        k_mean = jnp.mean(kb.astype(f32), axis=3)
        gate = jnp.einsum('bhsd,bhnd->bhsn', qh.astype(f32), k_mean)
        past = jnp.arange(nb)[None, :] < qblk[:, None]
        gate = jnp.where(past[None, None], gate, -jnp.inf)
        _, top_idx = lax.top_k(gate, n_sel)
        idx = jnp.concatenate([top_idx.astype(jnp.int32), own], axis=-1)
        valid = jnp.concatenate([jnp.arange(n_sel)[None, :] < qblk[:, None],
                                 jnp.ones((S, 1), bool)], axis=-1)
    else:
        idx = own
        valid = jnp.ones((S, 1), bool)
    n_j = idx.shape[-1]
    nc = S // MOBA_QCHUNK
    scale = hd ** -0.5

    def to_chunks(t):
        return jnp.moveaxis(t.reshape(Bsz, H, nc, MOBA_QCHUNK, *t.shape[3:]), 2, 0)

    gather = jax.vmap(jax.vmap(lambda blocks, i: blocks[i]))

    def chunk_attn(args):
        qc, ic, vc, pc = args
        kg = gather(kb, ic)
        vg = gather(vb, ic)
        s = jnp.einsum('bhqd,bhqjkd->bhqjk', qc, kg, preferred_element_type=f32) * scale
        kpos = ic[..., None] * MOBA_BLOCK + jnp.arange(MOBA_BLOCK)
        mask = (kpos <= pc[None, None, :, None, None]) & vc[None, None, :, :, None]
        s = jnp.where(mask, s, -jnp.inf)
        p = jax.nn.softmax(s.reshape(Bsz, H, MOBA_QCHUNK, n_j * MOBA_BLOCK), axis=-1)
        p = p.reshape(s.shape)
        return jnp.einsum('bhqjk,bhqjkd->bhqd', p, vg.astype(f32)).astype(q.dtype)

    out = lax.map(chunk_attn, (to_chunks(qh), to_chunks(idx),
                               valid.reshape(nc, MOBA_QCHUNK, n_j), pos.reshape(nc, MOBA_QCHUNK)))
    out = jnp.moveaxis(out, 0, 2).reshape(Bsz, H, S, hd)
    return out.transpose(0, 2, 1, 3)


def rwkv7_time_mix(p, mu, w0, w_up, a0, a_up, g_up, k_k, k_a, r_k, ln_w, ln_b):
    f32 = jnp.float32
    out_dtype = p.dtype
    Bsz, S, _ = p.shape
    p = p.astype(f32)
    prev = jnp.pad(p, ((0, 0), (1, 0), (0, 0)))[:, :S]
    p = p + (prev - p) * mu.astype(f32)
    r, k, v, wd, ad, gd = split_cols(p, RWKV_SPLITS)
    w_log = -jax.nn.softplus(-(w0.astype(f32) + jnp.tanh(wd) @ w_up.astype(f32))) - 0.5
    decay = jnp.exp(-jnp.exp(w_log))
    a = jax.nn.sigmoid(a0.astype(f32) + ad @ a_up.astype(f32))
    g = jax.nn.sigmoid(gd) @ g_up.astype(f32)

    def heads(t):
        return t.reshape(Bsz, S, RWKV_HEADS, HEAD_DIM)

    kk = heads(k * k_k.astype(f32))
    kk = kk / jnp.maximum(jnp.sqrt(jnp.sum(kk * kk, axis=-1, keepdims=True)), 1e-12)
    k = k * (1.0 + (a - 1.0) * k_a.astype(f32))
    r, decay, k, v, a = heads(r), heads(decay), heads(k), heads(v), heads(a)
    xs = (jnp.moveaxis(r, 1, 0), jnp.moveaxis(decay, 1, 0), jnp.moveaxis(k, 1, 0),
          jnp.moveaxis(v, 1, 0), jnp.moveaxis(-kk, 1, 0), jnp.moveaxis(kk * a, 1, 0))

    def step(state, inp):
        r_t, w_t, k_t, v_t, a_t, b_t = inp
        sa = jnp.einsum('bhvk,bhk->bhv', state, a_t)
        state = (state * w_t[:, :, None, :] + sa[..., None] * b_t[:, :, None, :]
                 + v_t[..., None] * k_t[:, :, None, :])
        return state, jnp.einsum('bhvk,bhk->bhv', state, r_t)

    state0 = jnp.zeros((Bsz, RWKV_HEADS, HEAD_DIM, HEAD_DIM), f32)
    _, y = lax.scan(step, state0, xs)
    y = jnp.moveaxis(y, 0, 1)
    mean = jnp.mean(y, axis=-1, keepdims=True)
    var = jnp.mean(jnp.square(y - mean), axis=-1, keepdims=True)
    y = ((y - mean) * lax.rsqrt(var + RWKV_GN_EPS)).reshape(Bsz, S, RWKV_WIDTH)
    y = y * ln_w.astype(f32) + ln_b.astype(f32)
    bonus = jnp.sum(r * k * r_k.astype(f32), axis=-1, keepdims=True) * v
    return ((y + bonus.reshape(Bsz, S, RWKV_WIDTH)) * g).astype(out_dtype)


def dsa_attention(q, k, v, q_idx, k_idx, w_idx):
    f32 = jnp.float32
    Bsz, S, H, hd = q.shape
    topk = min(DSA_TOPK, S // 4)
    nq = S // DSA_QBLOCK
    scale = hd ** -0.5
    w_scaled = w_idx.astype(f32) * (DSA_IDX_HEADS ** -0.5 * DSA_IDX_DIM ** -0.5)
    pos = jnp.arange(S, dtype=jnp.int32)

    def blocks(t):
        return jnp.moveaxis(t.reshape(Bsz, nq, DSA_QBLOCK, *t.shape[2:]), 1, 0)

    gather = jax.vmap(lambda t, i: t[i])

    def block_attn(args):
        qb, qib, wb, pb = args
        logits = jnp.einsum('bqhd,bsd->bqhs', qib, k_idx, preferred_element_type=f32)
        score = jnp.einsum('bqhs,bqh->bqs', jax.nn.relu(logits), wb)
        causal = pos[None, :] <= pb[:, None]
        score = jnp.where(causal[None], score, -jnp.inf)
        _, sel = lax.top_k(score, topk)
        kg = gather(k, sel)
        vg = gather(v, sel)
        s = jnp.einsum('bqhd,bqkd->bqhk', qb, kg, preferred_element_type=f32) * scale
        ok = (sel <= pb[None, :, None])[:, :, None, :]
        p = jax.nn.softmax(jnp.where(ok, s, -jnp.inf), axis=-1)
        return jnp.einsum('bqhk,bqkd->bqhd', p, vg.astype(f32)).astype(q.dtype)

    out = lax.map(block_attn, (blocks(q), blocks(q_idx), blocks(w_scaled),
                               pos.reshape(nq, DSA_QBLOCK)))
    return jnp.moveaxis(out, 0, 1).reshape(Bsz, S, H * hd)


def moe_swiglu(x, router, w_gate, w_up, w_down):
    f32 = jnp.float32
    Bsz, S, D = x.shape
    T = Bsz * S
    xt = x.reshape(T, D)
    logits = xt.astype(f32) @ router.astype(f32)
    top_val, top_exp = lax.top_k(logits, TOP_K)
    gates = jax.nn.softmax(top_val, axis=-1)
    flat_exp = top_exp.reshape(-1).astype(jnp.int32)
    flat_tok = jnp.repeat(jnp.arange(T, dtype=jnp.int32), TOP_K)
    flat_gate = gates.reshape(-1)
    order = jnp.argsort(flat_exp)
    sorted_exp = flat_exp[order]
    counts = jnp.bincount(flat_exp, length=N_EXPERTS).astype(jnp.int32)
    padded = (counts + MOE_BLOCK - 1) // MOE_BLOCK * MOE_BLOCK
    pad_end = jnp.cumsum(padded)
    pad_start = pad_end - padded
    grp_start = jnp.cumsum(counts) - counts
    rank = jnp.arange(T * TOP_K, dtype=jnp.int32) - grp_start[sorted_exp]
    dest = pad_start[sorted_exp] + rank
    n_blocks = -(-(T * TOP_K + N_EXPERTS * (MOE_BLOCK - 1)) // MOE_BLOCK)
    n_slots = n_blocks * MOE_BLOCK
    slot_tok = jnp.full((n_slots,), T, jnp.int32).at[dest].set(flat_tok[order])
    slot_gate = jnp.zeros((n_slots,), f32).at[dest].set(flat_gate[order])
    block_start = jnp.arange(n_blocks, dtype=jnp.int32) * MOE_BLOCK
    block_exp = jnp.minimum(jnp.searchsorted(pad_end, block_start, side='right'), N_EXPERTS - 1)
    x_pad = jnp.concatenate([xt, jnp.zeros((1, D), xt.dtype)], axis=0)

    def run_block(args):
        tok, e = args
        xb = x_pad[tok]
        return swiglu(xb, w_gate[e], w_up[e], w_down[e])

    yb = lax.map(run_block, (slot_tok.reshape(n_blocks, MOE_BLOCK), block_exp))
    y = jnp.zeros((T + 1, D), f32).at[slot_tok].add(
        yb.reshape(n_slots, D).astype(f32) * slot_gate[:, None])
    return y[:T].reshape(Bsz, S, D).astype(x.dtype)


def even_layer(h, pos, norm_mix, w_in, a_re, a_im, log_dt, b_re, b_im, c_re, c_im, d,
               glu_w, glu_b, w_out, norm_ffn, w_gate, w_up, w_down):
    Bsz, S, _ = h.shape
    proj = rms_norm(h, norm_mix) @ w_in
    u, q, k, v = split_cols(proj, EVEN_SPLITS)
    y_a = s5_mixer(u, a_re, a_im, log_dt, b_re, b_im, c_re, c_im, d, glu_w, glu_b)

    def heads(t):
        return t.reshape(Bsz, S, MOBA_HEADS, HEAD_DIM)

    y_b = moba_attention(partial_rope(heads(q), pos), partial_rope(heads(k), pos), heads(v))
    h = h + jnp.concatenate([y_a, y_b.reshape(Bsz, S, MOBA_WIDTH)], axis=-1) @ w_out
    return h + swiglu(rms_norm(h, norm_ffn), w_gate, w_up, w_down)


def odd_layer(h, pos, norm_mix, w_in, mu, w0, w_up_w, a0, a_up, g_up, k_k, k_a, r_k, ln_w, ln_b,
              w_out, norm_ffn, router, e_gate, e_up, e_down):
    Bsz, S, _ = h.shape
    proj = rms_norm(h, norm_mix) @ w_in
    proj_c, proj_d = jnp.split(proj, [RWKV_PROJ], axis=-1)
    y_c = rwkv7_time_mix(proj_c, mu, w0, w_up_w, a0, a_up, g_up, k_k, k_a, r_k, ln_w, ln_b)
    q, k, v, qi, ki, wi = split_cols(proj_d, DSA_SPLITS)
    q = partial_rope(q.reshape(Bsz, S, DSA_HEADS, HEAD_DIM), pos)
    k = partial_rope(k[:, :, None, :], pos)[:, :, 0]
    qi = partial_rope(qi.reshape(Bsz, S, DSA_IDX_HEADS, DSA_IDX_DIM), pos)
    ki = partial_rope(ki[:, :, None, :], pos)[:, :, 0]
    y_d = dsa_attention(q, k, v, qi, ki, wi)
    h = h + jnp.concatenate([y_c, y_d], axis=-1) @ w_out
    return h + moe_swiglu(rms_norm(h, norm_ffn), router, e_gate, e_up, e_down)


def setup_inputs(seed: int = 0) -> dict:
    key = jax.random.key(seed)
    ks = iter(jax.random.split(key, 48))
    f32 = jnp.float32

    def nrm(shape, scale):
        return scale * jax.random.normal(next(ks), shape, f32)

    D = D_MODEL
    NE, NO = N_EVEN, N_ODD
    n = jnp.arange(S5_STATE, dtype=f32)
    inp = {}
    inp['x'] = nrm((BATCH, SEQ, D), 1.0)
    inp['e_norm_mix'] = 1.0 + nrm((NE, D), 0.02)
    inp['e_w_in'] = nrm((NE, D, EVEN_PROJ), D ** -0.5)
    inp['s5_a_re'] = -0.5 + nrm((NE, S5_GROUPS, S5_STATE), 0.01)
    inp['s5_a_im'] = math.pi * n + nrm((NE, S5_GROUPS, S5_STATE), 0.01)
    inp['s5_log_dt'] = jax.random.uniform(next(ks), (NE, S5_GROUPS), f32,
                                          minval=math.log(1e-3), maxval=math.log(1e-1))
    inp['s5_b_re'] = nrm((NE, S5_GROUPS, S5_STATE, S5_GROUP), (2 * S5_GROUP) ** -0.5)
    inp['s5_b_im'] = nrm((NE, S5_GROUPS, S5_STATE, S5_GROUP), (2 * S5_GROUP) ** -0.5)
    inp['s5_c_re'] = nrm((NE, S5_GROUPS, S5_GROUP, S5_STATE), (2 * S5_STATE) ** -0.5)
    inp['s5_c_im'] = nrm((NE, S5_GROUPS, S5_GROUP, S5_STATE), (2 * S5_STATE) ** -0.5)
    inp['s5_d'] = nrm((NE, S5_WIDTH), 1.0)
    inp['s5_glu_w'] = nrm((NE, S5_WIDTH, S5_WIDTH), S5_WIDTH ** -0.5)
    inp['s5_glu_b'] = nrm((NE, S5_WIDTH), 0.01)
    inp['e_w_out'] = nrm((NE, MIX_WIDTH, D), MIX_WIDTH ** -0.5)
    inp['e_norm_ffn'] = 1.0 + nrm((NE, D), 0.02)
    inp['ffn_w_gate'] = nrm((NE, D, FFN_DENSE), D ** -0.5)
    inp['ffn_w_up'] = nrm((NE, D, FFN_DENSE), D ** -0.5)
    inp['ffn_w_down'] = nrm((NE, FFN_DENSE, D), FFN_DENSE ** -0.5)
    inp['o_norm_mix'] = 1.0 + nrm((NO, D), 0.02)
    inp['o_w_in'] = nrm((NO, D, ODD_PROJ), D ** -0.5)
    inp['rwkv_mu'] = jax.random.uniform(next(ks), (NO, RWKV_PROJ), f32)
    inp['rwkv_w0'] = -2.0 + nrm((NO, RWKV_WIDTH), 1.0)
    inp['rwkv_w_up'] = nrm((NO, RWKV_W_LORA, RWKV_WIDTH), 0.1)
    inp['rwkv_a0'] = nrm((NO, RWKV_WIDTH), 0.5)
    inp['rwkv_a_up'] = nrm((NO, RWKV_A_LORA, RWKV_WIDTH), 0.1)
    inp['rwkv_g_up'] = nrm((NO, RWKV_G_LORA, RWKV_WIDTH), RWKV_G_LORA ** -0.5)
    inp['rwkv_k_k'] = 0.85 + nrm((NO, RWKV_WIDTH), 0.02)
    inp['rwkv_k_a'] = 1.0 + nrm((NO, RWKV_WIDTH), 0.02)
    inp['rwkv_r_k'] = nrm((NO, RWKV_HEADS, HEAD_DIM), 0.1)
    inp['rwkv_ln_w'] = 1.0 + nrm((NO, RWKV_WIDTH), 0.02)
    inp['rwkv_ln_b'] = nrm((NO, RWKV_WIDTH), 0.01)
    inp['o_w_out'] = nrm((NO, MIX_WIDTH, D), MIX_WIDTH ** -0.5)
    inp['o_norm_ffn'] = 1.0 + nrm((NO, D), 0.02)
    inp['moe_router'] = nrm((NO, D, N_EXPERTS), D ** -0.5)
    inp['moe_w_gate'] = nrm((NO, N_EXPERTS, D, FFN_EXPERT), D ** -0.5)
    inp['moe_w_up'] = nrm((NO, N_EXPERTS, D, FFN_EXPERT), D ** -0.5)
    inp['moe_w_down'] = nrm((NO, N_EXPERTS, FFN_EXPERT, D), FFN_EXPERT ** -0.5)
    inp['final_norm'] = 1.0 + nrm((D,), 0.02)
    return inp


def reference(x, e_norm_mix, e_w_in, s5_a_re, s5_a_im, s5_log_dt, s5_b_re, s5_b_im, s5_c_re,
              s5_c_im, s5_d, s5_glu_w, s5_glu_b, e_w_out, e_norm_ffn, ffn_w_gate, ffn_w_up,
              ffn_w_down, o_norm_mix, o_w_in, rwkv_mu, rwkv_w0, rwkv_w_up, rwkv_a0, rwkv_a_up,
              rwkv_g_up, rwkv_k_k, rwkv_k_a, rwkv_r_k, rwkv_ln_w, rwkv_ln_b, o_w_out, o_norm_ffn,
              moe_router, moe_w_gate, moe_w_up, moe_w_down, final_norm):
    pos = jnp.arange(x.shape[1], dtype=jnp.int32)
    h = x
    for layer in range(DEPTH):
        j = layer // 2
        if layer % 2 == 0:
            h = even_layer(h, pos, e_norm_mix[j], e_w_in[j], s5_a_re[j], s5_a_im[j], s5_log_dt[j],
                           s5_b_re[j], s5_b_im[j], s5_c_re[j], s5_c_im[j], s5_d[j], s5_glu_w[j],
                           s5_glu_b[j], e_w_out[j], e_norm_ffn[j], ffn_w_gate[j], ffn_w_up[j],
                           ffn_w_down[j])
        else:
            h = odd_layer(h, pos, o_norm_mix[j], o_w_in[j], rwkv_mu[j], rwkv_w0[j], rwkv_w_up[j],
                          rwkv_a0[j], rwkv_a_up[j], rwkv_g_up[j], rwkv_k_k[j], rwkv_k_a[j],
                          rwkv_r_k[j], rwkv_ln_w[j], rwkv_ln_b[j], o_w_out[j], o_norm_ffn[j],
                          moe_router[j], moe_w_gate[j], moe_w_up[j], moe_w_down[j])
    return rms_norm(h, final_norm)
```

```cpp
#include <hip/hip_runtime.h>
#include <hip/hip_bf16.h>
#include <cstdio>
#include <cstdint>
#include <cmath>
#ifndef ABL_MOBA
#define ABL_MOBA 0
#endif
__device__ __forceinline__ int mk_lane() { int l; asm volatile("v_mbcnt_lo_u32_b32 %0, -1, 0\n\tv_mbcnt_hi_u32_b32 %0, -1, %0" : "=v"(l)); return l; }
namespace pg8 {
#define PG8_LAS __attribute__((address_space(3)))
typedef unsigned short bf16_t;
typedef short bf16x8 __attribute__((ext_vector_type(8)));
typedef float f32x4 __attribute__((ext_vector_type(4)));
typedef unsigned u32x4 __attribute__((ext_vector_type(4)));
constexpr int BM = 256, BK = 64, HALF = 128, HTB = HALF * BK * 2  , STAGE_BYTES = 8 * HTB, NXCD = 8, WGM = 8;

__host__ __device__ __forceinline__ int lds_byte(int r, int c) { const int st = (r >> 4) * 2 + (c >> 5), rr = r & 15, cc = c & 31, ob = rr * 64 + cc * 2; return st * 1024 + (ob ^ (((ob >> 9) & 1) << 5)); }
__host__ __device__ __forceinline__ void stage_rc(int b, int& R, int& C) { const int st = b / 1024, sb = b % 1024, swz = sb ^ (((sb >> 9) & 1) << 5); R = (st >> 1) * 16 + swz / 64; C = (st & 1) * 32 + (swz % 64) / 2; }
__host__ __device__ __forceinline__ int perm32(int rho) { const int n = rho >> 4, i = rho & 15; return 8 * (i >> 2) + 4 * n + (i & 3); }

struct Unit { int pm, pn, aux; };
struct Gemm { const bf16_t* A; const bf16_t* Bt; int lda, ldb, K; };

struct StaticOrder {
    int nM, nN, nwg, G, c;
    __host__ __device__ void init(int M, int N, int G_, int c_) { nM = M / BM; nN = N / BM; nwg = nM * nN; G = G_; c = c_; }
    __host__ __device__ bool next(int i, Unit& u) const {
        const long L = (long)i * G + c; if (L >= nwg) return false;
        int wgid = (int)L; { const int q = nwg / NXCD, r = nwg % NXCD, xcd = wgid % NXCD, off = wgid / NXCD; wgid = (xcd < r ? xcd * (q + 1) : r * (q + 1) + (xcd - r) * q) + off; }
        const int nig = WGM * nN, gid = wgid / nig, fm = gid * WGM, gsz = (nM - fm) < WGM ? (nM - fm) : WGM;
        u.pm = fm + ((wgid % nig) % gsz); u.pn = (wgid % nig) / gsz; u.aux = 0; return true;
    }
    __device__ __forceinline__ void a_ready(const Unit&) const {}
    __device__ __forceinline__ void done(const Unit&) const {}
};

__device__ __forceinline__ unsigned cvt_pk_bf16(float lo, float hi) { unsigned r; asm volatile("v_cvt_pk_bf16_f32 %0, %1, %2" : "=v"(r) : "v"(lo), "v"(hi)); return r; }

template <class F> struct Epi8 {
    static constexpr bool PERM = true, AFTER_DRAIN = false;
    F f;
    __device__ __forceinline__ void operator()(const f32x4 (&acc)[2][2][4][2], const Unit& u, int wr, int wc, int fr, int fq) const {
#pragma unroll
        for (int ai = 0; ai < 2; ++ai)
#pragma unroll
            for (int m = 0; m < 4; ++m) { const int r = ai * HALF + wr * 64 + m * 16 + fr;
#pragma unroll
                for (int bj = 0; bj < 2; ++bj) { const int c = bj * HALF + wc * 32 + 8 * fq;
                    float v[8] = {acc[ai][bj][m][0][0], acc[ai][bj][m][0][1], acc[ai][bj][m][0][2], acc[ai][bj][m][0][3], acc[ai][bj][m][1][0], acc[ai][bj][m][1][1], acc[ai][bj][m][1][2], acc[ai][bj][m][1][3]};
                    f(u, r, c, v, wc); } }
    }
};
template <class F> struct EpiGU {
    static constexpr bool PERM = true, AFTER_DRAIN = false;
    F f;
    __device__ __forceinline__ void operator()(const f32x4 (&acc)[2][2][4][2], const Unit& u, int wr, int wc, int fr, int fq) const {
#pragma unroll
        for (int ai = 0; ai < 2; ++ai)
#pragma unroll
            for (int m = 0; m < 4; ++m) { const int r = ai * HALF + wr * 64 + m * 16 + fr; const int c = wc * 32 + 8 * fq;
                float g[8] = {acc[ai][0][m][0][0], acc[ai][0][m][0][1], acc[ai][0][m][0][2], acc[ai][0][m][0][3], acc[ai][0][m][1][0], acc[ai][0][m][1][1], acc[ai][0][m][1][2], acc[ai][0][m][1][3]};
                float p[8] = {acc[ai][1][m][0][0], acc[ai][1][m][0][1], acc[ai][1][m][0][2], acc[ai][1][m][0][3], acc[ai][1][m][1][0], acc[ai][1][m][1][1], acc[ai][1][m][1][2], acc[ai][1][m][1][3]};
                f(u, r, c, g, p); }
    }
};

template <class Epi, class Sched, bool ALIGN_EPI = false, bool SP2 = false>
__device__ __forceinline__ void gemm_phase(PG8_LAS unsigned char* lds, const Gemm g, const Sched& S, const Epi& E, const int wave_s) {
    const int wid = wave_s, lane = mk_lane(), tid = wid * 64 + lane, wr = wid >> 2, wc = wid & 3, fr = lane & 15, fq = lane >> 4;
    const int K = g.K, nt = K / BK;
    unsigned voffA[2], voffB[2];
#pragma unroll
    for (int i = 0; i < 2; ++i) { int R, C; stage_rc(tid * 16 + i * 8192, R, C); const int Rb = Epi::PERM ? ((R & ~31) + perm32(R & 31)) : R;
        voffA[i] = (unsigned)(R * g.lda + C) * 2u; voffB[i] = (unsigned)(Rb * g.ldb + C) * 2u; }
    const size_t kstep = (size_t)(BK * 2);
    const size_t hstepA = (size_t)HALF * g.lda * 2, hstepB = (size_t)HALF * g.ldb * 2;
    const size_t tstepA = 2 * hstepA, tstepB = 2 * hstepB;
    const unsigned ldsw = (unsigned)wid * 1024u;
    const int aoff = lds_byte(wr * 64 + fr, fq * 8), boff = lds_byte(wc * 32 + fr, fq * 8);
#define PG8_SA(b, h) (((b) * 2 + (h)) * HTB)
#define PG8_SB(b, h) ((4 + (b) * 2 + (h)) * HTB)
#define PG8_STAGE(bufoff, gbase, voff) do { _Pragma("unroll") for (int _i = 0; _i < 2; ++_i) \
        __builtin_amdgcn_global_load_lds((const unsigned*)((const char*)(gbase) + (voff)[_i]), (PG8_LAS unsigned*)(lds + (bufoff) + ldsw + _i * 8192), 16, 0, 0); } while (0)
#define PG8_LDA(dst, b, h) do { _Pragma("unroll") for (int m = 0; m < 4; ++m) _Pragma("unroll") for (int k = 0; k < 2; ++k) dst[m][k] = *(const PG8_LAS bf16x8*)(lds + PG8_SA(b, h) + aoff + m * 2048 + k * 1024); } while (0)
#define PG8_LDB(dst, b, h) do { _Pragma("unroll") for (int n = 0; n < 2; ++n) _Pragma("unroll") for (int k = 0; k < 2; ++k) dst[n][k] = *(const PG8_LAS bf16x8*)(lds + PG8_SB(b, h) + boff + n * 2048 + k * 1024); } while (0)
#define PG8_MMA(ai, bj, At, Bt) do { __builtin_amdgcn_s_setprio(1); _Pragma("unroll") for (int m = 0; m < 4; ++m) _Pragma("unroll") for (int n = 0; n < 2; ++n) _Pragma("unroll") for (int k = 0; k < 2; ++k) \
        acc[ai][bj][m][n] = __builtin_amdgcn_mfma_f32_16x16x32_bf16(Bt[n][k], At[m][k], acc[ai][bj][m][n], 0, 0, 0); __builtin_amdgcn_s_setprio(0); } while (0)
#define PG8_WAIT_V(n) asm volatile("s_waitcnt vmcnt(" #n ")" ::: "memory")
#define PG8_WAIT_L(n) asm volatile("s_waitcnt lgkmcnt(" #n ")" ::: "memory")
#define PG8_BAR __builtin_amdgcn_s_barrier()
#define PG8_SCHED __builtin_amdgcn_sched_barrier(0)
    Unit cur, nxt; int ui = 0;
    if (!S.next(0, cur)) return;
    f32x4 acc[2][2][4][2];
#pragma unroll
    for (int a = 0; a < 2; ++a)
#pragma unroll
        for (int b = 0; b < 2; ++b)
#pragma unroll
            for (int m = 0; m < 4; ++m)
#pragma unroll
                for (int n = 0; n < 2; ++n) acc[a][b][m][n] = (f32x4){0.f, 0.f, 0.f, 0.f};
    bf16x8 At[4][2], B0[2][2], B1[2][2];
    const char* cA = (const char*)g.A + (size_t)cur.pm * tstepA; const char* cB = (const char*)g.Bt + (size_t)cur.pn * tstepB;
    S.a_ready(cur);
    if constexpr (SP2) {
        PG8_STAGE(PG8_SB(0, 0), cB, voffB); PG8_STAGE(PG8_SB(0, 1), cB + hstepB, voffB); PG8_STAGE(PG8_SA(0, 0), cA, voffA); PG8_STAGE(PG8_SA(0, 1), cA + hstepA, voffA);
        if (wr == 1) PG8_BAR;
        PG8_WAIT_V(2); PG8_BAR;
        PG8_STAGE(PG8_SB(1, 0), cB + kstep, voffB); PG8_STAGE(PG8_SA(1, 0), cA + kstep, voffA); PG8_STAGE(PG8_SB(1, 1), cB + hstepB + kstep, voffB);
        PG8_WAIT_V(6); PG8_BAR;
    } else {
        PG8_STAGE(PG8_SB(0, 0), cB, voffB); PG8_STAGE(PG8_SA(0, 0), cA, voffA); PG8_STAGE(PG8_SB(0, 1), cB + hstepB, voffB); PG8_STAGE(PG8_SA(0, 1), cA + hstepA, voffA);
        if (wr == 1) PG8_BAR;
        PG8_WAIT_V(4); PG8_BAR;
        PG8_STAGE(PG8_SB(1, 0), cB + kstep, voffB); PG8_STAGE(PG8_SA(1, 0), cA + kstep, voffA); PG8_STAGE(PG8_SB(1, 1), cB + hstepB + kstep, voffB);
        PG8_WAIT_V(6); PG8_BAR;
    }
    for (;;) {
        const bool has_next = S.next(ui + 1, nxt);
        const char* nA = has_next ? (const char*)g.A + (size_t)nxt.pm * tstepA : cA; const char* nB = has_next ? (const char*)g.Bt + (size_t)nxt.pn * tstepB : cB;
        for (int t = 0; t < nt; t += 2) {
            const bool last = (t == nt - 2);
            const char* a1 = cA + (size_t)(t + 1) * kstep;
            const char* a2 = last ? nA : cA + (size_t)(t + 2) * kstep; const char* b2 = last ? nB : cB + (size_t)(t + 2) * kstep;
            const char* a3 = a2 + kstep; const char* b3 = b2 + kstep;
            if (last && has_next) S.a_ready(nxt);
            if constexpr (SP2) {
            PG8_LDB(B0, 0, 0); PG8_LDB(B1, 0, 1); PG8_SCHED; PG8_LDA(At, 0, 0); PG8_STAGE(PG8_SA(1, 1), a1 + hstepA, voffA);
            PG8_WAIT_V(8); PG8_WAIT_L(0); PG8_BAR; PG8_MMA(0, 0, At, B0); PG8_MMA(0, 1, At, B1); PG8_BAR; PG8_SCHED;
            PG8_LDA(At, 0, 1); PG8_STAGE(PG8_SB(0, 0), b2, voffB); PG8_STAGE(PG8_SB(0, 1), b2 + hstepB, voffB); PG8_STAGE(PG8_SA(0, 0), a2, voffA);
            PG8_WAIT_V(8); PG8_WAIT_L(0); PG8_BAR; PG8_MMA(1, 0, At, B0); PG8_MMA(1, 1, At, B1); PG8_BAR; PG8_SCHED;
            PG8_LDB(B0, 1, 0); PG8_LDB(B1, 1, 1); PG8_SCHED; PG8_LDA(At, 1, 0); PG8_STAGE(PG8_SA(0, 1), a2 + hstepA, voffA);
            PG8_WAIT_V(8); PG8_WAIT_L(0); PG8_BAR; PG8_MMA(0, 0, At, B0); PG8_MMA(0, 1, At, B1); PG8_BAR; PG8_SCHED;
            PG8_LDA(At, 1, 1); PG8_STAGE(PG8_SB(1, 0), b3, voffB); PG8_STAGE(PG8_SB(1, 1), b3 + hstepB, voffB); PG8_STAGE(PG8_SA(1, 0), a3, voffA);
            PG8_WAIT_V(8); PG8_WAIT_L(0); PG8_BAR; PG8_MMA(1, 0, At, B0); PG8_MMA(1, 1, At, B1); PG8_BAR; PG8_SCHED;
            } else {
            PG8_LDB(B0, 0, 0); PG8_SCHED; PG8_LDA(At, 0, 0); PG8_STAGE(PG8_SA(1, 1), a1 + hstepA, voffA);
            PG8_WAIT_L(8); PG8_BAR; PG8_WAIT_L(0); PG8_MMA(0, 0, At, B0); PG8_BAR; PG8_SCHED;
            PG8_LDB(B1, 0, 1); PG8_STAGE(PG8_SB(0, 0), b2, voffB);
            PG8_BAR; PG8_WAIT_L(0); PG8_MMA(0, 1, At, B1); PG8_BAR;
            PG8_LDA(At, 0, 1); PG8_STAGE(PG8_SA(0, 0), a2, voffA);
            PG8_BAR; PG8_WAIT_L(0); PG8_MMA(1, 0, At, B0); PG8_BAR; PG8_SCHED;
            PG8_STAGE(PG8_SB(0, 1), b2 + hstepB, voffB);
            PG8_WAIT_V(6); PG8_BAR; PG8_MMA(1, 1, At, B1); PG8_BAR;
            PG8_LDB(B0, 1, 0); PG8_SCHED; PG8_LDA(At, 1, 0); PG8_STAGE(PG8_SA(0, 1), a2 + hstepA, voffA);
            PG8_WAIT_L(8); PG8_BAR; PG8_WAIT_L(0); PG8_MMA(0, 0, At, B0); PG8_BAR; PG8_SCHED;
            PG8_LDB(B1, 1, 1); PG8_STAGE(PG8_SB(1, 0), b3, voffB);
            PG8_BAR; PG8_WAIT_L(0); PG8_MMA(0, 1, At, B1); PG8_BAR;
            PG8_LDA(At, 1, 1); PG8_STAGE(PG8_SA(1, 0), a3, voffA);
            PG8_BAR; PG8_WAIT_L(0); PG8_MMA(1, 0, At, B0); PG8_BAR; PG8_SCHED;
            PG8_STAGE(PG8_SB(1, 1), b3 + hstepB, voffB);
            PG8_WAIT_V(6); PG8_BAR; PG8_MMA(1, 1, At, B1); PG8_BAR;
            }
        }
        if constexpr (ALIGN_EPI) { if (wr == 0) PG8_BAR; }
        if constexpr (!Epi::AFTER_DRAIN) { E(acc, cur, wr, wc, fr, fq); S.done(cur); }
        if (!has_next) break;
#pragma unroll
        for (int a = 0; a < 2; ++a)
#pragma unroll
            for (int b = 0; b < 2; ++b)
#pragma unroll
                for (int m = 0; m < 4; ++m)
#pragma unroll
                    for (int n = 0; n < 2; ++n) acc[a][b][m][n] = (f32x4){0.f, 0.f, 0.f, 0.f};
        cur = nxt; cA = nA; cB = nB; ++ui;
        if constexpr (ALIGN_EPI) { if (wr == 1) PG8_BAR; }
    }
    PG8_WAIT_V(0);
    if constexpr (!ALIGN_EPI) { if (wr == 0) PG8_BAR; }
    PG8_BAR;
    if constexpr (Epi::AFTER_DRAIN) { E.fused(acc, cur, wr, wc, fr, fq, lds, wid, lane); S.done(cur); }
#undef PG8_SA
#undef PG8_SB
#undef PG8_STAGE
#undef PG8_LDA
#undef PG8_LDB
#undef PG8_MMA
#undef PG8_WAIT_V
#undef PG8_WAIT_L
#undef PG8_BAR
#undef PG8_SCHED
}
}

namespace attn_body {
using bf16=__hip_bfloat16;
using bf16x8=__attribute__((ext_vector_type(8)))short;
using s16x4=__attribute__((ext_vector_type(4)))short;
using f32x16=__attribute__((ext_vector_type(16)))float;
using u32x4=__attribute__((ext_vector_type(4)))unsigned;
constexpr int BATCH=4,NHEAD=8,SEQ=8192,D=64,DM=NHEAD*D,ODM=1024;
constexpr int NW=8,QBLK=32,QB=QBLK*NW,KVBLK=64,NQB=SEQ/QB;
constexpr int ATTN_PITCH=DM, ATTN_UNIT_ROWS=QB;
__device__ __forceinline__ int crow(int r,int hi){return (r&3)+8*(r>>2)+4*hi;}
#define SBAR() __builtin_amdgcn_sched_barrier(0)
__device__ __forceinline__ void cmask(f32x16&p0,f32x16&p1,int jb,int qrel,int hi){
  const float NEG=-INFINITY; int kb=64*jb+4*hi;
  #pragma unroll
  for(int r=0;r<16;++r){int kv=kb+(r&3)+8*(r>>2); if(kv>qrel)p0[r]=NEG; if(kv+32>qrel)p1[r]=NEG;}
}

constexpr int NSLOT=3, SLOTB=8192;
constexpr int LDS_K=0, LDS_V=NSLOT*SLOTB, LDS_WS=2*NSLOT*SLOTB, LDS_OST=LDS_WS+NW*64*4, LDS_BYTES=LDS_OST+NW*4096;
constexpr float C2=0.125f*1.4426950408889634f;
__device__ __forceinline__ void glds16(const void*gsrc,unsigned lds_dst){unsigned keep;
  asm volatile("s_mov_b32 %0, m0\n\ts_mov_b32 m0, %2\n\ts_nop 0\n\tglobal_load_lds_dwordx4 %1, off\n\ts_mov_b32 m0, %0":"=&s"(keep):"v"(gsrc),"s"(lds_dst):"memory");}
__device__ __forceinline__ float max3f(float a,float b,float c){float r;asm("v_max3_f32 %0, %1, %2, %3":"=v"(r):"v"(a),"v"(b),"v"(c));return r;}
__device__ __forceinline__ float max2f(float a,float b){float r;asm("v_max_f32_e32 %0, %1, %2":"=v"(r):"v"(a),"v"(b));return r;}
__device__ __forceinline__ float fadd_s(float a,float b){float r;asm("v_add_f32_e32 %0, %1, %2":"=v"(r):"v"(a),"v"(b));return r;}
__device__ __forceinline__ float fsub_s(float a,float b){float r;asm("v_sub_f32_e32 %0, %1, %2":"=v"(r):"v"(a),"v"(b));return r;}
typedef float f32x2_t __attribute__((ext_vector_type(2))); typedef __bf16 bf16x2_t __attribute__((ext_vector_type(2)));
__device__ __forceinline__ unsigned cvtpk_s(float lo,float hi){f32x2_t v={lo,hi};bf16x2_t b=__builtin_convertvector(v,bf16x2_t);return __builtin_bit_cast(unsigned,b);}
#define WAIT_BAR(N) asm volatile("s_waitcnt vmcnt(" #N ") lgkmcnt(0)\n\ts_barrier":::"memory")

__device__ __forceinline__ void qkt(f32x16&p0,f32x16&p1,const char*Kslot,const bf16x8*qr,const f32x16&negm,int r32,int hi){
  const char*kb=Kslot+hi*1024+r32*16;
  #pragma unroll
  for(int d0=0;d0<4;++d0){
    const bf16x8 b0=*reinterpret_cast<const bf16x8*>(kb+d0*2048);
    const bf16x8 b1=*reinterpret_cast<const bf16x8*>(kb+d0*2048+512);
    if(d0==0){p0=__builtin_amdgcn_mfma_f32_32x32x16_bf16(b0,qr[0],negm,0,0,0);p1=__builtin_amdgcn_mfma_f32_32x32x16_bf16(b1,qr[0],negm,0,0,0);}
    else{p0=__builtin_amdgcn_mfma_f32_32x32x16_bf16(b0,qr[d0],p0,0,0,0);p1=__builtin_amdgcn_mfma_f32_32x32x16_bf16(b1,qr[d0],p1,0,0,0);}}
}
typedef __attribute__((address_space(3))) const char* lds_cptr;
typedef short v4i16_t __attribute__((ext_vector_type(4)));
__device__ __forceinline__ void kload8(bf16x8*kf,lds_cptr kp){
  kf[0]=*(const __attribute__((address_space(3))) bf16x8*)(kp);      kf[1]=*(const __attribute__((address_space(3))) bf16x8*)(kp+512);
  kf[2]=*(const __attribute__((address_space(3))) bf16x8*)(kp+2048); kf[3]=*(const __attribute__((address_space(3))) bf16x8*)(kp+2560);
  kf[4]=*(const __attribute__((address_space(3))) bf16x8*)(kp+4096); kf[5]=*(const __attribute__((address_space(3))) bf16x8*)(kp+4608);
  kf[6]=*(const __attribute__((address_space(3))) bf16x8*)(kp+6144); kf[7]=*(const __attribute__((address_space(3))) bf16x8*)(kp+6656);
}
__device__ __forceinline__ void kload2(bf16x8*kf,lds_cptr kp,int j){ kf[2*j]=*(const __attribute__((address_space(3))) bf16x8*)(kp+j*2048); kf[2*j+1]=*(const __attribute__((address_space(3))) bf16x8*)(kp+j*2048+512); }
__device__ __forceinline__ s16x4 vtr(lds_cptr p){ return __builtin_bit_cast(s16x4,__builtin_amdgcn_ds_read_tr16_b64_v4i16((__attribute__((address_space(3))) v4i16_t*)p)); }
__device__ __forceinline__ float rowmax(const f32x16&p0,const f32x16&p1){
  float a=max3f(p0[0],p0[1],p1[0]),b=max3f(p0[2],p0[3],p1[1]);a=max3f(a,p1[2],p1[3]);
  #pragma unroll
  for(int r=4;r<16;r+=4){a=max3f(a,p0[r],p0[r+1]);b=max3f(b,p0[r+2],p0[r+3]);a=max3f(a,p1[r],p1[r+1]);b=max3f(b,p1[r+2],p1[r+3]);}
  const float m=max2f(a,b);
  auto rr=__builtin_amdgcn_permlane32_swap(__float_as_uint(m),__float_as_uint(m),false,false);
  return max2f(__uint_as_float(rr[0]),__uint_as_float(rr[1]));
}
__device__ __forceinline__ void pv(f32x16*o,int vb,bf16x8 pa0,bf16x8 pa1,bf16x8 pa2,bf16x8 pa3){
  #pragma unroll
  for(int d0=0;d0<2;++d0){s16x4 lo[4],hi[4];
    #pragma unroll
    for(int ks=0;ks<4;++ks){
      asm volatile("ds_read_b64_tr_b16 %0,%1 offset:%c2":"=&v"(lo[ks]):"v"(vb),"i"(d0*4096+ks*1024):"memory");
      asm volatile("ds_read_b64_tr_b16 %0,%1 offset:%c2":"=&v"(hi[ks]):"v"(vb),"i"(d0*4096+ks*1024+512):"memory");}
    asm volatile("s_waitcnt lgkmcnt(0)":::"memory");SBAR();
    #define PK(k) (bf16x8){lo[k][0],lo[k][1],lo[k][2],lo[k][3],hi[k][0],hi[k][1],hi[k][2],hi[k][3]}
    o[d0]=__builtin_amdgcn_mfma_f32_32x32x16_bf16(pa0,PK(0),o[d0],0,0,0);
    o[d0]=__builtin_amdgcn_mfma_f32_32x32x16_bf16(pa1,PK(1),o[d0],0,0,0);
    o[d0]=__builtin_amdgcn_mfma_f32_32x32x16_bf16(pa2,PK(2),o[d0],0,0,0);
    o[d0]=__builtin_amdgcn_mfma_f32_32x32x16_bf16(pa3,PK(3),o[d0],0,0,0);
    #undef PK
  }
}

#ifndef ATTN_STORE16
#define ATTN_STORE16(p,v) (*(u32x4*)(p)=(v))
#endif
template<int THRL> __device__ __forceinline__ void attn_unit(int b,int h,int qb,const bf16*Q,const bf16*__restrict__ K,const bf16*__restrict__ V,bf16*O,const unsigned*__restrict__ SEL,char*shm,const int wave_s){
  const int wid=wave_s,lane=mk_lane(),r32=lane&31,hi=lane>>5;
  const long rowbase=(long)b*SEQ; const int q0=qb*QB;
  const bf16*Qw=Q+(rowbase+q0+wid*QBLK)*DM+h*D;
  const bf16*Kh=K+rowbase*DM+h*D,*Vh=V+rowbase*DM+h*D;
  const unsigned lds0=(unsigned)(uintptr_t)shm;
  float*wsf=(float*)(shm+LDS_WS)+wid*64;
  const bf16*ksrc=Kh+(long)lane*DM+wid*8;
  const bf16*vsrc=Vh+(long)(16*(wid&3)+(lane>>2))*DM+(wid>>2)*32+(lane&3)*8;
  const unsigned kdst=lds0+LDS_K+wid*1024, vdst=lds0+LDS_V+wid*1024;
  #define TAU(t) (((t)<4)?(NT-4+(t)):((t)-4))
  #define DMA_K(t,slot) glds16(ksrc+(long)TAU(t)*KVBLK*DM,(unsigned)__builtin_amdgcn_readfirstlane(kdst+(slot)))
  #define DMA_V(t,slot) glds16(vsrc+(long)TAU(t)*KVBLK*DM,(unsigned)__builtin_amdgcn_readfirstlane(vdst+(slot)))
  const int vb0=(int)(lds0+LDS_V)+((lane>>4)&1)*32+(lane&3)*8+(4*hi+((lane&15)>>2))*64;
  const char*Kbase=shm+LDS_K; bf16x8 kf[8];
  const lds_cptr shm3=(lds_cptr)shm; const lds_cptr kp0=shm3+LDS_K+hi*1024+r32*16; const lds_cptr vp0=shm3+LDS_V+((lane>>4)&1)*32+(lane&3)*8+(4*hi+((lane&15)>>2))*64;
  const int NT=(q0+QB)/KVBLK;
  DMA_K(0,0);DMA_V(0,0);DMA_K(1,SLOTB);
  bf16x8 qr[4];
  #pragma unroll
  for(int d0=0;d0<4;++d0)qr[d0]=*reinterpret_cast<const bf16x8*>(&Qw[(long)r32*DM+d0*16+hi*8]);
  float mhat=0.f,l_reg=0.f;f32x16 o[2];o[0]=f32x16{};o[1]=f32x16{};const f32x16 negm=f32x16{};
  const int qrel=wid*QBLK+r32;
  const unsigned selw_addr=lds0+LDS_BYTES+wid*128+r32*4;
  { const unsigned sm0_=SEL[(size_t)(b*NHEAD+h)*SEQ+q0+qrel]; if(hi==0){ asm volatile("ds_write_b32 %0, %1"::"v"(selw_addr),"v"(sm0_):"memory"); } }
  #define CMASK(P0,P1,t) do{ unsigned sm_; asm volatile("ds_read_b32 %0, %1\n\ts_waitcnt lgkmcnt(0)":"=v"(sm_):"v"(selw_addr):"memory"); const int pt_=((t)<4)?0:((t)-4)>>2; const int lim_=((t)<4)?(qrel-64*(t)):((((sm_>>pt_)&1u)!=0u)?64:-1); cmask(P0,P1,0,lim_,hi); }while(0)
  bool resc=false;
  #define START(P0,P1) do{ const float rm=rowmax(P0,P1); resc=false; \
    { const float dl=rm; mhat=fadd_s(mhat,dl); \
      _Pragma("unroll") for(int r=0;r<16;++r){P0[r]=fsub_s(P0[r],dl);P1[r]=fsub_s(P1[r],dl);} \
    } \
    _Pragma("unroll") for(int r=0;r<16;++r)P0[r]=__builtin_amdgcn_exp2f(P0[r]); }while(0)
  #define RESC() do{ if(resc){ asm volatile("s_waitcnt lgkmcnt(0)":::"memory"); \
      _Pragma("unroll") for(int d_=0;d_<2;++d_) _Pragma("unroll") for(int r=0;r<16;++r)o[d_][r]*=wsf[crow(r,hi)]; } }while(0)
  f32x16 pA0,pA1,pB0,pB1;
  int sl_prev=0,sl_cur=0,sl_next=SLOTB;
  #define ROT() do{sl_prev=sl_cur;sl_cur=sl_next;sl_next=(sl_next==(NSLOT-1)*SLOTB)?0:sl_next+SLOTB;}while(0)
  DMA_K(2,2*SLOTB);
  WAIT_BAR(3);
  qkt(pA0,pA1,Kbase,qr,negm,r32,hi);asm volatile("s_nop 15\n\ts_nop 7":"+v"(pA0),"+v"(pA1));CMASK(pA0,pA1,0);
  START(pA0,pA1);
  _Pragma("unroll") for(int r=0;r<16;++r)pA1[r]=__builtin_amdgcn_exp2f(pA1[r]);
  WAIT_BAR(0);
  DMA_K(3,0);DMA_V(1,SLOTB);
  ROT();
  kload8(kf,kp0+sl_cur);
  WAIT_BAR(2);
  s16x4 vlo[8],vhi[8]; u32x4 pw0,pw1,pw2,pw3;
  #define PKW(P,B) cvtpk_s(P[B],P[B+1])
  #define PAF(k) __builtin_bit_cast(bf16x8,pw##k)
  #define VFR(i) (bf16x8){vlo[i][0],vlo[i][1],vlo[i][2],vlo[i][3],vhi[i][0],vhi[i][1],vhi[i][2],vhi[i][3]}
  #define PIN(x) asm volatile("":"+v"(x))
  #define MX3(a,b,c) __builtin_fmaxf(__builtin_fmaxf((a),(b)),(c))
  #define GAPA(MF,A0,A1,A2,A3,W0,W1,PW) do{ MF; sacc+=A0; sacc+=A1; sacc+=A2; sacc+=A3; PIN(sacc); W0; W1; PIN(PW); SBAR(); }while(0)
  #define EX(v) __builtin_amdgcn_exp2f(v)
  #define GAPB(MF,X,B) do{ MF; X[B]=EX(X[B]); X[B+1]=EX(X[B+1]); X[B+2]=EX(X[B+2]); X[B+3]=EX(X[B+3]); PIN(X); SBAR(); }while(0)
  #define VRD(i) do{ vlo[i]=vtr(vp_+(((i)>>2)*4096+((i)&3)*1024)); vhi[i]=vtr(vp_+(((i)>>2)*4096+((i)&3)*1024+512)); }while(0)
  #define KRD(G,j) do{ if(G){ kload2(kf,kp0+sl_next,j); SBAR(); } }while(0)
  #define STEP(C0,C1,P0,P1,t,GK,GV,GL) do{ SBAR(); \
    const lds_cptr vp_=vp0+sl_prev; \
    VRD(0); SBAR(); float sacc=(P0[0]+P0[1]); \
    GAPA(C0=__builtin_amdgcn_mfma_f32_32x32x16_bf16(kf[0],qr[0],negm,0,0,0), P0[2],P0[3],P0[4],P0[5],     pw0[0]=PKW(P0,0), pw0[1]=PKW(P0,2), pw0); \
    VRD(4); SBAR(); GAPA(C1=__builtin_amdgcn_mfma_f32_32x32x16_bf16(kf[1],qr[0],negm,0,0,0), P0[6],P0[7],P0[8],P0[9],     pw0[2]=PKW(P0,4), pw0[3]=PKW(P0,6), pw0); \
    VRD(1); SBAR(); GAPA(C0=__builtin_amdgcn_mfma_f32_32x32x16_bf16(kf[2],qr[1],C0,0,0,0),   P0[10],P0[11],P0[12],P0[13], pw1[0]=PKW(P0,8), pw1[1]=PKW(P0,10), pw1); \
    VRD(5); SBAR(); GAPA(C1=__builtin_amdgcn_mfma_f32_32x32x16_bf16(kf[3],qr[1],C1,0,0,0),   P0[14],P0[15],P1[0],P1[1],   pw1[2]=PKW(P0,12),pw1[3]=PKW(P0,14), pw1); \
    VRD(2); SBAR(); GAPA(C0=__builtin_amdgcn_mfma_f32_32x32x16_bf16(kf[4],qr[2],C0,0,0,0),   P1[2],P1[3],P1[4],P1[5],     pw2[0]=PKW(P1,0), pw2[1]=PKW(P1,2), pw2); \
    VRD(6); SBAR(); GAPA(C1=__builtin_amdgcn_mfma_f32_32x32x16_bf16(kf[5],qr[2],C1,0,0,0),   P1[6],P1[7],P1[8],P1[9],     pw2[2]=PKW(P1,4), pw2[3]=PKW(P1,6), pw2); \
    VRD(3); SBAR(); GAPA(C0=__builtin_amdgcn_mfma_f32_32x32x16_bf16(kf[6],qr[3],C0,0,0,0),   P1[10],P1[11],P1[12],P1[13], pw3[0]=PKW(P1,8), pw3[1]=PKW(P1,10), pw3); \
    VRD(7); SBAR(); GAPA(C1=__builtin_amdgcn_mfma_f32_32x32x16_bf16(kf[7],qr[3],C1,0,0,0),   P1[14],P1[15],0.f,0.f,       pw3[2]=PKW(P1,12),pw3[3]=PKW(P1,14), pw3); \
    l_reg+=sacc; \
    if(GK){DMA_K((t)+3,sl_cur);} if(GV){DMA_V((t)+1,sl_next);} \
    _Pragma("unroll") for(int r=0;r<16;++r){C0[r]-=mhat;C1[r]-=mhat;} \
    CMASK(C0,C1,t); \
    { float a=MX3(C0[0],C0[1],C1[0]),b=MX3(C0[2],C0[3],C1[1]); a=MX3(a,C1[2],C1[3]); \
      _Pragma("unroll") for(int r=4;r<16;r+=4){a=MX3(a,C0[r],C0[r+1]);b=MX3(b,C0[r+2],C0[r+3]);a=MX3(a,C1[r],C1[r+1]);b=MX3(b,C1[r+2],C1[r+3]);} \
      float rm=__builtin_fmaxf(a,b); { auto rr=__builtin_amdgcn_permlane32_swap(__float_as_uint(rm),__float_as_uint(rm),false,false); rm=__builtin_fmaxf(__uint_as_float(rr[0]),__uint_as_float(rr[1])); } \
      resc=false; \
      if(__builtin_expect(__any(rm>(float)THRL),0)){ const float dl=__builtin_fmaxf(rm,0.f); mhat+=dl; \
        _Pragma("unroll") for(int r=0;r<16;++r){C0[r]-=dl;C1[r]-=dl;} \
        const float f=__builtin_amdgcn_exp2f(-dl); l_reg*=f; if(hi==0)wsf[r32]=f; resc=true; } } \
    SBAR(); \
    GAPB(o[0]=__builtin_amdgcn_mfma_f32_32x32x16_bf16(PAF(0),VFR(0),o[0],0,0,0), C0,0); \
    GAPB(o[1]=__builtin_amdgcn_mfma_f32_32x32x16_bf16(PAF(0),VFR(4),o[1],0,0,0), C0,4); \
    KRD(GL,0); GAPB(o[0]=__builtin_amdgcn_mfma_f32_32x32x16_bf16(PAF(1),VFR(1),o[0],0,0,0), C0,8); \
    KRD(GL,1); GAPB(o[1]=__builtin_amdgcn_mfma_f32_32x32x16_bf16(PAF(1),VFR(5),o[1],0,0,0), C0,12); \
    KRD(GL,2); GAPB(o[0]=__builtin_amdgcn_mfma_f32_32x32x16_bf16(PAF(2),VFR(2),o[0],0,0,0), C1,0); \
    KRD(GL,3); GAPB(o[1]=__builtin_amdgcn_mfma_f32_32x32x16_bf16(PAF(2),VFR(6),o[1],0,0,0), C1,4); \
    GAPB(o[0]=__builtin_amdgcn_mfma_f32_32x32x16_bf16(PAF(3),VFR(3),o[0],0,0,0), C1,8); \
    GAPB(o[1]=__builtin_amdgcn_mfma_f32_32x32x16_bf16(PAF(3),VFR(7),o[1],0,0,0), C1,12); \
    }while(0)
  int t=1;
  #undef CMASK
  #define CMASK(P0,P1,t) do{ unsigned sm_; asm volatile("ds_read_b32 %0, %1\n\ts_waitcnt lgkmcnt(0)":"=v"(sm_):"v"(selw_addr):"memory"); const int pt_=((t)<4)?0:((t)-4)>>2; const int lim_=((t)<4)?(qrel-64*(t)):((((sm_>>pt_)&1u)!=0u)?64:-1); cmask(P0,P1,0,lim_,hi); }while(0)
  for(;t+5<NT;t+=2){
    STEP(pB0,pB1,pA0,pA1,t,true,true,true);     WAIT_BAR(2); RESC(); ROT();
    STEP(pA0,pA1,pB0,pB1,t+1,true,true,true);   WAIT_BAR(2); RESC(); ROT();
  }
  #undef CMASK
  #define CMASK(P0,P1,t) do{ unsigned sm_; asm volatile("ds_read_b32 %0, %1\n\ts_waitcnt lgkmcnt(0)":"=v"(sm_):"v"(selw_addr):"memory"); const int pt_=((t)<4)?0:((t)-4)>>2; const int lim_=((t)<4)?(qrel-64*(t)):((((sm_>>pt_)&1u)!=0u)?64:-1); cmask(P0,P1,0,lim_,hi); }while(0)
  #define ENDW(tt) do{ if((tt)+3<NT){WAIT_BAR(2);} else if((tt)+2<NT){WAIT_BAR(1);} else {WAIT_BAR(0);} }while(0)
  for(;t+1<NT;t+=2){
    STEP(pB0,pB1,pA0,pA1,t,(t+3<NT),(t+1<NT),(t+1<NT));       ENDW(t);   RESC(); ROT();
    STEP(pA0,pA1,pB0,pB1,t+1,(t+4<NT),(t+2<NT),(t+2<NT));     ENDW(t+1); RESC(); ROT();
  }
  STEP(pB0,pB1,pA0,pA1,NT-1,false,false,false); RESC();
  { float sacc=pB0[0]+pB0[1]; _Pragma("unroll") for(int r=2;r<16;++r)sacc+=pB0[r]; _Pragma("unroll") for(int r=0;r<16;++r)sacc+=pB1[r]; l_reg+=sacc;
    pw0=(u32x4){PKW(pB0,0),PKW(pB0,2),PKW(pB0,4),PKW(pB0,6)};pw1=(u32x4){PKW(pB0,8),PKW(pB0,10),PKW(pB0,12),PKW(pB0,14)};pw2=(u32x4){PKW(pB1,0),PKW(pB1,2),PKW(pB1,4),PKW(pB1,6)};pw3=(u32x4){PKW(pB1,8),PKW(pB1,10),PKW(pB1,12),PKW(pB1,14)};
    SBAR(); pv(o,vb0+sl_cur,PAF(0),PAF(1),PAF(2),PAF(3)); }
  #undef PKW
  #undef PAF
  #undef VFR
  #undef PIN
  #undef MX3
  #undef GAPA
  #undef GAPB
  #undef EX
  #undef VRD
  #undef KRD
  #undef STEP
  #undef ENDW
  {auto rr=__builtin_amdgcn_permlane32_swap(__float_as_uint(l_reg),__float_as_uint(l_reg),false,false);l_reg=__uint_as_float(rr[0])+__uint_as_float(rr[1]);}
  if(hi==0)wsf[32+r32]=l_reg;asm volatile("s_waitcnt lgkmcnt(0)":::"memory");
  float rli[16];
  #pragma unroll
  for(int r=0;r<16;++r)rli[r]=__builtin_amdgcn_rcpf(wsf[32+crow(r,hi)]);
  bf16*Ow=O+(rowbase+q0+wid*QBLK)*ODM+h*D;
  { bf16*stg=(bf16*)(shm+LDS_OST)+wid*2048;
    #pragma unroll
    for(int r=0;r<16;++r){const int orow=crow(r,hi);
      #pragma unroll
      for(int d0=0;d0<2;++d0)stg[orow*64+d0*32+r32]=__float2bfloat16(ABL_MOBA?0.f:o[d0][r]*rli[r]);}
    asm volatile("s_waitcnt lgkmcnt(0)":::"memory");
    #pragma unroll
    for(int i=0;i<4;++i){const int row=i*8+(lane>>3),ch=lane&7; const u32x4 v=*(const u32x4*)(stg+row*64+ch*8); ATTN_STORE16(Ow+(long)row*ODM+ch*8,v);} }
  asm volatile("s_waitcnt lgkmcnt(0)\n\ts_barrier":::"memory");
  #undef DMA_K
  #undef DMA_V
  #undef CMASK
  #undef START
  #undef RESC
  #undef ROT
}
constexpr int ATTN_LDS_BYTES=LDS_BYTES;
struct AttnTensors { const bf16* Q; const bf16* K; const bf16* V; bf16* O; const unsigned* SEL; };
struct AttnUnit { int bh; int qb; };
struct StaticOrder {
  int vcu;
  __device__ __forceinline__ explicit StaticOrder(int grid,int block):vcu((block%8)*(grid/8)+block/8){}
  __device__ __forceinline__ bool next(int i,AttnUnit&u)const{ if(i>=4)return false; const int s=vcu&7; u.bh=vcu>>3; u.qb=(i==0)?s:(i==1)?15-s:(i==2)?16+s:31-s; return true; }
  __device__ __forceinline__ void a_ready(const AttnUnit&)const{}
  __device__ __forceinline__ void done(const AttnUnit&)const{}
};
template<class Sched,int THRL=8> __device__ __forceinline__ void attn_phase(char*lds,const AttnTensors&T,const Sched&S,const int wave_s){
  AttnUnit u;
  for(int i=0;S.next(i,u);++i){ S.a_ready(u); attn_unit<THRL>(u.bh/NHEAD,u.bh%NHEAD,u.qb,T.Q,T.K,T.V,T.O,T.SEL,lds,wave_s); S.done(u); }
}
#undef SBAR
#undef WAIT_BAR
}

#define LAS __attribute__((address_space(3)))
#define XB_TMO      128
#define XB_XCNT(j)  (256  + 64 * (j))
#define XB_XSUB(j)  (1280 + 64 * (j))
#define XB_XGEN(j)  (2304 + 64 * (j))
#define XB_TOP      3328
#define XB_TOPGEN   3392
#define XCD_BAR_WORDS 3456
#define XB_SPIN_CAP (1u << 18)

__device__ __forceinline__ unsigned xb_ld(unsigned* p)              { return __hip_atomic_load(p, __ATOMIC_RELAXED, __HIP_MEMORY_SCOPE_AGENT); }
__device__ __forceinline__ unsigned xb_add(unsigned* p, unsigned v) { return __hip_atomic_fetch_add(p, v, __ATOMIC_RELAXED, __HIP_MEMORY_SCOPE_AGENT); }
__device__ __forceinline__ unsigned xb_xcc_id() { return (unsigned)__builtin_amdgcn_s_getreg((3 << 11) | 20) & 0xFu; }
#define XB_SPIN(cond, bar) do { unsigned _sp = 0; while (cond) { __builtin_amdgcn_s_sleep(1); \
    if ((++_sp & 255u) == 0u) { if (xb_ld(&(bar)[XB_TMO])) break; if (_sp > XB_SPIN_CAP) { atomicAdd(&(bar)[XB_TMO], 1u); break; } } } } while (0)

struct XcdBarrier {
    unsigned* bar; unsigned x;
    volatile LAS unsigned* st;
};

__device__ __forceinline__ XcdBarrier xcd_barrier_post(unsigned* bar, volatile LAS unsigned* st) {
    XcdBarrier b; b.bar = bar; b.x = xb_xcc_id(); b.st = st;
    if (threadIdx.x == 0) (void)xb_add(&bar[XB_XCNT(b.x)], 1u);
    return b;
}
__device__ __forceinline__ void xcd_barrier_complete(unsigned* bar, unsigned x, unsigned& nloc, unsigned& nx) {
    const unsigned G = gridDim.x * gridDim.y * gridDim.z;
    unsigned sum, cnt, mine, sp = 0u;
    for (;;) {
        sum = 0u; cnt = 0u; mine = 0u;
#pragma unroll
        for (unsigned j = 0; j < 16; ++j) { const unsigned c = xb_ld(&bar[XB_XCNT(j)]); sum += c; cnt += (c > 0u) ? 1u : 0u; mine = (j == x) ? c : mine; }
        if (sum == G) break;
        __builtin_amdgcn_s_sleep(1);
        if ((++sp & 255u) == 0u) { if (xb_ld(&bar[XB_TMO])) break; if (sp > XB_SPIN_CAP) { atomicAdd(&bar[XB_TMO], 1u); break; } }
    }
    nloc = mine > 0u ? mine : 1u; nx = cnt > 0u ? cnt : 1u;
}

__device__ __forceinline__ void xcd_barrier(const XcdBarrier& b, const bool is_t0) {
    asm volatile("s_waitcnt vmcnt(0)" ::: "memory");
    __syncthreads();
    if (is_t0) {
        unsigned* bar = b.bar;
        __builtin_amdgcn_s_waitcnt(0);
        unsigned nloc = b.st[0], nx = b.st[1];
        if (nloc == 0u) { xcd_barrier_complete(bar, b.x, nloc, nx); b.st[0] = nloc; b.st[1] = nx; }
        const unsigned old = xb_add(&bar[XB_XSUB(b.x)], 1u);
        const unsigned gen = old / nloc;
        if (old + 1u == (gen + 1u) * nloc) {
            __builtin_amdgcn_fence(__ATOMIC_RELEASE, "agent");
            asm volatile("s_waitcnt vmcnt(0)" ::: "memory");
            const unsigned og = xb_add(&bar[XB_TOP], 1u);
            const unsigned tg = og / nx;
            if (og + 1u == (tg + 1u) * nx) xb_add(&bar[XB_TOPGEN], 1u);
            else XB_SPIN(xb_ld(&bar[XB_TOPGEN]) == tg, bar);
            __builtin_amdgcn_fence(__ATOMIC_ACQUIRE, "agent");
            xb_add(&bar[XB_XGEN(b.x)], 1u);
            asm volatile("s_waitcnt vmcnt(0)" ::: "memory");
        } else {
            XB_SPIN(xb_ld(&bar[XB_XGEN(b.x)]) == gen, bar);
            __builtin_amdgcn_fence(__ATOMIC_ACQUIRE, "agent");
            asm volatile("s_waitcnt vmcnt(0)" ::: "memory");
        }
    }
    __syncthreads();
}

#ifndef MOE_SCALE
#define MOE_SCALE 1.0f
#endif
#ifndef DIAG
#define DIAG 0
#endif
#ifndef ABL_MOE
#define ABL_MOE 0
#endif
#ifndef ABL_RWKV
#define ABL_RWKV 0
#endif
#ifndef ABL_DSA
#define ABL_DSA 0
#endif
#ifndef ABL_S5
#define ABL_S5 0
#endif
#ifndef ABL_MOBA
#define ABL_MOBA 0
#endif
#ifndef ABL_FFN0
#define ABL_FFN0 0
#endif
constexpr int NWAVES = 8;
constexpr int T_TOK = 32768, DMODEL = 1024, SEQL = 8192, NBATCH = 4;
constexpr int FFN_D = 2816, ODD_PROJ = 2756, ODD_PAD = 2816, FEXP = 3584, NEXP = 8;
constexpr float NORM_EPS = 1e-6f;
constexpr size_t MiB = 1u << 20;
constexpr size_t WS_CTL = 0, CTL_ZERO_BYTES = 1 * MiB;
constexpr size_t WS_ROPE = 1 * MiB;
constexpr size_t WS_KMEAN = WS_ROPE + 512 * 1024;
constexpr size_t WS_TOKINFO = 2 * MiB;
constexpr size_t WS_TOKSLOT = WS_TOKINFO + 512 * 1024;
constexpr size_t WS_TILEEXP = WS_TOKSLOT + 256 * 1024;
constexpr size_t WS_WE_IN = 3 * MiB;
constexpr size_t WS_WGLU = WS_WE_IN + 4 * MiB;
constexpr size_t WS_WE_OUT = WS_WGLU + MiB / 2;
constexpr size_t WS_WFFN_GU = WS_WE_OUT + 2 * MiB;
constexpr size_t WS_WFFN_D = WS_WFFN_GU + 11 * MiB;
constexpr size_t WS_WO_IN = WS_WFFN_D + 11 * MiB / 2;
constexpr size_t WS_WLORA = WS_WO_IN + 11 * MiB / 2;
constexpr size_t WS_WO_OUT = WS_WLORA + 3 * MiB / 4;
constexpr size_t WS_S5MT = 35 * MiB;
constexpr size_t WS_S5BEND = 55 * MiB;
static_assert(WS_WO_OUT + 2 * MiB <= WS_S5MT, "weights map");
constexpr size_t WS_XN = 64 * MiB;
constexpr size_t WS_CAT = WS_XN;
constexpr size_t WS_UG = 128 * MiB;
constexpr size_t WS_Q0 = 168 * MiB, WS_K0 = 200 * MiB, WS_V0 = 232 * MiB;
constexpr size_t WS_XEND = 264 * MiB;
constexpr size_t WS_YA = 280 * MiB;
constexpr size_t WS_SELM = 312 * MiB;
constexpr size_t WS_ACT = 128 * MiB;
constexpr size_t WS_P1 = 128 * MiB;
constexpr size_t WS_LORA = 304 * MiB;
constexpr size_t WS_QD = 400 * MiB;
constexpr size_t WS_KD = 432 * MiB;
constexpr size_t WS_KI = 436 * MiB;
constexpr size_t WS_QI = 440 * MiB;
constexpr size_t WS_WI = 456 * MiB;
constexpr size_t WS_ALORA = 457 * MiB;
constexpr size_t WS_YR = 457 * MiB;
constexpr int MOE_MAXTILES = 264, MOE_CHUNK = 64;
constexpr size_t WS_XG = 64 * MiB;
constexpr size_t WS_WMOE_GU = 196 * MiB;
constexpr size_t WS_WMOE_D = 308 * MiB;
constexpr size_t WS_ACTQ = 364 * MiB;
constexpr size_t WS_NEED = 490 * MiB;
constexpr int CW_BAR = 4096;
constexpr int MAX_LAUNCH = 36;
constexpr int CW_EXPCNT = 196608;
static_assert((CW_BAR + MAX_LAUNCH * 3456) <= CW_EXPCNT && (CW_EXPCNT + 8 * 64) * 4 <= (int)CTL_ZERO_BYTES, "ctl map");

constexpr int RING_BYTES = 131072;
constexpr int MISC_OFF = RING_BYTES + 320;
constexpr int LDS_BYTES = 147456;

#define GAS __attribute__((address_space(1)))
typedef unsigned short bf16;
typedef unsigned v4u __attribute__((ext_vector_type(4)));
typedef unsigned v2u __attribute__((ext_vector_type(2)));
typedef float f32x4 __attribute__((ext_vector_type(4)));
typedef float f32x2 __attribute__((ext_vector_type(2)));
typedef short bf16x8 __attribute__((ext_vector_type(8)));
#define LDS_WAIT() asm volatile("s_waitcnt lgkmcnt(0)" ::: "memory")
#define VM_WAIT() asm volatile("s_waitcnt vmcnt(0)" ::: "memory")
__device__ __forceinline__ unsigned f2bf(float f) { unsigned u = __builtin_bit_cast(unsigned, f); return (u + 0x7fffu + ((u >> 16) & 1u)) >> 16; }
__device__ __forceinline__ unsigned pk2(float lo, float hi) { return f2bf(lo) | (f2bf(hi) << 16); }
__device__ __forceinline__ float bf2f(unsigned short b) { return __builtin_bit_cast(float, (unsigned)b << 16); }
__device__ __forceinline__ float bflo(unsigned w) { return __builtin_bit_cast(float, w << 16); }
__device__ __forceinline__ float bfhi(unsigned w) { return __builtin_bit_cast(float, w & 0xffff0000u); }
__device__ __forceinline__ void unpack8(const v4u w, float (&o)[8]) { o[0] = bflo(w.x); o[1] = bfhi(w.x); o[2] = bflo(w.y); o[3] = bfhi(w.y); o[4] = bflo(w.z); o[5] = bfhi(w.z); o[6] = bflo(w.w); o[7] = bfhi(w.w); }
__device__ __forceinline__ v4u pack8(const float (&v)[8]) { v4u w; w.x = pk2(v[0], v[1]); w.y = pk2(v[2], v[3]); w.z = pk2(v[4], v[5]); w.w = pk2(v[6], v[7]); return w; }
__device__ __forceinline__ void store8_bf16(bf16* dst, const float (&v)[8]) { *(v4u*)dst = pack8(v); }
__device__ __forceinline__ void load8_bf16(const bf16* src, float (&o)[8]) { const v4u w = *(const v4u*)src; unpack8(w, o); }
__device__ __forceinline__ float wave_sum(float v) {
#pragma unroll
    for (int o = 1; o < 64; o <<= 1) v += __shfl_xor(v, o);
    return v;
}
__device__ __forceinline__ float sigmoidf_(float x) { return 1.0f / (1.0f + __expf(-x)); }
__device__ __forceinline__ float gelu_tanh(float x) { const float z = 0.7978845608028654f * (x + 0.044715f * x * x * x); const float t = 1.0f - 2.0f / (1.0f + __expf(2.0f * z)); return 0.5f * x * (1.0f + t); }


struct Args { const float* in[38]; float* out; unsigned char* ws; int ph_lo, ph_hi, li, pad; };
struct Frame {
    LAS unsigned char* lds;
    int wave, G;
    const float* const* in; float* out; unsigned char* ws;
};
enum InIdx { I_X = 0, I_E_NORM_MIX, I_E_W_IN, I_S5_A_RE, I_S5_A_IM, I_S5_LOG_DT, I_S5_B_RE, I_S5_B_IM, I_S5_C_RE, I_S5_C_IM, I_S5_D, I_S5_GLU_W, I_S5_GLU_B, I_E_W_OUT, I_E_NORM_FFN,
             I_FFN_GATE, I_FFN_UP, I_FFN_DOWN, I_O_NORM_MIX, I_O_W_IN, I_RWKV_MU, I_RWKV_W0, I_RWKV_W_UP, I_RWKV_A0, I_RWKV_A_UP, I_RWKV_G_UP, I_RWKV_K_K, I_RWKV_K_A, I_RWKV_R_K,
             I_RWKV_LN_W, I_RWKV_LN_B, I_O_W_OUT, I_O_NORM_FFN, I_MOE_ROUTER, I_MOE_GATE, I_MOE_UP, I_MOE_DOWN, I_FINAL_NORM };

template <int MODE>
__device__ __forceinline__ void tr_item(const float* __restrict__ W, int K, int N, bf16* __restrict__ WT, int ldo, int row_off, const float* __restrict__ gain, LAS float* scr, int kb, int nb, int lane) {
    const int k0 = 64 * kb, n0 = 32 * nb; const int nn = n0 + (lane & 31);
#pragma unroll 8
    for (int i = 0; i < 32; ++i) { const int kk = 2 * i + (lane >> 5); float w = (nn < N) ? W[(size_t)(k0 + kk) * N + nn] : 0.f; if (gain) w *= gain[k0 + kk]; scr[kk * 33 + (lane & 31)] = w; }
    LDS_WAIT(); asm volatile("" ::: "memory");
    const int c = lane & 7;
#pragma unroll
    for (int j = 0; j < 4; ++j) { const int nl = (lane >> 3) + 8 * j; const int n = n0 + nl; const LAS float* s = scr + (8 * c) * 33 + nl;
        v4u o; o.x = pk2(s[0 * 33], s[1 * 33]); o.y = pk2(s[2 * 33], s[3 * 33]); o.z = pk2(s[4 * 33], s[5 * 33]); o.w = pk2(s[6 * 33], s[7 * 33]);
        const int row = (MODE == 0) ? (row_off + n) : (row_off + (n >> 7) * 256 + (n & 127));
        if (n < N) *(v4u*)(WT + (size_t)row * ldo + k0 + 8 * c) = o; }
    LDS_WAIT(); asm volatile("" ::: "memory");
}
__device__ __forceinline__ void rms_row_to_bf16(const float* xrow, bf16* orow, int lane) {
    const f32x4* xr = (const f32x4*)xrow + lane;
    f32x4 v[4]; float s = 0.f;
#pragma unroll
    for (int j = 0; j < 4; ++j) { v[j] = xr[64 * j]; s += (v[j].x * v[j].x + v[j].y * v[j].y) + (v[j].z * v[j].z + v[j].w * v[j].w); }
    const float rstd = 1.0f / sqrtf(wave_sum(s) * (1.f / DMODEL) + NORM_EPS);
    unsigned long long* o8 = (unsigned long long*)orow + lane;
#pragma unroll
    for (int j = 0; j < 4; ++j) o8[64 * j] = (unsigned long long)pk2(v[j].x * rstd, v[j].y * rstd) | ((unsigned long long)pk2(v[j].z * rstd, v[j].w * rstd) << 32);
}
__device__ __forceinline__ void norm_phase(Frame& F, const float* src, bf16* dst) {
    const int gw = blockIdx.x * NWAVES + F.wave, NGW = F.G * NWAVES, lane = mk_lane();
    for (int m = gw; m < T_TOK; m += NGW) rms_row_to_bf16(src + (size_t)m * DMODEL, dst + (size_t)m * DMODEL, lane);
}

__device__ __forceinline__ void s5_build_group(Frame& F, int g) {
    LAS float* pw_re = (LAS float*)F.lds;
    LAS float* pw_im = pw_re + 33 * 64;
    LAS float* bb_re = pw_im + 33 * 64;
    LAS float* bb_im = bb_re + 1024;
    LAS float* cc_re = bb_im + 1024;
    LAS float* cc_im = cc_re + 1024;
    LAS float* klag = cc_im + 1024;
    LAS float* lm = klag + 8192;
    LAS float* th = lm + 64;
    LAS float* fr = th + 64;
    LAS float* fi = fr + 64;
    const float* a_re = F.in[I_S5_A_RE]; const float* a_im = F.in[I_S5_A_IM]; const float* log_dt = F.in[I_S5_LOG_DT];
    const float* b_re = F.in[I_S5_B_RE]; const float* b_im = F.in[I_S5_B_IM]; const float* c_re = F.in[I_S5_C_RE]; const float* c_im = F.in[I_S5_C_IM];
    const int tid = F.wave * 64 + mk_lane();
    if (tid < 64) { const int p = tid; const float ar = a_re[g * 64 + p], ai = a_im[g * 64 + p], dt = expf(log_dt[g]);
        const float mag = expf(dt * ar); float sn, cs; sincosf(dt * ai, &sn, &cs); const float abr = mag * cs, abi = mag * sn;
        const float den = ar * ar + ai * ai, xr = abr - 1.0f, xi = abi;
        lm[p] = dt * ar; th[p] = dt * ai; fr[p] = (xr * ar + xi * ai) / den; fi[p] = (xi * ar - xr * ai) / den; }
    __syncthreads();
    for (int idx = tid; idx < 33 * 64; idx += 512) { const int tau = idx >> 6, p = idx & 63; const float mag = expf((float)tau * lm[p]); float sn, cs; sincosf((float)tau * th[p], &sn, &cs); pw_re[idx] = mag * cs; pw_im[idx] = mag * sn; }
    for (int idx = tid; idx < 1024; idx += 512) { const int p = idx >> 4; const float br = b_re[(size_t)g * 1024 + idx], bi = b_im[(size_t)g * 1024 + idx];
        bb_re[idx] = fr[p] * br - fi[p] * bi; bb_im[idx] = fr[p] * bi + fi[p] * br;
        cc_re[idx] = c_re[(size_t)g * 1024 + idx]; cc_im[idx] = c_im[(size_t)g * 1024 + idx]; }
    __syncthreads();
    for (int idx = tid; idx < 8192; idx += 512) { const int tau = idx >> 8, c = (idx >> 4) & 15, c2 = idx & 15; float s = 0.f;
        for (int p = 0; p < 64; ++p) { const float cr = cc_re[c * 64 + p], ci = cc_im[c * 64 + p], pr = pw_re[tau * 64 + p], pi = pw_im[tau * 64 + p];
            const float er = cr * pr - ci * pi, ei = cr * pi + ci * pr; s += er * bb_re[p * 16 + c2] - ei * bb_im[p * 16 + c2]; }
        klag[idx] = s; }
    __syncthreads();
    bf16* MT = (bf16*)(F.ws + WS_S5MT) + (size_t)g * 512 * 640;
    for (int ch = tid; ch < 512 * 80; ch += 512) { const int n = ch / 80, kc = ch % 80, t = n >> 4, c = n & 15, k0 = 8 * kc; float v[8];
        if (k0 < 512) { const int s = k0 >> 4, c0 = k0 & 15;
#pragma unroll
            for (int j = 0; j < 8; ++j) v[j] = (s <= t) ? klag[((t - s) * 16 + c) * 16 + c0 + j] : 0.f;
        } else {
#pragma unroll
            for (int j = 0; j < 8; ++j) { const int jj = k0 - 512 + j, p = jj >> 1; const float cr = cc_re[c * 64 + p], ci = cc_im[c * 64 + p], pr = pw_re[(t + 1) * 64 + p], pi = pw_im[(t + 1) * 64 + p];
                v[j] = (jj & 1) ? -(cr * pi + ci * pr) : (cr * pr - ci * pi); }
        }
        store8_bf16(MT + (size_t)n * 640 + k0, v); }
    bf16* BE = (bf16*)(F.ws + WS_S5BEND) + (size_t)g * 256 * 512;
    for (int ch = tid; ch < 256 * 64; ch += 512) { const int n = ch >> 6, kc = ch & 63, k0 = 8 * kc, s = k0 >> 4, c0 = k0 & 15; float v[8];
        if (n < 128) { const int p = n >> 1; const float pr = pw_re[(31 - s) * 64 + p], pi = pw_im[(31 - s) * 64 + p];
#pragma unroll
            for (int j = 0; j < 8; ++j) { const float br = bb_re[p * 16 + c0 + j], bi = bb_im[p * 16 + c0 + j]; v[j] = (n & 1) ? (pr * bi + pi * br) : (pr * br - pi * bi); }
        } else {
#pragma unroll
            for (int j = 0; j < 8; ++j) v[j] = 0.f;
        }
        store8_bf16(BE + (size_t)n * 512 + k0, v); }
    __syncthreads();
}

__device__ __forceinline__ void p0_prologue(Frame& F) {
    if ((int)blockIdx.x < 32) s5_build_group(F, (int)blockIdx.x);
    if (F.G < 32) { for (int g = F.G + (int)blockIdx.x; g < 32; g += F.G) s5_build_group(F, g); }
    LAS float* scr = (LAS float*)(F.lds + F.wave * 16384);
    const int lane = mk_lane(), tid = F.wave * 64 + lane;
    const int gw = blockIdx.x * NWAVES + F.wave, NGW = F.G * NWAVES;
    constexpr int J0 = 16 * 64, J1 = 8 * 16, J2 = 16 * 32, J3 = 16 * 88, J4 = J3, J5 = 44 * 32, J6 = 16 * 87, J7 = 16 * 32;
    constexpr int NIT = J0 + J1 + J2 + J3 + J4 + J5 + J6 + J7;
    unsigned char* ws = F.ws;
    for (int it = gw; it < NIT; it += NGW) {
        int r = it;
        if (r < J0) { tr_item<0>(F.in[I_E_W_IN], 1024, 2048, (bf16*)(ws + WS_WE_IN), 1024, 0, F.in[I_E_NORM_MIX], scr, r / 64, r % 64, lane); continue; } r -= J0;
        if (r < J1) { tr_item<0>(F.in[I_S5_GLU_W], 512, 512, (bf16*)(ws + WS_WGLU), 512, 0, nullptr, scr, r / 16, r % 16, lane); continue; } r -= J1;
        if (r < J2) { tr_item<0>(F.in[I_E_W_OUT], 1024, 1024, (bf16*)(ws + WS_WE_OUT), 1024, 0, nullptr, scr, r / 32, r % 32, lane); continue; } r -= J2;
        if (r < J3) { tr_item<1>(F.in[I_FFN_GATE], 1024, FFN_D, (bf16*)(ws + WS_WFFN_GU), 1024, 0, F.in[I_E_NORM_FFN], scr, r / 88, r % 88, lane); continue; } r -= J3;
        if (r < J4) { tr_item<1>(F.in[I_FFN_UP], 1024, FFN_D, (bf16*)(ws + WS_WFFN_GU), 1024, 128, F.in[I_E_NORM_FFN], scr, r / 88, r % 88, lane); continue; } r -= J4;
        if (r < J5) { tr_item<0>(F.in[I_FFN_DOWN], FFN_D, 1024, (bf16*)(ws + WS_WFFN_D), FFN_D, 0, nullptr, scr, r / 32, r % 32, lane); continue; } r -= J5;
        if (r < J6) { tr_item<0>(F.in[I_O_W_IN], 1024, ODD_PROJ, (bf16*)(ws + WS_WO_IN), 1024, 0, F.in[I_O_NORM_MIX], scr, r / 87, r % 87, lane); continue; } r -= J6;
        tr_item<0>(F.in[I_O_W_OUT], 1024, 1024, (bf16*)(ws + WS_WO_OUT), 1024, 0, nullptr, scr, r / 32, r % 32, lane);
    }
    const int gt = blockIdx.x * 512 + tid, NGT = F.G * 512;
    { bf16* w = (bf16*)(ws + WS_WO_IN) + (size_t)ODD_PROJ * 1024; for (int i = gt; i < (ODD_PAD - ODD_PROJ) * 1024 / 8; i += NGT) *(v4u*)(w + (size_t)i * 8) = (v4u){0u, 0u, 0u, 0u}; }
    { bf16* w = (bf16*)(ws + WS_WLORA); const float* wu = F.in[I_RWKV_W_UP]; const float* au = F.in[I_RWKV_A_UP]; const float* gu = F.in[I_RWKV_G_UP];
      for (int i = gt; i < 1536 * 256; i += NGT) { const int n = i >> 8, k = i & 255; float v = 0.f;
          if (n < 512) { if (k < 64) v = wu[k * 512 + n]; } else if (n < 1024) { if (k >= 64 && k < 128) v = au[(k - 64) * 512 + (n - 512)]; } else { if (k >= 128) v = gu[(k - 128) * 512 + (n - 1024)]; }
          w[i] = (bf16)f2bf(v); } }
    { float* rp = (float*)(ws + WS_ROPE); for (int i = gt; i < 8192 * 8; i += NGT) { const int pos = i >> 3, j = i & 7; const float inv = powf(500000.0f, -(float)j / 8.0f); const float ang = (float)pos * inv;
          rp[pos * 16 + j] = cosf(ang); rp[pos * 16 + 8 + j] = sinf(ang); } }
    norm_phase(F, F.in[I_X], (bf16*)(ws + WS_XN));
}

constexpr float ATT_C2 = 0.125f * 1.4426950408889634f;
struct F_E1 {
    bf16* UG; bf16* Q0; bf16* K0; bf16* V0; const float* rope;
    __device__ __forceinline__ void operator()(const pg8::Unit& u, int r, int c, float (&v)[8], int wc) const {
        const int row = u.pm * 256 + r, col = u.pn * 256 + c, seg = u.pn >> 1;
        if (seg == 0) { const int g = col >> 4, c0 = col & 15; store8_bf16(UG + ((size_t)(g * 1024 + (row >> 5)) * 640 + (row & 31) * 16 + c0), v); }
        else if (seg == 3) { store8_bf16(V0 + (size_t)row * 512 + (col - 1536), v); }
        else { const int ch = col - seg * 512;
            if ((wc & 1) == 0) { float o[8];
#pragma unroll
                for (int j = 0; j < 8; ++j) o[j] = __shfl_xor(v[j], 16);
                const int d = ch & 63;
                if (d < 16) { const float* cs = rope + (size_t)(row & 8191) * 16; const f32x4 c0 = *(const f32x4*)cs, c1 = *(const f32x4*)(cs + 4), s0 = *(const f32x4*)(cs + 8), s1 = *(const f32x4*)(cs + 12);
                    const float cv[8] = {c0.x, c0.y, c0.z, c0.w, c1.x, c1.y, c1.z, c1.w}, sv[8] = {s0.x, s0.y, s0.z, s0.w, s1.x, s1.y, s1.z, s1.w};
                    const float sgn = (d == 0) ? -1.0f : 1.0f;
#pragma unroll
                    for (int j = 0; j < 8; ++j) v[j] = v[j] * cv[j] + sgn * o[j] * sv[j]; } }
            if (seg == 1) {
#pragma unroll
                for (int j = 0; j < 8; ++j) v[j] *= ATT_C2;
                store8_bf16(Q0 + (size_t)row * 512 + ch, v); }
            else store8_bf16(K0 + (size_t)row * 512 + ch, v); }
    }
};
struct F_XEND { float* XEND;
    __device__ __forceinline__ void operator()(const pg8::Unit& u, int r, int c, float (&v)[8], int) const {
        if (c < 128) { float* d = XEND + (size_t)(u.pm * 256 + r) * 128 + c; *(f32x4*)d = (f32x4){v[0], v[1], v[2], v[3]}; *(f32x4*)(d + 4) = (f32x4){v[4], v[5], v[6], v[7]}; } }
};
struct F_S5Y { const bf16* UG; const float* dsk; bf16* YA;
    __device__ __forceinline__ void operator()(const pg8::Unit& u, int r, int c, float (&v)[8], int) const {
        const int row = u.pm * 256 + r, lc = (u.pn & 1) * 256 + c, g = u.pm >> 2, t = lc >> 4, c0 = lc & 15;
        const int token = (row & 1023) * 32 + t, ch = g * 16 + c0;
        float uu[8]; load8_bf16(UG + (size_t)row * 640 + lc, uu);
        const f32x4 d0 = *(const f32x4*)(dsk + ch), d1 = *(const f32x4*)(dsk + ch + 4); const float dv[8] = {d0.x, d0.y, d0.z, d0.w, d1.x, d1.y, d1.z, d1.w};
#pragma unroll
        for (int j = 0; j < 8; ++j) v[j] = gelu_tanh(v[j] + dv[j] * uu[j]);
        store8_bf16(YA + (size_t)token * 512 + ch, v); }
};
struct F_GLU { const bf16* YA; const float* gb; bf16* CAT;
    __device__ __forceinline__ void operator()(const pg8::Unit& u, int r, int c, float (&v)[8], int) const {
        const int row = u.pm * 256 + r, col = u.pn * 256 + c;
        float ya[8]; load8_bf16(YA + (size_t)row * 512 + col, ya);
        const f32x4 b0 = *(const f32x4*)(gb + col), b1 = *(const f32x4*)(gb + col + 4); const float bv[8] = {b0.x, b0.y, b0.z, b0.w, b1.x, b1.y, b1.z, b1.w};
#pragma unroll
        for (int j = 0; j < 8; ++j) v[j] = ABL_S5 ? 0.f : ya[j] * sigmoidf_(v[j] + bv[j]);
        store8_bf16(CAT + (size_t)row * 1024 + col, v); }
};
struct F_RES { const float* base; float* out;
    __device__ __forceinline__ void operator()(const pg8::Unit& u, int r, int c, float (&v)[8], int) const {
        const size_t o = (size_t)(u.pm * 256 + r) * 1024 + u.pn * 256 + c;
        const f32x4 a = *(const f32x4*)(base + o), b = *(const f32x4*)(base + o + 4);
        *(f32x4*)(out + o) = (f32x4){a.x + v[0], a.y + v[1], a.z + v[2], a.w + v[3]}; *(f32x4*)(out + o + 4) = (f32x4){b.x + v[4], b.y + v[5], b.z + v[6], b.w + v[7]}; }
};
struct F_SWIGLU { bf16* ACT; int ld;
    __device__ __forceinline__ void operator()(const pg8::Unit& u, int r, int c, float (&g)[8], float (&p)[8]) const {
        float o[8];
#pragma unroll
        for (int j = 0; j < 8; ++j) o[j] = ABL_FFN0 ? 0.f : g[j] * sigmoidf_(g[j]) * p[j];
        store8_bf16(ACT + (size_t)(u.pm * 256 + r) * ld + u.pn * 128 + c, o); }
};
struct SchedXend { int G, c;
    __device__ __forceinline__ bool next(int i, pg8::Unit& u) const { const int L = i * G + c; if (L >= 128) return false; u.pm = L; u.pn = L >> 2; u.aux = 0; return true; }
    __device__ __forceinline__ void a_ready(const pg8::Unit&) const {}
    __device__ __forceinline__ void done(const pg8::Unit&) const {} };
struct SchedS5Y { int G, c;
    __device__ __forceinline__ bool next(int i, pg8::Unit& u) const { const int L = i * G + c; if (L >= 256) return false; const int g = L >> 3; u.pm = g * 4 + ((L >> 1) & 3); u.pn = g * 2 + (L & 1); u.aux = 0; return true; }
    __device__ __forceinline__ void a_ready(const pg8::Unit&) const {}
    __device__ __forceinline__ void done(const pg8::Unit&) const {} };

__device__ __forceinline__ void kmean_phase(Frame& F) {
    const bf16* K0 = (const bf16*)(F.ws + WS_K0); float* km = (float*)(F.ws + WS_KMEAN); const int tid = F.wave * 64 + mk_lane();
    for (int un = ((int)blockIdx.x + F.G - (128 % F.G)) % F.G; un < 128; un += F.G) { const int b = un >> 5, n = un & 31; const bf16* src = K0 + ((size_t)b * SEQL + n * 256) * 512 + tid; float s = 0.f;
#pragma unroll 8
        for (int i = 0; i < 256; ++i) s += bf2f(src[(size_t)i * 512]);
        const int h = tid >> 6, d = tid & 63; km[((size_t)(b * 8 + h) * 32 + n) * 64 + d] = s * (1.0f / 256.0f); }
}
__device__ __forceinline__ void s5_carry_phase(Frame& F) {
    const int gid = blockIdx.x * 512 + F.wave * 64 + mk_lane();
    if (gid < 8192) { const int p = gid & 63, b = (gid >> 6) & 3, g = gid >> 8;
        const float ar = F.in[I_S5_A_RE][g * 64 + p], ai = F.in[I_S5_A_IM][g * 64 + p], dt = expf(F.in[I_S5_LOG_DT][g]);
        const float mag = expf(32.0f * dt * ar); float sn, cs; sincosf(32.0f * dt * ai, &sn, &cs); const float a_r = mag * cs, a_i = mag * sn;
        const float* __restrict__ xe = (const float*)(F.ws + WS_XEND) + (size_t)(g * 1024 + b * 256) * 128 + 2 * p;
        unsigned* __restrict__ ug = (unsigned*)((bf16*)(F.ws + WS_UG) + (size_t)(g * 1024 + b * 256) * 640 + 512 + 2 * p);
        float cr = 0.f, ci = 0.f;
        for (int c0 = 0; c0 < 256; c0 += 8) { f32x2 x[8];
#pragma unroll
            for (int j = 0; j < 8; ++j) x[j] = *(const f32x2*)(xe + (size_t)(c0 + j) * 128);
#pragma unroll
            for (int j = 0; j < 8; ++j) { ug[(size_t)(c0 + j) * 320] = pk2(cr, ci); const float nr = a_r * cr - a_i * ci + x[j].x, ni = a_r * ci + a_i * cr + x[j].y; cr = nr; ci = ni; } } }
}
__device__ __forceinline__ void moba_select_phase(Frame& F) {
    LAS float* km = (LAS float*)F.lds;
    const bf16* Q0 = (const bf16*)(F.ws + WS_Q0); const float* kmg = (const float*)(F.ws + WS_KMEAN); unsigned* SELM = (unsigned*)(F.ws + WS_SELM); const int tid = F.wave * 64 + mk_lane();
    for (int un = blockIdx.x; un < 512; un += F.G) { const int b = un >> 7, qb = (un >> 2) & 31, hp = un & 3;
        for (int i = tid; i < 4096; i += 512) km[i] = kmg[(size_t)(b * 8 + hp * 2 + (i >> 11)) * 2048 + (i & 2047)];
        __syncthreads();
        const int hl = tid >> 8, tl = tid & 255, h = hp * 2 + hl, t = qb * 256 + tl;
        float q[64]; const bf16* qp = Q0 + ((size_t)b * SEQL + t) * 512 + h * 64;
#pragma unroll
        for (int j = 0; j < 8; ++j) { float tmp[8]; load8_bf16(qp + 8 * j, tmp);
#pragma unroll
            for (int e = 0; e < 8; ++e) q[8 * j + e] = tmp[e]; }
        float v1 = -INFINITY, v2 = -INFINITY, v3 = -INFINITY; int i1 = -1, i2 = -1, i3 = -1;
        for (int n = 0; n < qb; ++n) { const LAS float* kp = km + (hl * 32 + n) * 64; float s = 0.f;
#pragma unroll
            for (int d = 0; d < 64; d += 4) { const f32x4 kv = *(const LAS f32x4*)(kp + d); s += q[d] * kv.x + q[d + 1] * kv.y + q[d + 2] * kv.z + q[d + 3] * kv.w; }
            if (s > v1) { v3 = v2; i3 = i2; v2 = v1; i2 = i1; v1 = s; i1 = n; } else if (s > v2) { v3 = v2; i3 = i2; v2 = s; i2 = n; } else if (s > v3) { v3 = s; i3 = n; } }
        unsigned m = 1u << qb; if (i1 >= 0) m |= 1u << i1; if (i2 >= 0) m |= 1u << i2; if (i3 >= 0) m |= 1u << i3;
        SELM[(size_t)(b * 8 + h) * SEQL + t] = m;
        __syncthreads(); }
}

constexpr int P1_LD = ODD_PAD;
constexpr int PC_R = 0, PC_K = 512, PC_V = 1024, PC_WD = 1536, PC_AD = 1600, PC_GD = 1664, PC_Q = 1792, PC_KD = 2304, PC_VD = 2368, PC_QI = 2432, PC_KI = 2688, PC_WI = 2752;
struct F_P1 { bf16* P1;
    __device__ __forceinline__ void operator()(const pg8::Unit& u, int r, int c, float (&v)[8], int) const { store8_bf16(P1 + (size_t)(u.pm * 256 + r) * P1_LD + u.pn * 256 + c, v); } };
struct F_LORA { bf16* LORA; const float* w0; const float* a0;
    __device__ __forceinline__ void operator()(const pg8::Unit& u, int r, int c, float (&v)[8], int) const {
        const int row = u.pm * 256 + r, col = u.pn * 256 + c, seg = u.pn >> 1;
        if (seg == 0) {
#pragma unroll
            for (int j = 0; j < 8; ++j) v[j] = -0.6065306597126334f * sigmoidf_(w0[col + j] + v[j]); }
        else if (seg == 1) {
#pragma unroll
            for (int j = 0; j < 8; ++j) v[j] = sigmoidf_(a0[col - 512 + j] + v[j]); }
        store8_bf16(LORA + (size_t)row * 1536 + col, v); }
};
struct F_MOEGU { bf16* ACTQ; int rt0;
    __device__ __forceinline__ void operator()(const pg8::Unit& u, int r, int c, float (&g)[8], float (&p)[8]) const {
        float o[8];
#pragma unroll
        for (int j = 0; j < 8; ++j) o[j] = g[j] * sigmoidf_(g[j]) * p[j];
        store8_bf16(ACTQ + (size_t)((u.pm - rt0) * 256 + r) * FEXP + u.aux * 128 + c, o); }
};
struct F_MOED { bf16* YS;
    __device__ __forceinline__ void operator()(const pg8::Unit& u, int r, int c, float (&v)[8], int) const { store8_bf16(YS + (size_t)(u.aux * 256 + r) * 1024 + (u.pn & 3) * 256 + c, v); } };
struct SchedMoeGU { const int* tile_exp; int rt0, ntq, G, c;
    __device__ __forceinline__ bool next(int i, pg8::Unit& u) const { const int L = i * G + c; if (L >= ntq * 28) return false; const int rt = rt0 + L % ntq, pn = L / ntq; const int e = tile_exp[rt]; u.pm = rt; u.pn = e * 28 + pn; u.aux = pn; return true; }
    __device__ __forceinline__ void a_ready(const pg8::Unit&) const {}
    __device__ __forceinline__ void done(const pg8::Unit&) const {} };
struct SchedMoeD { const int* tile_exp; int rt0, ntq, G, c;
    __device__ __forceinline__ bool next(int i, pg8::Unit& u) const { const int L = i * G + c; if (L >= ntq * 4) return false; const int rt = rt0 + L % ntq, pn = L / ntq; const int e = tile_exp[rt]; u.pm = rt - rt0; u.pn = e * 4 + pn; u.aux = rt; return true; }
    __device__ __forceinline__ void a_ready(const pg8::Unit&) const {}
    __device__ __forceinline__ void done(const pg8::Unit&) const {} };

__device__ __forceinline__ void rope8_x1(float (&v)[8], int d0, const float* cs) {
    float o[8];
#pragma unroll
    for (int j = 0; j < 8; ++j) o[j] = __shfl_xor(v[j], 1);
    if (d0 < 16) { const f32x4 c0 = *(const f32x4*)cs, c1 = *(const f32x4*)(cs + 4), s0 = *(const f32x4*)(cs + 8), s1 = *(const f32x4*)(cs + 12);
        const float cv[8] = {c0.x, c0.y, c0.z, c0.w, c1.x, c1.y, c1.z, c1.w}, sv[8] = {s0.x, s0.y, s0.z, s0.w, s1.x, s1.y, s1.z, s1.w};
        const float sgn = (d0 == 0) ? -1.0f : 1.0f;
#pragma unroll
        for (int j = 0; j < 8; ++j) v[j] = v[j] * cv[j] + sgn * o[j] * sv[j]; }
}
__device__ __forceinline__ void l1_prep_phase(Frame& F) {
    const int gw = blockIdx.x * NWAVES + F.wave, NGW = F.G * NWAVES, lane = mk_lane();
    const bf16* P1 = (const bf16*)(F.ws + WS_P1); const float* mu = F.in[I_RWKV_MU]; const float* rope = (const float*)(F.ws + WS_ROPE);
    bf16* ALORA = (bf16*)(F.ws + WS_ALORA); bf16* QD = (bf16*)(F.ws + WS_QD); bf16* KD = (bf16*)(F.ws + WS_KD); bf16* KI = (bf16*)(F.ws + WS_KI); bf16* QI = (bf16*)(F.ws + WS_QI); float* WI = (float*)(F.ws + WS_WI);
    for (int tok = gw; tok < T_TOK; tok += NGW) { const bf16* row = P1 + (size_t)tok * P1_LD; const int pos = tok & (SEQL - 1); const float* cs = rope + (size_t)pos * 16;
        if (lane < 32) { const int col = PC_WD + 8 * lane; float cur[8], prv[8]; load8_bf16(row + col, cur);
            if (pos != 0) load8_bf16(row - P1_LD + col, prv); else {
#pragma unroll
                for (int j = 0; j < 8; ++j) prv[j] = 0.f; }
#pragma unroll
            for (int j = 0; j < 8; ++j) { const float x = cur[j] + (prv[j] - cur[j]) * mu[col + j];
                cur[j] = (lane < 8) ? tanhf(x) : ((lane < 16) ? x : sigmoidf_(x)); }
            store8_bf16(ALORA + (size_t)tok * 256 + 8 * lane, cur); }
        { float v[8]; load8_bf16(row + PC_Q + 8 * lane, v); rope8_x1(v, 8 * (lane & 7), cs);
#pragma unroll
          for (int j = 0; j < 8; ++j) v[j] *= ATT_C2;
          store8_bf16(QD + (size_t)tok * 512 + 8 * lane, v); }
        { const int src = (lane < 32) ? (PC_QI + 8 * lane) : ((lane < 40) ? (PC_KD + 8 * (lane - 32)) : (PC_KI + 8 * (lane & 7)));
          float v[8]; load8_bf16(row + src, v); rope8_x1(v, 8 * (lane & 7), cs);
          if (lane < 32) store8_bf16(QI + (size_t)tok * 256 + 8 * lane, v);
          else if (lane < 40) store8_bf16(KD + (size_t)tok * 64 + 8 * (lane - 32), v);
          else if (lane < 48) store8_bf16(KI + (size_t)tok * 64 + 8 * (lane - 40), v); }
        if (lane < 4) WI[(size_t)tok * 4 + lane] = bf2f(row[PC_WI + lane]) * 0.0625f;
    }
}
__device__ __forceinline__ void rwkv_post_phase(Frame& F) {
    const int gw = blockIdx.x * NWAVES + F.wave, NGW = F.G * NWAVES, lane = mk_lane();
    const bf16* P1 = (const bf16*)(F.ws + WS_P1); const bf16* LORA = (const bf16*)(F.ws + WS_LORA); const bf16* YR = (const bf16*)(F.ws + WS_YR); bf16* CAT2 = (bf16*)(F.ws + WS_CAT);
    const float* mu = F.in[I_RWKV_MU]; const float* k_a = F.in[I_RWKV_K_A]; const float* r_k = F.in[I_RWKV_R_K]; const float* ln_w = F.in[I_RWKV_LN_W]; const float* ln_b = F.in[I_RWKV_LN_B];
    for (int it = gw; it < T_TOK * 8; it += NGW) { const int tok = it >> 3, h = it & 7, ch = h * 64 + lane; const bool first = (tok & (SEQL - 1)) == 0;
        const bf16* row = P1 + (size_t)tok * P1_LD; const bf16* prow = row - P1_LD;
        const float rc = bf2f(row[PC_R + ch]), kc = bf2f(row[PC_K + ch]), vc = bf2f(row[PC_V + ch]);
        const float rp = first ? 0.f : bf2f(prow[PC_R + ch]), kp = first ? 0.f : bf2f(prow[PC_K + ch]), vp = first ? 0.f : bf2f(prow[PC_V + ch]);
        const float r = rc + (rp - rc) * mu[PC_R + ch], k0 = kc + (kp - kc) * mu[PC_K + ch], v = vc + (vp - vc) * mu[PC_V + ch];
        const float a = bf2f(LORA[(size_t)tok * 1536 + 512 + ch]), g = bf2f(LORA[(size_t)tok * 1536 + 1024 + ch]);
        const float k = k0 * (1.0f + (a - 1.0f) * k_a[ch]);
        const float y = bf2f(YR[(size_t)tok * 512 + ch]);
        const float mean = wave_sum(y) * (1.0f / 64.0f); const float dy = y - mean; const float var = wave_sum(dy * dy) * (1.0f / 64.0f);
        const float yn = dy * (1.0f / sqrtf(var + 64e-5f)) * ln_w[ch] + ln_b[ch];
        const float bonus = wave_sum(r * k * r_k[ch]) * v;
        CAT2[(size_t)tok * 1024 + ch] = ABL_RWKV ? (bf16)0 : (bf16)f2bf((yn + bonus) * g); }
}
__device__ __forceinline__ void moe_convert_phase(Frame& F) {
    LAS float* scr = (LAS float*)(F.lds + F.wave * 16384); const int lane = mk_lane();
    const int gw = blockIdx.x * NWAVES + F.wave, NGW = F.G * NWAVES;
    constexpr int PER = 1792, NIT = 3 * 8 * PER;
    bf16* WGU = (bf16*)(F.ws + WS_WMOE_GU); bf16* WD = (bf16*)(F.ws + WS_WMOE_D);
    for (int it = gw; it < NIT; it += NGW) { const int m = it / (8 * PER), r = it % (8 * PER), e = r / PER, q = r % PER;
        if (m == 0) tr_item<1>(F.in[I_MOE_GATE] + (size_t)e * 1024 * FEXP, 1024, FEXP, WGU, 1024, e * 7168, F.in[I_O_NORM_FFN], scr, q / 112, q % 112, lane);
        else if (m == 1) tr_item<1>(F.in[I_MOE_UP] + (size_t)e * 1024 * FEXP, 1024, FEXP, WGU, 1024, e * 7168 + 128, F.in[I_O_NORM_FFN], scr, q / 112, q % 112, lane);
        else tr_item<0>(F.in[I_MOE_DOWN] + (size_t)e * FEXP * 1024, FEXP, 1024, WD, FEXP, e * 1024, nullptr, scr, q / 32, q % 32, lane); }
}
__device__ __forceinline__ void router_phase(Frame& F) {
    const int gw = blockIdx.x * NWAVES + F.wave, NGW = F.G * NWAVES, lane = mk_lane();
    const float* gn = F.in[I_O_NORM_FFN]; const float* rt = F.in[I_MOE_ROUTER]; unsigned* cnt = (unsigned*)(F.ws + WS_CTL) + CW_EXPCNT; v2u* info = (v2u*)(F.ws + WS_TOKINFO);
    for (int tok = gw; tok < T_TOK; tok += NGW) { const f32x4* xr = (const f32x4*)(F.out + (size_t)tok * DMODEL) + lane; f32x4 v[4]; float s = 0.f;
#pragma unroll
        for (int j = 0; j < 4; ++j) { v[j] = xr[64 * j]; s += (v[j].x * v[j].x + v[j].y * v[j].y) + (v[j].z * v[j].z + v[j].w * v[j].w); }
        const float rstd = 1.0f / sqrtf(wave_sum(s) * (1.f / DMODEL) + NORM_EPS);
        float lg[8] = {0.f, 0.f, 0.f, 0.f, 0.f, 0.f, 0.f, 0.f};
#pragma unroll
        for (int j = 0; j < 4; ++j) { const int k0 = 4 * (lane + 64 * j); const f32x4 gg = *(const f32x4*)(gn + k0); const float xv[4] = {v[j].x * rstd * gg.x, v[j].y * rstd * gg.y, v[j].z * rstd * gg.z, v[j].w * rstd * gg.w};
#pragma unroll
            for (int q = 0; q < 4; ++q) { const f32x4 w0 = *(const f32x4*)(rt + (size_t)(k0 + q) * 8), w1 = *(const f32x4*)(rt + (size_t)(k0 + q) * 8 + 4);
                lg[0] += xv[q] * w0.x; lg[1] += xv[q] * w0.y; lg[2] += xv[q] * w0.z; lg[3] += xv[q] * w0.w; lg[4] += xv[q] * w1.x; lg[5] += xv[q] * w1.y; lg[6] += xv[q] * w1.z; lg[7] += xv[q] * w1.w; } }
#pragma unroll
        for (int e = 0; e < 8; ++e) lg[e] = wave_sum(lg[e]);
        int e1 = 0; float l1 = lg[0];
#pragma unroll
        for (int e = 1; e < 8; ++e) if (lg[e] > l1) { l1 = lg[e]; e1 = e; }
        int e2 = -1; float l2 = -INFINITY;
#pragma unroll
        for (int e = 0; e < 8; ++e) if (e != e1 && lg[e] > l2) { l2 = lg[e]; e2 = e; }
        const float g1 = 1.0f / (1.0f + __expf(l2 - l1)), g2 = 1.0f - g1;
        if (lane == 0) { const unsigned r1 = atomicAdd(cnt + 64 * e1, 1u), r2 = atomicAdd(cnt + 64 * e2, 1u);
            info[(size_t)tok * 2] = (v2u){((unsigned)e1 << 24) | r1, __builtin_bit_cast(unsigned, g1)}; info[(size_t)tok * 2 + 1] = (v2u){((unsigned)e2 << 24) | r2, __builtin_bit_cast(unsigned, g2)}; } }
}
__device__ __forceinline__ void moe_scatter_phase(Frame& F) {
    const int gw = blockIdx.x * NWAVES + F.wave, NGW = F.G * NWAVES, lane = mk_lane();
    const unsigned* cnt = (const unsigned*)(F.ws + WS_CTL) + CW_EXPCNT; const v2u* info = (const v2u*)(F.ws + WS_TOKINFO); int* tokslot = (int*)(F.ws + WS_TOKSLOT); int* tile_exp = (int*)(F.ws + WS_TILEEXP);
    int pstart[8]; int acc = 0;
#pragma unroll
    for (int e = 0; e < 8; ++e) { const int c = (int)__hip_atomic_load(cnt + 64 * e, __ATOMIC_RELAXED, __HIP_MEMORY_SCOPE_AGENT); pstart[e] = acc; acc += (c + 255) & ~255; }
    const int ntiles = acc >> 8;
    if (blockIdx.x == 0 && F.wave == 0) { for (int t = lane; t < 512; t += 64) { int e = 7;
#pragma unroll
            for (int q = 7; q >= 1; --q) if (t * 256 < pstart[q]) e = q - 1;
            tile_exp[t] = (t == 511) ? ntiles : e; } }
    bf16* XG = (bf16*)(F.ws + WS_XG);
    for (int tok = gw; tok < T_TOK; tok += NGW) { const f32x4* xr = (const f32x4*)(F.out + (size_t)tok * DMODEL) + lane; f32x4 v[4]; float s = 0.f;
#pragma unroll
        for (int j = 0; j < 4; ++j) { v[j] = xr[64 * j]; s += (v[j].x * v[j].x + v[j].y * v[j].y) + (v[j].z * v[j].z + v[j].w * v[j].w); }
        const float rstd = 1.0f / sqrtf(wave_sum(s) * (1.f / DMODEL) + NORM_EPS);
        unsigned long long w[4];
#pragma unroll
        for (int j = 0; j < 4; ++j) w[j] = (unsigned long long)pk2(v[j].x * rstd, v[j].y * rstd) | ((unsigned long long)pk2(v[j].z * rstd, v[j].w * rstd) << 32);
#pragma unroll
        for (int k = 0; k < 2; ++k) { const v2u inf = info[(size_t)tok * 2 + k]; const int e = (int)(inf.x >> 24), rank = (int)(inf.x & 0xffffffu);
            int ps = 0;
#pragma unroll
            for (int q = 0; q < 8; ++q) ps = (e == q) ? pstart[q] : ps;
            const int slot = ps + rank; unsigned long long* o8 = (unsigned long long*)(XG + (size_t)slot * 1024) + lane;
#pragma unroll
            for (int j = 0; j < 4; ++j) o8[64 * j] = w[j];
            if (lane == 0) tokslot[(size_t)tok * 2 + k] = slot; } }
}
__device__ __forceinline__ void moe_combine_final_phase(Frame& F) {
    const int gw = blockIdx.x * NWAVES + F.wave, NGW = F.G * NWAVES, lane = mk_lane(); const float* gn = F.in[I_FINAL_NORM];
    const v2u* info = (const v2u*)(F.ws + WS_TOKINFO); const int* tokslot = (const int*)(F.ws + WS_TOKSLOT); const bf16* YS = (const bf16*)(F.ws + WS_XG);
    f32x4 gv[4];
#pragma unroll
    for (int j = 0; j < 4; ++j) gv[j] = ((const f32x4*)gn)[lane + 64 * j];
    for (int tok = gw; tok < T_TOK; tok += NGW) { f32x4* xr = (f32x4*)(F.out + (size_t)tok * DMODEL) + lane; f32x4 v[4];
#pragma unroll
        for (int j = 0; j < 4; ++j) v[j] = xr[64 * j];
#pragma unroll
        for (int k = 0; k < 2; ++k) { const unsigned gkb = info[(size_t)tok * 2 + k].y; const float gk = MOE_SCALE * __builtin_bit_cast(float, gkb);     const int slot = tokslot[(size_t)tok * 2 + k];
            const v2u* yr = (const v2u*)(YS + (size_t)slot * 1024) + lane;
#pragma unroll
            for (int j = 0; j < 4; ++j) { v2u w = yr[64 * j]; if (ABL_MOE) w = (v2u){0u, 0u}; v[j].x += gk * bflo(w.x); v[j].y += gk * bfhi(w.x); v[j].z += gk * bflo(w.y); v[j].w += gk * bfhi(w.y); } }
        float s = 0.f;
#pragma unroll
        for (int j = 0; j < 4; ++j) s += (v[j].x * v[j].x + v[j].y * v[j].y) + (v[j].z * v[j].z + v[j].w * v[j].w);
        const float rstd = 1.0f / sqrtf(wave_sum(s) * (1.f / DMODEL) + NORM_EPS);
#pragma unroll
        for (int j = 0; j < 4; ++j) xr[64 * j] = v[j] * rstd * gv[j]; }
}

__device__ __forceinline__ float dpp_sum8(float x) {
    x += __builtin_bit_cast(float, __builtin_amdgcn_mov_dpp(__builtin_bit_cast(int, x), 0xB1, 0xf, 0xf, true));
    x += __builtin_bit_cast(float, __builtin_amdgcn_mov_dpp(__builtin_bit_cast(int, x), 0x4E, 0xf, 0xf, true));
    x += __builtin_bit_cast(float, __builtin_amdgcn_mov_dpp(__builtin_bit_cast(int, x), 0x141, 0xf, 0xf, true));
    return x;
}
constexpr int RW_STEPS = 32, RW_REC = 5 * 64, RW_BUF_FLOATS = RW_STEPS * RW_REC + RW_STEPS * 32;
__device__ __forceinline__ void rwkv_produce(Frame& F, LAS float* buf, int b, int h, int half, int j, int pw, int lane) {
    const bf16* P1 = (const bf16*)(F.ws + WS_P1); const bf16* LORA = (const bf16*)(F.ws + WS_LORA);
    const float* mu = F.in[I_RWKV_MU]; const int ch = h * 64 + lane;
    const float mu_r = mu[PC_R + ch], mu_k = mu[PC_K + ch], mu_v = mu[PC_V + ch], kkw = F.in[I_RWKV_K_K][ch], kaw = F.in[I_RWKV_K_A][ch];
    float rc[8], kc[8], vc[8], rp[8], kp[8], vp[8], lw[8], al[8];
#pragma unroll
    for (int i = 0; i < 8; ++i) { const int tt = 8 * pw + i, pos = 32 * j + tt; const size_t tok = (size_t)b * SEQL + pos; const bf16* row = P1 + tok * P1_LD; const bf16* prow = (pos == 0) ? row : (row - P1_LD);
        rc[i] = bf2f(row[PC_R + ch]); kc[i] = bf2f(row[PC_K + ch]); vc[i] = bf2f(row[PC_V + ch]);
        rp[i] = bf2f(prow[PC_R + ch]); kp[i] = bf2f(prow[PC_K + ch]); vp[i] = bf2f(prow[PC_V + ch]);
        lw[i] = bf2f(LORA[tok * 1536 + ch]); al[i] = bf2f(LORA[tok * 1536 + 512 + ch]); }
#pragma unroll
    for (int i = 0; i < 8; ++i) { const int tt = 8 * pw + i, pos = 32 * j + tt; const bool first = (pos == 0);
        const float r = rc[i] + ((first ? 0.f : rp[i]) - rc[i]) * mu_r, k0 = kc[i] + ((first ? 0.f : kp[i]) - kc[i]) * mu_k, v = vc[i] + ((first ? 0.f : vp[i]) - vc[i]) * mu_v;
        const float kkv = k0 * kkw; const float nrm = sqrtf(wave_sum(kkv * kkv)); const float kk = kkv / fmaxf(nrm, 1e-12f);
        const float a = al[i]; LAS float* rec = buf + tt * RW_REC;
        rec[lane] = __expf(lw[i]); rec[64 + lane] = -kk; rec[128 + lane] = kk * a; rec[192 + lane] = k0 * (1.0f + (a - 1.0f) * kaw); rec[256 + lane] = r;
        if ((lane >> 5) == half) buf[RW_STEPS * RW_REC + tt * 32 + (lane & 31)] = v; }
}
__device__ __forceinline__ void rwkv_seq_block(Frame& F, int blk) {
    const int bh = blk >> 1, half = blk & 1, b = bh >> 3, h = bh & 7; const int lane = mk_lane(), wave = F.wave;
    LAS float* buf0 = (LAS float*)F.lds; LAS float* buf1 = buf0 + RW_BUF_FLOATS;
    bf16* YR = (bf16*)(F.ws + WS_YR);
    const int rowl = 8 * (wave & 3) + (lane >> 3), kg = lane & 7;
    f32x2 s[4] = {{0.f, 0.f}, {0.f, 0.f}, {0.f, 0.f}, {0.f, 0.f}};
    if (wave >= 4) rwkv_produce(F, buf0, b, h, half, 0, wave - 4, lane);
    __syncthreads();
    for (int j = 0; j < SEQL / RW_STEPS; ++j) { LAS float* cur = (j & 1) ? buf1 : buf0; LAS float* nxt = (j & 1) ? buf0 : buf1;
        if (wave >= 4) { if (j + 1 < SEQL / RW_STEPS) rwkv_produce(F, nxt, b, h, half, j + 1, wave - 4, lane); }
        else { bf16* yo = YR + ((size_t)b * SEQL + 32 * j) * 512 + h * 64 + 32 * half + rowl;
#pragma unroll 4
            for (int t = 0; t < RW_STEPS; ++t) { const LAS float* rec = cur + t * RW_REC + 8 * kg;
                const f32x4 w0 = *(const LAS f32x4*)(rec), w1 = *(const LAS f32x4*)(rec + 4), a0 = *(const LAS f32x4*)(rec + 64), a1 = *(const LAS f32x4*)(rec + 68);
                const f32x4 b0 = *(const LAS f32x4*)(rec + 128), b1 = *(const LAS f32x4*)(rec + 132), k0 = *(const LAS f32x4*)(rec + 192), k1 = *(const LAS f32x4*)(rec + 196);
                const f32x4 r0 = *(const LAS f32x4*)(rec + 256), r1 = *(const LAS f32x4*)(rec + 260);
                const float vv = cur[RW_STEPS * RW_REC + t * 32 + rowl];
                f32x2 sa2 = s[0] * (f32x2){a0.x, a0.y} + s[1] * (f32x2){a0.z, a0.w} + s[2] * (f32x2){a1.x, a1.y} + s[3] * (f32x2){a1.z, a1.w};
                const float sa = dpp_sum8(sa2.x + sa2.y); const f32x2 sav = {sa, sa}, vvv = {vv, vv};
                s[0] = s[0] * (f32x2){w0.x, w0.y} + sav * (f32x2){b0.x, b0.y} + vvv * (f32x2){k0.x, k0.y};
                s[1] = s[1] * (f32x2){w0.z, w0.w} + sav * (f32x2){b0.z, b0.w} + vvv * (f32x2){k0.z, k0.w};
                s[2] = s[2] * (f32x2){w1.x, w1.y} + sav * (f32x2){b1.x, b1.y} + vvv * (f32x2){k1.x, k1.y};
                s[3] = s[3] * (f32x2){w1.z, w1.w} + sav * (f32x2){b1.z, b1.w} + vvv * (f32x2){k1.z, k1.w};
                f32x2 y2 = s[0] * (f32x2){r0.x, r0.y} + s[1] * (f32x2){r0.z, r0.w} + s[2] * (f32x2){r1.x, r1.y} + s[3] * (f32x2){r1.z, r1.w};
                const float y = dpp_sum8(y2.x + y2.y);
                if (kg == 0) yo[(size_t)t * 512] = (bf16)f2bf(y); } }
        __syncthreads(); }
}

typedef float f32x4_t __attribute__((ext_vector_type(4)));
constexpr int DSA_SEL_OFF = 131072 + 1024, DSA_META_OFF = DSA_SEL_OFF + 16 * 256 * 2, DSA_CAND_CAP = 1024;
constexpr int CW_DSAQ = CW_EXPCNT + 8 * 64;
static_assert(DSA_META_OFF + 512 <= LDS_BYTES && (CW_DSAQ + 1) * 4 <= (int)CTL_ZERO_BYTES, "dsa lds / ctl map");
__device__ __forceinline__ unsigned f32_order_key(float x) { x = x + 0.0f; const unsigned u = __builtin_bit_cast(unsigned, x); return (u & 0x80000000u) ? ~u : (u | 0x80000000u); }
template <int MODE>
__device__ __forceinline__ void dsa_score_pass(const bf16* __restrict__ KIb, const bf16x8 (&qa)[4][2], const float (&wq)[4][4], int t0, int nkt, int wave, int lane,
                                               LAS unsigned* hist, LAS unsigned short* sel, LAS int* meta) {
    const int g = lane >> 4, c = lane & 15;
    int bst[4] = {0, 0, 0, 0};
    if (MODE == 1) {
#pragma unroll
        for (int m = 0; m < 4; ++m) bst[m] = meta[4 * m + g]; }
    for (int kt = wave; kt < nkt; kt += 8) { const bf16* kp = KIb + (size_t)(16 * kt + c) * 64 + 8 * g;
        const bf16x8 kb0 = *(const bf16x8*)kp, kb1 = *(const bf16x8*)(kp + 32); const int key = 16 * kt + c;
#pragma unroll
        for (int m = 0; m < 4; ++m) { f32x4_t acc = {0.f, 0.f, 0.f, 0.f};
            acc = __builtin_amdgcn_mfma_f32_16x16x32_bf16(qa[m][0], kb0, acc, 0, 0, 0); acc = __builtin_amdgcn_mfma_f32_16x16x32_bf16(qa[m][1], kb1, acc, 0, 0, 0);
            float sc = fmaxf(acc[0], 0.f) * wq[m][0]; sc += fmaxf(acc[1], 0.f) * wq[m][1]; sc += fmaxf(acc[2], 0.f) * wq[m][2]; sc += fmaxf(acc[3], 0.f) * wq[m][3];
            const int q = 4 * m + g;
            if (key <= t0 + q) { const unsigned uk = f32_order_key(sc); const int bin = (int)(uk >> 20);
                if (MODE == 0) { __hip_atomic_fetch_add(hist + q * 2048 + (bin >> 1), 1u << (16 * (bin & 1)), __ATOMIC_RELAXED, __HIP_MEMORY_SCOPE_WORKGROUP); }
                else { if (bin > bst[m]) { const int p = __hip_atomic_fetch_add((LAS unsigned*)(meta + 32 + q), 1u, __ATOMIC_RELAXED, __HIP_MEMORY_SCOPE_WORKGROUP); if (p < 256) sel[q * 256 + p] = (unsigned short)key; }
                       else if (bin == bst[m]) { const int p = __hip_atomic_fetch_add((LAS unsigned*)(meta + 48 + q), 1u, __ATOMIC_RELAXED, __HIP_MEMORY_SCOPE_WORKGROUP);
                           if (p < DSA_CAND_CAP) { hist[(q * DSA_CAND_CAP + p) * 2] = uk; hist[(q * DSA_CAND_CAP + p) * 2 + 1] = (unsigned)key; } } } } } }
}
__device__ __forceinline__ void dsa_tile(Frame& F, int item) {
    const int lane = mk_lane(), wave = F.wave, tid = wave * 64 + lane;
    const int b = item & 3, ti = 511 - (item >> 2), t0 = 16 * ti, nkt = ti + 1; const size_t tok0 = (size_t)b * SEQL + t0;
    LAS unsigned* hist = (LAS unsigned*)F.lds; LAS unsigned short* sel = (LAS unsigned short*)(F.lds + DSA_SEL_OFF); LAS int* meta = (LAS int*)(F.lds + DSA_META_OFF);
    const bf16* QI = (const bf16*)(F.ws + WS_QI); const bf16* KIb = (const bf16*)(F.ws + WS_KI) + (size_t)b * SEQL * 64; const float* WI = (const float*)(F.ws + WS_WI);
    const int g = lane >> 4, c = lane & 15;
    if (ti >= 16) {
        for (int i = tid; i < 32768 / 4; i += 512) ((LAS v4u*)hist)[i] = (v4u){0u, 0u, 0u, 0u};
        if (tid < 64) meta[tid] = 0;
        bf16x8 qa[4][2]; float wq[4][4];
#pragma unroll
        for (int m = 0; m < 4; ++m) { const bf16* qp = QI + (tok0 + 4 * m + (c >> 2)) * 256 + (c & 3) * 64 + 8 * g; qa[m][0] = *(const bf16x8*)qp; qa[m][1] = *(const bf16x8*)(qp + 32);
            const f32x4 w4 = *(const f32x4*)(WI + (tok0 + 4 * m + g) * 4); wq[m][0] = w4.x; wq[m][1] = w4.y; wq[m][2] = w4.z; wq[m][3] = w4.w; }
        __syncthreads();
        dsa_score_pass<0>(KIb, qa, wq, t0, nkt, wave, lane, hist, sel, meta);
        __syncthreads();
#pragma unroll 1
        for (int qq = 0; qq < 2; ++qq) { const int q = 2 * wave + qq; const LAS v4u* hw = (const LAS v4u*)(hist + q * 2048 + 32 * lane); unsigned s = 0;
#pragma unroll
            for (int i = 0; i < 8; ++i) { const v4u w = hw[i]; s += (w.x & 0xffffu) + (w.x >> 16) + (w.y & 0xffffu) + (w.y >> 16) + (w.z & 0xffffu) + (w.z >> 16) + (w.w & 0xffffu) + (w.w >> 16); }
            unsigned tsum = s;
#pragma unroll
            for (int off = 1; off < 64; off <<= 1) { const unsigned o = __shfl_down(tsum, off); tsum += (lane + off < 64) ? o : 0u; }
            const unsigned above = tsum - s;
            if (above < 256u && tsum >= 256u) { unsigned cacc = above; int bs = 64 * lane; unsigned na = above;
                for (int bin = 64 * lane + 63; bin >= 64 * lane; --bin) { const unsigned w = hist[q * 2048 + (bin >> 1)]; const unsigned cn = (bin & 1) ? (w >> 16) : (w & 0xffffu);
                    if (cacc + cn >= 256u) { bs = bin; na = cacc; break; } cacc += cn; }
                meta[q] = bs; meta[16 + q] = (int)na; } }
        __syncthreads();
        dsa_score_pass<1>(KIb, qa, wq, t0, nkt, wave, lane, hist, sel, meta);
        __syncthreads();
#pragma unroll 1
        for (int qq = 0; qq < 2; ++qq) { const int q = 2 * wave + qq; int n = meta[48 + q]; n = n < DSA_CAND_CAP ? n : DSA_CAND_CAP; const int R = 256 - meta[16 + q];
            const LAS v2u* cd = (const LAS v2u*)(hist + (size_t)q * DSA_CAND_CAP * 2);
            for (int ci = lane; ci < n; ci += 64) { const v2u me = cd[ci]; int rank = 0;
                for (int cj = 0; cj < n; ++cj) { const v2u o = cd[cj]; rank += (o.x > me.x || (o.x == me.x && o.y < me.y)) ? 1 : 0; }
                if (rank < R) { const int p = __hip_atomic_fetch_add((LAS unsigned*)(meta + 32 + q), 1u, __ATOMIC_RELAXED, __HIP_MEMORY_SCOPE_WORKGROUP); if (p < 256) sel[q * 256 + p] = (unsigned short)me.y; } } }
    } else {
        for (int i = tid; i < 16 * 256; i += 512) sel[i] = (unsigned short)(i & 255);
    }
    __syncthreads();
    const bf16* QD = (const bf16*)(F.ws + WS_QD); const bf16* KD = (const bf16*)(F.ws + WS_KD) + (size_t)b * SEQL * 64; const bf16* VDb = (const bf16*)(F.ws + WS_P1) + (size_t)b * SEQL * P1_LD + PC_VD;
    bf16* CAT2 = (bf16*)(F.ws + WS_CAT);
    bf16x8 esel[2];
#pragma unroll
    for (int d = 0; d < 2; ++d)
#pragma unroll
        for (int j = 0; j < 8; ++j) esel[d][j] = (8 * g + j == 16 * d + c) ? (short)0x3F80 : (short)0;
#pragma unroll 1
    for (int qq = 0; qq < 2; ++qq) { const int q = 2 * wave + qq; const int pos = t0 + q; const size_t tok = tok0 + q; const int nsel = (pos + 1 < 256) ? (pos + 1) : 256;
        bf16x8 qb[2];
        { const bf16* qp = QD + tok * 512 + (c & 7) * 64 + 8 * g; qb[0] = *(const bf16x8*)qp; qb[1] = *(const bf16x8*)(qp + 32);
          if (c >= 8) { qb[0] = (bf16x8){0, 0, 0, 0, 0, 0, 0, 0}; qb[1] = qb[0]; } }
        f32x4_t st[16];
#pragma unroll
        for (int i = 0; i < 16; ++i) { const int idx = 16 * i + c; const int key = (idx < nsel) ? (int)sel[q * 256 + idx] : 0; const bf16* kp = KD + (size_t)key * 64 + 8 * g;
            const bf16x8 ka0 = *(const bf16x8*)kp, ka1 = *(const bf16x8*)(kp + 32); f32x4_t a = {0.f, 0.f, 0.f, 0.f};
            a = __builtin_amdgcn_mfma_f32_16x16x32_bf16(ka0, qb[0], a, 0, 0, 0); a = __builtin_amdgcn_mfma_f32_16x16x32_bf16(ka1, qb[1], a, 0, 0, 0);
#pragma unroll
            for (int j = 0; j < 4; ++j) if (16 * i + 4 * g + j >= nsel) a[j] = -INFINITY;
            st[i] = a; }
        float mx = -INFINITY;
#pragma unroll
        for (int i = 0; i < 16; ++i) mx = fmaxf(fmaxf(mx, fmaxf(st[i][0], st[i][1])), fmaxf(st[i][2], st[i][3]));
        mx = fmaxf(mx, __shfl_xor(mx, 16)); mx = fmaxf(mx, __shfl_xor(mx, 32));
        float ls = 0.f;
#pragma unroll
        for (int i = 0; i < 16; ++i) {
#pragma unroll
            for (int j = 0; j < 4; ++j) { const float p = __builtin_amdgcn_exp2f(st[i][j] - mx); st[i][j] = p; ls += p; } }
        ls += __shfl_xor(ls, 16); ls += __shfl_xor(ls, 32);
        f32x4_t o[4] = {{0.f, 0.f, 0.f, 0.f}, {0.f, 0.f, 0.f, 0.f}, {0.f, 0.f, 0.f, 0.f}, {0.f, 0.f, 0.f, 0.f}};
#pragma unroll
        for (int ks = 0; ks < 8; ++ks) { v4u pw; pw.x = pk2(st[2 * ks][0], st[2 * ks][1]); pw.y = pk2(st[2 * ks][2], st[2 * ks][3]); pw.z = pk2(st[2 * ks + 1][0], st[2 * ks + 1][1]); pw.w = pk2(st[2 * ks + 1][2], st[2 * ks + 1][3]);
            const bf16x8 pa = __builtin_bit_cast(bf16x8, pw);
            f32x4_t tr[2][4];
#pragma unroll
            for (int tt = 0; tt < 2; ++tt) { const int idx = 16 * (2 * ks + tt) + c; const int key = (idx < nsel) ? (int)sel[q * 256 + idx] : 0; const bf16* vp = VDb + (size_t)key * P1_LD + 8 * g;
                const bf16x8 va0 = *(const bf16x8*)vp, va1 = *(const bf16x8*)(vp + 32); const f32x4_t z = {0.f, 0.f, 0.f, 0.f};
                tr[tt][0] = __builtin_amdgcn_mfma_f32_16x16x32_bf16(va0, esel[0], z, 0, 0, 0); tr[tt][1] = __builtin_amdgcn_mfma_f32_16x16x32_bf16(va0, esel[1], z, 0, 0, 0);
                tr[tt][2] = __builtin_amdgcn_mfma_f32_16x16x32_bf16(va1, esel[0], z, 0, 0, 0); tr[tt][3] = __builtin_amdgcn_mfma_f32_16x16x32_bf16(va1, esel[1], z, 0, 0, 0); }
#pragma unroll
            for (int db = 0; db < 4; ++db) { v4u vw; vw.x = pk2(tr[0][db][0], tr[0][db][1]); vw.y = pk2(tr[0][db][2], tr[0][db][3]); vw.z = pk2(tr[1][db][0], tr[1][db][1]); vw.w = pk2(tr[1][db][2], tr[1][db][3]);
                o[db] = __builtin_amdgcn_mfma_f32_16x16x32_bf16(pa, __builtin_bit_cast(bf16x8, vw), o[db], 0, 0, 0); } }
        float li[4];
#pragma unroll
        for (int j = 0; j < 4; ++j) li[j] = 1.0f / __shfl(ls, (4 * g + j) & 15);
        if (g < 2) { bf16* op = CAT2 + tok * 1024 + 512 + c;
#pragma unroll
            for (int j = 0; j < 4; ++j)
#pragma unroll
                for (int db = 0; db < 4; ++db) op[(4 * g + j) * 64 + 16 * db] = ABL_DSA ? (bf16)0 : (bf16)f2bf(o[db][j] * li[j]); } }
    __syncthreads();
}
__device__ __forceinline__ void dsa_phase(Frame& F) {
    unsigned* qhead = (unsigned*)(F.ws + WS_CTL) + CW_DSAQ; LAS int* meta = (LAS int*)(F.lds + DSA_META_OFF);
    for (;;) { if (F.wave == 0 && mk_lane() == 0) meta[100] = (int)atomicAdd(qhead, 1u);
        __syncthreads(); const int item = meta[100]; __syncthreads();
        if (item >= 2048) break;
        dsa_tile(F, item); }
}

__device__ __forceinline__ void final_norm_phase(Frame& F) {
    const int gw = blockIdx.x * NWAVES + F.wave, NGW = F.G * NWAVES, lane = mk_lane(); const float* gn = F.in[I_FINAL_NORM];
    f32x4 gv[4];
#pragma unroll
    for (int j = 0; j < 4; ++j) gv[j] = ((const f32x4*)gn)[lane + 64 * j];
    for (int m = gw; m < T_TOK; m += NGW) { f32x4* xr = (f32x4*)(F.out + (size_t)m * DMODEL) + lane; f32x4 v[4]; float s = 0.f;
#pragma unroll
        for (int j = 0; j < 4; ++j) { v[j] = xr[64 * j]; s += (v[j].x * v[j].x + v[j].y * v[j].y) + (v[j].z * v[j].z + v[j].w * v[j].w); }
        const float rstd = 1.0f / sqrtf(wave_sum(s) * (1.f / DMODEL) + NORM_EPS);
#pragma unroll
        for (int j = 0; j < 4; ++j) xr[64 * j] = v[j] * rstd * gv[j]; }
}

constexpr int NPHASE = 30;
__global__ void __launch_bounds__(NWAVES * 64, 2) mega_fwd(Args args) {
    extern __shared__ __attribute__((aligned(16))) unsigned char lds[];
    Frame F;
    F.lds = (LAS unsigned char*)lds;
    F.wave = __builtin_amdgcn_readfirstlane((int)threadIdx.x >> 6); F.G = gridDim.x;
    F.in = args.in; F.out = args.out; F.ws = args.ws;
    unsigned char* ws = args.ws;
    for (int u = threadIdx.x; u < (LDS_BYTES - RING_BYTES) / 4; u += NWAVES * 64) ((LAS unsigned*)(F.lds + RING_BYTES))[u] = 0u;
    __syncthreads();
    XcdBarrier bar = xcd_barrier_post((unsigned*)(ws + WS_CTL) + CW_BAR + args.li * XCD_BAR_WORDS, (volatile LAS unsigned*)(F.lds + MISC_OFF));
    const int lo = args.ph_lo, hi = args.ph_hi;
#define IN(k) (lo <= (k) && (k) < hi)
#define SEAM(k) do { if (IN(k) && IN((k) + 1)) xcd_barrier(bar, F.wave == 0 && mk_lane() == 0); } while (0)
    bf16* XN = (bf16*)(ws + WS_XN); bf16* CAT = (bf16*)(ws + WS_CAT); bf16* UG = (bf16*)(ws + WS_UG);
    bf16* Q0 = (bf16*)(ws + WS_Q0); bf16* K0 = (bf16*)(ws + WS_K0); bf16* V0 = (bf16*)(ws + WS_V0); bf16* YA = (bf16*)(ws + WS_YA);

    if (IN(0)) { p0_prologue(F); } SEAM(0);
    if (IN(1)) { pg8::Gemm g{XN, (const bf16*)(ws + WS_WE_IN), 1024, 1024, 1024}; pg8::StaticOrder S; S.init(T_TOK, 2048, F.G, (int)blockIdx.x);
        pg8::Epi8<F_E1> E{{UG, Q0, K0, V0, (const float*)(ws + WS_ROPE)}};
        pg8::gemm_phase<pg8::Epi8<F_E1>, pg8::StaticOrder, true, true>(F.lds, g, S, E, F.wave); } SEAM(1);
    if (IN(2)) { pg8::Gemm g{UG, (const bf16*)(ws + WS_S5BEND), 640, 512, 512}; SchedXend S{F.G, (int)blockIdx.x};
        pg8::Epi8<F_XEND> E{{(float*)(ws + WS_XEND)}};
        pg8::gemm_phase<pg8::Epi8<F_XEND>, SchedXend, true, true>(F.lds, g, S, E, F.wave);
        kmean_phase(F); } SEAM(2);
    if (IN(3)) { s5_carry_phase(F); moba_select_phase(F); } SEAM(3);
    if (IN(4)) { { pg8::Gemm g{UG, (const bf16*)(ws + WS_S5MT), 640, 640, 640}; SchedS5Y S{F.G, (int)blockIdx.x};
          pg8::Epi8<F_S5Y> E{{UG, F.in[I_S5_D], YA}};
          pg8::gemm_phase<pg8::Epi8<F_S5Y>, SchedS5Y, true, true>(F.lds, g, S, E, F.wave); }
        if (F.G == 256) { const attn_body::AttnTensors AT{(const attn_body::bf16*)Q0, (const attn_body::bf16*)K0, (const attn_body::bf16*)V0, (attn_body::bf16*)(CAT + 512), (const unsigned*)(ws + WS_SELM)};
          const attn_body::StaticOrder S((int)F.G, (int)blockIdx.x);
          attn_body::attn_phase<attn_body::StaticOrder>((char*)lds, AT, S, F.wave); } } SEAM(4);
    if (IN(5)) { pg8::Gemm g{YA, (const bf16*)(ws + WS_WGLU), 512, 512, 512}; pg8::StaticOrder S; S.init(T_TOK, 512, F.G, (int)blockIdx.x);
        pg8::Epi8<F_GLU> E{{YA, F.in[I_S5_GLU_B], CAT}};
        pg8::gemm_phase<pg8::Epi8<F_GLU>, pg8::StaticOrder, true, true>(F.lds, g, S, E, F.wave); } SEAM(5);
    if (IN(6)) { pg8::Gemm g{CAT, (const bf16*)(ws + WS_WE_OUT), 1024, 1024, 1024}; pg8::StaticOrder S; S.init(T_TOK, 1024, F.G, (int)blockIdx.x);
        pg8::Epi8<F_RES> E{{F.in[I_X], F.out}};
        pg8::gemm_phase<pg8::Epi8<F_RES>, pg8::StaticOrder, true, true>(F.lds, g, S, E, F.wave); } SEAM(6);
    if (IN(7)) { norm_phase(F, F.out, XN); } SEAM(7);
    if (IN(8)) { pg8::Gemm g{XN, (const bf16*)(ws + WS_WFFN_GU), 1024, 1024, 1024}; pg8::StaticOrder S; S.init(T_TOK, 2 * FFN_D, F.G, (int)blockIdx.x);
        pg8::EpiGU<F_SWIGLU> E{{(bf16*)(ws + WS_ACT), FFN_D}};
        pg8::gemm_phase<pg8::EpiGU<F_SWIGLU>, pg8::StaticOrder, true, true>(F.lds, g, S, E, F.wave); } SEAM(8);
    if (IN(9)) { pg8::Gemm g{(const bf16*)(ws + WS_ACT), (const bf16*)(ws + WS_WFFN_D), FFN_D, FFN_D, FFN_D}; pg8::StaticOrder S; S.init(T_TOK, 1024, F.G, (int)blockIdx.x);
        pg8::Epi8<F_RES> E{{F.out, F.out}};
        pg8::gemm_phase<pg8::Epi8<F_RES>, pg8::StaticOrder, true, true>(F.lds, g, S, E, F.wave); } SEAM(9);
    if (IN(10)) { norm_phase(F, F.out, XN); } SEAM(10);
    if (IN(11)) { pg8::Gemm g{XN, (const bf16*)(ws + WS_WO_IN), 1024, 1024, 1024}; pg8::StaticOrder S; S.init(T_TOK, ODD_PAD, F.G, (int)blockIdx.x);
        pg8::Epi8<F_P1> E{{(bf16*)(ws + WS_P1)}};
        pg8::gemm_phase<pg8::Epi8<F_P1>, pg8::StaticOrder, true, true>(F.lds, g, S, E, F.wave); } SEAM(11);
    if (IN(12)) { l1_prep_phase(F); } SEAM(12);
    if (IN(13)) { pg8::Gemm g{(const bf16*)(ws + WS_ALORA), (const bf16*)(ws + WS_WLORA), 256, 256, 256}; pg8::StaticOrder S; S.init(T_TOK, 1536, F.G, (int)blockIdx.x);
        pg8::Epi8<F_LORA> E{{(bf16*)(ws + WS_LORA), F.in[I_RWKV_W0], F.in[I_RWKV_A0]}};
        pg8::gemm_phase<pg8::Epi8<F_LORA>, pg8::StaticOrder, true, true>(F.lds, g, S, E, F.wave); } SEAM(13);
    if (IN(14)) { if (F.G == 256) { if ((int)blockIdx.x < 64) rwkv_seq_block(F, (int)blockIdx.x); else dsa_phase(F); } } SEAM(14);
    if (IN(15)) { rwkv_post_phase(F); } SEAM(15);
    if (IN(16)) { { pg8::Gemm g{CAT, (const bf16*)(ws + WS_WO_OUT), 1024, 1024, 1024}; pg8::StaticOrder S; S.init(T_TOK, 1024, F.G, (int)blockIdx.x);
          pg8::Epi8<F_RES> E{{F.out, F.out}};
          pg8::gemm_phase<pg8::Epi8<F_RES>, pg8::StaticOrder, true, true>(F.lds, g, S, E, F.wave); }
        moe_convert_phase(F); } SEAM(16);
    if (IN(17)) { router_phase(F); } SEAM(17);
    if (IN(18)) { moe_scatter_phase(F); } SEAM(18);
#define MOE_CHUNK_PHASES(PH, Q) \
    if (IN(PH)) { const int* te = (const int*)(ws + WS_TILEEXP); const int ntl = te[511]; int ntq = ntl - 64 * (Q); ntq = ntq < 0 ? 0 : (ntq > 64 ? 64 : ntq); if ((Q) == 4) ntq = (ntl > 256) ? (ntl - 256) : 0; \
        pg8::Gemm g{(const bf16*)(ws + WS_XG), (const bf16*)(ws + WS_WMOE_GU), 1024, 1024, 1024}; SchedMoeGU S{te, 64 * (Q), ntq, F.G, (int)blockIdx.x}; \
        pg8::EpiGU<F_MOEGU> E{{(bf16*)(ws + WS_ACTQ), 64 * (Q)}}; \
        pg8::gemm_phase<pg8::EpiGU<F_MOEGU>, SchedMoeGU, true, true>(F.lds, g, S, E, F.wave); } SEAM(PH); \
    if (IN((PH) + 1)) { const int* te = (const int*)(ws + WS_TILEEXP); const int ntl = te[511]; int ntq = ntl - 64 * (Q); ntq = ntq < 0 ? 0 : (ntq > 64 ? 64 : ntq); if ((Q) == 4) ntq = (ntl > 256) ? (ntl - 256) : 0; \
        pg8::Gemm g{(const bf16*)(ws + WS_ACTQ), (const bf16*)(ws + WS_WMOE_D), FEXP, FEXP, FEXP}; SchedMoeD S{te, 64 * (Q), ntq, F.G, (int)blockIdx.x}; \
        pg8::Epi8<F_MOED> E{{(bf16*)(ws + WS_XG)}}; \
        pg8::gemm_phase<pg8::Epi8<F_MOED>, SchedMoeD, true, true>(F.lds, g, S, E, F.wave); } SEAM((PH) + 1);
    MOE_CHUNK_PHASES(19, 0)
    MOE_CHUNK_PHASES(21, 1)
    MOE_CHUNK_PHASES(23, 2)
    MOE_CHUNK_PHASES(25, 3)
    MOE_CHUNK_PHASES(27, 4)
#undef MOE_CHUNK_PHASES
    if (IN(29)) { moe_combine_final_phase(F); }
#undef IN
#undef SEAM
}

#ifndef MK_ONE_LAUNCH
#define MK_ONE_LAUNCH 0
#endif
extern "C" void kernel_launch(void* const* d_in, const int* in_sizes, int n_in, void* d_out, int out_size, void* d_ws, size_t ws_size, hipStream_t stream) {
    static int grid = 0;
    if (grid == 0) {
        if (n_in != 38 || in_sizes[0] != T_TOK * DMODEL || out_size != T_TOK * DMODEL || ws_size < WS_NEED) { fprintf(stderr, "kernel_launch: unexpected shapes (n_in %d, in0 %d, out %d, ws %zu); nothing launched\n", n_in, n_in > 0 ? in_sizes[0] : -1, out_size, ws_size); grid = -1; return; }
        int dev = 0, cus = 0, per_cu = 0;
        if (hipGetDevice(&dev) != hipSuccess || hipDeviceGetAttribute(&cus, hipDeviceAttributeMultiprocessorCount, dev) != hipSuccess) { grid = -1; return; }
        if (hipFuncSetAttribute((const void*)mega_fwd, hipFuncAttributeMaxDynamicSharedMemorySize, LDS_BYTES) != hipSuccess) { fprintf(stderr, "kernel_launch: hipFuncSetAttribute failed\n"); grid = -1; return; }
        if (hipOccupancyMaxActiveBlocksPerMultiprocessor(&per_cu, (const void*)mega_fwd, NWAVES * 64, LDS_BYTES) != hipSuccess || per_cu < 1) fprintf(stderr, "kernel_launch: occupancy query reports %d\n", per_cu);
        (void)hipGetLastError();
        grid = cus;
    }
    if (grid < 0) return;
    if (hipMemsetAsync((char*)d_ws + WS_CTL, 0, CTL_ZERO_BYTES, stream) != hipSuccess) return;
    Args a{};
    for (int i = 0; i < 38; ++i) a.in[i] = (const float*)d_in[i];
    a.out = (float*)d_out; a.ws = (unsigned char*)d_ws; a.pad = 0;
#if MK_ONE_LAUNCH
    a.ph_lo = 0; a.ph_hi = NPHASE; a.li = 0;
    hipLaunchKernelGGL(mega_fwd, dim3(grid), dim3(NWAVES * 64), LDS_BYTES, stream, a);
#else
    for (int p = 0; p < NPHASE; ++p) { a.ph_lo = p; a.ph_hi = p + 1; a.li = p;
        hipLaunchKernelGGL(mega_fwd, dim3(grid), dim3(NWAVES * 64), LDS_BYTES, stream, a);
        if (hipPeekAtLastError() != hipSuccess) { fprintf(stderr, "kernel_launch: launch %d failed\n", p); break; } }
#endif
}
```

```cpp
#include <hip/hip_runtime.h>
#include <hip/hip_bf16.h>
#include <cstdio>
#include <cstdint>
#include <cmath>
#ifndef ABL_MOBA
#define ABL_MOBA 0
#endif
__device__ __forceinline__ int mk_lane() { int l; asm volatile("v_mbcnt_lo_u32_b32 %0, -1, 0\n\tv_mbcnt_hi_u32_b32 %0, -1, %0" : "=v"(l)); return l; }
namespace pg8 {
#define PG8_LAS __attribute__((address_space(3)))
typedef unsigned short bf16_t;
typedef short bf16x8 __attribute__((ext_vector_type(8)));
typedef float f32x4 __attribute__((ext_vector_type(4)));
typedef unsigned u32x4 __attribute__((ext_vector_type(4)));
constexpr int BM = 256, BK = 64, HALF = 128, HTB = HALF * BK * 2  , STAGE_BYTES = 8 * HTB, NXCD = 8, WGM = 8;

__host__ __device__ __forceinline__ int lds_byte(int r, int c) { const int st = (r >> 4) * 2 + (c >> 5), rr = r & 15, cc = c & 31, ob = rr * 64 + cc * 2; return st * 1024 + (ob ^ (((ob >> 9) & 1) << 5)); }
__host__ __device__ __forceinline__ void stage_rc(int b, int& R, int& C) { const int st = b / 1024, sb = b % 1024, swz = sb ^ (((sb >> 9) & 1) << 5); R = (st >> 1) * 16 + swz / 64; C = (st & 1) * 32 + (swz % 64) / 2; }
__host__ __device__ __forceinline__ int perm32(int rho) { const int n = rho >> 4, i = rho & 15; return 8 * (i >> 2) + 4 * n + (i & 3); }

struct Unit { int pm, pn, aux; };
struct Gemm { const bf16_t* A; const bf16_t* Bt; int lda, ldb, K; };

struct StaticOrder {
    int nM, nN, nwg, G, c;
    __host__ __device__ void init(int M, int N, int G_, int c_) { nM = M / BM; nN = N / BM; nwg = nM * nN; G = G_; c = c_; }
    __host__ __device__ bool next(int i, Unit& u) const {
        const long L = (long)i * G + c; if (L >= nwg) return false;
        int wgid = (int)L; { const int q = nwg / NXCD, r = nwg % NXCD, xcd = wgid % NXCD, off = wgid / NXCD; wgid = (xcd < r ? xcd * (q + 1) : r * (q + 1) + (xcd - r) * q) + off; }
        const int nig = WGM * nN, gid = wgid / nig, fm = gid * WGM, gsz = (nM - fm) < WGM ? (nM - fm) : WGM;
        u.pm = fm + ((wgid % nig) % gsz); u.pn = (wgid % nig) / gsz; u.aux = 0; return true;
    }
    __device__ __forceinline__ void a_ready(const Unit&) const {}
    __device__ __forceinline__ void done(const Unit&) const {}
};

__device__ __forceinline__ unsigned cvt_pk_bf16(float lo, float hi) { unsigned r; asm volatile("v_cvt_pk_bf16_f32 %0, %1, %2" : "=v"(r) : "v"(lo), "v"(hi)); return r; }

template <class F> struct Epi8 {
    static constexpr bool PERM = true, AFTER_DRAIN = false;
    F f;
    __device__ __forceinline__ void operator()(const f32x4 (&acc)[2][2][4][2], const Unit& u, int wr, int wc, int fr, int fq) const {
#pragma unroll
        for (int ai = 0; ai < 2; ++ai)
#pragma unroll
            for (int m = 0; m < 4; ++m) { const int r = ai * HALF + wr * 64 + m * 16 + fr;
#pragma unroll
                for (int bj = 0; bj < 2; ++bj) { const int c = bj * HALF + wc * 32 + 8 * fq;
                    float v[8] = {acc[ai][bj][m][0][0], acc[ai][bj][m][0][1], acc[ai][bj][m][0][2], acc[ai][bj][m][0][3], acc[ai][bj][m][1][0], acc[ai][bj][m][1][1], acc[ai][bj][m][1][2], acc[ai][bj][m][1][3]};
                    f(u, r, c, v, wc); } }
    }
};
template <class F> struct EpiGU {
    static constexpr bool PERM = true, AFTER_DRAIN = false;
    F f;
    __device__ __forceinline__ void operator()(const f32x4 (&acc)[2][2][4][2], const Unit& u, int wr, int wc, int fr, int fq) const {
#pragma unroll
        for (int ai = 0; ai < 2; ++ai)
#pragma unroll
            for (int m = 0; m < 4; ++m) { const int r = ai * HALF + wr * 64 + m * 16 + fr; const int c = wc * 32 + 8 * fq;
                float g[8] = {acc[ai][0][m][0][0], acc[ai][0][m][0][1], acc[ai][0][m][0][2], acc[ai][0][m][0][3], acc[ai][0][m][1][0], acc[ai][0][m][1][1], acc[ai][0][m][1][2], acc[ai][0][m][1][3]};
                float p[8] = {acc[ai][1][m][0][0], acc[ai][1][m][0][1], acc[ai][1][m][0][2], acc[ai][1][m][0][3], acc[ai][1][m][1][0], acc[ai][1][m][1][1], acc[ai][1][m][1][2], acc[ai][1][m][1][3]};
                f(u, r, c, g, p); }
    }
};

template <class Epi, class Sched, bool ALIGN_EPI = false, bool SP2 = false>
__device__ __forceinline__ void gemm_phase(PG8_LAS unsigned char* lds, const Gemm g, const Sched& S, const Epi& E, const int wave_s) {
    const int wid = wave_s, lane = mk_lane(), tid = wid * 64 + lane, wr = wid >> 2, wc = wid & 3, fr = lane & 15, fq = lane >> 4;
    const int K = g.K, nt = K / BK;
    unsigned voffA[2], voffB[2];
#pragma unroll
    for (int i = 0; i < 2; ++i) { int R, C; stage_rc(tid * 16 + i * 8192, R, C); const int Rb = Epi::PERM ? ((R & ~31) + perm32(R & 31)) : R;
        voffA[i] = (unsigned)(R * g.lda + C) * 2u; voffB[i] = (unsigned)(Rb * g.ldb + C) * 2u; }
    const size_t kstep = (size_t)(BK * 2);
    const size_t hstepA = (size_t)HALF * g.lda * 2, hstepB = (size_t)HALF * g.ldb * 2;
    const size_t tstepA = 2 * hstepA, tstepB = 2 * hstepB;
    const unsigned ldsw = (unsigned)wid * 1024u;
    const int aoff = lds_byte(wr * 64 + fr, fq * 8), boff = lds_byte(wc * 32 + fr, fq * 8);
#define PG8_SA(b, h) (((b) * 2 + (h)) * HTB)
#define PG8_SB(b, h) ((4 + (b) * 2 + (h)) * HTB)
#define PG8_STAGE(bufoff, gbase, voff) do { _Pragma("unroll") for (int _i = 0; _i < 2; ++_i) \
        __builtin_amdgcn_global_load_lds((const unsigned*)((const char*)(gbase) + (voff)[_i]), (PG8_LAS unsigned*)(lds + (bufoff) + ldsw + _i * 8192), 16, 0, 0); } while (0)
#define PG8_LDA(dst, b, h) do { _Pragma("unroll") for (int m = 0; m < 4; ++m) _Pragma("unroll") for (int k = 0; k < 2; ++k) dst[m][k] = *(const PG8_LAS bf16x8*)(lds + PG8_SA(b, h) + aoff + m * 2048 + k * 1024); } while (0)
#define PG8_LDB(dst, b, h) do { _Pragma("unroll") for (int n = 0; n < 2; ++n) _Pragma("unroll") for (int k = 0; k < 2; ++k) dst[n][k] = *(const PG8_LAS bf16x8*)(lds + PG8_SB(b, h) + boff + n * 2048 + k * 1024); } while (0)
#define PG8_MMA(ai, bj, At, Bt) do { __builtin_amdgcn_s_setprio(1); _Pragma("unroll") for (int m = 0; m < 4; ++m) _Pragma("unroll") for (int n = 0; n < 2; ++n) _Pragma("unroll") for (int k = 0; k < 2; ++k) \
        acc[ai][bj][m][n] = __builtin_amdgcn_mfma_f32_16x16x32_bf16(Bt[n][k], At[m][k], acc[ai][bj][m][n], 0, 0, 0); __builtin_amdgcn_s_setprio(0); } while (0)
#define PG8_WAIT_V(n) asm volatile("s_waitcnt vmcnt(" #n ")" ::: "memory")
#define PG8_WAIT_L(n) asm volatile("s_waitcnt lgkmcnt(" #n ")" ::: "memory")
#define PG8_BAR __builtin_amdgcn_s_barrier()
#define PG8_SCHED __builtin_amdgcn_sched_barrier(0)
    Unit cur, nxt; int ui = 0;
    if (!S.next(0, cur)) return;
    f32x4 acc[2][2][4][2];
#pragma unroll
    for (int a = 0; a < 2; ++a)
#pragma unroll
        for (int b = 0; b < 2; ++b)
#pragma unroll
            for (int m = 0; m < 4; ++m)
#pragma unroll
                for (int n = 0; n < 2; ++n) acc[a][b][m][n] = (f32x4){0.f, 0.f, 0.f, 0.f};
    bf16x8 At[4][2], B0[2][2], B1[2][2];
    const char* cA = (const char*)g.A + (size_t)cur.pm * tstepA; const char* cB = (const char*)g.Bt + (size_t)cur.pn * tstepB;
    S.a_ready(cur);
    if constexpr (SP2) {
        PG8_STAGE(PG8_SB(0, 0), cB, voffB); PG8_STAGE(PG8_SB(0, 1), cB + hstepB, voffB); PG8_STAGE(PG8_SA(0, 0), cA, voffA); PG8_STAGE(PG8_SA(0, 1), cA + hstepA, voffA);
        if (wr == 1) PG8_BAR;
        PG8_WAIT_V(2); PG8_BAR;
        PG8_STAGE(PG8_SB(1, 0), cB + kstep, voffB); PG8_STAGE(PG8_SA(1, 0), cA + kstep, voffA); PG8_STAGE(PG8_SB(1, 1), cB + hstepB + kstep, voffB);
        PG8_WAIT_V(6); PG8_BAR;
    } else {
        PG8_STAGE(PG8_SB(0, 0), cB, voffB); PG8_STAGE(PG8_SA(0, 0), cA, voffA); PG8_STAGE(PG8_SB(0, 1), cB + hstepB, voffB); PG8_STAGE(PG8_SA(0, 1), cA + hstepA, voffA);
        if (wr == 1) PG8_BAR;
        PG8_WAIT_V(4); PG8_BAR;
        PG8_STAGE(PG8_SB(1, 0), cB + kstep, voffB); PG8_STAGE(PG8_SA(1, 0), cA + kstep, voffA); PG8_STAGE(PG8_SB(1, 1), cB + hstepB + kstep, voffB);
        PG8_WAIT_V(6); PG8_BAR;
    }
    for (;;) {
        const bool has_next = S.next(ui + 1, nxt);
        const char* nA = has_next ? (const char*)g.A + (size_t)nxt.pm * tstepA : cA; const char* nB = has_next ? (const char*)g.Bt + (size_t)nxt.pn * tstepB : cB;
        for (int t = 0; t < nt; t += 2) {
            const bool last = (t == nt - 2);
            const char* a1 = cA + (size_t)(t + 1) * kstep;
            const char* a2 = last ? nA : cA + (size_t)(t + 2) * kstep; const char* b2 = last ? nB : cB + (size_t)(t + 2) * kstep;
            const char* a3 = a2 + kstep; const char* b3 = b2 + kstep;
            if (last && has_next) S.a_ready(nxt);
            if constexpr (SP2) {
            PG8_LDB(B0, 0, 0); PG8_LDB(B1, 0, 1); PG8_SCHED; PG8_LDA(At, 0, 0); PG8_STAGE(PG8_SA(1, 1), a1 + hstepA, voffA);
            PG8_WAIT_V(8); PG8_WAIT_L(0); PG8_BAR; PG8_MMA(0, 0, At, B0); PG8_MMA(0, 1, At, B1); PG8_BAR; PG8_SCHED;
            PG8_LDA(At, 0, 1); PG8_STAGE(PG8_SB(0, 0), b2, voffB); PG8_STAGE(PG8_SB(0, 1), b2 + hstepB, voffB); PG8_STAGE(PG8_SA(0, 0), a2, voffA);
            PG8_WAIT_V(8); PG8_WAIT_L(0); PG8_BAR; PG8_MMA(1, 0, At, B0); PG8_MMA(1, 1, At, B1); PG8_BAR; PG8_SCHED;
            PG8_LDB(B0, 1, 0); PG8_LDB(B1, 1, 1); PG8_SCHED; PG8_LDA(At, 1, 0); PG8_STAGE(PG8_SA(0, 1), a2 + hstepA, voffA);
            PG8_WAIT_V(8); PG8_WAIT_L(0); PG8_BAR; PG8_MMA(0, 0, At, B0); PG8_MMA(0, 1, At, B1); PG8_BAR; PG8_SCHED;
            PG8_LDA(At, 1, 1); PG8_STAGE(PG8_SB(1, 0), b3, voffB); PG8_STAGE(PG8_SB(1, 1), b3 + hstepB, voffB); PG8_STAGE(PG8_SA(1, 0), a3, voffA);
            PG8_WAIT_V(8); PG8_WAIT_L(0); PG8_BAR; PG8_MMA(1, 0, At, B0); PG8_MMA(1, 1, At, B1); PG8_BAR; PG8_SCHED;
            } else {
            PG8_LDB(B0, 0, 0); PG8_SCHED; PG8_LDA(At, 0, 0); PG8_STAGE(PG8_SA(1, 1), a1 + hstepA, voffA);
            PG8_WAIT_L(8); PG8_BAR; PG8_WAIT_L(0); PG8_MMA(0, 0, At, B0); PG8_BAR; PG8_SCHED;
            PG8_LDB(B1, 0, 1); PG8_STAGE(PG8_SB(0, 0), b2, voffB);
            PG8_BAR; PG8_WAIT_L(0); PG8_MMA(0, 1, At, B1); PG8_BAR;
            PG8_LDA(At, 0, 1); PG8_STAGE(PG8_SA(0, 0), a2, voffA);
            PG8_BAR; PG8_WAIT_L(0); PG8_MMA(1, 0, At, B0); PG8_BAR; PG8_SCHED;
            PG8_STAGE(PG8_SB(0, 1), b2 + hstepB, voffB);
            PG8_WAIT_V(6); PG8_BAR; PG8_MMA(1, 1, At, B1); PG8_BAR;
            PG8_LDB(B0, 1, 0); PG8_SCHED; PG8_LDA(At, 1, 0); PG8_STAGE(PG8_SA(0, 1), a2 + hstepA, voffA);
            PG8_WAIT_L(8); PG8_BAR; PG8_WAIT_L(0); PG8_MMA(0, 0, At, B0); PG8_BAR; PG8_SCHED;
            PG8_LDB(B1, 1, 1); PG8_STAGE(PG8_SB(1, 0), b3, voffB);
            PG8_BAR; PG8_WAIT_L(0); PG8_MMA(0, 1, At, B1); PG8_BAR;
            PG8_LDA(At, 1, 1); PG8_STAGE(PG8_SA(1, 0), a3, voffA);
            PG8_BAR; PG8_WAIT_L(0); PG8_MMA(1, 0, At, B0); PG8_BAR; PG8_SCHED;
            PG8_STAGE(PG8_SB(1, 1), b3 + hstepB, voffB);
            PG8_WAIT_V(6); PG8_BAR; PG8_MMA(1, 1, At, B1); PG8_BAR;
            }
        }
        if constexpr (ALIGN_EPI) { if (wr == 0) PG8_BAR; }
        if constexpr (!Epi::AFTER_DRAIN) { E(acc, cur, wr, wc, fr, fq); S.done(cur); }
        if (!has_next) break;
#pragma unroll
        for (int a = 0; a < 2; ++a)
#pragma unroll
            for (int b = 0; b < 2; ++b)
#pragma unroll
                for (int m = 0; m < 4; ++m)
#pragma unroll
                    for (int n = 0; n < 2; ++n) acc[a][b][m][n] = (f32x4){0.f, 0.f, 0.f, 0.f};
        cur = nxt; cA = nA; cB = nB; ++ui;
        if constexpr (ALIGN_EPI) { if (wr == 1) PG8_BAR; }
    }
    PG8_WAIT_V(0);
    if constexpr (!ALIGN_EPI) { if (wr == 0) PG8_BAR; }
    PG8_BAR;
    if constexpr (Epi::AFTER_DRAIN) { E.fused(acc, cur, wr, wc, fr, fq, lds, wid, lane); S.done(cur); }
#undef PG8_SA
#undef PG8_SB
#undef PG8_STAGE
#undef PG8_LDA
#undef PG8_LDB
#undef PG8_MMA
#undef PG8_WAIT_V
#undef PG8_WAIT_L
#undef PG8_BAR
#undef PG8_SCHED
}
}

namespace attn_body {
using bf16=__hip_bfloat16;
using bf16x8=__attribute__((ext_vector_type(8)))short;
using s16x4=__attribute__((ext_vector_type(4)))short;
using f32x16=__attribute__((ext_vector_type(16)))float;
using u32x4=__attribute__((ext_vector_type(4)))unsigned;
constexpr int BATCH=4,NHEAD=8,SEQ=8192,D=64,DM=NHEAD*D,ODM=1024;
constexpr int NW=8,QBLK=32,QB=QBLK*NW,KVBLK=64,NQB=SEQ/QB;
constexpr int ATTN_PITCH=DM, ATTN_UNIT_ROWS=QB;
__device__ __forceinline__ int crow(int r,int hi){return (r&3)+8*(r>>2)+4*hi;}
#define SBAR() __builtin_amdgcn_sched_barrier(0)
__device__ __forceinline__ void cmask(f32x16&p0,f32x16&p1,int jb,int qrel,int hi){
  const float NEG=-INFINITY; int kb=64*jb+4*hi;
  #pragma unroll
  for(int r=0;r<16;++r){int kv=kb+(r&3)+8*(r>>2); if(kv>qrel)p0[r]=NEG; if(kv+32>qrel)p1[r]=NEG;}
}

constexpr int NSLOT=3, SLOTB=8192;
constexpr int LDS_K=0, LDS_V=NSLOT*SLOTB, LDS_WS=2*NSLOT*SLOTB, LDS_OST=LDS_WS+NW*64*4, LDS_BYTES=LDS_OST+NW*4096;
constexpr float C2=0.125f*1.4426950408889634f;
__device__ __forceinline__ void glds16(const void*gsrc,unsigned lds_dst){unsigned keep;
  asm volatile("s_mov_b32 %0, m0\n\ts_mov_b32 m0, %2\n\ts_nop 0\n\tglobal_load_lds_dwordx4 %1, off\n\ts_mov_b32 m0, %0":"=&s"(keep):"v"(gsrc),"s"(lds_dst):"memory");}
__device__ __forceinline__ float max3f(float a,float b,float c){float r;asm("v_max3_f32 %0, %1, %2, %3":"=v"(r):"v"(a),"v"(b),"v"(c));return r;}
__device__ __forceinline__ float max2f(float a,float b){float r;asm("v_max_f32_e32 %0, %1, %2":"=v"(r):"v"(a),"v"(b));return r;}
__device__ __forceinline__ float fadd_s(float a,float b){float r;asm("v_add_f32_e32 %0, %1, %2":"=v"(r):"v"(a),"v"(b));return r;}
__device__ __forceinline__ float fsub_s(float a,float b){float r;asm("v_sub_f32_e32 %0, %1, %2":"=v"(r):"v"(a),"v"(b));return r;}
typedef float f32x2_t __attribute__((ext_vector_type(2))); typedef __bf16 bf16x2_t __attribute__((ext_vector_type(2)));
__device__ __forceinline__ unsigned cvtpk_s(float lo,float hi){f32x2_t v={lo,hi};bf16x2_t b=__builtin_convertvector(v,bf16x2_t);return __builtin_bit_cast(unsigned,b);}
#define WAIT_BAR(N) asm volatile("s_waitcnt vmcnt(" #N ") lgkmcnt(0)\n\ts_barrier":::"memory")

__device__ __forceinline__ void qkt(f32x16&p0,f32x16&p1,const char*Kslot,const bf16x8*qr,const f32x16&negm,int r32,int hi){
  const char*kb=Kslot+hi*1024+r32*16;
  #pragma unroll
  for(int d0=0;d0<4;++d0){
    const bf16x8 b0=*reinterpret_cast<const bf16x8*>(kb+d0*2048);
    const bf16x8 b1=*reinterpret_cast<const bf16x8*>(kb+d0*2048+512);
    if(d0==0){p0=__builtin_amdgcn_mfma_f32_32x32x16_bf16(b0,qr[0],negm,0,0,0);p1=__builtin_amdgcn_mfma_f32_32x32x16_bf16(b1,qr[0],negm,0,0,0);}
    else{p0=__builtin_amdgcn_mfma_f32_32x32x16_bf16(b0,qr[d0],p0,0,0,0);p1=__builtin_amdgcn_mfma_f32_32x32x16_bf16(b1,qr[d0],p1,0,0,0);}}
}
typedef __attribute__((address_space(3))) const char* lds_cptr;
typedef short v4i16_t __attribute__((ext_vector_type(4)));
__device__ __forceinline__ void kload8(bf16x8*kf,lds_cptr kp){
  kf[0]=*(const __attribute__((address_space(3))) bf16x8*)(kp);      kf[1]=*(const __attribute__((address_space(3))) bf16x8*)(kp+512);
  kf[2]=*(const __attribute__((address_space(3))) bf16x8*)(kp+2048); kf[3]=*(const __attribute__((address_space(3))) bf16x8*)(kp+2560);
  kf[4]=*(const __attribute__((address_space(3))) bf16x8*)(kp+4096); kf[5]=*(const __attribute__((address_space(3))) bf16x8*)(kp+4608);
  kf[6]=*(const __attribute__((address_space(3))) bf16x8*)(kp+6144); kf[7]=*(const __attribute__((address_space(3))) bf16x8*)(kp+6656);
}
__device__ __forceinline__ void kload2(bf16x8*kf,lds_cptr kp,int j){ kf[2*j]=*(const __attribute__((address_space(3))) bf16x8*)(kp+j*2048); kf[2*j+1]=*(const __attribute__((address_space(3))) bf16x8*)(kp+j*2048+512); }
__device__ __forceinline__ s16x4 vtr(lds_cptr p){ return __builtin_bit_cast(s16x4,__builtin_amdgcn_ds_read_tr16_b64_v4i16((__attribute__((address_space(3))) v4i16_t*)p)); }
__device__ __forceinline__ float rowmax(const f32x16&p0,const f32x16&p1){
  float a=max3f(p0[0],p0[1],p1[0]),b=max3f(p0[2],p0[3],p1[1]);a=max3f(a,p1[2],p1[3]);
  #pragma unroll
  for(int r=4;r<16;r+=4){a=max3f(a,p0[r],p0[r+1]);b=max3f(b,p0[r+2],p0[r+3]);a=max3f(a,p1[r],p1[r+1]);b=max3f(b,p1[r+2],p1[r+3]);}
  const float m=max2f(a,b);
  auto rr=__builtin_amdgcn_permlane32_swap(__float_as_uint(m),__float_as_uint(m),false,false);
  return max2f(__uint_as_float(rr[0]),__uint_as_float(rr[1]));
}
__device__ __forceinline__ void pv(f32x16*o,int vb,bf16x8 pa0,bf16x8 pa1,bf16x8 pa2,bf16x8 pa3){
  #pragma unroll
  for(int d0=0;d0<2;++d0){s16x4 lo[4],hi[4];
    #pragma unroll
    for(int ks=0;ks<4;++ks){
      asm volatile("ds_read_b64_tr_b16 %0,%1 offset:%c2":"=&v"(lo[ks]):"v"(vb),"i"(d0*4096+ks*1024):"memory");
      asm volatile("ds_read_b64_tr_b16 %0,%1 offset:%c2":"=&v"(hi[ks]):"v"(vb),"i"(d0*4096+ks*1024+512):"memory");}
    asm volatile("s_waitcnt lgkmcnt(0)":::"memory");SBAR();
    #define PK(k) (bf16x8){lo[k][0],lo[k][1],lo[k][2],lo[k][3],hi[k][0],hi[k][1],hi[k][2],hi[k][3]}
    o[d0]=__builtin_amdgcn_mfma_f32_32x32x16_bf16(pa0,PK(0),o[d0],0,0,0);
    o[d0]=__builtin_amdgcn_mfma_f32_32x32x16_bf16(pa1,PK(1),o[d0],0,0,0);
    o[d0]=__builtin_amdgcn_mfma_f32_32x32x16_bf16(pa2,PK(2),o[d0],0,0,0);
    o[d0]=__builtin_amdgcn_mfma_f32_32x32x16_bf16(pa3,PK(3),o[d0],0,0,0);
    #undef PK
  }
}

#ifndef ATTN_STORE16
#define ATTN_STORE16(p,v) (*(u32x4*)(p)=(v))
#endif
template<int THRL> __device__ __forceinline__ void attn_unit(int b,int h,int qb,const bf16*Q,const bf16*__restrict__ K,const bf16*__restrict__ V,bf16*O,const unsigned*__restrict__ SEL,char*shm,const int wave_s){
  const int wid=wave_s,lane=mk_lane(),r32=lane&31,hi=lane>>5;
  const long rowbase=(long)b*SEQ; const int q0=qb*QB;
  const bf16*Qw=Q+(rowbase+q0+wid*QBLK)*DM+h*D;
  const bf16*Kh=K+rowbase*DM+h*D,*Vh=V+rowbase*DM+h*D;
  const unsigned lds0=(unsigned)(uintptr_t)shm;
  float*wsf=(float*)(shm+LDS_WS)+wid*64;
  const bf16*ksrc=Kh+(long)lane*DM+wid*8;
  const bf16*vsrc=Vh+(long)(16*(wid&3)+(lane>>2))*DM+(wid>>2)*32+(lane&3)*8;
  const unsigned kdst=lds0+LDS_K+wid*1024, vdst=lds0+LDS_V+wid*1024;
  #define TAU(t) (((t)<4)?(NT-4+(t)):((t)-4))
  #define DMA_K(t,slot) glds16(ksrc+(long)TAU(t)*KVBLK*DM,(unsigned)__builtin_amdgcn_readfirstlane(kdst+(slot)))
  #define DMA_V(t,slot) glds16(vsrc+(long)TAU(t)*KVBLK*DM,(unsigned)__builtin_amdgcn_readfirstlane(vdst+(slot)))
  const int vb0=(int)(lds0+LDS_V)+((lane>>4)&1)*32+(lane&3)*8+(4*hi+((lane&15)>>2))*64;
  const char*Kbase=shm+LDS_K; bf16x8 kf[8];
  const lds_cptr shm3=(lds_cptr)shm; const lds_cptr kp0=shm3+LDS_K+hi*1024+r32*16; const lds_cptr vp0=shm3+LDS_V+((lane>>4)&1)*32+(lane&3)*8+(4*hi+((lane&15)>>2))*64;
  const int NT=(q0+QB)/KVBLK;
  DMA_K(0,0);DMA_V(0,0);DMA_K(1,SLOTB);
  bf16x8 qr[4];
  #pragma unroll
  for(int d0=0;d0<4;++d0)qr[d0]=*reinterpret_cast<const bf16x8*>(&Qw[(long)r32*DM+d0*16+hi*8]);
  float mhat=0.f,l_reg=0.f;f32x16 o[2];o[0]=f32x16{};o[1]=f32x16{};const f32x16 negm=f32x16{};
  const int qrel=wid*QBLK+r32;
  const unsigned selw_addr=lds0+LDS_BYTES+wid*128+r32*4;
  { const unsigned sm0_=SEL[(size_t)(b*NHEAD+h)*SEQ+q0+qrel]; if(hi==0){ asm volatile("ds_write_b32 %0, %1"::"v"(selw_addr),"v"(sm0_):"memory"); } }
  #define CMASK(P0,P1,t) do{ unsigned sm_; asm volatile("ds_read_b32 %0, %1\n\ts_waitcnt lgkmcnt(0)":"=v"(sm_):"v"(selw_addr):"memory"); const int pt_=((t)<4)?0:((t)-4)>>2; const int lim_=((t)<4)?(qrel-64*(t)):((((sm_>>pt_)&1u)!=0u)?64:-1); cmask(P0,P1,0,lim_,hi); }while(0)
  bool resc=false;
  #define START(P0,P1) do{ const float rm=rowmax(P0,P1); resc=false; \
    { const float dl=rm; mhat=fadd_s(mhat,dl); \
      _Pragma("unroll") for(int r=0;r<16;++r){P0[r]=fsub_s(P0[r],dl);P1[r]=fsub_s(P1[r],dl);} \
    } \
    _Pragma("unroll") for(int r=0;r<16;++r)P0[r]=__builtin_amdgcn_exp2f(P0[r]); }while(0)
  #define RESC() do{ if(resc){ asm volatile("s_waitcnt lgkmcnt(0)":::"memory"); \
      _Pragma("unroll") for(int d_=0;d_<2;++d_) _Pragma("unroll") for(int r=0;r<16;++r)o[d_][r]*=wsf[crow(r,hi)]; } }while(0)
  f32x16 pA0,pA1,pB0,pB1;
  int sl_prev=0,sl_cur=0,sl_next=SLOTB;
  #define ROT() do{sl_prev=sl_cur;sl_cur=sl_next;sl_next=(sl_next==(NSLOT-1)*SLOTB)?0:sl_next+SLOTB;}while(0)
  DMA_K(2,2*SLOTB);
  WAIT_BAR(3);
  qkt(pA0,pA1,Kbase,qr,negm,r32,hi);asm volatile("s_nop 15\n\ts_nop 7":"+v"(pA0),"+v"(pA1));CMASK(pA0,pA1,0);
  START(pA0,pA1);
  _Pragma("unroll") for(int r=0;r<16;++r)pA1[r]=__builtin_amdgcn_exp2f(pA1[r]);
  WAIT_BAR(0);
  DMA_K(3,0);DMA_V(1,SLOTB);
  ROT();
  kload8(kf,kp0+sl_cur);
  WAIT_BAR(2);
  s16x4 vlo[8],vhi[8]; u32x4 pw0,pw1,pw2,pw3;
  #define PKW(P,B) cvtpk_s(P[B],P[B+1])
  #define PAF(k) __builtin_bit_cast(bf16x8,pw##k)
  #define VFR(i) (bf16x8){vlo[i][0],vlo[i][1],vlo[i][2],vlo[i][3],vhi[i][0],vhi[i][1],vhi[i][2],vhi[i][3]}
  #define PIN(x) asm volatile("":"+v"(x))
  #define MX3(a,b,c) __builtin_fmaxf(__builtin_fmaxf((a),(b)),(c))
  #define GAPA(MF,A0,A1,A2,A3,W0,W1,PW) do{ MF; sacc+=A0; sacc+=A1; sacc+=A2; sacc+=A3; PIN(sacc); W0; W1; PIN(PW); SBAR(); }while(0)
  #define EX(v) __builtin_amdgcn_exp2f(v)
  #define GAPB(MF,X,B) do{ MF; X[B]=EX(X[B]); X[B+1]=EX(X[B+1]); X[B+2]=EX(X[B+2]); X[B+3]=EX(X[B+3]); PIN(X); SBAR(); }while(0)
  #define VRD(i) do{ vlo[i]=vtr(vp_+(((i)>>2)*4096+((i)&3)*1024)); vhi[i]=vtr(vp_+(((i)>>2)*4096+((i)&3)*1024+512)); }while(0)
  #define KRD(G,j) do{ if(G){ kload2(kf,kp0+sl_next,j); SBAR(); } }while(0)
  #define STEP(C0,C1,P0,P1,t,GK,GV,GL) do{ SBAR(); \
    const lds_cptr vp_=vp0+sl_prev; \
    VRD(0); SBAR(); float sacc=(P0[0]+P0[1]); \
    GAPA(C0=__builtin_amdgcn_mfma_f32_32x32x16_bf16(kf[0],qr[0],negm,0,0,0), P0[2],P0[3],P0[4],P0[5],     pw0[0]=PKW(P0,0), pw0[1]=PKW(P0,2), pw0); \
    VRD(4); SBAR(); GAPA(C1=__builtin_amdgcn_mfma_f32_32x32x16_bf16(kf[1],qr[0],negm,0,0,0), P0[6],P0[7],P0[8],P0[9],     pw0[2]=PKW(P0,4), pw0[3]=PKW(P0,6), pw0); \
    VRD(1); SBAR(); GAPA(C0=__builtin_amdgcn_mfma_f32_32x32x16_bf16(kf[2],qr[1],C0,0,0,0),   P0[10],P0[11],P0[12],P0[13], pw1[0]=PKW(P0,8), pw1[1]=PKW(P0,10), pw1); \
    VRD(5); SBAR(); GAPA(C1=__builtin_amdgcn_mfma_f32_32x32x16_bf16(kf[3],qr[1],C1,0,0,0),   P0[14],P0[15],P1[0],P1[1],   pw1[2]=PKW(P0,12),pw1[3]=PKW(P0,14), pw1); \
    VRD(2); SBAR(); GAPA(C0=__builtin_amdgcn_mfma_f32_32x32x16_bf16(kf[4],qr[2],C0,0,0,0),   P1[2],P1[3],P1[4],P1[5],     pw2[0]=PKW(P1,0), pw2[1]=PKW(P1,2), pw2); \
    VRD(6); SBAR(); GAPA(C1=__builtin_amdgcn_mfma_f32_32x32x16_bf16(kf[5],qr[2],C1,0,0,0),   P1[6],P1[7],P1[8],P1[9],     pw2[2]=PKW(P1,4), pw2[3]=PKW(P1,6), pw2); \
    VRD(3); SBAR(); GAPA(C0=__builtin_amdgcn_mfma_f32_32x32x16_bf16(kf[6],qr[3],C0,0,0,0),   P1[10],P1[11],P1[12],P1[13], pw3[0]=PKW(P1,8), pw3[1]=PKW(P1,10), pw3); \
    VRD(7); SBAR(); GAPA(C1=__builtin_amdgcn_mfma_f32_32x32x16_bf16(kf[7],qr[3],C1,0,0,0),   P1[14],P1[15],0.f,0.f,       pw3[2]=PKW(P1,12),pw3[3]=PKW(P1,14), pw3); \
    l_reg+=sacc; \
    if(GK){DMA_K((t)+3,sl_cur);} if(GV){DMA_V((t)+1,sl_next);} \
    _Pragma("unroll") for(int r=0;r<16;++r){C0[r]-=mhat;C1[r]-=mhat;} \
    CMASK(C0,C1,t); \
    { float a=MX3(C0[0],C0[1],C1[0]),b=MX3(C0[2],C0[3],C1[1]); a=MX3(a,C1[2],C1[3]); \
      _Pragma("unroll") for(int r=4;r<16;r+=4){a=MX3(a,C0[r],C0[r+1]);b=MX3(b,C0[r+2],C0[r+3]);a=MX3(a,C1[r],C1[r+1]);b=MX3(b,C1[r+2],C1[r+3]);} \
      float rm=__builtin_fmaxf(a,b); { auto rr=__builtin_amdgcn_permlane32_swap(__float_as_uint(rm),__float_as_uint(rm),false,false); rm=__builtin_fmaxf(__uint_as_float(rr[0]),__uint_as_float(rr[1])); } \
      resc=false; \
      if(__builtin_expect(__any(rm>(float)THRL),0)){ const float dl=__builtin_fmaxf(rm,0.f); mhat+=dl; \
        _Pragma("unroll") for(int r=0;r<16;++r){C0[r]-=dl;C1[r]-=dl;} \
        const float f=__builtin_amdgcn_exp2f(-dl); l_reg*=f; if(hi==0)wsf[r32]=f; resc=true; } } \
    SBAR(); \
    GAPB(o[0]=__builtin_amdgcn_mfma_f32_32x32x16_bf16(PAF(0),VFR(0),o[0],0,0,0), C0,0); \
    GAPB(o[1]=__builtin_amdgcn_mfma_f32_32x32x16_bf16(PAF(0),VFR(4),o[1],0,0,0), C0,4); \
    KRD(GL,0); GAPB(o[0]=__builtin_amdgcn_mfma_f32_32x32x16_bf16(PAF(1),VFR(1),o[0],0,0,0), C0,8); \
    KRD(GL,1); GAPB(o[1]=__builtin_amdgcn_mfma_f32_32x32x16_bf16(PAF(1),VFR(5),o[1],0,0,0), C0,12); \
    KRD(GL,2); GAPB(o[0]=__builtin_amdgcn_mfma_f32_32x32x16_bf16(PAF(2),VFR(2),o[0],0,0,0), C1,0); \
    KRD(GL,3); GAPB(o[1]=__builtin_amdgcn_mfma_f32_32x32x16_bf16(PAF(2),VFR(6),o[1],0,0,0), C1,4); \
    GAPB(o[0]=__builtin_amdgcn_mfma_f32_32x32x16_bf16(PAF(3),VFR(3),o[0],0,0,0), C1,8); \
    GAPB(o[1]=__builtin_amdgcn_mfma_f32_32x32x16_bf16(PAF(3),VFR(7),o[1],0,0,0), C1,12); \
    }while(0)
  int t=1;
  #undef CMASK
  #define CMASK(P0,P1,t) do{ unsigned sm_; asm volatile("ds_read_b32 %0, %1\n\ts_waitcnt lgkmcnt(0)":"=v"(sm_):"v"(selw_addr):"memory"); const int pt_=((t)<4)?0:((t)-4)>>2; const int lim_=((t)<4)?(qrel-64*(t)):((((sm_>>pt_)&1u)!=0u)?64:-1); cmask(P0,P1,0,lim_,hi); }while(0)
  for(;t+5<NT;t+=2){
    STEP(pB0,pB1,pA0,pA1,t,true,true,true);     WAIT_BAR(2); RESC(); ROT();
    STEP(pA0,pA1,pB0,pB1,t+1,true,true,true);   WAIT_BAR(2); RESC(); ROT();
  }
  #undef CMASK
  #define CMASK(P0,P1,t) do{ unsigned sm_; asm volatile("ds_read_b32 %0, %1\n\ts_waitcnt lgkmcnt(0)":"=v"(sm_):"v"(selw_addr):"memory"); const int pt_=((t)<4)?0:((t)-4)>>2; const int lim_=((t)<4)?(qrel-64*(t)):((((sm_>>pt_)&1u)!=0u)?64:-1); cmask(P0,P1,0,lim_,hi); }while(0)
  #define ENDW(tt) do{ if((tt)+3<NT){WAIT_BAR(2);} else if((tt)+2<NT){WAIT_BAR(1);} else {WAIT_BAR(0);} }while(0)
  for(;t+1<NT;t+=2){
    STEP(pB0,pB1,pA0,pA1,t,(t+3<NT),(t+1<NT),(t+1<NT));       ENDW(t);   RESC(); ROT();
    STEP(pA0,pA1,pB0,pB1,t+1,(t+4<NT),(t+2<NT),(t+2<NT));     ENDW(t+1); RESC(); ROT();
  }
  STEP(pB0,pB1,pA0,pA1,NT-1,false,false,false); RESC();
  { float sacc=pB0[0]+pB0[1]; _Pragma("unroll") for(int r=2;r<16;++r)sacc+=pB0[r]; _Pragma("unroll") for(int r=0;r<16;++r)sacc+=pB1[r]; l_reg+=sacc;
    pw0=(u32x4){PKW(pB0,0),PKW(pB0,2),PKW(pB0,4),PKW(pB0,6)};pw1=(u32x4){PKW(pB0,8),PKW(pB0,10),PKW(pB0,12),PKW(pB0,14)};pw2=(u32x4){PKW(pB1,0),PKW(pB1,2),PKW(pB1,4),PKW(pB1,6)};pw3=(u32x4){PKW(pB1,8),PKW(pB1,10),PKW(pB1,12),PKW(pB1,14)};
    SBAR(); pv(o,vb0+sl_cur,PAF(0),PAF(1),PAF(2),PAF(3)); }
  #undef PKW
  #undef PAF
  #undef VFR
  #undef PIN
  #undef MX3
  #undef GAPA
  #undef GAPB
  #undef EX
  #undef VRD
  #undef KRD
  #undef STEP
  #undef ENDW
  {auto rr=__builtin_amdgcn_permlane32_swap(__float_as_uint(l_reg),__float_as_uint(l_reg),false,false);l_reg=__uint_as_float(rr[0])+__uint_as_float(rr[1]);}
  if(hi==0)wsf[32+r32]=l_reg;asm volatile("s_waitcnt lgkmcnt(0)":::"memory");
  float rli[16];
  #pragma unroll
  for(int r=0;r<16;++r)rli[r]=__builtin_amdgcn_rcpf(wsf[32+crow(r,hi)]);
  bf16*Ow=O+(rowbase+q0+wid*QBLK)*ODM+h*D;
  { bf16*stg=(bf16*)(shm+LDS_OST)+wid*2048;
    #pragma unroll
    for(int r=0;r<16;++r){const int orow=crow(r,hi);
      #pragma unroll
      for(int d0=0;d0<2;++d0)stg[orow*64+d0*32+r32]=__float2bfloat16(ABL_MOBA?0.f:o[d0][r]*rli[r]);}
    asm volatile("s_waitcnt lgkmcnt(0)":::"memory");
    #pragma unroll
    for(int i=0;i<4;++i){const int row=i*8+(lane>>3),ch=lane&7; const u32x4 v=*(const u32x4*)(stg+row*64+ch*8); ATTN_STORE16(Ow+(long)row*ODM+ch*8,v);} }
  asm volatile("s_waitcnt lgkmcnt(0)\n\ts_barrier":::"memory");
  #undef DMA_K
  #undef DMA_V
  #undef CMASK
  #undef START
  #undef RESC
  #undef ROT
}
constexpr int ATTN_LDS_BYTES=LDS_BYTES;
struct AttnTensors { const bf16* Q; const bf16* K; const bf16* V; bf16* O; const unsigned* SEL; };
struct AttnUnit { int bh; int qb; };
struct StaticOrder {
  int vcu;
  __device__ __forceinline__ explicit StaticOrder(int grid,int block):vcu((block%8)*(grid/8)+block/8){}
  __device__ __forceinline__ bool next(int i,AttnUnit&u)const{ if(i>=4)return false; const int s=vcu&7; u.bh=vcu>>3; u.qb=(i==0)?s:(i==1)?15-s:(i==2)?16+s:31-s; return true; }
  __device__ __forceinline__ void a_ready(const AttnUnit&)const{}
  __device__ __forceinline__ void done(const AttnUnit&)const{}
};
template<class Sched,int THRL=8> __device__ __forceinline__ void attn_phase(char*lds,const AttnTensors&T,const Sched&S,const int wave_s){
  AttnUnit u;
  for(int i=0;S.next(i,u);++i){ S.a_ready(u); attn_unit<THRL>(u.bh/NHEAD,u.bh%NHEAD,u.qb,T.Q,T.K,T.V,T.O,T.SEL,lds,wave_s); S.done(u); }
}
#undef SBAR
#undef WAIT_BAR
}

#define LAS __attribute__((address_space(3)))
#define XB_TMO      128
#define XB_XCNT(j)  (256  + 64 * (j))
#define XB_XSUB(j)  (1280 + 64 * (j))
#define XB_XGEN(j)  (2304 + 64 * (j))
#define XB_TOP      3328
#define XB_TOPGEN   3392
#define XCD_BAR_WORDS 3456
#define XB_SPIN_CAP (1u << 18)

__device__ __forceinline__ unsigned xb_ld(unsigned* p)              { return __hip_atomic_load(p, __ATOMIC_RELAXED, __HIP_MEMORY_SCOPE_AGENT); }
__device__ __forceinline__ unsigned xb_add(unsigned* p, unsigned v) { return __hip_atomic_fetch_add(p, v, __ATOMIC_RELAXED, __HIP_MEMORY_SCOPE_AGENT); }
__device__ __forceinline__ unsigned xb_xcc_id() { return (unsigned)__builtin_amdgcn_s_getreg((3 << 11) | 20) & 0xFu; }
#define XB_SPIN(cond, bar) do { unsigned _sp = 0; while (cond) { __builtin_amdgcn_s_sleep(1); \
    if ((++_sp & 255u) == 0u) { if (xb_ld(&(bar)[XB_TMO])) break; if (_sp > XB_SPIN_CAP) { atomicAdd(&(bar)[XB_TMO], 1u); break; } } } } while (0)

struct XcdBarrier {
    unsigned* bar; unsigned x;
    volatile LAS unsigned* st;
};

__device__ __forceinline__ XcdBarrier xcd_barrier_post(unsigned* bar, volatile LAS unsigned* st) {
    XcdBarrier b; b.bar = bar; b.x = xb_xcc_id(); b.st = st;
    if (threadIdx.x == 0) (void)xb_add(&bar[XB_XCNT(b.x)], 1u);
    return b;
}
__device__ __forceinline__ void xcd_barrier_complete(unsigned* bar, unsigned x, unsigned& nloc, unsigned& nx) {
    const unsigned G = gridDim.x * gridDim.y * gridDim.z;
    unsigned sum, cnt, mine, sp = 0u;
    for (;;) {
        sum = 0u; cnt = 0u; mine = 0u;
#pragma unroll
        for (unsigned j = 0; j < 16; ++j) { const unsigned c = xb_ld(&bar[XB_XCNT(j)]); sum += c; cnt += (c > 0u) ? 1u : 0u; mine = (j == x) ? c : mine; }
        if (sum == G) break;
        __builtin_amdgcn_s_sleep(1);
        if ((++sp & 255u) == 0u) { if (xb_ld(&bar[XB_TMO])) break; if (sp > XB_SPIN_CAP) { atomicAdd(&bar[XB_TMO], 1u); break; } }
    }
    nloc = mine > 0u ? mine : 1u; nx = cnt > 0u ? cnt : 1u;
}

__device__ __forceinline__ void xcd_barrier(const XcdBarrier& b, const bool is_t0) {
    asm volatile("s_waitcnt vmcnt(0)" ::: "memory");
    __syncthreads();
    if (is_t0) {
        unsigned* bar = b.bar;
        __builtin_amdgcn_s_waitcnt(0);
        unsigned nloc = b.st[0], nx = b.st[1];
        if (nloc == 0u) { xcd_barrier_complete(bar, b.x, nloc, nx); b.st[0] = nloc; b.st[1] = nx; }
        const unsigned old = xb_add(&bar[XB_XSUB(b.x)], 1u);
        const unsigned gen = old / nloc;
        if (old + 1u == (gen + 1u) * nloc) {
            __builtin_amdgcn_fence(__ATOMIC_RELEASE, "agent");
            asm volatile("s_waitcnt vmcnt(0)" ::: "memory");
            const unsigned og = xb_add(&bar[XB_TOP], 1u);
            const unsigned tg = og / nx;
            if (og + 1u == (tg + 1u) * nx) xb_add(&bar[XB_TOPGEN], 1u);
            else XB_SPIN(xb_ld(&bar[XB_TOPGEN]) == tg, bar);
            __builtin_amdgcn_fence(__ATOMIC_ACQUIRE, "agent");
            xb_add(&bar[XB_XGEN(b.x)], 1u);
            asm volatile("s_waitcnt vmcnt(0)" ::: "memory");
        } else {
            XB_SPIN(xb_ld(&bar[XB_XGEN(b.x)]) == gen, bar);
            __builtin_amdgcn_fence(__ATOMIC_ACQUIRE, "agent");
            asm volatile("s_waitcnt vmcnt(0)" ::: "memory");
        }
    }
    __syncthreads();
}

#ifndef MOE_SCALE
#define MOE_SCALE 1.0f
#endif
#ifndef DIAG
#define DIAG 0
#endif
#ifndef ABL_MOE
#define ABL_MOE 0
#endif
#ifndef ABL_RWKV
#define ABL_RWKV 0
#endif
#ifndef ABL_DSA
#define ABL_DSA 0
#endif
#ifndef ABL_S5
#define ABL_S5 0
#endif
#ifndef ABL_MOBA
#define ABL_MOBA 0
#endif
#ifndef ABL_FFN0
#define ABL_FFN0 0
#endif
constexpr int NWAVES = 8;
constexpr int T_TOK = 32768, DMODEL = 1024, SEQL = 8192, NBATCH = 4;
constexpr int FFN_D = 2816, ODD_PROJ = 2756, ODD_PAD = 2816, FEXP = 3584, NEXP = 8;
constexpr float NORM_EPS = 1e-6f;
constexpr size_t MiB = 1u << 20;
constexpr size_t WS_CTL = 0, CTL_ZERO_BYTES = 1 * MiB;
constexpr size_t WS_ROPE = 1 * MiB;
constexpr size_t WS_KMEAN = WS_ROPE + 512 * 1024;
constexpr size_t WS_TOKINFO = 2 * MiB;
constexpr size_t WS_TOKSLOT = WS_TOKINFO + 512 * 1024;
constexpr size_t WS_TILEEXP = WS_TOKSLOT + 256 * 1024;
constexpr size_t WS_WE_IN = 3 * MiB;
constexpr size_t WS_WGLU = WS_WE_IN + 4 * MiB;
constexpr size_t WS_WE_OUT = WS_WGLU + MiB / 2;
constexpr size_t WS_WFFN_GU = WS_WE_OUT + 2 * MiB;
constexpr size_t WS_WFFN_D = WS_WFFN_GU + 11 * MiB;
constexpr size_t WS_WO_IN = WS_WFFN_D + 11 * MiB / 2;
constexpr size_t WS_WLORA = WS_WO_IN + 11 * MiB / 2;
constexpr size_t WS_WO_OUT = WS_WLORA + 3 * MiB / 4;
constexpr size_t WS_S5MT = 35 * MiB;
constexpr size_t WS_S5BEND = 55 * MiB;
static_assert(WS_WO_OUT + 2 * MiB <= WS_S5MT, "weights map");
constexpr size_t WS_XN = 64 * MiB;
constexpr size_t WS_CAT = WS_XN;
constexpr size_t WS_UG = 128 * MiB;
constexpr size_t WS_Q0 = 168 * MiB, WS_K0 = 200 * MiB, WS_V0 = 232 * MiB;
constexpr size_t WS_XEND = 264 * MiB;
constexpr size_t WS_YA = 280 * MiB;
constexpr size_t WS_SELM = 312 * MiB;
constexpr size_t WS_ACT = 128 * MiB;
constexpr size_t WS_P1 = 128 * MiB;
constexpr size_t WS_LORA = 304 * MiB;
constexpr size_t WS_QD = 400 * MiB;
constexpr size_t WS_KD = 432 * MiB;
constexpr size_t WS_KI = 436 * MiB;
constexpr size_t WS_QI = 440 * MiB;
constexpr size_t WS_WI = 456 * MiB;
constexpr size_t WS_ALORA = 457 * MiB;
constexpr size_t WS_YR = 457 * MiB;
constexpr int MOE_MAXTILES = 264, MOE_CHUNK = 64;
constexpr size_t WS_XG = 64 * MiB;
constexpr size_t WS_WMOE_GU = 196 * MiB;
constexpr size_t WS_WMOE_D = 308 * MiB;
constexpr size_t WS_ACTQ = 364 * MiB;
constexpr size_t WS_NEED = 490 * MiB;
constexpr int CW_BAR = 4096;
constexpr int MAX_LAUNCH = 36;
constexpr int CW_EXPCNT = 196608;
static_assert((CW_BAR + MAX_LAUNCH * 3456) <= CW_EXPCNT && (CW_EXPCNT + 8 * 64) * 4 <= (int)CTL_ZERO_BYTES, "ctl map");

constexpr int RING_BYTES = 131072;
constexpr int MISC_OFF = RING_BYTES + 320;
constexpr int LDS_BYTES = 147456;

#define GAS __attribute__((address_space(1)))
typedef unsigned short bf16;
typedef unsigned v4u __attribute__((ext_vector_type(4)));
typedef unsigned v2u __attribute__((ext_vector_type(2)));
typedef float f32x4 __attribute__((ext_vector_type(4)));
typedef float f32x2 __attribute__((ext_vector_type(2)));
typedef short bf16x8 __attribute__((ext_vector_type(8)));
#define LDS_WAIT() asm volatile("s_waitcnt lgkmcnt(0)" ::: "memory")
#define VM_WAIT() asm volatile("s_waitcnt vmcnt(0)" ::: "memory")
__device__ __forceinline__ unsigned f2bf(float f) { unsigned u = __builtin_bit_cast(unsigned, f); return (u + 0x7fffu + ((u >> 16) & 1u)) >> 16; }
__device__ __forceinline__ unsigned pk2(float lo, float hi) { return f2bf(lo) | (f2bf(hi) << 16); }
__device__ __forceinline__ float bf2f(unsigned short b) { return __builtin_bit_cast(float, (unsigned)b << 16); }
__device__ __forceinline__ float bflo(unsigned w) { return __builtin_bit_cast(float, w << 16); }
__device__ __forceinline__ float bfhi(unsigned w) { return __builtin_bit_cast(float, w & 0xffff0000u); }
__device__ __forceinline__ void unpack8(const v4u w, float (&o)[8]) { o[0] = bflo(w.x); o[1] = bfhi(w.x); o[2] = bflo(w.y); o[3] = bfhi(w.y); o[4] = bflo(w.z); o[5] = bfhi(w.z); o[6] = bflo(w.w); o[7] = bfhi(w.w); }
__device__ __forceinline__ v4u pack8(const float (&v)[8]) { v4u w; w.x = pk2(v[0], v[1]); w.y = pk2(v[2], v[3]); w.z = pk2(v[4], v[5]); w.w = pk2(v[6], v[7]); return w; }
__device__ __forceinline__ void store8_bf16(bf16* dst, const float (&v)[8]) { *(v4u*)dst = pack8(v); }
__device__ __forceinline__ void load8_bf16(const bf16* src, float (&o)[8]) { const v4u w = *(const v4u*)src; unpack8(w, o); }
__device__ __forceinline__ float wave_sum(float v) {
#pragma unroll
    for (int o = 1; o < 64; o <<= 1) v += __shfl_xor(v, o);
    return v;
}
__device__ __forceinline__ float sigmoidf_(float x) { return 1.0f / (1.0f + __expf(-x)); }
__device__ __forceinline__ float gelu_tanh(float x) { const float z = 0.7978845608028654f * (x + 0.044715f * x * x * x); const float t = 1.0f - 2.0f / (1.0f + __expf(2.0f * z)); return 0.5f * x * (1.0f + t); }


struct Args { const float* in[38]; float* out; unsigned char* ws; int ph_lo, ph_hi, li, pad; };
struct Frame {
    LAS unsigned char* lds;
    int wave, G;
    const float* const* in; float* out; unsigned char* ws;
};
enum InIdx { I_X = 0, I_E_NORM_MIX, I_E_W_IN, I_S5_A_RE, I_S5_A_IM, I_S5_LOG_DT, I_S5_B_RE, I_S5_B_IM, I_S5_C_RE, I_S5_C_IM, I_S5_D, I_S5_GLU_W, I_S5_GLU_B, I_E_W_OUT, I_E_NORM_FFN,
             I_FFN_GATE, I_FFN_UP, I_FFN_DOWN, I_O_NORM_MIX, I_O_W_IN, I_RWKV_MU, I_RWKV_W0, I_RWKV_W_UP, I_RWKV_A0, I_RWKV_A_UP, I_RWKV_G_UP, I_RWKV_K_K, I_RWKV_K_A, I_RWKV_R_K,
             I_RWKV_LN_W, I_RWKV_LN_B, I_O_W_OUT, I_O_NORM_FFN, I_MOE_ROUTER, I_MOE_GATE, I_MOE_UP, I_MOE_DOWN, I_FINAL_NORM };

template <int MODE>
__device__ __forceinline__ void tr_item(const float* __restrict__ W, int K, int N, bf16* __restrict__ WT, int ldo, int row_off, const float* __restrict__ gain, LAS float* scr, int kb, int nb, int lane) {
    const int k0 = 64 * kb, n0 = 32 * nb; const int nn = n0 + (lane & 31);
#pragma unroll 8
    for (int i = 0; i < 32; ++i) { const int kk = 2 * i + (lane >> 5); float w = (nn < N) ? W[(size_t)(k0 + kk) * N + nn] : 0.f; if (gain) w *= gain[k0 + kk]; scr[kk * 33 + (lane & 31)] = w; }
    LDS_WAIT(); asm volatile("" ::: "memory");
    const int c = lane & 7;
#pragma unroll
    for (int j = 0; j < 4; ++j) { const int nl = (lane >> 3) + 8 * j; const int n = n0 + nl; const LAS float* s = scr + (8 * c) * 33 + nl;
        v4u o; o.x = pk2(s[0 * 33], s[1 * 33]); o.y = pk2(s[2 * 33], s[3 * 33]); o.z = pk2(s[4 * 33], s[5 * 33]); o.w = pk2(s[6 * 33], s[7 * 33]);
        const int row = (MODE == 0) ? (row_off + n) : (row_off + (n >> 7) * 256 + (n & 127));
        if (n < N) *(v4u*)(WT + (size_t)row * ldo + k0 + 8 * c) = o; }
    LDS_WAIT(); asm volatile("" ::: "memory");
}
__device__ __forceinline__ void rms_row_to_bf16(const float* xrow, bf16* orow, int lane) {
    const f32x4* xr = (const f32x4*)xrow + lane;
    f32x4 v[4]; float s = 0.f;
#pragma unroll
    for (int j = 0; j < 4; ++j) { v[j] = xr[64 * j]; s += (v[j].x * v[j].x + v[j].y * v[j].y) + (v[j].z * v[j].z + v[j].w * v[j].w); }
    const float rstd = 1.0f / sqrtf(wave_sum(s) * (1.f / DMODEL) + NORM_EPS);
    unsigned long long* o8 = (unsigned long long*)orow + lane;
#pragma unroll
    for (int j = 0; j < 4; ++j) o8[64 * j] = (unsigned long long)pk2(v[j].x * rstd, v[j].y * rstd) | ((unsigned long long)pk2(v[j].z * rstd, v[j].w * rstd) << 32);
}
__device__ __forceinline__ void norm_phase(Frame& F, const float* src, bf16* dst) {
    const int gw = blockIdx.x * NWAVES + F.wave, NGW = F.G * NWAVES, lane = mk_lane();
    for (int m = gw; m < T_TOK; m += NGW) rms_row_to_bf16(src + (size_t)m * DMODEL, dst + (size_t)m * DMODEL, lane);
}

__device__ __forceinline__ void s5_build_group(Frame& F, int g) {
    LAS float* pw_re = (LAS float*)F.lds;
    LAS float* pw_im = pw_re + 33 * 64;
    LAS float* bb_re = pw_im + 33 * 64;
    LAS float* bb_im = bb_re + 1024;
    LAS float* cc_re = bb_im + 1024;
    LAS float* cc_im = cc_re + 1024;
    LAS float* klag = cc_im + 1024;
    LAS float* lm = klag + 8192;
    LAS float* th = lm + 64;
    LAS float* fr = th + 64;
    LAS float* fi = fr + 64;
    const float* a_re = F.in[I_S5_A_RE]; const float* a_im = F.in[I_S5_A_IM]; const float* log_dt = F.in[I_S5_LOG_DT];
    const float* b_re = F.in[I_S5_B_RE]; const float* b_im = F.in[I_S5_B_IM]; const float* c_re = F.in[I_S5_C_RE]; const float* c_im = F.in[I_S5_C_IM];
    const int tid = F.wave * 64 + mk_lane();
    if (tid < 64) { const int p = tid; const float ar = a_re[g * 64 + p], ai = a_im[g * 64 + p], dt = expf(log_dt[g]);
        const float mag = expf(dt * ar); float sn, cs; sincosf(dt * ai, &sn, &cs); const float abr = mag * cs, abi = mag * sn;
        const float den = ar * ar + ai * ai, xr = abr - 1.0f, xi = abi;
        lm[p] = dt * ar; th[p] = dt * ai; fr[p] = (xr * ar + xi * ai) / den; fi[p] = (xi * ar - xr * ai) / den; }
    __syncthreads();
    for (int idx = tid; idx < 33 * 64; idx += 512) { const int tau = idx >> 6, p = idx & 63; const float mag = expf((float)tau * lm[p]); float sn, cs; sincosf((float)tau * th[p], &sn, &cs); pw_re[idx] = mag * cs; pw_im[idx] = mag * sn; }
    for (int idx = tid; idx < 1024; idx += 512) { const int p = idx >> 4; const float br = b_re[(size_t)g * 1024 + idx], bi = b_im[(size_t)g * 1024 + idx];
        bb_re[idx] = fr[p] * br - fi[p] * bi; bb_im[idx] = fr[p] * bi + fi[p] * br;
        cc_re[idx] = c_re[(size_t)g * 1024 + idx]; cc_im[idx] = c_im[(size_t)g * 1024 + idx]; }
    __syncthreads();
    for (int idx = tid; idx < 8192; idx += 512) { const int tau = idx >> 8, c = (idx >> 4) & 15, c2 = idx & 15; float s = 0.f;
        for (int p = 0; p < 64; ++p) { const float cr = cc_re[c * 64 + p], ci = cc_im[c * 64 + p], pr = pw_re[tau * 64 + p], pi = pw_im[tau * 64 + p];
            const float er = cr * pr - ci * pi, ei = cr * pi + ci * pr; s += er * bb_re[p * 16 + c2] - ei * bb_im[p * 16 + c2]; }
        klag[idx] = s; }
    __syncthreads();
    bf16* MT = (bf16*)(F.ws + WS_S5MT) + (size_t)g * 512 * 640;
    for (int ch = tid; ch < 512 * 80; ch += 512) { const int n = ch / 80, kc = ch % 80, t = n >> 4, c = n & 15, k0 = 8 * kc; float v[8];
        if (k0 < 512) { const int s = k0 >> 4, c0 = k0 & 15;
#pragma unroll
            for (int j = 0; j < 8; ++j) v[j] = (s <= t) ? klag[((t - s) * 16 + c) * 16 + c0 + j] : 0.f;
        } else {
#pragma unroll
            for (int j = 0; j < 8; ++j) { const int jj = k0 - 512 + j, p = jj >> 1; const float cr = cc_re[c * 64 + p], ci = cc_im[c * 64 + p], pr = pw_re[(t + 1) * 64 + p], pi = pw_im[(t + 1) * 64 + p];
                v[j] = (jj & 1) ? -(cr * pi + ci * pr) : (cr * pr - ci * pi); }
        }
        store8_bf16(MT + (size_t)n * 640 + k0, v); }
    bf16* BE = (bf16*)(F.ws + WS_S5BEND) + (size_t)g * 256 * 512;
    for (int ch = tid; ch < 256 * 64; ch += 512) { const int n = ch >> 6, kc = ch & 63, k0 = 8 * kc, s = k0 >> 4, c0 = k0 & 15; float v[8];
        if (n < 128) { const int p = n >> 1; const float pr = pw_re[(31 - s) * 64 + p], pi = pw_im[(31 - s) * 64 + p];
#pragma unroll
            for (int j = 0; j < 8; ++j) { const float br = bb_re[p * 16 + c0 + j], bi = bb_im[p * 16 + c0 + j]; v[j] = (n & 1) ? (pr * bi + pi * br) : (pr * br - pi * bi); }
        } else {
#pragma unroll
            for (int j = 0; j < 8; ++j) v[j] = 0.f;
        }
        store8_bf16(BE + (size_t)n * 512 + k0, v); }
    __syncthreads();
}

__device__ __forceinline__ void p0_prologue(Frame& F) {
    if ((int)blockIdx.x < 32) s5_build_group(F, (int)blockIdx.x);
    if (F.G < 32) { for (int g = F.G + (int)blockIdx.x; g < 32; g += F.G) s5_build_group(F, g); }
    LAS float* scr = (LAS float*)(F.lds + F.wave * 16384);
    const int lane = mk_lane(), tid = F.wave * 64 + lane;
    const int gw = blockIdx.x * NWAVES + F.wave, NGW = F.G * NWAVES;
    constexpr int J0 = 16 * 64, J1 = 8 * 16, J2 = 16 * 32, J3 = 16 * 88, J4 = J3, J5 = 44 * 32, J6 = 16 * 87, J7 = 16 * 32;
    constexpr int NIT = J0 + J1 + J2 + J3 + J4 + J5 + J6 + J7;
    unsigned char* ws = F.ws;
    for (int it = gw; it < NIT; it += NGW) {
        int r = it;
        if (r < J0) { tr_item<0>(F.in[I_E_W_IN], 1024, 2048, (bf16*)(ws + WS_WE_IN), 1024, 0, F.in[I_E_NORM_MIX], scr, r / 64, r % 64, lane); continue; } r -= J0;
        if (r < J1) { tr_item<0>(F.in[I_S5_GLU_W], 512, 512, (bf16*)(ws + WS_WGLU), 512, 0, nullptr, scr, r / 16, r % 16, lane); continue; } r -= J1;
        if (r < J2) { tr_item<0>(F.in[I_E_W_OUT], 1024, 1024, (bf16*)(ws + WS_WE_OUT), 1024, 0, nullptr, scr, r / 32, r % 32, lane); continue; } r -= J2;
        if (r < J3) { tr_item<1>(F.in[I_FFN_GATE], 1024, FFN_D, (bf16*)(ws + WS_WFFN_GU), 1024, 0, F.in[I_E_NORM_FFN], scr, r / 88, r % 88, lane); continue; } r -= J3;
        if (r < J4) { tr_item<1>(F.in[I_FFN_UP], 1024, FFN_D, (bf16*)(ws + WS_WFFN_GU), 1024, 128, F.in[I_E_NORM_FFN], scr, r / 88, r % 88, lane); continue; } r -= J4;
        if (r < J5) { tr_item<0>(F.in[I_FFN_DOWN], FFN_D, 1024, (bf16*)(ws + WS_WFFN_D), FFN_D, 0, nullptr, scr, r / 32, r % 32, lane); continue; } r -= J5;
        if (r < J6) { tr_item<0>(F.in[I_O_W_IN], 1024, ODD_PROJ, (bf16*)(ws + WS_WO_IN), 1024, 0, F.in[I_O_NORM_MIX], scr, r / 87, r % 87, lane); continue; } r -= J6;
        tr_item<0>(F.in[I_O_W_OUT], 1024, 1024, (bf16*)(ws + WS_WO_OUT), 1024, 0, nullptr, scr, r / 32, r % 32, lane);
    }
    const int gt = blockIdx.x * 512 + tid, NGT = F.G * 512;
    { bf16* w = (bf16*)(ws + WS_WO_IN) + (size_t)ODD_PROJ * 1024; for (int i = gt; i < (ODD_PAD - ODD_PROJ) * 1024 / 8; i += NGT) *(v4u*)(w + (size_t)i * 8) = (v4u){0u, 0u, 0u, 0u}; }
    { bf16* w = (bf16*)(ws + WS_WLORA); const float* wu = F.in[I_RWKV_W_UP]; const float* au = F.in[I_RWKV_A_UP]; const float* gu = F.in[I_RWKV_G_UP];
      for (int i = gt; i < 1536 * 256; i += NGT) { const int n = i >> 8, k = i & 255; float v = 0.f;
          if (n < 512) { if (k < 64) v = wu[k * 512 + n]; } else if (n < 1024) { if (k >= 64 && k < 128) v = au[(k - 64) * 512 + (n - 512)]; } else { if (k >= 128) v = gu[(k - 128) * 512 + (n - 1024)]; }
          w[i] = (bf16)f2bf(v); } }
    { float* rp = (float*)(ws + WS_ROPE); for (int i = gt; i < 8192 * 8; i += NGT) { const int pos = i >> 3, j = i & 7; const float inv = powf(500000.0f, -(float)j / 8.0f); const float ang = (float)pos * inv;
          rp[pos * 16 + j] = cosf(ang); rp[pos * 16 + 8 + j] = sinf(ang); } }
    norm_phase(F, F.in[I_X], (bf16*)(ws + WS_XN));
}

constexpr float ATT_C2 = 0.125f * 1.4426950408889634f;
struct F_E1 {
    bf16* UG; bf16* Q0; bf16* K0; bf16* V0; const float* rope;
    __device__ __forceinline__ void operator()(const pg8::Unit& u, int r, int c, float (&v)[8], int wc) const {
        const int row = u.pm * 256 + r, col = u.pn * 256 + c, seg = u.pn >> 1;
        if (seg == 0) { const int g = col >> 4, c0 = col & 15; store8_bf16(UG + ((size_t)(g * 1024 + (row >> 5)) * 640 + (row & 31) * 16 + c0), v); }
        else if (seg == 3) { store8_bf16(V0 + (size_t)row * 512 + (col - 1536), v); }
        else { const int ch = col - seg * 512;
            if ((wc & 1) == 0) { float o[8];
#pragma unroll
                for (int j = 0; j < 8; ++j) o[j] = __shfl_xor(v[j], 16);
                const int d = ch & 63;
                if (d < 16) { const float* cs = rope + (size_t)(row & 8191) * 16; const f32x4 c0 = *(const f32x4*)cs, c1 = *(const f32x4*)(cs + 4), s0 = *(const f32x4*)(cs + 8), s1 = *(const f32x4*)(cs + 12);
                    const float cv[8] = {c0.x, c0.y, c0.z, c0.w, c1.x, c1.y, c1.z, c1.w}, sv[8] = {s0.x, s0.y, s0.z, s0.w, s1.x, s1.y, s1.z, s1.w};
                    const float sgn = (d == 0) ? -1.0f : 1.0f;
#pragma unroll
                    for (int j = 0; j < 8; ++j) v[j] = v[j] * cv[j] + sgn * o[j] * sv[j]; } }
            if (seg == 1) {
#pragma unroll
                for (int j = 0; j < 8; ++j) v[j] *= ATT_C2;
                store8_bf16(Q0 + (size_t)row * 512 + ch, v); }
            else store8_bf16(K0 + (size_t)row * 512 + ch, v); }
    }
};
struct F_XEND { float* XEND;
    __device__ __forceinline__ void operator()(const pg8::Unit& u, int r, int c, float (&v)[8], int) const {
        if (c < 128) { float* d = XEND + (size_t)(u.pm * 256 + r) * 128 + c; *(f32x4*)d = (f32x4){v[0], v[1], v[2], v[3]}; *(f32x4*)(d + 4) = (f32x4){v[4], v[5], v[6], v[7]}; } }
};
struct F_S5Y { const bf16* UG; const float* dsk; bf16* YA;
    __device__ __forceinline__ void operator()(const pg8::Unit& u, int r, int c, float (&v)[8], int) const {
        const int row = u.pm * 256 + r, lc = (u.pn & 1) * 256 + c, g = u.pm >> 2, t = lc >> 4, c0 = lc & 15;
        const int token = (row & 1023) * 32 + t, ch = g * 16 + c0;
        float uu[8]; load8_bf16(UG + (size_t)row * 640 + lc, uu);
        const f32x4 d0 = *(const f32x4*)(dsk + ch), d1 = *(const f32x4*)(dsk + ch + 4); const float dv[8] = {d0.x, d0.y, d0.z, d0.w, d1.x, d1.y, d1.z, d1.w};
#pragma unroll
        for (int j = 0; j < 8; ++j) v[j] = gelu_tanh(v[j] + dv[j] * uu[j]);
        store8_bf16(YA + (size_t)token * 512 + ch, v); }
};
struct F_GLU { const bf16* YA; const float* gb; bf16* CAT;
    __device__ __forceinline__ void operator()(const pg8::Unit& u, int r, int c, float (&v)[8], int) const {
        const int row = u.pm * 256 + r, col = u.pn * 256 + c;
        float ya[8]; load8_bf16(YA + (size_t)row * 512 + col, ya);
        const f32x4 b0 = *(const f32x4*)(gb + col), b1 = *(const f32x4*)(gb + col + 4); const float bv[8] = {b0.x, b0.y, b0.z, b0.w, b1.x, b1.y, b1.z, b1.w};
#pragma unroll
        for (int j = 0; j < 8; ++j) v[j] = ABL_S5 ? 0.f : ya[j] * sigmoidf_(v[j] + bv[j]);
        store8_bf16(CAT + (size_t)row * 1024 + col, v); }
};
struct F_RES { const float* base; float* out;
    __device__ __forceinline__ void operator()(const pg8::Unit& u, int r, int c, float (&v)[8], int) const {
        const size_t o = (size_t)(u.pm * 256 + r) * 1024 + u.pn * 256 + c;
        const f32x4 a = *(const f32x4*)(base + o), b = *(const f32x4*)(base + o + 4);
        *(f32x4*)(out + o) = (f32x4){a.x + v[0], a.y + v[1], a.z + v[2], a.w + v[3]}; *(f32x4*)(out + o + 4) = (f32x4){b.x + v[4], b.y + v[5], b.z + v[6], b.w + v[7]}; }
};
struct F_SWIGLU { bf16* ACT; int ld;
    __device__ __forceinline__ void operator()(const pg8::Unit& u, int r, int c, float (&g)[8], float (&p)[8]) const {
        float o[8];
#pragma unroll
        for (int j = 0; j < 8; ++j) o[j] = ABL_FFN0 ? 0.f : g[j] * sigmoidf_(g[j]) * p[j];
        store8_bf16(ACT + (size_t)(u.pm * 256 + r) * ld + u.pn * 128 + c, o); }
};
struct SchedXend { int G, c;
    __device__ __forceinline__ bool next(int i, pg8::Unit& u) const { const int L = i * G + c; if (L >= 128) return false; u.pm = L; u.pn = L >> 2; u.aux = 0; return true; }
    __device__ __forceinline__ void a_ready(const pg8::Unit&) const {}
    __device__ __forceinline__ void done(const pg8::Unit&) const {} };
struct SchedS5Y { int G, c;
    __device__ __forceinline__ bool next(int i, pg8::Unit& u) const { const int L = i * G + c; if (L >= 256) return false; const int g = L >> 3; u.pm = g * 4 + ((L >> 1) & 3); u.pn = g * 2 + (L & 1); u.aux = 0; return true; }
    __device__ __forceinline__ void a_ready(const pg8::Unit&) const {}
    __device__ __forceinline__ void done(const pg8::Unit&) const {} };

__device__ __forceinline__ void kmean_phase(Frame& F) {
    const bf16* K0 = (const bf16*)(F.ws + WS_K0); float* km = (float*)(F.ws + WS_KMEAN); const int tid = F.wave * 64 + mk_lane();
    for (int un = ((int)blockIdx.x + F.G - (128 % F.G)) % F.G; un < 128; un += F.G) { const int b = un >> 5, n = un & 31; const bf16* src = K0 + ((size_t)b * SEQL + n * 256) * 512 + tid; float s = 0.f;
#pragma unroll 8
        for (int i = 0; i < 256; ++i) s += bf2f(src[(size_t)i * 512]);
        const int h = tid >> 6, d = tid & 63; km[((size_t)(b * 8 + h) * 32 + n) * 64 + d] = s * (1.0f / 256.0f); }
}
__device__ __forceinline__ void s5_carry_phase(Frame& F) {
    const int gid = blockIdx.x * 512 + F.wave * 64 + mk_lane();
    if (gid < 8192) { const int p = gid & 63, b = (gid >> 6) & 3, g = gid >> 8;
        const float ar = F.in[I_S5_A_RE][g * 64 + p], ai = F.in[I_S5_A_IM][g * 64 + p], dt = expf(F.in[I_S5_LOG_DT][g]);
        const float mag = expf(32.0f * dt * ar); float sn, cs; sincosf(32.0f * dt * ai, &sn, &cs); const float a_r = mag * cs, a_i = mag * sn;
        const float* __restrict__ xe = (const float*)(F.ws + WS_XEND) + (size_t)(g * 1024 + b * 256) * 128 + 2 * p;
        unsigned* __restrict__ ug = (unsigned*)((bf16*)(F.ws + WS_UG) + (size_t)(g * 1024 + b * 256) * 640 + 512 + 2 * p);
        float cr = 0.f, ci = 0.f;
        for (int c0 = 0; c0 < 256; c0 += 8) { f32x2 x[8];
#pragma unroll
            for (int j = 0; j < 8; ++j) x[j] = *(const f32x2*)(xe + (size_t)(c0 + j) * 128);
#pragma unroll
            for (int j = 0; j < 8; ++j) { ug[(size_t)(c0 + j) * 320] = pk2(cr, ci); const float nr = a_r * cr - a_i * ci + x[j].x, ni = a_r * ci + a_i * cr + x[j].y; cr = nr; ci = ni; } } }
}
__device__ __forceinline__ void moba_select_phase(Frame& F) {
    LAS float* km = (LAS float*)F.lds;
    const bf16* Q0 = (const bf16*)(F.ws + WS_Q0); const float* kmg = (const float*)(F.ws + WS_KMEAN); unsigned* SELM = (unsigned*)(F.ws + WS_SELM); const int tid = F.wave * 64 + mk_lane();
    for (int un = blockIdx.x; un < 512; un += F.G) { const int b = un >> 7, qb = (un >> 2) & 31, hp = un & 3;
        for (int i = tid; i < 4096; i += 512) km[i] = kmg[(size_t)(b * 8 + hp * 2 + (i >> 11)) * 2048 + (i & 2047)];
        __syncthreads();
        const int hl = tid >> 8, tl = tid & 255, h = hp * 2 + hl, t = qb * 256 + tl;
        float q[64]; const bf16* qp = Q0 + ((size_t)b * SEQL + t) * 512 + h * 64;
#pragma unroll
        for (int j = 0; j < 8; ++j) { float tmp[8]; load8_bf16(qp + 8 * j, tmp);
#pragma unroll
            for (int e = 0; e < 8; ++e) q[8 * j + e] = tmp[e]; }
        float v1 = -INFINITY, v2 = -INFINITY, v3 = -INFINITY; int i1 = -1, i2 = -1, i3 = -1;
        for (int n = 0; n < qb; ++n) { const LAS float* kp = km + (hl * 32 + n) * 64; float s = 0.f;
#pragma unroll
            for (int d = 0; d < 64; d += 4) { const f32x4 kv = *(const LAS f32x4*)(kp + d); s += q[d] * kv.x + q[d + 1] * kv.y + q[d + 2] * kv.z + q[d + 3] * kv.w; }
            if (s > v1) { v3 = v2; i3 = i2; v2 = v1; i2 = i1; v1 = s; i1 = n; } else if (s > v2) { v3 = v2; i3 = i2; v2 = s; i2 = n; } else if (s > v3) { v3 = s; i3 = n; } }
        unsigned m = 1u << qb; if (i1 >= 0) m |= 1u << i1; if (i2 >= 0) m |= 1u << i2; if (i3 >= 0) m |= 1u << i3;
        SELM[(size_t)(b * 8 + h) * SEQL + t] = m;
        __syncthreads(); }
}

constexpr int P1_LD = ODD_PAD;
constexpr int PC_R = 0, PC_K = 512, PC_V = 1024, PC_WD = 1536, PC_AD = 1600, PC_GD = 1664, PC_Q = 1792, PC_KD = 2304, PC_VD = 2368, PC_QI = 2432, PC_KI = 2688, PC_WI = 2752;
struct F_P1 { bf16* P1;
    __device__ __forceinline__ void operator()(const pg8::Unit& u, int r, int c, float (&v)[8], int) const { store8_bf16(P1 + (size_t)(u.pm * 256 + r) * P1_LD + u.pn * 256 + c, v); } };
struct F_LORA { bf16* LORA; const float* w0; const float* a0;
    __device__ __forceinline__ void operator()(const pg8::Unit& u, int r, int c, float (&v)[8], int) const {
        const int row = u.pm * 256 + r, col = u.pn * 256 + c, seg = u.pn >> 1;
        if (seg == 0) {
#pragma unroll
            for (int j = 0; j < 8; ++j) v[j] = -0.6065306597126334f * sigmoidf_(w0[col + j] + v[j]); }
        else if (seg == 1) {
#pragma unroll
            for (int j = 0; j < 8; ++j) v[j] = sigmoidf_(a0[col - 512 + j] + v[j]); }
        store8_bf16(LORA + (size_t)row * 1536 + col, v); }
};
struct F_MOEGU { bf16* ACTQ; int rt0;
    __device__ __forceinline__ void operator()(const pg8::Unit& u, int r, int c, float (&g)[8], float (&p)[8]) const {
        float o[8];
#pragma unroll
        for (int j = 0; j < 8; ++j) o[j] = g[j] * sigmoidf_(g[j]) * p[j];
        store8_bf16(ACTQ + (size_t)((u.pm - rt0) * 256 + r) * FEXP + u.aux * 128 + c, o); }
};
struct F_MOED { bf16* YS;
    __device__ __forceinline__ void operator()(const pg8::Unit& u, int r, int c, float (&v)[8], int) const { store8_bf16(YS + (size_t)(u.aux * 256 + r) * 1024 + (u.pn & 3) * 256 + c, v); } };
struct SchedMoeGU { const int* tile_exp; int rt0, ntq, G, c;
    __device__ __forceinline__ bool next(int i, pg8::Unit& u) const { const int L = i * G + c; if (L >= ntq * 28) return false; const int rt = rt0 + L % ntq, pn = L / ntq; const int e = tile_exp[rt]; u.pm = rt; u.pn = e * 28 + pn; u.aux = pn; return true; }
    __device__ __forceinline__ void a_ready(const pg8::Unit&) const {}
    __device__ __forceinline__ void done(const pg8::Unit&) const {} };
struct SchedMoeD { const int* tile_exp; int rt0, ntq, G, c;
    __device__ __forceinline__ bool next(int i, pg8::Unit& u) const { const int L = i * G + c; if (L >= ntq * 4) return false; const int rt = rt0 + L % ntq, pn = L / ntq; const int e = tile_exp[rt]; u.pm = rt - rt0; u.pn = e * 4 + pn; u.aux = rt; return true; }
    __device__ __forceinline__ void a_ready(const pg8::Unit&) const {}
    __device__ __forceinline__ void done(const pg8::Unit&) const {} };

__device__ __forceinline__ void rope8_x1(float (&v)[8], int d0, const float* cs) {
    float o[8];
#pragma unroll
    for (int j = 0; j < 8; ++j) o[j] = __shfl_xor(v[j], 1);
    if (d0 < 16) { const f32x4 c0 = *(const f32x4*)cs, c1 = *(const f32x4*)(cs + 4), s0 = *(const f32x4*)(cs + 8), s1 = *(const f32x4*)(cs + 12);
        const float cv[8] = {c0.x, c0.y, c0.z, c0.w, c1.x, c1.y, c1.z, c1.w}, sv[8] = {s0.x, s0.y, s0.z, s0.w, s1.x, s1.y, s1.z, s1.w};
        const float sgn = (d0 == 0) ? -1.0f : 1.0f;
#pragma unroll
        for (int j = 0; j < 8; ++j) v[j] = v[j] * cv[j] + sgn * o[j] * sv[j]; }
}
__device__ __forceinline__ void l1_prep_phase(Frame& F) {
    const int gw = blockIdx.x * NWAVES + F.wave, NGW = F.G * NWAVES, lane = mk_lane();
    const bf16* P1 = (const bf16*)(F.ws + WS_P1); const float* mu = F.in[I_RWKV_MU]; const float* rope = (const float*)(F.ws + WS_ROPE);
    bf16* ALORA = (bf16*)(F.ws + WS_ALORA); bf16* QD = (bf16*)(F.ws + WS_QD); bf16* KD = (bf16*)(F.ws + WS_KD); bf16* KI = (bf16*)(F.ws + WS_KI); bf16* QI = (bf16*)(F.ws + WS_QI); float* WI = (float*)(F.ws + WS_WI);
    for (int tok = gw; tok < T_TOK; tok += NGW) { const bf16* row = P1 + (size_t)tok * P1_LD; const int pos = tok & (SEQL - 1); const float* cs = rope + (size_t)pos * 16;
        if (lane < 32) { const int col = PC_WD + 8 * lane; float cur[8], prv[8]; load8_bf16(row + col, cur);
            if (pos != 0) load8_bf16(row - P1_LD + col, prv); else {
#pragma unroll
                for (int j = 0; j < 8; ++j) prv[j] = 0.f; }
#pragma unroll
            for (int j = 0; j < 8; ++j) { const float x = cur[j] + (prv[j] - cur[j]) * mu[col + j];
                cur[j] = (lane < 8) ? tanhf(x) : ((lane < 16) ? x : sigmoidf_(x)); }
            store8_bf16(ALORA + (size_t)tok * 256 + 8 * lane, cur); }
        { float v[8]; load8_bf16(row + PC_Q + 8 * lane, v); rope8_x1(v, 8 * (lane & 7), cs);
#pragma unroll
          for (int j = 0; j < 8; ++j) v[j] *= ATT_C2;
          store8_bf16(QD + (size_t)tok * 512 + 8 * lane, v); }
        { const int src = (lane < 32) ? (PC_QI + 8 * lane) : ((lane < 40) ? (PC_KD + 8 * (lane - 32)) : (PC_KI + 8 * (lane & 7)));
          float v[8]; load8_bf16(row + src, v); rope8_x1(v, 8 * (lane & 7), cs);
          if (lane < 32) store8_bf16(QI + (size_t)tok * 256 + 8 * lane, v);
          else if (lane < 40) store8_bf16(KD + (size_t)tok * 64 + 8 * (lane - 32), v);
          else if (lane < 48) store8_bf16(KI + (size_t)tok * 64 + 8 * (lane - 40), v); }
        if (lane < 4) WI[(size_t)tok * 4 + lane] = bf2f(row[PC_WI + lane]) * 0.0625f;
    }
}
__device__ __forceinline__ void rwkv_post_phase(Frame& F) {
    const int gw = blockIdx.x * NWAVES + F.wave, NGW = F.G * NWAVES, lane = mk_lane();
    const bf16* P1 = (const bf16*)(F.ws + WS_P1); const bf16* LORA = (const bf16*)(F.ws + WS_LORA); const bf16* YR = (const bf16*)(F.ws + WS_YR); bf16* CAT2 = (bf16*)(F.ws + WS_CAT);
    const float* mu = F.in[I_RWKV_MU]; const float* k_a = F.in[I_RWKV_K_A]; const float* r_k = F.in[I_RWKV_R_K]; const float* ln_w = F.in[I_RWKV_LN_W]; const float* ln_b = F.in[I_RWKV_LN_B];
    for (int it = gw; it < T_TOK * 8; it += NGW) { const int tok = it >> 3, h = it & 7, ch = h * 64 + lane; const bool first = (tok & (SEQL - 1)) == 0;
        const bf16* row = P1 + (size_t)tok * P1_LD; const bf16* prow = row - P1_LD;
        const float rc = bf2f(row[PC_R + ch]), kc = bf2f(row[PC_K + ch]), vc = bf2f(row[PC_V + ch]);
        const float rp = first ? 0.f : bf2f(prow[PC_R + ch]), kp = first ? 0.f : bf2f(prow[PC_K + ch]), vp = first ? 0.f : bf2f(prow[PC_V + ch]);
        const float r = rc + (rp - rc) * mu[PC_R + ch], k0 = kc + (kp - kc) * mu[PC_K + ch], v = vc + (vp - vc) * mu[PC_V + ch];
        const float a = bf2f(LORA[(size_t)tok * 1536 + 512 + ch]), g = bf2f(LORA[(size_t)tok * 1536 + 1024 + ch]);
        const float k = k0 * (1.0f + (a - 1.0f) * k_a[ch]);
        const float y = bf2f(YR[(size_t)tok * 512 + ch]);
        const float mean = wave_sum(y) * (1.0f / 64.0f); const float dy = y - mean; const float var = wave_sum(dy * dy) * (1.0f / 64.0f);
        const float yn = dy * (1.0f / sqrtf(var + 64e-5f)) * ln_w[ch] + ln_b[ch];
        const float bonus = wave_sum(r * k * r_k[ch]) * v;
        CAT2[(size_t)tok * 1024 + ch] = ABL_RWKV ? (bf16)0 : (bf16)f2bf((yn + bonus) * g); }
}
__device__ __forceinline__ void moe_convert_phase(Frame& F) {
    LAS float* scr = (LAS float*)(F.lds + F.wave * 16384); const int lane = mk_lane();
    const int gw = blockIdx.x * NWAVES + F.wave, NGW = F.G * NWAVES;
    constexpr int PER = 1792, NIT = 3 * 8 * PER;
    bf16* WGU = (bf16*)(F.ws + WS_WMOE_GU); bf16* WD = (bf16*)(F.ws + WS_WMOE_D);
    for (int it = gw; it < NIT; it += NGW) { const int m = it / (8 * PER), r = it % (8 * PER), e = r / PER, q = r % PER;
        if (m == 0) tr_item<1>(F.in[I_MOE_GATE] + (size_t)e * 1024 * FEXP, 1024, FEXP, WGU, 1024, e * 7168, F.in[I_O_NORM_FFN], scr, q / 112, q % 112, lane);
        else if (m == 1) tr_item<1>(F.in[I_MOE_UP] + (size_t)e * 1024 * FEXP, 1024, FEXP, WGU, 1024, e * 7168 + 128, F.in[I_O_NORM_FFN], scr, q / 112, q % 112, lane);
        else tr_item<0>(F.in[I_MOE_DOWN] + (size_t)e * FEXP * 1024, FEXP, 1024, WD, FEXP, e * 1024, nullptr, scr, q / 32, q % 32, lane); }
}
__device__ __forceinline__ void router_phase(Frame& F) {
    const int gw = blockIdx.x * NWAVES + F.wave, NGW = F.G * NWAVES, lane = mk_lane();
    const float* gn = F.in[I_O_NORM_FFN]; const float* rt = F.in[I_MOE_ROUTER]; unsigned* cnt = (unsigned*)(F.ws + WS_CTL) + CW_EXPCNT; v2u* info = (v2u*)(F.ws + WS_TOKINFO);
    for (int tok = gw; tok < T_TOK; tok += NGW) { const f32x4* xr = (const f32x4*)(F.out + (size_t)tok * DMODEL) + lane; f32x4 v[4]; float s = 0.f;
#pragma unroll
        for (int j = 0; j < 4; ++j) { v[j] = xr[64 * j]; s += (v[j].x * v[j].x + v[j].y * v[j].y) + (v[j].z * v[j].z + v[j].w * v[j].w); }
        const float rstd = 1.0f / sqrtf(wave_sum(s) * (1.f / DMODEL) + NORM_EPS);
        float lg[8] = {0.f, 0.f, 0.f, 0.f, 0.f, 0.f, 0.f, 0.f};
#pragma unroll
        for (int j = 0; j < 4; ++j) { const int k0 = 4 * (lane + 64 * j); const f32x4 gg = *(const f32x4*)(gn + k0); const float xv[4] = {v[j].x * rstd * gg.x, v[j].y * rstd * gg.y, v[j].z * rstd * gg.z, v[j].w * rstd * gg.w};
#pragma unroll
            for (int q = 0; q < 4; ++q) { const f32x4 w0 = *(const f32x4*)(rt + (size_t)(k0 + q) * 8), w1 = *(const f32x4*)(rt + (size_t)(k0 + q) * 8 + 4);
                lg[0] += xv[q] * w0.x; lg[1] += xv[q] * w0.y; lg[2] += xv[q] * w0.z; lg[3] += xv[q] * w0.w; lg[4] += xv[q] * w1.x; lg[5] += xv[q] * w1.y; lg[6] += xv[q] * w1.z; lg[7] += xv[q] * w1.w; } }
#pragma unroll
        for (int e = 0; e < 8; ++e) lg[e] = wave_sum(lg[e]);
        int e1 = 0; float l1 = lg[0];
#pragma unroll
        for (int e = 1; e < 8; ++e) if (lg[e] > l1) { l1 = lg[e]; e1 = e; }
        int e2 = -1; float l2 = -INFINITY;
#pragma unroll
        for (int e = 0; e < 8; ++e) if (e != e1 && lg[e] > l2) { l2 = lg[e]; e2 = e; }
        const float g1 = 1.0f / (1.0f + __expf(l2 - l1)), g2 = 1.0f - g1;
        if (lane == 0) { const unsigned r1 = atomicAdd(cnt + 64 * e1, 1u), r2 = atomicAdd(cnt + 64 * e2, 1u);
            info[(size_t)tok * 2] = (v2u){((unsigned)e1 << 24) | r1, __builtin_bit_cast(unsigned, g1)}; info[(size_t)tok * 2 + 1] = (v2u){((unsigned)e2 << 24) | r2, __builtin_bit_cast(unsigned, g2)}; } }
}
__device__ __forceinline__ void moe_scatter_phase(Frame& F) {
    const int gw = blockIdx.x * NWAVES + F.wave, NGW = F.G * NWAVES, lane = mk_lane();
    const unsigned* cnt = (const unsigned*)(F.ws + WS_CTL) + CW_EXPCNT; const v2u* info = (const v2u*)(F.ws + WS_TOKINFO); int* tokslot = (int*)(F.ws + WS_TOKSLOT); int* tile_exp = (int*)(F.ws + WS_TILEEXP);
    int pstart[8]; int acc = 0;
#pragma unroll
    for (int e = 0; e < 8; ++e) { const int c = (int)__hip_atomic_load(cnt + 64 * e, __ATOMIC_RELAXED, __HIP_MEMORY_SCOPE_AGENT); pstart[e] = acc; acc += (c + 255) & ~255; }
    const int ntiles = acc >> 8;
    if (blockIdx.x == 0 && F.wave == 0) { for (int t = lane; t < 512; t += 64) { int e = 7;
#pragma unroll
            for (int q = 7; q >= 1; --q) if (t * 256 < pstart[q]) e = q - 1;
            tile_exp[t] = (t == 511) ? ntiles : e; } }
    bf16* XG = (bf16*)(F.ws + WS_XG);
    for (int tok = gw; tok < T_TOK; tok += NGW) { const f32x4* xr = (const f32x4*)(F.out + (size_t)tok * DMODEL) + lane; f32x4 v[4]; float s = 0.f;
#pragma unroll
        for (int j = 0; j < 4; ++j) { v[j] = xr[64 * j]; s += (v[j].x * v[j].x + v[j].y * v[j].y) + (v[j].z * v[j].z + v[j].w * v[j].w); }
        const float rstd = 1.0f / sqrtf(wave_sum(s) * (1.f / DMODEL) + NORM_EPS);
        unsigned long long w[4];
#pragma unroll
        for (int j = 0; j < 4; ++j) w[j] = (unsigned long long)pk2(v[j].x * rstd, v[j].y * rstd) | ((unsigned long long)pk2(v[j].z * rstd, v[j].w * rstd) << 32);
#pragma unroll
        for (int k = 0; k < 2; ++k) { const v2u inf = info[(size_t)tok * 2 + k]; const int e = (int)(inf.x >> 24), rank = (int)(inf.x & 0xffffffu);
            int ps = 0;
#pragma unroll
            for (int q = 0; q < 8; ++q) ps = (e == q) ? pstart[q] : ps;
            const int slot = ps + rank; unsigned long long* o8 = (unsigned long long*)(XG + (size_t)slot * 1024) + lane;
#pragma unroll
            for (int j = 0; j < 4; ++j) o8[64 * j] = w[j];
            if (lane == 0) tokslot[(size_t)tok * 2 + k] = slot; } }
}
__device__ __forceinline__ void moe_combine_final_phase(Frame& F) {
    const int gw = blockIdx.x * NWAVES + F.wave, NGW = F.G * NWAVES, lane = mk_lane(); const float* gn = F.in[I_FINAL_NORM];
    const v2u* info = (const v2u*)(F.ws + WS_TOKINFO); const int* tokslot = (const int*)(F.ws + WS_TOKSLOT); const bf16* YS = (const bf16*)(F.ws + WS_XG);
    f32x4 gv[4];
#pragma unroll
    for (int j = 0; j < 4; ++j) gv[j] = ((const f32x4*)gn)[lane + 64 * j];
    for (int tok = gw; tok < T_TOK; tok += NGW) { f32x4* xr = (f32x4*)(F.out + (size_t)tok * DMODEL) + lane; f32x4 v[4];
#pragma unroll
        for (int j = 0; j < 4; ++j) v[j] = xr[64 * j];
#pragma unroll
        for (int k = 0; k < 2; ++k) { const unsigned gkb = info[(size_t)tok * 2 + k].y; const float gk = MOE_SCALE * __builtin_bit_cast(float, gkb);     const int slot = tokslot[(size_t)tok * 2 + k];
            const v2u* yr = (const v2u*)(YS + (size_t)slot * 1024) + lane;
#pragma unroll
            for (int j = 0; j < 4; ++j) { v2u w = yr[64 * j]; if (ABL_MOE) w = (v2u){0u, 0u}; v[j].x += gk * bflo(w.x); v[j].y += gk * bfhi(w.x); v[j].z += gk * bflo(w.y); v[j].w += gk * bfhi(w.y); } }
        float s = 0.f;
#pragma unroll
        for (int j = 0; j < 4; ++j) s += (v[j].x * v[j].x + v[j].y * v[j].y) + (v[j].z * v[j].z + v[j].w * v[j].w);
        const float rstd = 1.0f / sqrtf(wave_sum(s) * (1.f / DMODEL) + NORM_EPS);
#pragma unroll
        for (int j = 0; j < 4; ++j) xr[64 * j] = v[j] * rstd * gv[j]; }
}

__device__ __forceinline__ float dpp_sum8(float x) {
    x += __builtin_bit_cast(float, __builtin_amdgcn_mov_dpp(__builtin_bit_cast(int, x), 0xB1, 0xf, 0xf, true));
    x += __builtin_bit_cast(float, __builtin_amdgcn_mov_dpp(__builtin_bit_cast(int, x), 0x4E, 0xf, 0xf, true));
    x += __builtin_bit_cast(float, __builtin_amdgcn_mov_dpp(__builtin_bit_cast(int, x), 0x141, 0xf, 0xf, true));
    return x;
}
constexpr int RW_STEPS = 32, RW_REC = 5 * 64, RW_BUF_FLOATS = RW_STEPS * RW_REC + RW_STEPS * 32;
__device__ __forceinline__ void rwkv_produce(Frame& F, LAS float* buf, int b, int h, int half, int j, int pw, int lane) {
    const bf16* P1 = (const bf16*)(F.ws + WS_P1); const bf16* LORA = (const bf16*)(F.ws + WS_LORA);
    const float* mu = F.in[I_RWKV_MU]; const int ch = h * 64 + lane;
    const float mu_r = mu[PC_R + ch], mu_k = mu[PC_K + ch], mu_v = mu[PC_V + ch], kkw = F.in[I_RWKV_K_K][ch], kaw = F.in[I_RWKV_K_A][ch];
    float rc[8], kc[8], vc[8], rp[8], kp[8], vp[8], lw[8], al[8];
#pragma unroll
    for (int i = 0; i < 8; ++i) { const int tt = 8 * pw + i, pos = 32 * j + tt; const size_t tok = (size_t)b * SEQL + pos; const bf16* row = P1 + tok * P1_LD; const bf16* prow = (pos == 0) ? row : (row - P1_LD);
        rc[i] = bf2f(row[PC_R + ch]); kc[i] = bf2f(row[PC_K + ch]); vc[i] = bf2f(row[PC_V + ch]);
        rp[i] = bf2f(prow[PC_R + ch]); kp[i] = bf2f(prow[PC_K + ch]); vp[i] = bf2f(prow[PC_V + ch]);
        lw[i] = bf2f(LORA[tok * 1536 + ch]); al[i] = bf2f(LORA[tok * 1536 + 512 + ch]); }
#pragma unroll
    for (int i = 0; i < 8; ++i) { const int tt = 8 * pw + i, pos = 32 * j + tt; const bool first = (pos == 0);
        const float r = rc[i] + ((first ? 0.f : rp[i]) - rc[i]) * mu_r, k0 = kc[i] + ((first ? 0.f : kp[i]) - kc[i]) * mu_k, v = vc[i] + ((first ? 0.f : vp[i]) - vc[i]) * mu_v;
        const float kkv = k0 * kkw; const float nrm = sqrtf(wave_sum(kkv * kkv)); const float kk = kkv / fmaxf(nrm, 1e-12f);
        const float a = al[i]; LAS float* rec = buf + tt * RW_REC;
        rec[lane] = __expf(lw[i]); rec[64 + lane] = -kk; rec[128 + lane] = kk * a; rec[192 + lane] = k0 * (1.0f + (a - 1.0f) * kaw); rec[256 + lane] = r;
        if ((lane >> 5) == half) buf[RW_STEPS * RW_REC + tt * 32 + (lane & 31)] = v; }
}
__device__ __forceinline__ void rwkv_seq_block(Frame& F, int blk) {
    const int bh = blk >> 1, half = blk & 1, b = bh >> 3, h = bh & 7; const int lane = mk_lane(), wave = F.wave;
    LAS float* buf0 = (LAS float*)F.lds; LAS float* buf1 = buf0 + RW_BUF_FLOATS;
    bf16* YR = (bf16*)(F.ws + WS_YR);
    const int rowl = 8 * (wave & 3) + (lane >> 3), kg = lane & 7;
    f32x2 s[4] = {{0.f, 0.f}, {0.f, 0.f}, {0.f, 0.f}, {0.f, 0.f}};
    if (wave >= 4) rwkv_produce(F, buf0, b, h, half, 0, wave - 4, lane);
    __syncthreads();
    for (int j = 0; j < SEQL / RW_STEPS; ++j) { LAS float* cur = (j & 1) ? buf1 : buf0; LAS float* nxt = (j & 1) ? buf0 : buf1;
        if (wave >= 4) { if (j + 1 < SEQL / RW_STEPS) rwkv_produce(F, nxt, b, h, half, j + 1, wave - 4, lane); }
        else { bf16* yo = YR + ((size_t)b * SEQL + 32 * j) * 512 + h * 64 + 32 * half + rowl;
#pragma unroll 4
            for (int t = 0; t < RW_STEPS; ++t) { const LAS float* rec = cur + t * RW_REC + 8 * kg;
                const f32x4 w0 = *(const LAS f32x4*)(rec), w1 = *(const LAS f32x4*)(rec + 4), a0 = *(const LAS f32x4*)(rec + 64), a1 = *(const LAS f32x4*)(rec + 68);
                const f32x4 b0 = *(const LAS f32x4*)(rec + 128), b1 = *(const LAS f32x4*)(rec + 132), k0 = *(const LAS f32x4*)(rec + 192), k1 = *(const LAS f32x4*)(rec + 196);
                const f32x4 r0 = *(const LAS f32x4*)(rec + 256), r1 = *(const LAS f32x4*)(rec + 260);
                const float vv = cur[RW_STEPS * RW_REC + t * 32 + rowl];
                f32x2 sa2 = s[0] * (f32x2){a0.x, a0.y} + s[1] * (f32x2){a0.z, a0.w} + s[2] * (f32x2){a1.x, a1.y} + s[3] * (f32x2){a1.z, a1.w};
                const float sa = dpp_sum8(sa2.x + sa2.y); const f32x2 sav = {sa, sa}, vvv = {vv, vv};
                s[0] = s[0] * (f32x2){w0.x, w0.y} + sav * (f32x2){b0.x, b0.y} + vvv * (f32x2){k0.x, k0.y};
                s[1] = s[1] * (f32x2){w0.z, w0.w} + sav * (f32x2){b0.z, b0.w} + vvv * (f32x2){k0.z, k0.w};
                s[2] = s[2] * (f32x2){w1.x, w1.y} + sav * (f32x2){b1.x, b1.y} + vvv * (f32x2){k1.x, k1.y};
                s[3] = s[3] * (f32x2){w1.z, w1.w} + sav * (f32x2){b1.z, b1.w} + vvv * (f32x2){k1.z, k1.w};
                f32x2 y2 = s[0] * (f32x2){r0.x, r0.y} + s[1] * (f32x2){r0.z, r0.w} + s[2] * (f32x2){r1.x, r1.y} + s[3] * (f32x2){r1.z, r1.w};
                const float y = dpp_sum8(y2.x + y2.y);
                if (kg == 0) yo[(size_t)t * 512] = (bf16)f2bf(y); } }
        __syncthreads(); }
}

typedef float f32x4_t __attribute__((ext_vector_type(4)));
constexpr int DSA_SEL_OFF = 131072 + 1024, DSA_META_OFF = DSA_SEL_OFF + 16 * 256 * 2, DSA_CAND_CAP = 1024;
constexpr int CW_DSAQ = CW_EXPCNT + 8 * 64;
static_assert(DSA_META_OFF + 512 <= LDS_BYTES && (CW_DSAQ + 1) * 4 <= (int)CTL_ZERO_BYTES, "dsa lds / ctl map");
__device__ __forceinline__ unsigned f32_order_key(float x) { x = x + 0.0f; const unsigned u = __builtin_bit_cast(unsigned, x); return (u & 0x80000000u) ? ~u : (u | 0x80000000u); }
template <int MODE>
__device__ __forceinline__ void dsa_score_pass(const bf16* __restrict__ KIb, const bf16x8 (&qa)[4][2], const float (&wq)[4][4], int t0, int nkt, int wave, int lane,
                                               LAS unsigned* hist, LAS unsigned short* sel, LAS int* meta) {
    const int g = lane >> 4, c = lane & 15;
    int bst[4] = {0, 0, 0, 0};
    if (MODE == 1) {
#pragma unroll
        for (int m = 0; m < 4; ++m) bst[m] = meta[4 * m + g]; }
    for (int kt = wave; kt < nkt; kt += 8) { const bf16* kp = KIb + (size_t)(16 * kt + c) * 64 + 8 * g;
        const bf16x8 kb0 = *(const bf16x8*)kp, kb1 = *(const bf16x8*)(kp + 32); const int key = 16 * kt + c;
#pragma unroll
        for (int m = 0; m < 4; ++m) { f32x4_t acc = {0.f, 0.f, 0.f, 0.f};
            acc = __builtin_amdgcn_mfma_f32_16x16x32_bf16(qa[m][0], kb0, acc, 0, 0, 0); acc = __builtin_amdgcn_mfma_f32_16x16x32_bf16(qa[m][1], kb1, acc, 0, 0, 0);
            float sc = fmaxf(acc[0], 0.f) * wq[m][0]; sc += fmaxf(acc[1], 0.f) * wq[m][1]; sc += fmaxf(acc[2], 0.f) * wq[m][2]; sc += fmaxf(acc[3], 0.f) * wq[m][3];
            const int q = 4 * m + g;
            if (key <= t0 + q) { const unsigned uk = f32_order_key(sc); const int bin = (int)(uk >> 20);
                if (MODE == 0) { __hip_atomic_fetch_add(hist + q * 2048 + (bin >> 1), 1u << (16 * (bin & 1)), __ATOMIC_RELAXED, __HIP_MEMORY_SCOPE_WORKGROUP); }
                else { if (bin > bst[m]) { const int p = __hip_atomic_fetch_add((LAS unsigned*)(meta + 32 + q), 1u, __ATOMIC_RELAXED, __HIP_MEMORY_SCOPE_WORKGROUP); if (p < 256) sel[q * 256 + p] = (unsigned short)key; }
                       else if (bin == bst[m]) { const int p = __hip_atomic_fetch_add((LAS unsigned*)(meta + 48 + q), 1u, __ATOMIC_RELAXED, __HIP_MEMORY_SCOPE_WORKGROUP);
                           if (p < DSA_CAND_CAP) { hist[(q * DSA_CAND_CAP + p) * 2] = uk; hist[(q * DSA_CAND_CAP + p) * 2 + 1] = (unsigned)key; } } } } } }
}
__device__ __forceinline__ void dsa_tile(Frame& F, int item) {
    const int lane = mk_lane(), wave = F.wave, tid = wave * 64 + lane;
    const int b = item & 3, ti = 511 - (item >> 2), t0 = 16 * ti, nkt = ti + 1; const size_t tok0 = (size_t)b * SEQL + t0;
    LAS unsigned* hist = (LAS unsigned*)F.lds; LAS unsigned short* sel = (LAS unsigned short*)(F.lds + DSA_SEL_OFF); LAS int* meta = (LAS int*)(F.lds + DSA_META_OFF);
    const bf16* QI = (const bf16*)(F.ws + WS_QI); const bf16* KIb = (const bf16*)(F.ws + WS_KI) + (size_t)b * SEQL * 64; const float* WI = (const float*)(F.ws + WS_WI);
    const int g = lane >> 4, c = lane & 15;
    if (ti >= 16) {
        for (int i = tid; i < 32768 / 4; i += 512) ((LAS v4u*)hist)[i] = (v4u){0u, 0u, 0u, 0u};
        if (tid < 64) meta[tid] = 0;
        bf16x8 qa[4][2]; float wq[4][4];
#pragma unroll
        for (int m = 0; m < 4; ++m) { const bf16* qp = QI + (tok0 + 4 * m + (c >> 2)) * 256 + (c & 3) * 64 + 8 * g; qa[m][0] = *(const bf16x8*)qp; qa[m][1] = *(const bf16x8*)(qp + 32);
            const f32x4 w4 = *(const f32x4*)(WI + (tok0 + 4 * m + g) * 4); wq[m][0] = w4.x; wq[m][1] = w4.y; wq[m][2] = w4.z; wq[m][3] = w4.w; }
        __syncthreads();
        dsa_score_pass<0>(KIb, qa, wq, t0, nkt, wave, lane, hist, sel, meta);
        __syncthreads();
#pragma unroll 1
        for (int qq = 0; qq < 2; ++qq) { const int q = 2 * wave + qq; const LAS v4u* hw = (const LAS v4u*)(hist + q * 2048 + 32 * lane); unsigned s = 0;
#pragma unroll
            for (int i = 0; i < 8; ++i) { const v4u w = hw[i]; s += (w.x & 0xffffu) + (w.x >> 16) + (w.y & 0xffffu) + (w.y >> 16) + (w.z & 0xffffu) + (w.z >> 16) + (w.w & 0xffffu) + (w.w >> 16); }
            unsigned tsum = s;
#pragma unroll
            for (int off = 1; off < 64; off <<= 1) { const unsigned o = __shfl_down(tsum, off); tsum += (lane + off < 64) ? o : 0u; }
            const unsigned above = tsum - s;
            if (above < 256u && tsum >= 256u) { unsigned cacc = above; int bs = 64 * lane; unsigned na = above;
                for (int bin = 64 * lane + 63; bin >= 64 * lane; --bin) { const unsigned w = hist[q * 2048 + (bin >> 1)]; const unsigned cn = (bin & 1) ? (w >> 16) : (w & 0xffffu);
                    if (cacc + cn >= 256u) { bs = bin; na = cacc; break; } cacc += cn; }
                meta[q] = bs; meta[16 + q] = (int)na; } }
        __syncthreads();
        dsa_score_pass<1>(KIb, qa, wq, t0, nkt, wave, lane, hist, sel, meta);
        __syncthreads();
#pragma unroll 1
        for (int qq = 0; qq < 2; ++qq) { const int q = 2 * wave + qq; int n = meta[48 + q]; n = n < DSA_CAND_CAP ? n : DSA_CAND_CAP; const int R = 256 - meta[16 + q];
            const LAS v2u* cd = (const LAS v2u*)(hist + (size_t)q * DSA_CAND_CAP * 2);
            for (int ci = lane; ci < n; ci += 64) { const v2u me = cd[ci]; int rank = 0;
                for (int cj = 0; cj < n; ++cj) { const v2u o = cd[cj]; rank += (o.x > me.x || (o.x == me.x && o.y < me.y)) ? 1 : 0; }
                if (rank < R) { const int p = __hip_atomic_fetch_add((LAS unsigned*)(meta + 32 + q), 1u, __ATOMIC_RELAXED, __HIP_MEMORY_SCOPE_WORKGROUP); if (p < 256) sel[q * 256 + p] = (unsigned short)me.y; } } }
    } else {
        for (int i = tid; i < 16 * 256; i += 512) sel[i] = (unsigned short)(i & 255);
    }
    __syncthreads();
    const bf16* QD = (const bf16*)(F.ws + WS_QD); const bf16* KD = (const bf16*)(F.ws + WS_KD) + (size_t)b * SEQL * 64; const bf16* VDb = (const bf16*)(F.ws + WS_P1) + (size_t)b * SEQL * P1_LD + PC_VD;
    bf16* CAT2 = (bf16*)(F.ws + WS_CAT);
    bf16x8 esel[2];
#pragma unroll
    for (int d = 0; d < 2; ++d)
#pragma unroll
        for (int j = 0; j < 8; ++j) esel[d][j] = (8 * g + j == 16 * d + c) ? (short)0x3F80 : (short)0;
#pragma unroll 1
    for (int qq = 0; qq < 2; ++qq) { const int q = 2 * wave + qq; const int pos = t0 + q; const size_t tok = tok0 + q; const int nsel = (pos + 1 < 256) ? (pos + 1) : 256;
        bf16x8 qb[2];
        { const bf16* qp = QD + tok * 512 + (c & 7) * 64 + 8 * g; qb[0] = *(const bf16x8*)qp; qb[1] = *(const bf16x8*)(qp + 32);
          if (c >= 8) { qb[0] = (bf16x8){0, 0, 0, 0, 0, 0, 0, 0}; qb[1] = qb[0]; } }
        f32x4_t st[16];
#pragma unroll
        for (int i = 0; i < 16; ++i) { const int idx = 16 * i + c; const int key = (idx < nsel) ? (int)sel[q * 256 + idx] : 0; const bf16* kp = KD + (size_t)key * 64 + 8 * g;
            const bf16x8 ka0 = *(const bf16x8*)kp, ka1 = *(const bf16x8*)(kp + 32); f32x4_t a = {0.f, 0.f, 0.f, 0.f};
            a = __builtin_amdgcn_mfma_f32_16x16x32_bf16(ka0, qb[0], a, 0, 0, 0); a = __builtin_amdgcn_mfma_f32_16x16x32_bf16(ka1, qb[1], a, 0, 0, 0);
#pragma unroll
            for (int j = 0; j < 4; ++j) if (16 * i + 4 * g + j >= nsel) a[j] = -INFINITY;
            st[i] = a; }
        float mx = -INFINITY;
#pragma unroll
        for (int i = 0; i < 16; ++i) mx = fmaxf(fmaxf(mx, fmaxf(st[i][0], st[i][1])), fmaxf(st[i][2], st[i][3]));
        mx = fmaxf(mx, __shfl_xor(mx, 16)); mx = fmaxf(mx, __shfl_xor(mx, 32));
        float ls = 0.f;
#pragma unroll
        for (int i = 0; i < 16; ++i) {
#pragma unroll
            for (int j = 0; j < 4; ++j) { const float p = __builtin_amdgcn_exp2f(st[i][j] - mx); st[i][j] = p; ls += p; } }
        ls += __shfl_xor(ls, 16); ls += __shfl_xor(ls, 32);
        f32x4_t o[4] = {{0.f, 0.f, 0.f, 0.f}, {0.f, 0.f, 0.f, 0.f}, {0.f, 0.f, 0.f, 0.f}, {0.f, 0.f, 0.f, 0.f}};
#pragma unroll
        for (int ks = 0; ks < 8; ++ks) { v4u pw; pw.x = pk2(st[2 * ks][0], st[2 * ks][1]); pw.y = pk2(st[2 * ks][2], st[2 * ks][3]); pw.z = pk2(st[2 * ks + 1][0], st[2 * ks + 1][1]); pw.w = pk2(st[2 * ks + 1][2], st[2 * ks + 1][3]);
            const bf16x8 pa = __builtin_bit_cast(bf16x8, pw);
            f32x4_t tr[2][4];
#pragma unroll
            for (int tt = 0; tt < 2; ++tt) { const int idx = 16 * (2 * ks + tt) + c; const int key = (idx < nsel) ? (int)sel[q * 256 + idx] : 0; const bf16* vp = VDb + (size_t)key * P1_LD + 8 * g;
                const bf16x8 va0 = *(const bf16x8*)vp, va1 = *(const bf16x8*)(vp + 32); const f32x4_t z = {0.f, 0.f, 0.f, 0.f};
                tr[tt][0] = __builtin_amdgcn_mfma_f32_16x16x32_bf16(va0, esel[0], z, 0, 0, 0); tr[tt][1] = __builtin_amdgcn_mfma_f32_16x16x32_bf16(va0, esel[1], z, 0, 0, 0);
                tr[tt][2] = __builtin_amdgcn_mfma_f32_16x16x32_bf16(va1, esel[0], z, 0, 0, 0); tr[tt][3] = __builtin_amdgcn_mfma_f32_16x16x32_bf16(va1, esel[1], z, 0, 0, 0); }
#pragma unroll
            for (int db = 0; db < 4; ++db) { v4u vw; vw.x = pk2(tr[0][db][0], tr[0][db][1]); vw.y = pk2(tr[0][db][2], tr[0][db][3]); vw.z = pk2(tr[1][db][0], tr[1][db][1]); vw.w = pk2(tr[1][db][2], tr[1][db][3]);
                o[db] = __builtin_amdgcn_mfma_f32_16x16x32_bf16(pa, __builtin_bit_cast(bf16x8, vw), o[db], 0, 0, 0); } }
        float li[4];
#pragma unroll
        for (int j = 0; j < 4; ++j) li[j] = 1.0f / __shfl(ls, (4 * g + j) & 15);
        if (g < 2) { bf16* op = CAT2 + tok * 1024 + 512 + c;
#pragma unroll
            for (int j = 0; j < 4; ++j)
#pragma unroll
                for (int db = 0; db < 4; ++db) op[(4 * g + j) * 64 + 16 * db] = ABL_DSA ? (bf16)0 : (bf16)f2bf(o[db][j] * li[j]); } }
    __syncthreads();
}
__device__ __forceinline__ void dsa_phase(Frame& F) {
    unsigned* qhead = (unsigned*)(F.ws + WS_CTL) + CW_DSAQ; LAS int* meta = (LAS int*)(F.lds + DSA_META_OFF);
    for (;;) { if (F.wave == 0 && mk_lane() == 0) meta[100] = (int)atomicAdd(qhead, 1u);
        __syncthreads(); const int item = meta[100]; __syncthreads();
        if (item >= 2048) break;
        dsa_tile(F, item); }
}

__device__ __forceinline__ void final_norm_phase(Frame& F) {
    const int gw = blockIdx.x * NWAVES + F.wave, NGW = F.G * NWAVES, lane = mk_lane(); const float* gn = F.in[I_FINAL_NORM];
    f32x4 gv[4];
#pragma unroll
    for (int j = 0; j < 4; ++j) gv[j] = ((const f32x4*)gn)[lane + 64 * j];
    for (int m = gw; m < T_TOK; m += NGW) { f32x4* xr = (f32x4*)(F.out + (size_t)m * DMODEL) + lane; f32x4 v[4]; float s = 0.f;
#pragma unroll
        for (int j = 0; j < 4; ++j) { v[j] = xr[64 * j]; s += (v[j].x * v[j].x + v[j].y * v[j].y) + (v[j].z * v[j].z + v[j].w * v[j].w); }
        const float rstd = 1.0f / sqrtf(wave_sum(s) * (1.f / DMODEL) + NORM_EPS);
#pragma unroll
        for (int j = 0; j < 4; ++j) xr[64 * j] = v[j] * rstd * gv[j]; }
}

constexpr int NPHASE = 30;
__global__ void __launch_bounds__(NWAVES * 64, 2) mega_fwd(Args args) {
    extern __shared__ __attribute__((aligned(16))) unsigned char lds[];
    Frame F;
    F.lds = (LAS unsigned char*)lds;
    F.wave = __builtin_amdgcn_readfirstlane((int)threadIdx.x >> 6); F.G = gridDim.x;
    F.in = args.in; F.out = args.out; F.ws = args.ws;
    unsigned char* ws = args.ws;
    for (int u = threadIdx.x; u < (LDS_BYTES - RING_BYTES) / 4; u += NWAVES * 64) ((LAS unsigned*)(F.lds + RING_BYTES))[u] = 0u;
    __syncthreads();
    XcdBarrier bar = xcd_barrier_post((unsigned*)(ws + WS_CTL) + CW_BAR + args.li * XCD_BAR_WORDS, (volatile LAS unsigned*)(F.lds + MISC_OFF));
    const int lo = args.ph_lo, hi = args.ph_hi;
#define IN(k) (lo <= (k) && (k) < hi)
#define SEAM(k) do { if (IN(k) && IN((k) + 1)) xcd_barrier(bar, F.wave == 0 && mk_lane() == 0); } while (0)
    bf16* XN = (bf16*)(ws + WS_XN); bf16* CAT = (bf16*)(ws + WS_CAT); bf16* UG = (bf16*)(ws + WS_UG);
    bf16* Q0 = (bf16*)(ws + WS_Q0); bf16* K0 = (bf16*)(ws + WS_K0); bf16* V0 = (bf16*)(ws + WS_V0); bf16* YA = (bf16*)(ws + WS_YA);

    if (IN(0)) { p0_prologue(F); } SEAM(0);
    if (IN(1)) { pg8::Gemm g{XN, (const bf16*)(ws + WS_WE_IN), 1024, 1024, 1024}; pg8::StaticOrder S; S.init(T_TOK, 2048, F.G, (int)blockIdx.x);
        pg8::Epi8<F_E1> E{{UG, Q0, K0, V0, (const float*)(ws + WS_ROPE)}};
        pg8::gemm_phase<pg8::Epi8<F_E1>, pg8::StaticOrder, true, true>(F.lds, g, S, E, F.wave); } SEAM(1);
    if (IN(2)) { pg8::Gemm g{UG, (const bf16*)(ws + WS_S5BEND), 640, 512, 512}; SchedXend S{F.G, (int)blockIdx.x};
        pg8::Epi8<F_XEND> E{{(float*)(ws + WS_XEND)}};
        pg8::gemm_phase<pg8::Epi8<F_XEND>, SchedXend, true, true>(F.lds, g, S, E, F.wave);
        kmean_phase(F); } SEAM(2);
    if (IN(3)) { s5_carry_phase(F); moba_select_phase(F); } SEAM(3);
    if (IN(4)) { { pg8::Gemm g{UG, (const bf16*)(ws + WS_S5MT), 640, 640, 640}; SchedS5Y S{F.G, (int)blockIdx.x};
          pg8::Epi8<F_S5Y> E{{UG, F.in[I_S5_D], YA}};
          pg8::gemm_phase<pg8::Epi8<F_S5Y>, SchedS5Y, true, true>(F.lds, g, S, E, F.wave); }
        if (F.G == 256) { const attn_body::AttnTensors AT{(const attn_body::bf16*)Q0, (const attn_body::bf16*)K0, (const attn_body::bf16*)V0, (attn_body::bf16*)(CAT + 512), (const unsigned*)(ws + WS_SELM)};
          const attn_body::StaticOrder S((int)F.G, (int)blockIdx.x);
          attn_body::attn_phase<attn_body::StaticOrder>((char*)lds, AT, S, F.wave); } } SEAM(4);
    if (IN(5)) { pg8::Gemm g{YA, (const bf16*)(ws + WS_WGLU), 512, 512, 512}; pg8::StaticOrder S; S.init(T_TOK, 512, F.G, (int)blockIdx.x);
        pg8::Epi8<F_GLU> E{{YA, F.in[I_S5_GLU_B], CAT}};
        pg8::gemm_phase<pg8::Epi8<F_GLU>, pg8::StaticOrder, true, true>(F.lds, g, S, E, F.wave); } SEAM(5);
    if (IN(6)) { pg8::Gemm g{CAT, (const bf16*)(ws + WS_WE_OUT), 1024, 1024, 1024}; pg8::StaticOrder S; S.init(T_TOK, 1024, F.G, (int)blockIdx.x);
        pg8::Epi8<F_RES> E{{F.in[I_X], F.out}};
        pg8::gemm_phase<pg8::Epi8<F_RES>, pg8::StaticOrder, true, true>(F.lds, g, S, E, F.wave); } SEAM(6);
    if (IN(7)) { norm_phase(F, F.out, XN); } SEAM(7);
    if (IN(8)) { pg8::Gemm g{XN, (const bf16*)(ws + WS_WFFN_GU), 1024, 1024, 1024}; pg8::StaticOrder S; S.init(T_TOK, 2 * FFN_D, F.G, (int)blockIdx.x);
        pg8::EpiGU<F_SWIGLU> E{{(bf16*)(ws + WS_ACT), FFN_D}};
        pg8::gemm_phase<pg8::EpiGU<F_SWIGLU>, pg8::StaticOrder, true, true>(F.lds, g, S, E, F.wave); } SEAM(8);
    if (IN(9)) { pg8::Gemm g{(const bf16*)(ws + WS_ACT), (const bf16*)(ws + WS_WFFN_D), FFN_D, FFN_D, FFN_D}; pg8::StaticOrder S; S.init(T_TOK, 1024, F.G, (int)blockIdx.x);
        pg8::Epi8<F_RES> E{{F.out, F.out}};
        pg8::gemm_phase<pg8::Epi8<F_RES>, pg8::StaticOrder, true, true>(F.lds, g, S, E, F.wave); } SEAM(9);
    if (IN(10)) { norm_phase(F, F.out, XN); } SEAM(10);
    if (IN(11)) { pg8::Gemm g{XN, (const bf16*)(ws + WS_WO_IN), 1024, 1024, 1024}; pg8::StaticOrder S; S.init(T_TOK, ODD_PAD, F.G, (int)blockIdx.x);
        pg8::Epi8<F_P1> E{{(bf16*)(ws + WS_P1)}};
        pg8::gemm_phase<pg8::Epi8<F_P1>, pg8::StaticOrder, true, true>(F.lds, g, S, E, F.wave); } SEAM(11);
    if (IN(12)) { l1_prep_phase(F); } SEAM(12);
    if (IN(13)) { pg8::Gemm g{(const bf16*)(ws + WS_ALORA), (const bf16*)(ws + WS_WLORA), 256, 256, 256}; pg8::StaticOrder S; S.init(T_TOK, 1536, F.G, (int)blockIdx.x);
        pg8::Epi8<F_LORA> E{{(bf16*)(ws + WS_LORA), F.in[I_RWKV_W0], F.in[I_RWKV_A0]}};
        pg8::gemm_phase<pg8::Epi8<F_LORA>, pg8::StaticOrder, true, true>(F.lds, g, S, E, F.wave); } SEAM(13);
    if (IN(14)) { if (F.G == 256) { if ((int)blockIdx.x < 64) rwkv_seq_block(F, (int)blockIdx.x); else dsa_phase(F); } } SEAM(14);
    if (IN(15)) { rwkv_post_phase(F); } SEAM(15);
    if (IN(16)) { { pg8::Gemm g{CAT, (const bf16*)(ws + WS_WO_OUT), 1024, 1024, 1024}; pg8::StaticOrder S; S.init(T_TOK, 1024, F.G, (int)blockIdx.x);
          pg8::Epi8<F_RES> E{{F.out, F.out}};
          pg8::gemm_phase<pg8::Epi8<F_RES>, pg8::StaticOrder, true, true>(F.lds, g, S, E, F.wave); }
        moe_convert_phase(F); } SEAM(16);
    if (IN(17)) { router_phase(F); } SEAM(17);
    if (IN(18)) { moe_scatter_phase(F); } SEAM(18);
#define MOE_CHUNK_PHASES(PH, Q) \
    if (IN(PH)) { const int* te = (const int*)(ws + WS_TILEEXP); const int ntl = te[511]; int ntq = ntl - 64 * (Q); ntq = ntq < 0 ? 0 : (ntq > 64 ? 64 : ntq); if ((Q) == 4) ntq = (ntl > 256) ? (ntl - 256) : 0; \
        pg8::Gemm g{(const bf16*)(ws + WS_XG), (const bf16*)(ws + WS_WMOE_GU), 1024, 1024, 1024}; SchedMoeGU S{te, 64 * (Q), ntq, F.G, (int)blockIdx.x}; \
        pg8::EpiGU<F_MOEGU> E{{(bf16*)(ws + WS_ACTQ), 64 * (Q)}}; \
        pg8::gemm_phase<pg8::EpiGU<F_MOEGU>, SchedMoeGU, true, true>(F.lds, g, S, E, F.wave); } SEAM(PH); \
    if (IN((PH) + 1)) { const int* te = (const int*)(ws + WS_TILEEXP); const int ntl = te[511]; int ntq = ntl - 64 * (Q); ntq = ntq < 0 ? 0 : (ntq > 64 ? 64 : ntq); if ((Q) == 4) ntq = (ntl > 256) ? (ntl - 256) : 0; \
        pg8::Gemm g{(const bf16*)(ws + WS_ACTQ), (const bf16*)(ws + WS_WMOE_D), FEXP, FEXP, FEXP}; SchedMoeD S{te, 64 * (Q), ntq, F.G, (int)blockIdx.x}; \
        pg8::Epi8<F_MOED> E{{(bf16*)(ws + WS_XG)}}; \
        pg8::gemm_phase<pg8::Epi8<F_MOED>, SchedMoeD, true, true>(F.lds, g, S, E, F.wave); } SEAM((PH) + 1);
    MOE_CHUNK_PHASES(19, 0)
    MOE_CHUNK_PHASES(21, 1)
    MOE_CHUNK_PHASES(23, 2)
    MOE_CHUNK_PHASES(25, 3)
    MOE_CHUNK_PHASES(27, 4)
#undef MOE_CHUNK_PHASES
    if (IN(29)) { moe_combine_final_phase(F); }
#undef IN
#undef SEAM
}

#ifndef MK_ONE_LAUNCH
#define MK_ONE_LAUNCH 1
#endif
extern "C" void kernel_launch(void* const* d_in, const int* in_sizes, int n_in, void* d_out, int out_size, void* d_ws, size_t ws_size, hipStream_t stream) {
    static int grid = 0;
    if (grid == 0) {
        if (n_in != 38 || in_sizes[0] != T_TOK * DMODEL || out_size != T_TOK * DMODEL || ws_size < WS_NEED) { fprintf(stderr, "kernel_launch: unexpected shapes (n_in %d, in0 %d, out %d, ws %zu); nothing launched\n", n_in, n_in > 0 ? in_sizes[0] : -1, out_size, ws_size); grid = -1; return; }
        int dev = 0, cus = 0, per_cu = 0;
        if (hipGetDevice(&dev) != hipSuccess || hipDeviceGetAttribute(&cus, hipDeviceAttributeMultiprocessorCount, dev) != hipSuccess) { grid = -1; return; }
        if (hipFuncSetAttribute((const void*)mega_fwd, hipFuncAttributeMaxDynamicSharedMemorySize, LDS_BYTES) != hipSuccess) { fprintf(stderr, "kernel_launch: hipFuncSetAttribute failed\n"); grid = -1; return; }
        if (hipOccupancyMaxActiveBlocksPerMultiprocessor(&per_cu, (const void*)mega_fwd, NWAVES * 64, LDS_BYTES) != hipSuccess || per_cu < 1) fprintf(stderr, "kernel_launch: occupancy query reports %d\n", per_cu);
        (void)hipGetLastError();
        grid = cus;
    }
    if (grid < 0) return;
    if (hipMemsetAsync((char*)d_ws + WS_CTL, 0, CTL_ZERO_BYTES, stream) != hipSuccess) return;
    Args a{};
    for (int i = 0; i < 38; ++i) a.in[i] = (const float*)d_in[i];
    a.out = (float*)d_out; a.ws = (unsigned char*)d_ws; a.pad = 0;
#if MK_ONE_LAUNCH
    a.ph_lo = 0; a.ph_hi = NPHASE; a.li = 0;
    hipLaunchKernelGGL(mega_fwd, dim3(grid), dim3(NWAVES * 64), LDS_BYTES, stream, a);
#else
    for (int p = 0; p < NPHASE; ++p) { a.ph_lo = p; a.ph_hi = p + 1; a.li = p;
        hipLaunchKernelGGL(mega_fwd, dim3(grid), dim3(NWAVES * 64), LDS_BYTES, stream, a);
        if (hipPeekAtLastError() != hipSuccess) { fprintf(stderr, "kernel_launch: launch %d failed\n", p); break; } }
#endif
}
```

```cpp
#include <hip/hip_runtime.h>
#include <hip/hip_bf16.h>
#include <cstdio>
#include <cstdint>
#include <cmath>
#ifndef ABL_MOBA
#define ABL_MOBA 0
#endif
__device__ __forceinline__ int mk_lane() { int l; asm volatile("v_mbcnt_lo_u32_b32 %0, -1, 0\n\tv_mbcnt_hi_u32_b32 %0, -1, %0" : "=v"(l)); return l; }
namespace pg8 {
#define PG8_LAS __attribute__((address_space(3)))
typedef unsigned short bf16_t;
typedef short bf16x8 __attribute__((ext_vector_type(8)));
typedef float f32x4 __attribute__((ext_vector_type(4)));
typedef unsigned u32x4 __attribute__((ext_vector_type(4)));
typedef int i32x4 __attribute__((ext_vector_type(4)));
typedef int i32x8 __attribute__((ext_vector_type(8)));
constexpr int BM = 256, BK = 64, HALF = 128, HTB = HALF * BK * 2  , STAGE_BYTES = 8 * HTB, NXCD = 8, WGM = 8;

__host__ __device__ __forceinline__ int lds_byte(int r, int c) { const int st = (r >> 4) * 2 + (c >> 5), rr = r & 15, cc = c & 31, ob = rr * 64 + cc * 2; return st * 1024 + (ob ^ (((ob >> 9) & 1) << 5)); }
__host__ __device__ __forceinline__ void stage_rc(int b, int& R, int& C) { const int st = b / 1024, sb = b % 1024, swz = sb ^ (((sb >> 9) & 1) << 5); R = (st >> 1) * 16 + swz / 64; C = (st & 1) * 32 + (swz % 64) / 2; }
__host__ __device__ __forceinline__ int perm32(int rho) { const int n = rho >> 4, i = rho & 15; return 8 * (i >> 2) + 4 * n + (i & 3); }

struct Unit { int pm, pn, aux; };
struct Gemm { const bf16_t* A; const bf16_t* Bt; int lda, ldb, K; };

struct StaticOrder {
    int nM, nN, nwg, G, c, zero;
    __host__ __device__ void init(int M, int N, int G_, int c_) { nM = M / BM; nN = N / BM; nwg = nM * nN; G = G_; c = c_; zero = 0; }
    __host__ __device__ bool next(int i, Unit& u) const {
        const long L = (long)i * G + c; if (L >= nwg) return false;
        int wgid = (int)L; { const int q = nwg / NXCD, r = nwg % NXCD, xcd = wgid % NXCD, off = wgid / NXCD; wgid = (xcd < r ? xcd * (q + 1) : r * (q + 1) + (xcd - r) * q) + off; }
        const int nig = WGM * nN, gid = wgid / nig, fm = gid * WGM, gsz = (nM - fm) < WGM ? (nM - fm) : WGM;
        u.pm = fm + ((wgid % nig) % gsz); u.pn = (wgid % nig) / gsz; u.aux = 0; if (zero) { u.pm &= (zero - 1); u.pn &= (zero - 1); } return true;
    }
    __device__ __forceinline__ void a_ready(const Unit&) const {}
    __device__ __forceinline__ void done(const Unit&) const {}
};

struct ColPanelOrder {
    int nM, nN, nwg, G, c;
    __host__ __device__ void init(int M, int N, int G_, int c_) { nM = M / BM; nN = N / BM; nwg = nM * nN; G = G_; c = c_; }
    __host__ __device__ bool next(int i, Unit& u) const { const int L = i * G + c; if (L >= nwg) return false; u.pm = L % nM; u.pn = L / nM; u.aux = 0; return true; }
    __device__ __forceinline__ void a_ready(const Unit&) const {}
    __device__ __forceinline__ void done(const Unit&) const {}
};
__device__ __forceinline__ unsigned cvt_pk_bf16(float lo, float hi) { unsigned r; asm volatile("v_cvt_pk_bf16_f32 %0, %1, %2" : "=v"(r) : "v"(lo), "v"(hi)); return r; }

template <class F> struct Epi8 {
    static constexpr bool PERM = true, AFTER_DRAIN = false;
    F f;
    __device__ __forceinline__ void operator()(const f32x4 (&acc)[2][2][4][2], const Unit& u, int wr, int wc, int fr, int fq) const {
#pragma unroll
        for (int ai = 0; ai < 2; ++ai)
#pragma unroll
            for (int m = 0; m < 4; ++m) { const int r = ai * HALF + wr * 64 + m * 16 + fr;
#pragma unroll
                for (int bj = 0; bj < 2; ++bj) { const int c = bj * HALF + wc * 32 + 8 * fq;
                    float v[8] = {acc[ai][bj][m][0][0], acc[ai][bj][m][0][1], acc[ai][bj][m][0][2], acc[ai][bj][m][0][3], acc[ai][bj][m][1][0], acc[ai][bj][m][1][1], acc[ai][bj][m][1][2], acc[ai][bj][m][1][3]};
                    f(u, r, c, v, wc); } }
    }
};
template <class F> struct EpiGU {
    static constexpr bool PERM = true, AFTER_DRAIN = false;
    F f;
    __device__ __forceinline__ void operator()(const f32x4 (&acc)[2][2][4][2], const Unit& u, int wr, int wc, int fr, int fq) const {
#pragma unroll
        for (int ai = 0; ai < 2; ++ai)
#pragma unroll
            for (int m = 0; m < 4; ++m) { const int r = ai * HALF + wr * 64 + m * 16 + fr; const int c = wc * 32 + 8 * fq;
                float g[8] = {acc[ai][0][m][0][0], acc[ai][0][m][0][1], acc[ai][0][m][0][2], acc[ai][0][m][0][3], acc[ai][0][m][1][0], acc[ai][0][m][1][1], acc[ai][0][m][1][2], acc[ai][0][m][1][3]};
                float p[8] = {acc[ai][1][m][0][0], acc[ai][1][m][0][1], acc[ai][1][m][0][2], acc[ai][1][m][0][3], acc[ai][1][m][1][0], acc[ai][1][m][1][1], acc[ai][1][m][1][2], acc[ai][1][m][1][3]};
                f(u, r, c, g, p); }
    }
};

template <class F> struct Epi8L {
    static constexpr bool PERM = true, AFTER_DRAIN = false;
    F f;
    __device__ __forceinline__ void operator()(const f32x4 (&acc)[2][2][4][2], const Unit& u, int wr, int wc, int fr, int fq) const {
        constexpr int MB = F::MB, NB = 8 / MB;
        typename F::Hoist h; f.hoist(u, wc, fq, h);
        typename F::Pre pre[2][MB][2];
#pragma unroll
        for (int mm = 0; mm < MB; ++mm)
#pragma unroll
            for (int bj = 0; bj < 2; ++bj) { const int ri = mm; f.load(u, (ri >> 2) * HALF + wr * 64 + (ri & 3) * 16 + fr, bj * HALF + wc * 32 + 8 * fq, pre[0][mm][bj]); }
#pragma unroll
        for (int b = 0; b < NB; ++b) {
            if (b + 1 < NB) {
#pragma unroll
                for (int mm = 0; mm < MB; ++mm)
#pragma unroll
                    for (int bj = 0; bj < 2; ++bj) { const int ri = (b + 1) * MB + mm; f.load(u, (ri >> 2) * HALF + wr * 64 + (ri & 3) * 16 + fr, bj * HALF + wc * 32 + 8 * fq, pre[(b + 1) & 1][mm][bj]); } }
#pragma unroll
            for (int mm = 0; mm < MB; ++mm)
#pragma unroll
                for (int bj = 0; bj < 2; ++bj) { const int ri = b * MB + mm, ai = ri >> 2, m = ri & 3;
                    float v[8] = {acc[ai][bj][m][0][0], acc[ai][bj][m][0][1], acc[ai][bj][m][0][2], acc[ai][bj][m][0][3], acc[ai][bj][m][1][0], acc[ai][bj][m][1][1], acc[ai][bj][m][1][2], acc[ai][bj][m][1][3]};
                    f.apply(u, ai * HALF + wr * 64 + m * 16 + fr, bj * HALF + wc * 32 + 8 * fq, v, pre[b & 1][mm][bj], h, bj); } }
    }
};
__device__ __forceinline__ void rows_rstd(const float* SS, int row0, int wr, int fr, int fq, float (&rs)[2][4]) {
    f32x4 pp[2][4];
#pragma unroll
    for (int ai = 0; ai < 2; ++ai)
#pragma unroll
        for (int m = 0; m < 4; ++m) pp[ai][m] = ((const f32x4*)(SS + (size_t)(row0 + ai * HALF + wr * 64 + m * 16 + fr) * 16))[fq];
#pragma unroll
    for (int ai = 0; ai < 2; ++ai)
#pragma unroll
        for (int m = 0; m < 4; ++m) { float s = (pp[ai][m][0] + pp[ai][m][1]) + (pp[ai][m][2] + pp[ai][m][3]); s += __shfl_xor(s, 16); s += __shfl_xor(s, 32); rs[ai][m] = __builtin_amdgcn_rsqf(s * (1.f / 1024.f) + 1e-6f); }
}
template <class F> struct Epi8R {
    static constexpr bool PERM = true, AFTER_DRAIN = false;
    F f;
    __device__ __forceinline__ void operator()(const f32x4 (&acc)[2][2][4][2], const Unit& u, int wr, int wc, int fr, int fq) const {
        float rs[2][4]; rows_rstd(f.SS, u.pm * 256, wr, fr, fq, rs);
#pragma unroll
        for (int ai = 0; ai < 2; ++ai)
#pragma unroll
            for (int m = 0; m < 4; ++m) { const int r = ai * HALF + wr * 64 + m * 16 + fr;
#pragma unroll
                for (int bj = 0; bj < 2; ++bj) { const int c = bj * HALF + wc * 32 + 8 * fq;
                    float v[8] = {acc[ai][bj][m][0][0], acc[ai][bj][m][0][1], acc[ai][bj][m][0][2], acc[ai][bj][m][0][3], acc[ai][bj][m][1][0], acc[ai][bj][m][1][1], acc[ai][bj][m][1][2], acc[ai][bj][m][1][3]};
                    f(u, r, c, v, rs[ai][m]); } }
    }
};
template <class F> struct EpiGUR {
    static constexpr bool PERM = true, AFTER_DRAIN = false;
    F f;
    __device__ __forceinline__ void operator()(const f32x4 (&acc)[2][2][4][2], const Unit& u, int wr, int wc, int fr, int fq) const {
        if (f.mode == 2) return;
        float rs[2][4]; rows_rstd(f.SS, u.pm * 256, wr, fr, fq, rs);
#pragma unroll
        for (int ai = 0; ai < 2; ++ai)
#pragma unroll
            for (int m = 0; m < 4; ++m) { const int r = ai * HALF + wr * 64 + m * 16 + fr; const int c = wc * 32 + 8 * fq;
                float g[8] = {acc[ai][0][m][0][0], acc[ai][0][m][0][1], acc[ai][0][m][0][2], acc[ai][0][m][0][3], acc[ai][0][m][1][0], acc[ai][0][m][1][1], acc[ai][0][m][1][2], acc[ai][0][m][1][3]};
                float p[8] = {acc[ai][1][m][0][0], acc[ai][1][m][0][1], acc[ai][1][m][0][2], acc[ai][1][m][0][3], acc[ai][1][m][1][0], acc[ai][1][m][1][1], acc[ai][1][m][1][2], acc[ai][1][m][1][3]};
                f(u, r, c, g, p, rs[ai][m]); }
    }
};

template <class Epi, class Sched, bool ALIGN_EPI = false, bool SP2 = false, bool F8 = false>
__device__ __forceinline__ void gemm_phase(PG8_LAS unsigned char* lds, const Gemm g, const Sched& S, const Epi& E, const int wave_s, const bool skip_epi = false) {
    const int wid = wave_s, lane = mk_lane(), tid = wid * 64 + lane, wr = wid >> 2, wc = wid & 3, fr = lane & 15, fq = lane >> 4;
    const int K = g.K, nt = K / BK;
    unsigned voffA[2], voffB[2];
#pragma unroll
    for (int i = 0; i < 2; ++i) { int R, C; stage_rc(tid * 16 + i * 8192, R, C); const int Rb = Epi::PERM ? ((R & ~31) + perm32(R & 31)) : R;
        voffA[i] = (unsigned)(R * g.lda + C) * 2u; voffB[i] = (unsigned)(Rb * g.ldb + C) * 2u; }
    const size_t kstep = (size_t)(BK * 2);
    const size_t hstepA = (size_t)HALF * g.lda * 2, hstepB = (size_t)HALF * g.ldb * 2;
    const size_t tstepA = 2 * hstepA, tstepB = 2 * hstepB;
    const unsigned ldsw = (unsigned)wid * 1024u;
    const int aoff = lds_byte(wr * 64 + fr, fq * 8), boff = lds_byte(wc * 32 + fr, fq * 8);
    const int f8_scale = 0x7F7F7F7F; (void)f8_scale;
    int aoffv = aoff, boffv = boff + 4 * HTB; if constexpr (F8) { asm volatile("" : "+v"(aoffv), "+v"(boffv)); } (void)aoffv; (void)boffv;
#define PG8_SA(b, h) (((b) * 2 + (h)) * HTB)
#define PG8_SB(b, h) ((4 + (b) * 2 + (h)) * HTB)
#define PG8_STAGE(bufoff, gbase, voff) do { _Pragma("unroll") for (int _i = 0; _i < 2; ++_i) \
        __builtin_amdgcn_global_load_lds((const unsigned*)((const char*)(gbase) + (voff)[_i]), (PG8_LAS unsigned*)(lds + (bufoff) + ldsw + _i * 8192), 16, 0, 0); } while (0)
#define PG8_LD16A(off) (*(const PG8_LAS i32x4*)(lds + aoffv + (off)))
#define PG8_LD16B(off) (*(const PG8_LAS i32x4*)(lds + boffv + (off)))
#define PG8_LDA(dst, b, h) do { if constexpr (F8) { _Pragma("unroll") for (int m = 0; m < 4; ++m) dst##8[m] = __builtin_shufflevector(PG8_LD16A(((b) * 2 + (h)) * HTB + m * 2048), PG8_LD16A(((b) * 2 + (h)) * HTB + m * 2048 + 1024), 0, 1, 2, 3, 4, 5, 6, 7); } \
    else { _Pragma("unroll") for (int m = 0; m < 4; ++m) _Pragma("unroll") for (int k = 0; k < 2; ++k) dst[m][k] = *(const PG8_LAS bf16x8*)(lds + PG8_SA(b, h) + aoff + m * 2048 + k * 1024); } } while (0)
#define PG8_LDB(dst, b, h) do { if constexpr (F8) { _Pragma("unroll") for (int n = 0; n < 2; ++n) dst##8[n] = __builtin_shufflevector(PG8_LD16B(((b) * 2 + (h)) * HTB + n * 2048), PG8_LD16B(((b) * 2 + (h)) * HTB + n * 2048 + 1024), 0, 1, 2, 3, 4, 5, 6, 7); } \
    else { _Pragma("unroll") for (int n = 0; n < 2; ++n) _Pragma("unroll") for (int k = 0; k < 2; ++k) dst[n][k] = *(const PG8_LAS bf16x8*)(lds + PG8_SB(b, h) + boff + n * 2048 + k * 1024); } } while (0)
#define PG8_MMA(ai, bj, At, Bt) do { __builtin_amdgcn_s_setprio(1); if constexpr (F8) { _Pragma("unroll") for (int m = 0; m < 4; ++m) _Pragma("unroll") for (int n = 0; n < 2; ++n) \
            asm volatile("v_mfma_scale_f32_16x16x128_f8f6f4 %0, %1, %2, %0, %3, %3 op_sel_hi:[0,0,0]" : "+v"(acc[ai][bj][m][n]) : "v"(Bt##8[n]), "v"(At##8[m]), "v"(f8_scale)); } \
        else { _Pragma("unroll") for (int m = 0; m < 4; ++m) _Pragma("unroll") for (int n = 0; n < 2; ++n) _Pragma("unroll") for (int k = 0; k < 2; ++k) \
        acc[ai][bj][m][n] = __builtin_amdgcn_mfma_f32_16x16x32_bf16(Bt[n][k], At[m][k], acc[ai][bj][m][n], 0, 0, 0); } __builtin_amdgcn_s_setprio(0); } while (0)
#define PG8_WAIT_V(n) asm volatile("s_waitcnt vmcnt(" #n ")" ::: "memory")
#define PG8_WAIT_L(n) asm volatile("s_waitcnt lgkmcnt(" #n ")" ::: "memory")
#define PG8_BAR __builtin_amdgcn_s_barrier()
#define PG8_SCHED __builtin_amdgcn_sched_barrier(0)
    Unit cur, nxt; int ui = 0;
    if (!S.next(0, cur)) return;
    f32x4 acc[2][2][4][2];
#pragma unroll
    for (int a = 0; a < 2; ++a)
#pragma unroll
        for (int b = 0; b < 2; ++b)
#pragma unroll
            for (int m = 0; m < 4; ++m)
#pragma unroll
                for (int n = 0; n < 2; ++n) acc[a][b][m][n] = (f32x4){0.f, 0.f, 0.f, 0.f};
    bf16x8 At[4][2], B0[2][2], B1[2][2]; i32x8 At8[4], B08[2], B18[2]; (void)At; (void)B0; (void)B1; (void)At8; (void)B08; (void)B18;
    const char* cA = (const char*)g.A + (size_t)cur.pm * tstepA; const char* cB = (const char*)g.Bt + (size_t)cur.pn * tstepB;
    S.a_ready(cur);
    if constexpr (SP2) {
        PG8_STAGE(PG8_SB(0, 0), cB, voffB); PG8_STAGE(PG8_SB(0, 1), cB + hstepB, voffB); PG8_STAGE(PG8_SA(0, 0), cA, voffA); PG8_STAGE(PG8_SA(0, 1), cA + hstepA, voffA);
        if (wr == 1) PG8_BAR;
        PG8_WAIT_V(2); PG8_BAR;
        PG8_STAGE(PG8_SB(1, 0), cB + kstep, voffB); PG8_STAGE(PG8_SA(1, 0), cA + kstep, voffA); PG8_STAGE(PG8_SB(1, 1), cB + hstepB + kstep, voffB);
        PG8_WAIT_V(6); PG8_BAR;
    } else {
        PG8_STAGE(PG8_SB(0, 0), cB, voffB); PG8_STAGE(PG8_SA(0, 0), cA, voffA); PG8_STAGE(PG8_SB(0, 1), cB + hstepB, voffB); PG8_STAGE(PG8_SA(0, 1), cA + hstepA, voffA);
        if (wr == 1) PG8_BAR;
        PG8_WAIT_V(4); PG8_BAR;
        PG8_STAGE(PG8_SB(1, 0), cB + kstep, voffB); PG8_STAGE(PG8_SA(1, 0), cA + kstep, voffA); PG8_STAGE(PG8_SB(1, 1), cB + hstepB + kstep, voffB);
        PG8_WAIT_V(6); PG8_BAR;
    }
    for (;;) {
        const bool has_next = S.next(ui + 1, nxt);
        const char* nA = has_next ? (const char*)g.A + (size_t)nxt.pm * tstepA : cA; const char* nB = has_next ? (const char*)g.Bt + (size_t)nxt.pn * tstepB : cB;
        if constexpr (F8) {
            _Pragma("unroll") for (int a = 0; a < 2; ++a) _Pragma("unroll") for (int b = 0; b < 2; ++b) _Pragma("unroll") for (int m = 0; m < 4; ++m) _Pragma("unroll") for (int n = 0; n < 2; ++n) asm volatile("" : "+v"(acc[a][b][m][n])); }
        _Pragma("clang loop unroll(disable)")
        for (int t = 0; t < nt; t += 2) {
            const bool last = (t == nt - 2);
            const char* a1 = cA + (size_t)(t + 1) * kstep;
            const char* a2 = last ? nA : cA + (size_t)(t + 2) * kstep; const char* b2 = last ? nB : cB + (size_t)(t + 2) * kstep;
            const char* a3 = a2 + kstep; const char* b3 = b2 + kstep;
            if (last && has_next) S.a_ready(nxt);
            if constexpr (SP2) {
            PG8_LDB(B0, 0, 0); PG8_LDB(B1, 0, 1); PG8_SCHED; PG8_LDA(At, 0, 0); PG8_STAGE(PG8_SA(1, 1), a1 + hstepA, voffA);
            PG8_WAIT_V(8); PG8_WAIT_L(0); PG8_BAR; PG8_MMA(0, 0, At, B0); PG8_MMA(0, 1, At, B1); PG8_BAR; PG8_SCHED;
            PG8_LDA(At, 0, 1); PG8_STAGE(PG8_SB(0, 0), b2, voffB); PG8_STAGE(PG8_SB(0, 1), b2 + hstepB, voffB); PG8_STAGE(PG8_SA(0, 0), a2, voffA);
            PG8_WAIT_V(8); PG8_WAIT_L(0); PG8_BAR; PG8_MMA(1, 0, At, B0); PG8_MMA(1, 1, At, B1); PG8_BAR; PG8_SCHED;
            PG8_LDB(B0, 1, 0); PG8_LDB(B1, 1, 1); PG8_SCHED; PG8_LDA(At, 1, 0); PG8_STAGE(PG8_SA(0, 1), a2 + hstepA, voffA);
            PG8_WAIT_V(8); PG8_WAIT_L(0); PG8_BAR; PG8_MMA(0, 0, At, B0); PG8_MMA(0, 1, At, B1); PG8_BAR; PG8_SCHED;
            PG8_LDA(At, 1, 1); PG8_STAGE(PG8_SB(1, 0), b3, voffB); PG8_STAGE(PG8_SB(1, 1), b3 + hstepB, voffB); PG8_STAGE(PG8_SA(1, 0), a3, voffA);
            PG8_WAIT_V(8); PG8_WAIT_L(0); PG8_BAR; PG8_MMA(1, 0, At, B0); PG8_MMA(1, 1, At, B1); PG8_BAR; PG8_SCHED;
            } else {
            PG8_LDB(B0, 0, 0); PG8_SCHED; PG8_LDA(At, 0, 0); PG8_STAGE(PG8_SA(1, 1), a1 + hstepA, voffA);
            PG8_WAIT_L(8); PG8_BAR; PG8_WAIT_L(0); PG8_MMA(0, 0, At, B0); PG8_BAR; PG8_SCHED;
            PG8_LDB(B1, 0, 1); PG8_STAGE(PG8_SB(0, 0), b2, voffB);
            PG8_BAR; PG8_WAIT_L(0); PG8_MMA(0, 1, At, B1); PG8_BAR;
            PG8_LDA(At, 0, 1); PG8_STAGE(PG8_SA(0, 0), a2, voffA);
            PG8_BAR; PG8_WAIT_L(0); PG8_MMA(1, 0, At, B0); PG8_BAR; PG8_SCHED;
            PG8_STAGE(PG8_SB(0, 1), b2 + hstepB, voffB);
            PG8_WAIT_V(6); PG8_BAR; PG8_MMA(1, 1, At, B1); PG8_BAR;
            PG8_LDB(B0, 1, 0); PG8_SCHED; PG8_LDA(At, 1, 0); PG8_STAGE(PG8_SA(0, 1), a2 + hstepA, voffA);
            PG8_WAIT_L(8); PG8_BAR; PG8_WAIT_L(0); PG8_MMA(0, 0, At, B0); PG8_BAR; PG8_SCHED;
            PG8_LDB(B1, 1, 1); PG8_STAGE(PG8_SB(1, 0), b3, voffB);
            PG8_BAR; PG8_WAIT_L(0); PG8_MMA(0, 1, At, B1); PG8_BAR;
            PG8_LDA(At, 1, 1); PG8_STAGE(PG8_SA(1, 0), a3, voffA);
            PG8_BAR; PG8_WAIT_L(0); PG8_MMA(1, 0, At, B0); PG8_BAR; PG8_SCHED;
            PG8_STAGE(PG8_SB(1, 1), b3 + hstepB, voffB);
            PG8_WAIT_V(6); PG8_BAR; PG8_MMA(1, 1, At, B1); PG8_BAR;
            }
        }
        if constexpr (F8) { asm volatile("s_nop 15\n\ts_nop 15" ::: "memory"); }
        if constexpr (ALIGN_EPI) { if (wr == 0) PG8_BAR; }
        if constexpr (!Epi::AFTER_DRAIN) { if (!skip_epi) E(acc, cur, wr, wc, fr, fq); S.done(cur); }
        if (!has_next) break;
#pragma unroll
        for (int a = 0; a < 2; ++a)
#pragma unroll
            for (int b = 0; b < 2; ++b)
#pragma unroll
                for (int m = 0; m < 4; ++m)
#pragma unroll
                    for (int n = 0; n < 2; ++n) acc[a][b][m][n] = (f32x4){0.f, 0.f, 0.f, 0.f};
        cur = nxt; cA = nA; cB = nB; ++ui;
        if constexpr (ALIGN_EPI) { if (wr == 1) PG8_BAR; }
    }
    PG8_WAIT_V(0);
    if constexpr (!ALIGN_EPI) { if (wr == 0) PG8_BAR; }
    PG8_BAR;
    if constexpr (Epi::AFTER_DRAIN) { E.fused(acc, cur, wr, wc, fr, fq, lds, wid, lane); S.done(cur); }
#undef PG8_SA
#undef PG8_SB
#undef PG8_STAGE
#undef PG8_LD16A
#undef PG8_LD16B
#undef PG8_LDA
#undef PG8_LDB
#undef PG8_MMA
#undef PG8_WAIT_V
#undef PG8_WAIT_L
#undef PG8_BAR
#undef PG8_SCHED
}
}

namespace attn_body {
using bf16=__hip_bfloat16;
using bf16x8=__attribute__((ext_vector_type(8)))short;
using s16x4=__attribute__((ext_vector_type(4)))short;
using f32x16=__attribute__((ext_vector_type(16)))float;
using u32x4=__attribute__((ext_vector_type(4)))unsigned;
constexpr int BATCH=4,NHEAD=8,SEQ=8192,D=64,DM=NHEAD*D,ODM=1024;
constexpr int NW=8,QBLK=32,QB=QBLK*NW,KVBLK=64,NQB=SEQ/QB;
constexpr int ATTN_PITCH=DM, ATTN_UNIT_ROWS=QB;
__device__ __forceinline__ int crow(int r,int hi){return (r&3)+8*(r>>2)+4*hi;}
#define SBAR() __builtin_amdgcn_sched_barrier(0)
__device__ __forceinline__ void cmask(f32x16&p0,f32x16&p1,int jb,int qrel,int hi){
  const float NEG=-INFINITY; int kb=64*jb+4*hi;
  #pragma unroll
  for(int r=0;r<16;++r){int kv=kb+(r&3)+8*(r>>2); if(kv>qrel)p0[r]=NEG; if(kv+32>qrel)p1[r]=NEG;}
}

constexpr int NSLOT=3, SLOTB=8192;
constexpr int LDS_K=0, LDS_V=NSLOT*SLOTB, LDS_WS=2*NSLOT*SLOTB, LDS_OST=LDS_WS+NW*64*4, LDS_BYTES=LDS_OST+NW*4096;
constexpr float C2=0.125f*1.4426950408889634f;
__device__ __forceinline__ void glds16(const void*gsrc,unsigned lds_dst){unsigned keep;
  asm volatile("s_mov_b32 %0, m0\n\ts_mov_b32 m0, %2\n\ts_nop 0\n\tglobal_load_lds_dwordx4 %1, off\n\ts_mov_b32 m0, %0":"=&s"(keep):"v"(gsrc),"s"(lds_dst):"memory");}
__device__ __forceinline__ float max3f(float a,float b,float c){float r;asm("v_max3_f32 %0, %1, %2, %3":"=v"(r):"v"(a),"v"(b),"v"(c));return r;}
__device__ __forceinline__ float max2f(float a,float b){float r;asm("v_max_f32_e32 %0, %1, %2":"=v"(r):"v"(a),"v"(b));return r;}
__device__ __forceinline__ float fadd_s(float a,float b){float r;asm("v_add_f32_e32 %0, %1, %2":"=v"(r):"v"(a),"v"(b));return r;}
__device__ __forceinline__ float fsub_s(float a,float b){float r;asm("v_sub_f32_e32 %0, %1, %2":"=v"(r):"v"(a),"v"(b));return r;}
typedef float f32x2_t __attribute__((ext_vector_type(2))); typedef __bf16 bf16x2_t __attribute__((ext_vector_type(2)));
__device__ __forceinline__ unsigned cvtpk_s(float lo,float hi){f32x2_t v={lo,hi};bf16x2_t b=__builtin_convertvector(v,bf16x2_t);return __builtin_bit_cast(unsigned,b);}
#define WAIT_BAR(N) asm volatile("s_waitcnt vmcnt(" #N ") lgkmcnt(0)\n\ts_barrier":::"memory")

__device__ __forceinline__ void qkt(f32x16&p0,f32x16&p1,const char*Kslot,const bf16x8*qr,const f32x16&negm,int r32,int hi){
  const char*kb=Kslot+hi*1024+r32*16;
  #pragma unroll
  for(int d0=0;d0<4;++d0){
    const bf16x8 b0=*reinterpret_cast<const bf16x8*>(kb+d0*2048);
    const bf16x8 b1=*reinterpret_cast<const bf16x8*>(kb+d0*2048+512);
    if(d0==0){p0=__builtin_amdgcn_mfma_f32_32x32x16_bf16(b0,qr[0],negm,0,0,0);p1=__builtin_amdgcn_mfma_f32_32x32x16_bf16(b1,qr[0],negm,0,0,0);}
    else{p0=__builtin_amdgcn_mfma_f32_32x32x16_bf16(b0,qr[d0],p0,0,0,0);p1=__builtin_amdgcn_mfma_f32_32x32x16_bf16(b1,qr[d0],p1,0,0,0);}}
}
typedef __attribute__((address_space(3))) const char* lds_cptr;
typedef short v4i16_t __attribute__((ext_vector_type(4)));
__device__ __forceinline__ void kload8(bf16x8*kf,lds_cptr kp){
  kf[0]=*(const __attribute__((address_space(3))) bf16x8*)(kp);      kf[1]=*(const __attribute__((address_space(3))) bf16x8*)(kp+512);
  kf[2]=*(const __attribute__((address_space(3))) bf16x8*)(kp+2048); kf[3]=*(const __attribute__((address_space(3))) bf16x8*)(kp+2560);
  kf[4]=*(const __attribute__((address_space(3))) bf16x8*)(kp+4096); kf[5]=*(const __attribute__((address_space(3))) bf16x8*)(kp+4608);
  kf[6]=*(const __attribute__((address_space(3))) bf16x8*)(kp+6144); kf[7]=*(const __attribute__((address_space(3))) bf16x8*)(kp+6656);
}
__device__ __forceinline__ void kload2(bf16x8*kf,lds_cptr kp,int j){ kf[2*j]=*(const __attribute__((address_space(3))) bf16x8*)(kp+j*2048); kf[2*j+1]=*(const __attribute__((address_space(3))) bf16x8*)(kp+j*2048+512); }
__device__ __forceinline__ s16x4 vtr(lds_cptr p){ return __builtin_bit_cast(s16x4,__builtin_amdgcn_ds_read_tr16_b64_v4i16((__attribute__((address_space(3))) v4i16_t*)p)); }
__device__ __forceinline__ float rowmax(const f32x16&p0,const f32x16&p1){
  float a=max3f(p0[0],p0[1],p1[0]),b=max3f(p0[2],p0[3],p1[1]);a=max3f(a,p1[2],p1[3]);
  #pragma unroll
  for(int r=4;r<16;r+=4){a=max3f(a,p0[r],p0[r+1]);b=max3f(b,p0[r+2],p0[r+3]);a=max3f(a,p1[r],p1[r+1]);b=max3f(b,p1[r+2],p1[r+3]);}
  const float m=max2f(a,b);
  auto rr=__builtin_amdgcn_permlane32_swap(__float_as_uint(m),__float_as_uint(m),false,false);
  return max2f(__uint_as_float(rr[0]),__uint_as_float(rr[1]));
}
__device__ __forceinline__ void pv(f32x16*o,int vb,bf16x8 pa0,bf16x8 pa1,bf16x8 pa2,bf16x8 pa3){
  #pragma unroll
  for(int d0=0;d0<2;++d0){s16x4 lo[4],hi[4];
    #pragma unroll
    for(int ks=0;ks<4;++ks){
      asm volatile("ds_read_b64_tr_b16 %0,%1 offset:%c2":"=&v"(lo[ks]):"v"(vb),"i"(d0*4096+ks*1024):"memory");
      asm volatile("ds_read_b64_tr_b16 %0,%1 offset:%c2":"=&v"(hi[ks]):"v"(vb),"i"(d0*4096+ks*1024+512):"memory");}
    asm volatile("s_waitcnt lgkmcnt(0)":::"memory");SBAR();
    #define PK(k) (bf16x8){lo[k][0],lo[k][1],lo[k][2],lo[k][3],hi[k][0],hi[k][1],hi[k][2],hi[k][3]}
    o[d0]=__builtin_amdgcn_mfma_f32_32x32x16_bf16(pa0,PK(0),o[d0],0,0,0);
    o[d0]=__builtin_amdgcn_mfma_f32_32x32x16_bf16(pa1,PK(1),o[d0],0,0,0);
    o[d0]=__builtin_amdgcn_mfma_f32_32x32x16_bf16(pa2,PK(2),o[d0],0,0,0);
    o[d0]=__builtin_amdgcn_mfma_f32_32x32x16_bf16(pa3,PK(3),o[d0],0,0,0);
    #undef PK
  }
}

#ifndef ATTN_STORE16
#define ATTN_STORE16(p,v) (*(u32x4*)(p)=(v))
#endif
template<int THRL> __device__ __forceinline__ void attn_unit(int b,int h,int qb,const bf16*Q,const bf16*__restrict__ K,const bf16*__restrict__ V,bf16*O,const unsigned*__restrict__ SEL,char*shm,const int wave_s){
  const int wid=wave_s,lane=mk_lane(),r32=lane&31,hi=lane>>5;
  const long rowbase=(long)b*SEQ; const int q0=qb*QB;
  const bf16*Qw=Q+(rowbase+q0+wid*QBLK)*DM+h*D;
  const bf16*Kh=K+rowbase*DM+h*D,*Vh=V+rowbase*DM+h*D;
  const unsigned lds0=(unsigned)(uintptr_t)shm;
  float*wsf=(float*)(shm+LDS_WS)+wid*64;
  const bf16*ksrc=Kh+(long)lane*DM+wid*8;
  const bf16*vsrc=Vh+(long)(16*(wid&3)+(lane>>2))*DM+(wid>>2)*32+(lane&3)*8;
  const unsigned kdst=lds0+LDS_K+wid*1024, vdst=lds0+LDS_V+wid*1024;
  #define TAU(t) (((t)<4)?(NT-4+(t)):((t)-4))
  #define DMA_K(t,slot) glds16(ksrc+(long)TAU(t)*KVBLK*DM,(unsigned)__builtin_amdgcn_readfirstlane(kdst+(slot)))
  #define DMA_V(t,slot) glds16(vsrc+(long)TAU(t)*KVBLK*DM,(unsigned)__builtin_amdgcn_readfirstlane(vdst+(slot)))
  const int vb0=(int)(lds0+LDS_V)+((lane>>4)&1)*32+(lane&3)*8+(4*hi+((lane&15)>>2))*64;
  const char*Kbase=shm+LDS_K; bf16x8 kf[8];
  const lds_cptr shm3=(lds_cptr)shm; const lds_cptr kp0=shm3+LDS_K+hi*1024+r32*16; const lds_cptr vp0=shm3+LDS_V+((lane>>4)&1)*32+(lane&3)*8+(4*hi+((lane&15)>>2))*64;
  const int NT=(q0+QB)/KVBLK;
  DMA_K(0,0);DMA_V(0,0);DMA_K(1,SLOTB);
  bf16x8 qr[4];
  #pragma unroll
  for(int d0=0;d0<4;++d0)qr[d0]=*reinterpret_cast<const bf16x8*>(&Qw[(long)r32*DM+d0*16+hi*8]);
  float mhat=0.f,l_reg=0.f;f32x16 o[2];o[0]=f32x16{};o[1]=f32x16{};const f32x16 negm=f32x16{};
  const int qrel=wid*QBLK+r32;
  const unsigned selw_addr=lds0+LDS_BYTES+wid*128+r32*4;
  { const unsigned sm0_=SEL[(size_t)(b*NHEAD+h)*SEQ+q0+qrel]; if(hi==0){ asm volatile("ds_write_b32 %0, %1"::"v"(selw_addr),"v"(sm0_):"memory"); } }
  #define CMASK(P0,P1,t) do{ unsigned sm_; asm volatile("ds_read_b32 %0, %1\n\ts_waitcnt lgkmcnt(0)":"=v"(sm_):"v"(selw_addr):"memory"); const int pt_=((t)<4)?0:((t)-4)>>2; const int lim_=((t)<4)?(qrel-64*(t)):((((sm_>>pt_)&1u)!=0u)?64:-1); cmask(P0,P1,0,lim_,hi); }while(0)
  bool resc=false;
  #define START(P0,P1) do{ const float rm=rowmax(P0,P1); resc=false; \
    { const float dl=rm; mhat=fadd_s(mhat,dl); \
      _Pragma("unroll") for(int r=0;r<16;++r){P0[r]=fsub_s(P0[r],dl);P1[r]=fsub_s(P1[r],dl);} \
    } \
    _Pragma("unroll") for(int r=0;r<16;++r)P0[r]=__builtin_amdgcn_exp2f(P0[r]); }while(0)
  #define RESC() do{ if(resc){ asm volatile("s_waitcnt lgkmcnt(0)":::"memory"); \
      _Pragma("unroll") for(int d_=0;d_<2;++d_) _Pragma("unroll") for(int r=0;r<16;++r)o[d_][r]*=wsf[crow(r,hi)]; } }while(0)
  f32x16 pA0,pA1,pB0,pB1;
  int sl_prev=0,sl_cur=0,sl_next=SLOTB;
  #define ROT() do{sl_prev=sl_cur;sl_cur=sl_next;sl_next=(sl_next==(NSLOT-1)*SLOTB)?0:sl_next+SLOTB;}while(0)
  DMA_K(2,2*SLOTB);
  WAIT_BAR(3);
  qkt(pA0,pA1,Kbase,qr,negm,r32,hi);asm volatile("s_nop 15\n\ts_nop 7":"+v"(pA0),"+v"(pA1));CMASK(pA0,pA1,0);
  START(pA0,pA1);
  _Pragma("unroll") for(int r=0;r<16;++r)pA1[r]=__builtin_amdgcn_exp2f(pA1[r]);
  WAIT_BAR(0);
  DMA_K(3,0);DMA_V(1,SLOTB);
  ROT();
  kload8(kf,kp0+sl_cur);
  WAIT_BAR(2);
  s16x4 vlo[8],vhi[8]; u32x4 pw0,pw1,pw2,pw3;
  #define PKW(P,B) cvtpk_s(P[B],P[B+1])
  #define PAF(k) __builtin_bit_cast(bf16x8,pw##k)
  #define VFR(i) (bf16x8){vlo[i][0],vlo[i][1],vlo[i][2],vlo[i][3],vhi[i][0],vhi[i][1],vhi[i][2],vhi[i][3]}
  #define PIN(x) asm volatile("":"+v"(x))
  #define MX3(a,b,c) __builtin_fmaxf(__builtin_fmaxf((a),(b)),(c))
  #define GAPA(MF,A0,A1,A2,A3,W0,W1,PW) do{ MF; sacc+=A0; sacc+=A1; sacc+=A2; sacc+=A3; PIN(sacc); W0; W1; PIN(PW); SBAR(); }while(0)
  #define EX(v) __builtin_amdgcn_exp2f(v)
  #define GAPB(MF,X,B) do{ MF; X[B]=EX(X[B]); X[B+1]=EX(X[B+1]); X[B+2]=EX(X[B+2]); X[B+3]=EX(X[B+3]); PIN(X); SBAR(); }while(0)
  #define VRD(i) do{ vlo[i]=vtr(vp_+(((i)>>2)*4096+((i)&3)*1024)); vhi[i]=vtr(vp_+(((i)>>2)*4096+((i)&3)*1024+512)); }while(0)
  #define KRD(G,j) do{ if(G){ kload2(kf,kp0+sl_next,j); SBAR(); } }while(0)
  #define STEP(C0,C1,P0,P1,t,GK,GV,GL) do{ SBAR(); \
    const lds_cptr vp_=vp0+sl_prev; \
    VRD(0); SBAR(); float sacc=(P0[0]+P0[1]); \
    GAPA(C0=__builtin_amdgcn_mfma_f32_32x32x16_bf16(kf[0],qr[0],negm,0,0,0), P0[2],P0[3],P0[4],P0[5],     pw0[0]=PKW(P0,0), pw0[1]=PKW(P0,2), pw0); \
    VRD(4); SBAR(); GAPA(C1=__builtin_amdgcn_mfma_f32_32x32x16_bf16(kf[1],qr[0],negm,0,0,0), P0[6],P0[7],P0[8],P0[9],     pw0[2]=PKW(P0,4), pw0[3]=PKW(P0,6), pw0); \
    VRD(1); SBAR(); GAPA(C0=__builtin_amdgcn_mfma_f32_32x32x16_bf16(kf[2],qr[1],C0,0,0,0),   P0[10],P0[11],P0[12],P0[13], pw1[0]=PKW(P0,8), pw1[1]=PKW(P0,10), pw1); \
    VRD(5); SBAR(); GAPA(C1=__builtin_amdgcn_mfma_f32_32x32x16_bf16(kf[3],qr[1],C1,0,0,0),   P0[14],P0[15],P1[0],P1[1],   pw1[2]=PKW(P0,12),pw1[3]=PKW(P0,14), pw1); \
    VRD(2); SBAR(); GAPA(C0=__builtin_amdgcn_mfma_f32_32x32x16_bf16(kf[4],qr[2],C0,0,0,0),   P1[2],P1[3],P1[4],P1[5],     pw2[0]=PKW(P1,0), pw2[1]=PKW(P1,2), pw2); \
    VRD(6); SBAR(); GAPA(C1=__builtin_amdgcn_mfma_f32_32x32x16_bf16(kf[5],qr[2],C1,0,0,0),   P1[6],P1[7],P1[8],P1[9],     pw2[2]=PKW(P1,4), pw2[3]=PKW(P1,6), pw2); \
    VRD(3); SBAR(); GAPA(C0=__builtin_amdgcn_mfma_f32_32x32x16_bf16(kf[6],qr[3],C0,0,0,0),   P1[10],P1[11],P1[12],P1[13], pw3[0]=PKW(P1,8), pw3[1]=PKW(P1,10), pw3); \
    VRD(7); SBAR(); GAPA(C1=__builtin_amdgcn_mfma_f32_32x32x16_bf16(kf[7],qr[3],C1,0,0,0),   P1[14],P1[15],0.f,0.f,       pw3[2]=PKW(P1,12),pw3[3]=PKW(P1,14), pw3); \
    l_reg+=sacc; \
    if(GK){DMA_K((t)+3,sl_cur);} if(GV){DMA_V((t)+1,sl_next);} \
    _Pragma("unroll") for(int r=0;r<16;++r){C0[r]-=mhat;C1[r]-=mhat;} \
    CMASK(C0,C1,t); \
    { float a=MX3(C0[0],C0[1],C1[0]),b=MX3(C0[2],C0[3],C1[1]); a=MX3(a,C1[2],C1[3]); \
      _Pragma("unroll") for(int r=4;r<16;r+=4){a=MX3(a,C0[r],C0[r+1]);b=MX3(b,C0[r+2],C0[r+3]);a=MX3(a,C1[r],C1[r+1]);b=MX3(b,C1[r+2],C1[r+3]);} \
      float rm=__builtin_fmaxf(a,b); { auto rr=__builtin_amdgcn_permlane32_swap(__float_as_uint(rm),__float_as_uint(rm),false,false); rm=__builtin_fmaxf(__uint_as_float(rr[0]),__uint_as_float(rr[1])); } \
      resc=false; \
      if(__builtin_expect(__any(rm>(float)THRL),0)){ const float dl=__builtin_fmaxf(rm,0.f); mhat+=dl; \
        _Pragma("unroll") for(int r=0;r<16;++r){C0[r]-=dl;C1[r]-=dl;} \
        const float f=__builtin_amdgcn_exp2f(-dl); l_reg*=f; if(hi==0)wsf[r32]=f; resc=true; } } \
    SBAR(); \
    GAPB(o[0]=__builtin_amdgcn_mfma_f32_32x32x16_bf16(PAF(0),VFR(0),o[0],0,0,0), C0,0); \
    GAPB(o[1]=__builtin_amdgcn_mfma_f32_32x32x16_bf16(PAF(0),VFR(4),o[1],0,0,0), C0,4); \
    KRD(GL,0); GAPB(o[0]=__builtin_amdgcn_mfma_f32_32x32x16_bf16(PAF(1),VFR(1),o[0],0,0,0), C0,8); \
    KRD(GL,1); GAPB(o[1]=__builtin_amdgcn_mfma_f32_32x32x16_bf16(PAF(1),VFR(5),o[1],0,0,0), C0,12); \
    KRD(GL,2); GAPB(o[0]=__builtin_amdgcn_mfma_f32_32x32x16_bf16(PAF(2),VFR(2),o[0],0,0,0), C1,0); \
    KRD(GL,3); GAPB(o[1]=__builtin_amdgcn_mfma_f32_32x32x16_bf16(PAF(2),VFR(6),o[1],0,0,0), C1,4); \
    GAPB(o[0]=__builtin_amdgcn_mfma_f32_32x32x16_bf16(PAF(3),VFR(3),o[0],0,0,0), C1,8); \
    GAPB(o[1]=__builtin_amdgcn_mfma_f32_32x32x16_bf16(PAF(3),VFR(7),o[1],0,0,0), C1,12); \
    }while(0)
  int t=1;
  #undef CMASK
  #define CMASK(P0,P1,t) do{ unsigned sm_; asm volatile("ds_read_b32 %0, %1\n\ts_waitcnt lgkmcnt(0)":"=v"(sm_):"v"(selw_addr):"memory"); const int pt_=((t)<4)?0:((t)-4)>>2; const int lim_=((t)<4)?(qrel-64*(t)):((((sm_>>pt_)&1u)!=0u)?64:-1); cmask(P0,P1,0,lim_,hi); }while(0)
  for(;t+5<NT;t+=2){
    STEP(pB0,pB1,pA0,pA1,t,true,true,true);     WAIT_BAR(2); RESC(); ROT();
    STEP(pA0,pA1,pB0,pB1,t+1,true,true,true);   WAIT_BAR(2); RESC(); ROT();
  }
  #undef CMASK
  #define CMASK(P0,P1,t) do{ unsigned sm_; asm volatile("ds_read_b32 %0, %1\n\ts_waitcnt lgkmcnt(0)":"=v"(sm_):"v"(selw_addr):"memory"); const int pt_=((t)<4)?0:((t)-4)>>2; const int lim_=((t)<4)?(qrel-64*(t)):((((sm_>>pt_)&1u)!=0u)?64:-1); cmask(P0,P1,0,lim_,hi); }while(0)
  #define ENDW(tt) do{ if((tt)+3<NT){WAIT_BAR(2);} else if((tt)+2<NT){WAIT_BAR(1);} else {WAIT_BAR(0);} }while(0)
  for(;t+1<NT;t+=2){
    STEP(pB0,pB1,pA0,pA1,t,(t+3<NT),(t+1<NT),(t+1<NT));       ENDW(t);   RESC(); ROT();
    STEP(pA0,pA1,pB0,pB1,t+1,(t+4<NT),(t+2<NT),(t+2<NT));     ENDW(t+1); RESC(); ROT();
  }
  STEP(pB0,pB1,pA0,pA1,NT-1,false,false,false); RESC();
  { float sacc=pB0[0]+pB0[1]; _Pragma("unroll") for(int r=2;r<16;++r)sacc+=pB0[r]; _Pragma("unroll") for(int r=0;r<16;++r)sacc+=pB1[r]; l_reg+=sacc;
    pw0=(u32x4){PKW(pB0,0),PKW(pB0,2),PKW(pB0,4),PKW(pB0,6)};pw1=(u32x4){PKW(pB0,8),PKW(pB0,10),PKW(pB0,12),PKW(pB0,14)};pw2=(u32x4){PKW(pB1,0),PKW(pB1,2),PKW(pB1,4),PKW(pB1,6)};pw3=(u32x4){PKW(pB1,8),PKW(pB1,10),PKW(pB1,12),PKW(pB1,14)};
    SBAR(); pv(o,vb0+sl_cur,PAF(0),PAF(1),PAF(2),PAF(3)); }
  #undef PKW
  #undef PAF
  #undef VFR
  #undef PIN
  #undef MX3
  #undef GAPA
  #undef GAPB
  #undef EX
  #undef VRD
  #undef KRD
  #undef STEP
  #undef ENDW
  {auto rr=__builtin_amdgcn_permlane32_swap(__float_as_uint(l_reg),__float_as_uint(l_reg),false,false);l_reg=__uint_as_float(rr[0])+__uint_as_float(rr[1]);}
  if(hi==0)wsf[32+r32]=l_reg;asm volatile("s_waitcnt lgkmcnt(0)":::"memory");
  float rli[16];
  #pragma unroll
  for(int r=0;r<16;++r)rli[r]=__builtin_amdgcn_rcpf(wsf[32+crow(r,hi)]);
  bf16*Ow=O+(rowbase+q0+wid*QBLK)*ODM+h*D;
  { bf16*stg=(bf16*)(shm+LDS_OST)+wid*2048;
    #pragma unroll
    for(int r=0;r<16;++r){const int orow=crow(r,hi);
      #pragma unroll
      for(int d0=0;d0<2;++d0)stg[orow*64+d0*32+r32]=__float2bfloat16(ABL_MOBA?0.f:o[d0][r]*rli[r]);}
    asm volatile("s_waitcnt lgkmcnt(0)":::"memory");
    #pragma unroll
    for(int i=0;i<4;++i){const int row=i*8+(lane>>3),ch=lane&7; const u32x4 v=*(const u32x4*)(stg+row*64+ch*8); ATTN_STORE16(Ow+(long)row*ODM+ch*8,v);} }
  asm volatile("s_waitcnt lgkmcnt(0)\n\ts_barrier":::"memory");
  #undef DMA_K
  #undef DMA_V
  #undef CMASK
  #undef START
  #undef RESC
  #undef ROT
}
constexpr int ATTN_LDS_BYTES=LDS_BYTES;
struct AttnTensors { const bf16* Q; const bf16* K; const bf16* V; bf16* O; const unsigned* SEL; };
struct AttnUnit { int bh; int qb; };
struct StaticOrder {
  int vcu;
  __device__ __forceinline__ explicit StaticOrder(int grid,int block):vcu((block%8)*(grid/8)+block/8){}
  __device__ __forceinline__ bool next(int i,AttnUnit&u)const{ if(i>=4)return false; const int s=vcu&7; u.bh=vcu>>3; u.qb=(i==0)?s:(i==1)?15-s:(i==2)?16+s:31-s; return true; }
  __device__ __forceinline__ void a_ready(const AttnUnit&)const{}
  __device__ __forceinline__ void done(const AttnUnit&)const{}
};
template<class Sched,int THRL=8> __device__ __forceinline__ void attn_phase(char*lds,const AttnTensors&T,const Sched&S,const int wave_s){
  AttnUnit u;
  for(int i=0;S.next(i,u);++i){ S.a_ready(u); attn_unit<THRL>(u.bh/NHEAD,u.bh%NHEAD,u.qb,T.Q,T.K,T.V,T.O,T.SEL,lds,wave_s); S.done(u); }
}
#undef SBAR
#undef WAIT_BAR
}

#define LAS __attribute__((address_space(3)))
#define XB_TMO      128
#define XB_XCNT(j)  (256  + 64 * (j))
#define XB_XSUB(j)  (1280 + 64 * (j))
#define XB_XGEN(j)  (2304 + 64 * (j))
#define XB_TOP      3328
#define XB_TOPGEN   3392
#define XCD_BAR_WORDS 3456
#define XB_SPIN_CAP (1u << 18)

__device__ __forceinline__ unsigned xb_ld(unsigned* p)              { return __hip_atomic_load(p, __ATOMIC_RELAXED, __HIP_MEMORY_SCOPE_AGENT); }
__device__ __forceinline__ unsigned xb_add(unsigned* p, unsigned v) { return __hip_atomic_fetch_add(p, v, __ATOMIC_RELAXED, __HIP_MEMORY_SCOPE_AGENT); }
__device__ __forceinline__ unsigned xb_xcc_id() { return (unsigned)__builtin_amdgcn_s_getreg((3 << 11) | 20) & 0xFu; }
#define XB_SPIN(cond, bar) do { unsigned _sp = 0; while (cond) { __builtin_amdgcn_s_sleep(1); \
    if ((++_sp & 255u) == 0u) { if (xb_ld(&(bar)[XB_TMO])) break; if (_sp > XB_SPIN_CAP) { atomicAdd(&(bar)[XB_TMO], 1u); break; } } } } while (0)

struct XcdBarrier {
    unsigned* bar; unsigned x;
    volatile LAS unsigned* st;
};

__device__ __forceinline__ XcdBarrier xcd_barrier_post(unsigned* bar, volatile LAS unsigned* st) {
    XcdBarrier b; b.bar = bar; b.x = xb_xcc_id(); b.st = st;
    if (threadIdx.x == 0) (void)xb_add(&bar[XB_XCNT(b.x)], 1u);
    return b;
}
__device__ __forceinline__ void xcd_barrier_complete(unsigned* bar, unsigned x, unsigned& nloc, unsigned& nx) {
    const unsigned G = gridDim.x * gridDim.y * gridDim.z;
    unsigned sum, cnt, mine, sp = 0u;
    for (;;) {
        sum = 0u; cnt = 0u; mine = 0u;
#pragma unroll
        for (unsigned j = 0; j < 16; ++j) { const unsigned c = xb_ld(&bar[XB_XCNT(j)]); sum += c; cnt += (c > 0u) ? 1u : 0u; mine = (j == x) ? c : mine; }
        if (sum == G) break;
        __builtin_amdgcn_s_sleep(1);
        if ((++sp & 255u) == 0u) { if (xb_ld(&bar[XB_TMO])) break; if (sp > XB_SPIN_CAP) { atomicAdd(&bar[XB_TMO], 1u); break; } }
    }
    nloc = mine > 0u ? mine : 1u; nx = cnt > 0u ? cnt : 1u;
}

__device__ __forceinline__ void xcd_barrier(const XcdBarrier& b, const bool is_t0) {
    asm volatile("s_waitcnt vmcnt(0)" ::: "memory");
    __syncthreads();
    if (is_t0) {
        unsigned* bar = b.bar;
        __builtin_amdgcn_s_waitcnt(0);
        unsigned nloc = b.st[0], nx = b.st[1];
        if (nloc == 0u) { xcd_barrier_complete(bar, b.x, nloc, nx); b.st[0] = nloc; b.st[1] = nx; }
        const unsigned old = xb_add(&bar[XB_XSUB(b.x)], 1u);
        const unsigned gen = old / nloc;
        if (old + 1u == (gen + 1u) * nloc) {
            __builtin_amdgcn_fence(__ATOMIC_RELEASE, "agent");
            asm volatile("s_waitcnt vmcnt(0)" ::: "memory");
            const unsigned og = xb_add(&bar[XB_TOP], 1u);
            const unsigned tg = og / nx;
            if (og + 1u == (tg + 1u) * nx) xb_add(&bar[XB_TOPGEN], 1u);
            else XB_SPIN(xb_ld(&bar[XB_TOPGEN]) == tg, bar);
            __builtin_amdgcn_fence(__ATOMIC_ACQUIRE, "agent");
            xb_add(&bar[XB_XGEN(b.x)], 1u);
            asm volatile("s_waitcnt vmcnt(0)" ::: "memory");
        } else {
            XB_SPIN(xb_ld(&bar[XB_XGEN(b.x)]) == gen, bar);
            __builtin_amdgcn_fence(__ATOMIC_ACQUIRE, "agent");
            asm volatile("s_waitcnt vmcnt(0)" ::: "memory");
        }
    }
    __syncthreads();
}

#ifndef STAMP_KA
#define STAMP_KA -1
#define STAMP_KB -1
#endif
#ifndef DUP_RWKV
#define DUP_RWKV 0
#endif
#ifndef DUPMASK
#define DUPMASK 0
#endif
#ifndef RWKV_SEQ_OVERRIDE
#define RWKV_SEQ_OVERRIDE 0
#endif
#ifndef RWKV_DBG
#define RWKV_DBG 0
#endif
#ifndef SKIP_DSA
#define SKIP_DSA 0
#endif
#ifndef DSA_DUP_ATT
#define DSA_DUP_ATT 0
#endif
#ifndef DSA_DUP_PASS
#define DSA_DUP_PASS 0
#endif
#ifndef DSA_DUP_KIND
#define DSA_DUP_KIND 0
#endif
#ifndef MOE_SCALE
#define MOE_SCALE 1.0f
#endif
#ifndef DIAG
#define DIAG 0
#endif
#ifndef ABL_MOE
#define ABL_MOE 0
#endif
#ifndef ABL_RWKV
#define ABL_RWKV 0
#endif
#ifndef ABL_DSA
#define ABL_DSA 0
#endif
#ifndef ABL_S5
#define ABL_S5 0
#endif
#ifndef ABL_MOBA
#define ABL_MOBA 0
#endif
#ifndef ABL_FFN0
#define ABL_FFN0 0
#endif
constexpr int NWAVES = 8;
constexpr int T_TOK = 32768, DMODEL = 1024, SEQL = 8192, NBATCH = 4;
constexpr int FFN_D = 2816, ODD_PROJ = 2756, ODD_PAD = 2816, FEXP = 3584, NEXP = 8;
constexpr float NORM_EPS = 1e-6f;
constexpr size_t MiB = 1u << 20;
constexpr size_t WS_CTL = 0, CTL_ZERO_BYTES = 1 * MiB;
constexpr size_t WS_ROPE = 1 * MiB;
constexpr size_t WS_KMEAN = WS_ROPE + 512 * 1024;
constexpr size_t WS_TOKINFO = 2 * MiB;
constexpr size_t WS_TOKSLOT = WS_TOKINFO + 512 * 1024;
constexpr size_t WS_TILEEXP = WS_TOKSLOT + 256 * 1024;
constexpr size_t WS_WE_IN = 3 * MiB;
constexpr size_t WS_WGLU = WS_WE_IN + 4 * MiB;
constexpr size_t WS_WE_OUT = WS_WGLU + MiB / 2;
constexpr size_t WS_WFFN_GU = WS_WE_OUT + 2 * MiB;
constexpr size_t WS_WFFN_D = WS_WFFN_GU + 11 * MiB;
constexpr size_t WS_WO_IN = WS_WFFN_D + 11 * MiB / 2;
constexpr size_t WS_WLORA = WS_WO_IN + 11 * MiB / 2;
constexpr size_t WS_WO_OUT = WS_WLORA + 3 * MiB / 4;
constexpr size_t WS_S5MT = 35 * MiB;
constexpr size_t WS_S5BEND = 55 * MiB;
static_assert(WS_WO_OUT + 2 * MiB <= WS_S5MT, "weights map");
constexpr size_t WS_XN = 64 * MiB;
constexpr size_t WS_CAT = WS_XN;
constexpr size_t WS_UG = 128 * MiB;
constexpr size_t WS_Q0 = 168 * MiB, WS_K0 = 200 * MiB, WS_V0 = 232 * MiB;
constexpr size_t WS_XEND = 264 * MiB;
constexpr size_t WS_YA = 280 * MiB;
constexpr size_t WS_SELM = 312 * MiB;
constexpr size_t WS_SS1 = 314 * MiB, WS_SS2 = 316 * MiB;
constexpr size_t WS_HB1 = 320 * MiB;
constexpr size_t WS_ACT = 128 * MiB;
constexpr size_t WS_P1 = 128 * MiB;
constexpr size_t WS_LORA = 304 * MiB;
constexpr size_t WS_QD = 400 * MiB;
constexpr size_t WS_KD = 432 * MiB;
constexpr size_t WS_KI = 436 * MiB;
constexpr size_t WS_QI = 440 * MiB;
constexpr size_t WS_WI = 456 * MiB;
constexpr size_t WS_VD = 490 * MiB;
constexpr size_t WS_ALORA = 457 * MiB;
constexpr size_t WS_YR = 457 * MiB;
constexpr int MOE_MAXTILES = 264, MOE_CHUNK = 128;
constexpr size_t WS_XG = 64 * MiB;
constexpr size_t WS_YS = 130 * MiB;
constexpr size_t WS_WMOE_GU = 262 * MiB;
constexpr size_t WS_WMOE_D = 318 * MiB;
constexpr size_t WS_ACTQ = 346 * MiB;
constexpr float MOE_WGU_SCALE = 32.0f, MOE_WD_SCALE = 64.0f, FFN_WGU_SCALE = 32.0f, FFN_WD_SCALE = 64.0f;
constexpr size_t WS_NEED = 494 * MiB;
constexpr int CW_BAR = 4096;
constexpr int MAX_LAUNCH = 36;
constexpr int CW_EXPCNT = 196608;
static_assert((CW_BAR + MAX_LAUNCH * 3456) <= CW_EXPCNT && (CW_EXPCNT + 8 * 64) * 4 <= (int)CTL_ZERO_BYTES, "ctl map");

constexpr int RING_BYTES = 131072;
constexpr int MISC_OFF = 147200;
constexpr int LDS_BYTES = 147456;

#define GAS __attribute__((address_space(1)))
typedef unsigned short bf16;
typedef unsigned v4u __attribute__((ext_vector_type(4)));
typedef unsigned v2u __attribute__((ext_vector_type(2)));
typedef float f32x4 __attribute__((ext_vector_type(4)));
typedef float f32x2 __attribute__((ext_vector_type(2)));
typedef short bf16x8 __attribute__((ext_vector_type(8)));
#define LDS_WAIT() asm volatile("s_waitcnt lgkmcnt(0)" ::: "memory")
#define VM_WAIT() asm volatile("s_waitcnt vmcnt(0)" ::: "memory")
typedef float cv_f32x2 __attribute__((ext_vector_type(2))); typedef __bf16 cv_bf16x2 __attribute__((ext_vector_type(2)));
__device__ __forceinline__ unsigned pk2(float lo, float hi) { const cv_f32x2 v = {lo, hi}; const cv_bf16x2 b = __builtin_convertvector(v, cv_bf16x2); return __builtin_bit_cast(unsigned, b); }
__device__ __forceinline__ unsigned f2bf(float f) { return pk2(f, 0.f) & 0xffffu; }
__device__ __forceinline__ float clamp448(float x) { return __builtin_amdgcn_fmed3f(x, -448.0f, 448.0f); }
__device__ __forceinline__ unsigned pk4_fp8(float a, float b, float c, float d) {
    unsigned w = __builtin_amdgcn_cvt_pk_fp8_f32(clamp448(a), clamp448(b), 0u, false); return __builtin_amdgcn_cvt_pk_fp8_f32(clamp448(c), clamp448(d), w, true); }
__device__ __forceinline__ float bf2f(unsigned short b) { return __builtin_bit_cast(float, (unsigned)b << 16); }
__device__ __forceinline__ float bflo(unsigned w) { return __builtin_bit_cast(float, w << 16); }
__device__ __forceinline__ float bfhi(unsigned w) { return __builtin_bit_cast(float, w & 0xffff0000u); }
__device__ __forceinline__ void unpack8(const v4u w, float (&o)[8]) { o[0] = bflo(w.x); o[1] = bfhi(w.x); o[2] = bflo(w.y); o[3] = bfhi(w.y); o[4] = bflo(w.z); o[5] = bfhi(w.z); o[6] = bflo(w.w); o[7] = bfhi(w.w); }
__device__ __forceinline__ v4u pack8(const float (&v)[8]) { v4u w; w.x = pk2(v[0], v[1]); w.y = pk2(v[2], v[3]); w.z = pk2(v[4], v[5]); w.w = pk2(v[6], v[7]); return w; }
__device__ __forceinline__ void store8_bf16(bf16* dst, const float (&v)[8]) { *(v4u*)dst = pack8(v); }
__device__ __forceinline__ void load8_bf16(const bf16* src, float (&o)[8]) { const v4u w = *(const v4u*)src; unpack8(w, o); }
__device__ __forceinline__ float wave_sum(float v) {
#pragma unroll
    for (int o = 1; o < 64; o <<= 1) v += __shfl_xor(v, o);
    return v;
}
__device__ __forceinline__ float sigmoidf_(float x) { return __builtin_amdgcn_rcpf(1.0f + __expf(-x)); }
__device__ __forceinline__ float gelu_tanh(float x) { const float z = 0.7978845608028654f * (x + 0.044715f * x * x * x); const float t = 1.0f - 2.0f * __builtin_amdgcn_rcpf(1.0f + __expf(2.0f * z)); return 0.5f * x * (1.0f + t); }


__device__ __forceinline__ float dpp_sum8(float x) {
    x += __builtin_bit_cast(float, __builtin_amdgcn_mov_dpp(__builtin_bit_cast(int, x), 0xB1, 0xf, 0xf, true));
    x += __builtin_bit_cast(float, __builtin_amdgcn_mov_dpp(__builtin_bit_cast(int, x), 0x4E, 0xf, 0xf, true));
    x += __builtin_bit_cast(float, __builtin_amdgcn_mov_dpp(__builtin_bit_cast(int, x), 0x141, 0xf, 0xf, true));
    return x;
}

struct Args { const float* in[38]; float* out; unsigned char* ws; int ph_lo, ph_hi, li, pad; };
struct Frame {
    LAS unsigned char* lds;
    int wave, G;
    const float* const* in; float* out; unsigned char* ws;
};
enum InIdx { I_X = 0, I_E_NORM_MIX, I_E_W_IN, I_S5_A_RE, I_S5_A_IM, I_S5_LOG_DT, I_S5_B_RE, I_S5_B_IM, I_S5_C_RE, I_S5_C_IM, I_S5_D, I_S5_GLU_W, I_S5_GLU_B, I_E_W_OUT, I_E_NORM_FFN,
             I_FFN_GATE, I_FFN_UP, I_FFN_DOWN, I_O_NORM_MIX, I_O_W_IN, I_RWKV_MU, I_RWKV_W0, I_RWKV_W_UP, I_RWKV_A0, I_RWKV_A_UP, I_RWKV_G_UP, I_RWKV_K_K, I_RWKV_K_A, I_RWKV_R_K,
             I_RWKV_LN_W, I_RWKV_LN_B, I_O_W_OUT, I_O_NORM_FFN, I_MOE_ROUTER, I_MOE_GATE, I_MOE_UP, I_MOE_DOWN, I_FINAL_NORM };

template <int MODE>
__device__ __forceinline__ void tr_item(const float* __restrict__ W, int K, int N, bf16* __restrict__ WT, int ldo, int row_off, const float* __restrict__ gain, LAS float* scr, int kb, int nb, int lane) {
    const int k0 = 64 * kb, n0 = 32 * nb; const int nn = n0 + (lane & 31);
#pragma unroll 8
    for (int i = 0; i < 32; ++i) { const int kk = 2 * i + (lane >> 5); float w = (nn < N) ? W[(size_t)(k0 + kk) * N + nn] : 0.f; if (gain) w *= gain[k0 + kk]; scr[kk * 33 + (lane & 31)] = w; }
    LDS_WAIT(); asm volatile("" ::: "memory");
    const int c = lane & 7;
#pragma unroll
    for (int j = 0; j < 4; ++j) { const int nl = (lane >> 3) + 8 * j; const int n = n0 + nl; const LAS float* s = scr + (8 * c) * 33 + nl;
        v4u o; o.x = pk2(s[0 * 33], s[1 * 33]); o.y = pk2(s[2 * 33], s[3 * 33]); o.z = pk2(s[4 * 33], s[5 * 33]); o.w = pk2(s[6 * 33], s[7 * 33]);
        const int row = (MODE == 0) ? (row_off + n) : (row_off + (n >> 7) * 256 + (n & 127));
        if (n < N) *(v4u*)(WT + (size_t)row * ldo + k0 + 8 * c) = o; }
    LDS_WAIT(); asm volatile("" ::: "memory");
}
template <int MODE>
__device__ __forceinline__ void tr_item64(const float* __restrict__ W, int K, int N, bf16* __restrict__ WT, int ldo, int row_off, const float* __restrict__ gain, LAS bf16* scr, int kb, int nb, int lane) {
    const int k0 = 64 * kb, n0 = 64 * nb, n4 = (lane & 15) * 4, kr = lane >> 4; const bool ok = (n0 + n4) < N;
    f32x4 v[16];
#pragma unroll
    for (int i = 0; i < 16; ++i) v[i] = ok ? *(const f32x4*)(W + (size_t)(k0 + 4 * i + kr) * N + n0 + n4) : (f32x4){0.f, 0.f, 0.f, 0.f};
#pragma unroll
    for (int i = 0; i < 16; ++i) { const int k = 4 * i + kr; const float gg = gain ? gain[k0 + k] : 1.0f; LAS bf16* d = scr + n4 * 72 + k;
        d[0] = (bf16)f2bf(v[i].x * gg); d[72] = (bf16)f2bf(v[i].y * gg); d[144] = (bf16)f2bf(v[i].z * gg); d[216] = (bf16)f2bf(v[i].w * gg); }
    LDS_WAIT(); asm volatile("" ::: "memory");
    const int c = lane & 7;
#pragma unroll
    for (int j = 0; j < 8; ++j) { const int nl = (lane >> 3) + 8 * j, n = n0 + nl; const v4u o = *(const LAS v4u*)(scr + nl * 72 + 8 * c);
        const int row = (MODE == 0) ? (row_off + n) : (row_off + (n >> 7) * 256 + (n & 127));
        if (n < N) *(v4u*)(WT + (size_t)row * ldo + k0 + 8 * c) = o; }
    LDS_WAIT(); asm volatile("" ::: "memory");
}
__device__ __forceinline__ void tr64_load(const float* __restrict__ W, int N, int kb, int nb, int lane, f32x4 (&v)[16]) {
    const int k0 = 64 * kb, n0 = 64 * nb, n4 = (lane & 15) * 4, kr = lane >> 4;
#pragma unroll
    for (int i = 0; i < 16; ++i) v[i] = *(const f32x4*)(W + (size_t)(k0 + 16 * (i >> 2) + 4 * kr + (i & 3)) * N + n0 + n4);
}
template <int MODE>
__device__ __forceinline__ void tr64_f8_finish(const f32x4 (&v)[16], unsigned char* __restrict__ WT, int ldo, int row_off, const float* __restrict__ gain, float scale, LAS unsigned char* scr, int kb, int nb, int lane) {
    const int k0 = 64 * kb, n0 = 64 * nb, n4 = (lane & 15) * 4, kr = lane >> 4;
#pragma unroll
    for (int i = 0; i < 16; ++i) { const int k = 16 * (i >> 2) + 4 * kr + (i & 3); const float gg = (gain ? gain[k0 + k] : 1.0f) * scale; const unsigned w = pk4_fp8(v[i].x * gg, v[i].y * gg, v[i].z * gg, v[i].w * gg); LAS unsigned char* d = scr + n4 * 68 + k;
        d[0] = (unsigned char)w; d[68] = (unsigned char)(w >> 8); d[136] = (unsigned char)(w >> 16); d[204] = (unsigned char)(w >> 24); }
    LDS_WAIT(); asm volatile("" ::: "memory");
    const int c = lane & 3;
#pragma unroll
    for (int j = 0; j < 4; ++j) { const int nl = (lane >> 2) + 16 * j, n = n0 + nl; const LAS unsigned* sp = (const LAS unsigned*)(scr + nl * 68 + 16 * c); const v4u o = {sp[0], sp[1], sp[2], sp[3]};
        const int row = (MODE == 0) ? (row_off + n) : (row_off + (n >> 7) * 256 + (n & 127));
        *(v4u*)(WT + (size_t)row * ldo + k0 + 16 * c) = o; }
    LDS_WAIT(); asm volatile("" ::: "memory");
}
template <int MODE>
__device__ __forceinline__ void tr_item64_f8(const float* __restrict__ W, int K, int N, unsigned char* __restrict__ WT, int ldo, int row_off, const float* __restrict__ gain, float scale, LAS unsigned char* scr, int kb, int nb, int lane) {
    f32x4 v[16]; tr64_load(W, N, kb, nb, lane, v); tr64_f8_finish<MODE>(v, WT, ldo, row_off, gain, scale, scr, kb, nb, lane);
}
__device__ __forceinline__ void rms_row_to_bf16(const float* xrow, bf16* orow, int lane) {
    const f32x4* xr = (const f32x4*)xrow + lane;
    f32x4 v[4]; float s = 0.f;
#pragma unroll
    for (int j = 0; j < 4; ++j) { v[j] = xr[64 * j]; s += (v[j].x * v[j].x + v[j].y * v[j].y) + (v[j].z * v[j].z + v[j].w * v[j].w); }
    const float rstd = __builtin_amdgcn_rsqf(wave_sum(s) * (1.f / DMODEL) + NORM_EPS);
    unsigned long long* o8 = (unsigned long long*)orow + lane;
#pragma unroll
    for (int j = 0; j < 4; ++j) o8[64 * j] = (unsigned long long)pk2(v[j].x * rstd, v[j].y * rstd) | ((unsigned long long)pk2(v[j].z * rstd, v[j].w * rstd) << 32);
}
__device__ __forceinline__ void norm_phase(Frame& F, const float* src, bf16* dst, int hb, int HG) {
    const int gw = hb * NWAVES + F.wave, NGW = HG * NWAVES, lane = mk_lane();
    for (int m0 = gw; m0 < T_TOK; m0 += 4 * NGW) { f32x4 v[4][4];
#pragma unroll
        for (int r = 0; r < 4; ++r) { const int m = m0 + r * NGW; const f32x4* xr = (const f32x4*)(src + (size_t)(m < T_TOK ? m : m0) * DMODEL) + lane;
#pragma unroll
            for (int j = 0; j < 4; ++j) v[r][j] = xr[64 * j]; }
#pragma unroll
        for (int r = 0; r < 4; ++r) { const int m = m0 + r * NGW; float s = 0.f;
#pragma unroll
            for (int j = 0; j < 4; ++j) s += (v[r][j].x * v[r][j].x + v[r][j].y * v[r][j].y) + (v[r][j].z * v[r][j].z + v[r][j].w * v[r][j].w);
            const float rstd = __builtin_amdgcn_rsqf(wave_sum(s) * (1.f / DMODEL) + NORM_EPS);
            if (m < T_TOK) { unsigned long long* o8 = (unsigned long long*)(dst + (size_t)m * DMODEL) + lane;
#pragma unroll
                for (int j = 0; j < 4; ++j) o8[64 * j] = (unsigned long long)pk2(v[r][j].x * rstd, v[r][j].y * rstd) | ((unsigned long long)pk2(v[r][j].z * rstd, v[r][j].w * rstd) << 32); } } }
}

__device__ __forceinline__ void s5_build_group(Frame& F, int g) {
    LAS float* pw_re = (LAS float*)F.lds;
    LAS float* pw_im = pw_re + 33 * 64;
    LAS float* bb_re = pw_im + 33 * 64;
    LAS float* bb_im = bb_re + 1024;
    LAS float* cc_re = bb_im + 1024;
    LAS float* cc_im = cc_re + 1024;
    LAS float* klag = cc_im + 1024;
    LAS float* lm = klag + 8192;
    LAS float* th = lm + 64;
    LAS float* fr = th + 64;
    LAS float* fi = fr + 64;
    const float* a_re = F.in[I_S5_A_RE]; const float* a_im = F.in[I_S5_A_IM]; const float* log_dt = F.in[I_S5_LOG_DT];
    const float* b_re = F.in[I_S5_B_RE]; const float* b_im = F.in[I_S5_B_IM]; const float* c_re = F.in[I_S5_C_RE]; const float* c_im = F.in[I_S5_C_IM];
    const int tid = F.wave * 64 + mk_lane();
    if (tid < 64) { const int p = tid; const float ar = a_re[g * 64 + p], ai = a_im[g * 64 + p], dt = expf(log_dt[g]);
        const float mag = expf(dt * ar); float sn, cs; sincosf(dt * ai, &sn, &cs); const float abr = mag * cs, abi = mag * sn;
        const float den = ar * ar + ai * ai, xr = abr - 1.0f, xi = abi;
        lm[p] = dt * ar; th[p] = dt * ai; fr[p] = (xr * ar + xi * ai) / den; fi[p] = (xi * ar - xr * ai) / den; }
    __syncthreads();
    for (int idx = tid; idx < 33 * 64; idx += 512) { const int tau = idx >> 6, p = idx & 63; const float mag = expf((float)tau * lm[p]); float sn, cs; sincosf((float)tau * th[p], &sn, &cs); pw_re[idx] = mag * cs; pw_im[idx] = mag * sn; }
    for (int idx = tid; idx < 1024; idx += 512) { const int p = idx >> 4; const float br = b_re[(size_t)g * 1024 + idx], bi = b_im[(size_t)g * 1024 + idx];
        bb_re[idx] = fr[p] * br - fi[p] * bi; bb_im[idx] = fr[p] * bi + fi[p] * br;
        cc_re[idx] = c_re[(size_t)g * 1024 + idx]; cc_im[idx] = c_im[(size_t)g * 1024 + idx]; }
    __syncthreads();
    for (int idx = tid; idx < 8192; idx += 512) { const int tau = idx >> 8, c = (idx >> 4) & 15, c2 = idx & 15; float s = 0.f;
        for (int p = 0; p < 64; ++p) { const float cr = cc_re[c * 64 + p], ci = cc_im[c * 64 + p], pr = pw_re[tau * 64 + p], pi = pw_im[tau * 64 + p];
            const float er = cr * pr - ci * pi, ei = cr * pi + ci * pr; s += er * bb_re[p * 16 + c2] - ei * bb_im[p * 16 + c2]; }
        klag[idx] = s; }
    __syncthreads();
    bf16* MT = (bf16*)(F.ws + WS_S5MT) + (size_t)g * 512 * 640;
    for (int ch = tid; ch < 512 * 80; ch += 512) { const int n = ch / 80, kc = ch % 80, t = n >> 4, c = n & 15, k0 = 8 * kc; float v[8];
        if (k0 < 512) { const int s = k0 >> 4, c0 = k0 & 15;
#pragma unroll
            for (int j = 0; j < 8; ++j) v[j] = (s <= t) ? klag[((t - s) * 16 + c) * 16 + c0 + j] : 0.f;
        } else {
#pragma unroll
            for (int j = 0; j < 8; ++j) { const int jj = k0 - 512 + j, p = jj >> 1; const float cr = cc_re[c * 64 + p], ci = cc_im[c * 64 + p], pr = pw_re[(t + 1) * 64 + p], pi = pw_im[(t + 1) * 64 + p];
                v[j] = (jj & 1) ? -(cr * pi + ci * pr) : (cr * pr - ci * pi); }
        }
        store8_bf16(MT + (size_t)n * 640 + k0, v); }
    bf16* BE = (bf16*)(F.ws + WS_S5BEND) + (size_t)g * 256 * 512;
    for (int ch = tid; ch < 256 * 64; ch += 512) { const int n = ch >> 6, kc = ch & 63, k0 = 8 * kc, s = k0 >> 4, c0 = k0 & 15; float v[8];
        if (n < 128) { const int p = n >> 1; const float pr = pw_re[(31 - s) * 64 + p], pi = pw_im[(31 - s) * 64 + p];
#pragma unroll
            for (int j = 0; j < 8; ++j) { const float br = bb_re[p * 16 + c0 + j], bi = bb_im[p * 16 + c0 + j]; v[j] = (n & 1) ? (pr * bi + pi * br) : (pr * br - pi * bi); }
        } else {
#pragma unroll
            for (int j = 0; j < 8; ++j) v[j] = 0.f;
        }
        store8_bf16(BE + (size_t)n * 512 + k0, v); }
    __syncthreads();
}

__device__ __forceinline__ void p0_prologue(Frame& F, int parts = 15) {
    if (parts & 1) { if ((int)blockIdx.x < 32) s5_build_group(F, (int)blockIdx.x);
        if (F.G < 32) { for (int g = F.G + (int)blockIdx.x; g < 32; g += F.G) s5_build_group(F, g); } }
    if (!(parts & 14)) return;
    LAS bf16* scr = (LAS bf16*)(F.lds + F.wave * 16384);
    const int lane = mk_lane(), tid = F.wave * 64 + lane;
    const bool sep = F.G >= 64; if (sep && (int)blockIdx.x < 32) return;
    const int hb = sep ? (int)blockIdx.x - 32 : (int)blockIdx.x, HG = sep ? F.G - 32 : F.G;
    const int gw = hb * NWAVES + F.wave, NGW = HG * NWAVES;
    constexpr int J0 = 16 * 32, J1 = 8 * 8, J2 = 16 * 16, J3 = 16 * 44, J4 = J3, J5 = 44 * 16, J6 = 16 * 44, J7 = 16 * 16;
    constexpr int NIT = J0 + J1 + J2 + J3 + J4 + J5 + J6; (void)J7;
    unsigned char* ws = F.ws;
    if (parts & 2) for (int it = gw; it < NIT; it += NGW) {
        int r = it;
        if (r < J0) { tr_item64<0>(F.in[I_E_W_IN], 1024, 2048, (bf16*)(ws + WS_WE_IN), 1024, 0, F.in[I_E_NORM_MIX], scr, r / 32, r % 32, lane); continue; } r -= J0;
        if (r < J1) { tr_item64<0>(F.in[I_S5_GLU_W], 512, 512, (bf16*)(ws + WS_WGLU), 512, 0, nullptr, scr, r / 8, r % 8, lane); continue; } r -= J1;
        if (r < J2) { tr_item64<0>(F.in[I_E_W_OUT], 1024, 1024, (bf16*)(ws + WS_WE_OUT), 1024, 0, nullptr, scr, r / 16, r % 16, lane); continue; } r -= J2;
        if (r < J3) { tr_item64<1>(F.in[I_FFN_GATE], 1024, FFN_D, (bf16*)(ws + WS_WFFN_GU), 1024, 0, F.in[I_E_NORM_FFN], scr, r / 44, r % 44, lane); continue; } r -= J3;
        if (r < J4) { tr_item64<1>(F.in[I_FFN_UP], 1024, FFN_D, (bf16*)(ws + WS_WFFN_GU), 1024, 128, F.in[I_E_NORM_FFN], scr, r / 44, r % 44, lane); continue; } r -= J4;
        if (r < J5) { tr_item64<0>(F.in[I_FFN_DOWN], FFN_D, 1024, (bf16*)(ws + WS_WFFN_D), FFN_D, 0, nullptr, scr, r / 16, r % 16, lane); continue; } r -= J5;
        tr_item64<0>(F.in[I_O_W_IN], 1024, ODD_PROJ, (bf16*)(ws + WS_WO_IN), 1024, 0, F.in[I_O_NORM_MIX], scr, r / 44, r % 44, lane);
    }
    const int gt = hb * 512 + tid, NGT = HG * 512;
    if (parts & 4) {
    { bf16* w = (bf16*)(ws + WS_WO_IN) + (size_t)ODD_PROJ * 1024; for (int i = gt; i < (ODD_PAD - ODD_PROJ) * 1024 / 8; i += NGT) *(v4u*)(w + (size_t)i * 8) = (v4u){0u, 0u, 0u, 0u}; }
    { bf16* w = (bf16*)(ws + WS_WLORA); const float* wu = F.in[I_RWKV_W_UP]; const float* au = F.in[I_RWKV_A_UP]; const float* gu = F.in[I_RWKV_G_UP];
      for (int i = gt; i < 1536 * 256; i += NGT) { const int n = i >> 8, k = i & 255; float v = 0.f;
          if (n < 512) { if (k < 64) v = wu[k * 512 + n]; } else if (n < 1024) { if (k >= 64 && k < 128) v = au[(k - 64) * 512 + (n - 512)]; } else { if (k >= 128) v = gu[(k - 128) * 512 + (n - 1024)]; }
          w[i] = (bf16)f2bf(v); } }
    { float* rp = (float*)(ws + WS_ROPE); for (int i = gt; i < 8192 * 8; i += NGT) { const int pos = i >> 3, j = i & 7; const float inv = powf(500000.0f, -(float)j / 8.0f); const float ang = (float)pos * inv;
          rp[pos * 16 + j] = cosf(ang); rp[pos * 16 + 8 + j] = sinf(ang); } }
    }
    if (parts & 8) norm_phase(F, F.in[I_X], (bf16*)(ws + WS_XN), hb, HG);
}

constexpr float ATT_C2 = 0.125f * 1.4426950408889634f;
struct F_E1 {
    bf16* UG; bf16* Q0; bf16* K0; bf16* V0; const float* rope;
    __device__ __forceinline__ void operator()(const pg8::Unit& u, int r, int c, float (&v)[8], int wc) const {
        const int row = u.pm * 256 + r, col = u.pn * 256 + c, seg = u.pn >> 1;
        if (seg == 0) { const int g = col >> 4, c0 = col & 15; store8_bf16(UG + ((size_t)(g * 1024 + (row >> 5)) * 640 + (row & 31) * 16 + c0), v); }
        else if (seg == 3) { store8_bf16(V0 + (size_t)row * 512 + (col - 1536), v); }
        else { const int ch = col - seg * 512;
            if ((wc & 1) == 0) { float o[8];
#pragma unroll
                for (int j = 0; j < 8; ++j) o[j] = __shfl_xor(v[j], 16);
                const int d = ch & 63;
                if (d < 16) { const float* cs = rope + (size_t)(row & 8191) * 16; const f32x4 c0 = *(const f32x4*)cs, c1 = *(const f32x4*)(cs + 4), s0 = *(const f32x4*)(cs + 8), s1 = *(const f32x4*)(cs + 12);
                    const float cv[8] = {c0.x, c0.y, c0.z, c0.w, c1.x, c1.y, c1.z, c1.w}, sv[8] = {s0.x, s0.y, s0.z, s0.w, s1.x, s1.y, s1.z, s1.w};
                    const float sgn = (d == 0) ? -1.0f : 1.0f;
#pragma unroll
                    for (int j = 0; j < 8; ++j) v[j] = v[j] * cv[j] + sgn * o[j] * sv[j]; } }
            if (seg == 1) {
#pragma unroll
                for (int j = 0; j < 8; ++j) v[j] *= ATT_C2;
                store8_bf16(Q0 + (size_t)row * 512 + ch, v); }
            else store8_bf16(K0 + (size_t)row * 512 + ch, v); }
    }
};
struct EpiE1 {
    static constexpr bool PERM = true, AFTER_DRAIN = false;
    bf16* UG; bf16* Q0; bf16* K0; bf16* V0; const float* rope;
    __device__ __forceinline__ void operator()(const pg8::f32x4 (&acc)[2][2][4][2], const pg8::Unit& u, int wr, int wc, int fr, int fq) const {
        const int seg = u.pn >> 1;
        if (seg == 0 || seg == 3) {
#pragma unroll
            for (int ai = 0; ai < 2; ++ai)
#pragma unroll
                for (int m = 0; m < 4; ++m) { const int row = u.pm * 256 + ai * 128 + wr * 64 + m * 16 + fr;
#pragma unroll
                    for (int bj = 0; bj < 2; ++bj) { const int col = u.pn * 256 + bj * 128 + wc * 32 + 8 * fq;
                        float v[8] = {acc[ai][bj][m][0][0], acc[ai][bj][m][0][1], acc[ai][bj][m][0][2], acc[ai][bj][m][0][3], acc[ai][bj][m][1][0], acc[ai][bj][m][1][1], acc[ai][bj][m][1][2], acc[ai][bj][m][1][3]};
                        if (seg == 0) { const int g = col >> 4, c0 = col & 15; store8_bf16(UG + ((size_t)(g * 1024 + (row >> 5)) * 640 + (row & 31) * 16 + c0), v); }
                        else store8_bf16(V0 + (size_t)row * 512 + (col - 1536), v); } }
            return; }
        bf16* dst = (seg == 1) ? Q0 : K0; const float osc = (seg == 1) ? ATT_C2 : 1.0f;
        const bool ropew = (wc & 1) == 0;
        if (!ropew) {
#pragma unroll
            for (int ai = 0; ai < 2; ++ai)
#pragma unroll
                for (int m = 0; m < 4; ++m) { const int row = u.pm * 256 + ai * 128 + wr * 64 + m * 16 + fr;
#pragma unroll
                    for (int bj = 0; bj < 2; ++bj) { const int ch = (u.pn & 1) * 256 + bj * 128 + wc * 32 + 8 * fq;
                        float v[8] = {acc[ai][bj][m][0][0] * osc, acc[ai][bj][m][0][1] * osc, acc[ai][bj][m][0][2] * osc, acc[ai][bj][m][0][3] * osc, acc[ai][bj][m][1][0] * osc, acc[ai][bj][m][1][1] * osc, acc[ai][bj][m][1][2] * osc, acc[ai][bj][m][1][3] * osc};
                        store8_bf16(dst + (size_t)row * 512 + ch, v); } }
            return; }
        const float sgn = (fq == 0) ? -osc : osc; const float keep = (fq < 2) ? 0.0f : osc;
        f32x4 pr[2][2][4];
#define E1_LOAD(b, buf) do { _Pragma("unroll") for (int mm = 0; mm < 2; ++mm) { const int ri = (b) * 2 + mm; const int row = u.pm * 256 + (ri >> 2) * 128 + wr * 64 + (ri & 3) * 16 + fr; \
            const f32x4* cs = (const f32x4*)(rope + (size_t)(row & 8191) * 16); pr[buf][mm][0] = cs[0]; pr[buf][mm][1] = cs[1]; pr[buf][mm][2] = cs[2]; pr[buf][mm][3] = cs[3]; } } while (0)
        E1_LOAD(0, 0);
#pragma unroll
        for (int b = 0; b < 4; ++b) {
            if (b + 1 < 4) E1_LOAD(b + 1, (b + 1) & 1);
#pragma unroll
            for (int mm = 0; mm < 2; ++mm) { const int ri = b * 2 + mm, ai = ri >> 2, m = ri & 3; const int row = u.pm * 256 + ai * 128 + wr * 64 + m * 16 + fr;
                const f32x4 c0 = pr[b & 1][mm][0], c1 = pr[b & 1][mm][1], s0 = pr[b & 1][mm][2], s1 = pr[b & 1][mm][3];
                float cv[8] = {c0.x, c0.y, c0.z, c0.w, c1.x, c1.y, c1.z, c1.w}, sv[8] = {s0.x, s0.y, s0.z, s0.w, s1.x, s1.y, s1.z, s1.w};
#pragma unroll
                for (int j = 0; j < 8; ++j) { cv[j] = (fq < 2) ? cv[j] * osc : keep; sv[j] = (fq < 2) ? sv[j] * sgn : 0.0f; }
#pragma unroll
                for (int bj = 0; bj < 2; ++bj) { const int ch = (u.pn & 1) * 256 + bj * 128 + wc * 32 + 8 * fq;
                    float v[8] = {acc[ai][bj][m][0][0], acc[ai][bj][m][0][1], acc[ai][bj][m][0][2], acc[ai][bj][m][0][3], acc[ai][bj][m][1][0], acc[ai][bj][m][1][1], acc[ai][bj][m][1][2], acc[ai][bj][m][1][3]};
                    float o[8];
#pragma unroll
                    for (int j = 0; j < 8; ++j) o[j] = __shfl_xor(v[j], 16);
#pragma unroll
                    for (int j = 0; j < 8; ++j) v[j] = v[j] * cv[j] + o[j] * sv[j];
                    store8_bf16(dst + (size_t)row * 512 + ch, v); } } }
#undef E1_LOAD
    }
};
struct F_XEND { float* XEND;
    __device__ __forceinline__ void operator()(const pg8::Unit& u, int r, int c, float (&v)[8], int) const {
        if (c < 128) { float* d = XEND + (size_t)(u.pm * 256 + r) * 128 + c; *(f32x4*)d = (f32x4){v[0], v[1], v[2], v[3]}; *(f32x4*)(d + 4) = (f32x4){v[4], v[5], v[6], v[7]}; } }
};
struct F_S5Y { const bf16* UG; const float* dsk; bf16* YA;
    static constexpr int MB = 4; typedef v4u Pre; struct Hoist { f32x4 d[2]; };
    __device__ __forceinline__ void hoist(const pg8::Unit& u, int, int fq, Hoist& h) const { const int ch = (u.pm >> 2) * 16 + ((8 * fq) & 15); h.d[0] = *(const f32x4*)(dsk + ch); h.d[1] = *(const f32x4*)(dsk + ch + 4); }
    __device__ __forceinline__ void load(const pg8::Unit& u, int r, int c, Pre& p) const { p = *(const v4u*)(UG + (size_t)(u.pm * 256 + r) * 640 + (u.pn & 1) * 256 + c); }
    __device__ __forceinline__ void apply(const pg8::Unit& u, int r, int c, float (&v)[8], const Pre& p, const Hoist& h, int) const {
        const int row = u.pm * 256 + r, lc = (u.pn & 1) * 256 + c, g = u.pm >> 2, t = lc >> 4, c0 = lc & 15;
        const int token = (row & 1023) * 32 + t, ch = g * 16 + c0;
        float uu[8]; unpack8(p, uu);
        const float dv[8] = {h.d[0].x, h.d[0].y, h.d[0].z, h.d[0].w, h.d[1].x, h.d[1].y, h.d[1].z, h.d[1].w};
#pragma unroll
        for (int j = 0; j < 8; ++j) v[j] = gelu_tanh(v[j] + dv[j] * uu[j]);
        store8_bf16(YA + (size_t)token * 512 + ch, v); }
};
struct F_GLU { const bf16* YA; const float* gb; bf16* CAT;
    static constexpr int MB = 4; typedef v4u Pre; struct Hoist { f32x4 b[2][2]; };
    __device__ __forceinline__ void hoist(const pg8::Unit& u, int wc, int fq, Hoist& h) const {
#pragma unroll
        for (int bj = 0; bj < 2; ++bj) { const int col = u.pn * 256 + bj * 128 + wc * 32 + 8 * fq; h.b[bj][0] = *(const f32x4*)(gb + col); h.b[bj][1] = *(const f32x4*)(gb + col + 4); } }
    __device__ __forceinline__ void load(const pg8::Unit& u, int r, int c, Pre& p) const { p = *(const v4u*)(YA + (size_t)(u.pm * 256 + r) * 512 + u.pn * 256 + c); }
    __device__ __forceinline__ void apply(const pg8::Unit& u, int r, int c, float (&v)[8], const Pre& p, const Hoist& h, int bj) const {
        const int row = u.pm * 256 + r, col = u.pn * 256 + c;
        float ya[8]; unpack8(p, ya);
        const f32x4 b0 = h.b[bj][0], b1 = h.b[bj][1]; const float bv[8] = {b0.x, b0.y, b0.z, b0.w, b1.x, b1.y, b1.z, b1.w};
#pragma unroll
        for (int j = 0; j < 8; ++j) v[j] = ABL_S5 ? 0.f : ya[j] * sigmoidf_(v[j] + bv[j]);
        store8_bf16(CAT + (size_t)row * 1024 + col, v); }
};
constexpr int RES_LD = 2 * DMODEL;
struct F_RES { const bf16* base; bf16* out;
    static constexpr int MB = 4; typedef v4u Pre; struct Hoist {};
    __device__ __forceinline__ void hoist(const pg8::Unit&, int, int, Hoist&) const {}
    __device__ __forceinline__ void load(const pg8::Unit& u, int r, int c, Pre& p) const { p = *(const v4u*)(base + (size_t)(u.pm * 256 + r) * RES_LD + u.pn * 256 + c); }
    __device__ __forceinline__ void apply(const pg8::Unit& u, int r, int c, float (&v)[8], const Pre& p, const Hoist&, int) const {
        float b[8]; unpack8(p, b);
#pragma unroll
        for (int j = 0; j < 8; ++j) v[j] += b[j];
        store8_bf16(out + (size_t)(u.pm * 256 + r) * RES_LD + u.pn * 256 + c, v); }
};
__device__ __forceinline__ float row_rstd16(const float* SS, int row) {
    const f32x4* p = (const f32x4*)(SS + (size_t)row * 16); const f32x4 a = p[0], b = p[1], c = p[2], d = p[3];
    const float s = ((a.x + a.y) + (a.z + a.w)) + ((b.x + b.y) + (b.z + b.w)) + ((c.x + c.y) + (c.z + c.w)) + ((d.x + d.y) + (d.z + d.w));
    return __builtin_amdgcn_rsqf(s * (1.f / DMODEL) + NORM_EPS); }
struct F_SWIGLU { bf16* ACT; int ld; const float* SS; int mode = 0;
    __device__ __forceinline__ void operator()(const pg8::Unit& u, int r, int c, float (&g)[8], float (&p)[8], float rs) const {
        const int row = u.pm * 256 + r;
        float o[8];
#pragma unroll
        for (int j = 0; j < 8; ++j) { const float gg = g[j] * rs; o[j] = ABL_FFN0 ? 0.f : gg * sigmoidf_(gg) * (p[j] * rs); }
        if (mode == 0 || o[0] == 1.2345e-30f) store8_bf16(ACT + (size_t)row * ld + u.pn * 128 + c, o); }
};
template <bool BASE_BF16> struct EpiResNorm {
    static constexpr bool PERM = true, AFTER_DRAIN = false;
    const void* base; bf16* HB; bf16* RES; float* SS; int skip = 0;
    __device__ __forceinline__ void operator()(const pg8::f32x4 (&acc)[2][2][4][2], const pg8::Unit& u, int wr, int wc, int fr, int fq) const {
        if (skip) return;
        f32x4 pa[2][2][2][2];
#define ERN_LOAD(b, buf) do { _Pragma("unroll") for (int mm = 0; mm < 2; ++mm) { const int ri = (b) * 2 + mm; const int row = u.pm * 256 + (ri >> 2) * 128 + wr * 64 + (ri & 3) * 16 + fr; \
            _Pragma("unroll") for (int bj = 0; bj < 2; ++bj) { const size_t o = (size_t)row * 1024 + u.pn * 256 + bj * 128 + wc * 32 + 8 * fq; \
                if (BASE_BF16) pa[buf][mm][bj][0] = __builtin_bit_cast(f32x4, *(const v4u*)((const bf16*)base + o)); \
                else { pa[buf][mm][bj][0] = *(const f32x4*)((const float*)base + o); pa[buf][mm][bj][1] = *(const f32x4*)((const float*)base + o + 4); } } } } while (0)
        ERN_LOAD(0, 0);
#pragma unroll
        for (int b = 0; b < 4; ++b) {
            if (b + 1 < 4) ERN_LOAD(b + 1, (b + 1) & 1);
#pragma unroll
            for (int mm = 0; mm < 2; ++mm) { const int ri = b * 2 + mm, ai = ri >> 2, m = ri & 3; const int row = u.pm * 256 + ai * 128 + wr * 64 + m * 16 + fr; float ss = 0.f;
#pragma unroll
                for (int bj = 0; bj < 2; ++bj) { const int col = u.pn * 256 + bj * 128 + wc * 32 + 8 * fq;
                    float bv[8];
                    if (BASE_BF16) unpack8(__builtin_bit_cast(v4u, pa[b & 1][mm][bj][0]), bv);
                    else { const f32x4 a = pa[b & 1][mm][bj][0], bb = pa[b & 1][mm][bj][1]; bv[0] = a.x; bv[1] = a.y; bv[2] = a.z; bv[3] = a.w; bv[4] = bb.x; bv[5] = bb.y; bv[6] = bb.z; bv[7] = bb.w; }
                    float v[8] = {bv[0] + acc[ai][bj][m][0][0], bv[1] + acc[ai][bj][m][0][1], bv[2] + acc[ai][bj][m][0][2], bv[3] + acc[ai][bj][m][0][3],
                                  bv[4] + acc[ai][bj][m][1][0], bv[5] + acc[ai][bj][m][1][1], bv[6] + acc[ai][bj][m][1][2], bv[7] + acc[ai][bj][m][1][3]};
                    const v4u pk = pack8(v);
                    *(v4u*)(HB + (size_t)row * 1024 + col) = pk;
                    if (RES) *(v4u*)(RES + (size_t)row * RES_LD + col) = pk;
#pragma unroll
                    for (int j = 0; j < 8; ++j) ss += v[j] * v[j]; }
                ss += __shfl_xor(ss, 16); ss += __shfl_xor(ss, 32);
                if (fq == 0) SS[(size_t)row * 16 + u.pn * 4 + wc] = ss; } }
#undef ERN_LOAD
    }
};
struct SchedXend { int G, c;
    __device__ __forceinline__ bool next(int i, pg8::Unit& u) const { const int L = i * G + c; if (L >= 128) return false; u.pm = L; u.pn = L >> 2; u.aux = 0; return true; }
    __device__ __forceinline__ void a_ready(const pg8::Unit&) const {}
    __device__ __forceinline__ void done(const pg8::Unit&) const {} };
struct SchedS5Y { int G, c;
    __device__ __forceinline__ bool next(int i, pg8::Unit& u) const { const int L = i * G + c; if (L >= 256) return false; const int g = L >> 3; u.pm = g * 4 + ((L >> 1) & 3); u.pn = g * 2 + (L & 1); u.aux = 0; return true; }
    __device__ __forceinline__ void a_ready(const pg8::Unit&) const {}
    __device__ __forceinline__ void done(const pg8::Unit&) const {} };

__device__ __forceinline__ void kmean_phase(Frame& F) {
    const bf16* K0 = (const bf16*)(F.ws + WS_K0); float* km = (float*)(F.ws + WS_KMEAN); const int lane = mk_lane(), tid = F.wave * 64 + lane; LAS float* red = (LAS float*)F.lds;
    for (int un = ((int)blockIdx.x + F.G - (128 % F.G)) % F.G; un < 128; un += F.G) { const int b = un >> 5, n = un & 31; const bf16* src = K0 + ((size_t)b * SEQL + n * 256 + F.wave) * 512 + 8 * lane;
        float s[8] = {0.f, 0.f, 0.f, 0.f, 0.f, 0.f, 0.f, 0.f};
#pragma unroll 8
        for (int i = 0; i < 32; ++i) { float t[8]; load8_bf16(src + (size_t)i * 8 * 512, t);
#pragma unroll
            for (int e = 0; e < 8; ++e) s[e] += t[e]; }
        *(LAS f32x4*)(red + F.wave * 512 + 8 * lane) = (f32x4){s[0], s[1], s[2], s[3]}; *(LAS f32x4*)(red + F.wave * 512 + 8 * lane + 4) = (f32x4){s[4], s[5], s[6], s[7]};
        __syncthreads();
        float a = 0.f;
#pragma unroll
        for (int w = 0; w < 8; ++w) a += red[w * 512 + tid];
        const int h = tid >> 6, d = tid & 63; km[((size_t)(b * 8 + h) * 32 + n) * 64 + d] = a * (1.0f / 256.0f);
        __syncthreads(); }
}
__device__ __forceinline__ void s5_carry_phase(Frame& F) {
    const int lane = mk_lane(), tid = F.wave * 64 + lane; LAS float* xs = (LAS float*)F.lds;
    for (int un = blockIdx.x; un < 128; un += F.G) { const int g = un >> 2, b = un & 3;
        const f32x4* src = (const f32x4*)((const float*)(F.ws + WS_XEND) + (size_t)(g * 1024 + b * 256) * 128);
#pragma unroll 4
        for (int i = tid; i < 8192; i += 512) ((LAS f32x4*)xs)[i] = src[i];
        __syncthreads();
        if (F.wave == 0) { const int p = lane;
            const float ar = F.in[I_S5_A_RE][g * 64 + p], ai = F.in[I_S5_A_IM][g * 64 + p], dt = expf(F.in[I_S5_LOG_DT][g]);
            const float mag = expf(32.0f * dt * ar); float sn, cs; sincosf(32.0f * dt * ai, &sn, &cs); const float a_r = mag * cs, a_i = mag * sn;
            unsigned* __restrict__ ug = (unsigned*)((bf16*)(F.ws + WS_UG) + (size_t)(g * 1024 + b * 256) * 640 + 512 + 2 * p);
            float cr = 0.f, ci = 0.f;
#pragma unroll 8
            for (int c = 0; c < 256; ++c) { const f32x2 x = *(const LAS f32x2*)(xs + c * 128 + 2 * p); ug[(size_t)c * 320] = pk2(cr, ci);
                const float nr = a_r * cr - a_i * ci + x.x, ni = a_r * ci + a_i * cr + x.y; cr = nr; ci = ni; } }
        __syncthreads(); }
}
__device__ __forceinline__ void moba_select_phase(Frame& F) {
    LAS float* km = (LAS float*)F.lds;
    const bf16* Q0 = (const bf16*)(F.ws + WS_Q0); const float* kmg = (const float*)(F.ws + WS_KMEAN); unsigned* SELM = (unsigned*)(F.ws + WS_SELM); const int tid = F.wave * 64 + mk_lane();
    const bool split = (F.G == 256); const int ufirst = split ? ((int)blockIdx.x < 128 ? (int)blockIdx.x : 128 + ((int)blockIdx.x - 128) * 3) : (int)blockIdx.x;
    const int ucount = split ? ((int)blockIdx.x < 128 ? 1 : 3) : (512 - (int)blockIdx.x + F.G - 1) / F.G;
    for (int ui = 0; ui < ucount; ++ui) { const int un = split ? ufirst + ui : ufirst + ui * F.G; const int b = un >> 7, qb = (un >> 2) & 31, hp = un & 3;
        for (int i = tid; i < 4096; i += 512) km[i] = kmg[(size_t)(b * 8 + hp * 2 + (i >> 11)) * 2048 + (i & 2047)];
        __syncthreads();
        const int hl = tid >> 8, tl = tid & 255, h = hp * 2 + hl, t = qb * 256 + tl;
        float q[64]; const bf16* qp = Q0 + ((size_t)b * SEQL + t) * 512 + h * 64;
#pragma unroll
        for (int j = 0; j < 8; ++j) { float tmp[8]; load8_bf16(qp + 8 * j, tmp);
#pragma unroll
            for (int e = 0; e < 8; ++e) q[8 * j + e] = tmp[e]; }
        float v1 = -INFINITY, v2 = -INFINITY, v3 = -INFINITY; int i1 = -1, i2 = -1, i3 = -1;
        for (int n = 0; n < qb; ++n) { const LAS float* kp = km + (hl * 32 + n) * 64; float s = 0.f;
#pragma unroll
            for (int d = 0; d < 64; d += 4) { const f32x4 kv = *(const LAS f32x4*)(kp + d); s += q[d] * kv.x + q[d + 1] * kv.y + q[d + 2] * kv.z + q[d + 3] * kv.w; }
            if (s > v1) { v3 = v2; i3 = i2; v2 = v1; i2 = i1; v1 = s; i1 = n; } else if (s > v2) { v3 = v2; i3 = i2; v2 = s; i2 = n; } else if (s > v3) { v3 = s; i3 = n; } }
        unsigned m = 1u << qb; if (i1 >= 0) m |= 1u << i1; if (i2 >= 0) m |= 1u << i2; if (i3 >= 0) m |= 1u << i3;
        SELM[(size_t)(b * 8 + h) * SEQL + t] = m;
        __syncthreads(); }
}

constexpr int P1_LD = ODD_PAD;
constexpr int PC_R = 0, PC_K = 512, PC_V = 1024, PC_WD = 1536, PC_AD = 1600, PC_GD = 1664, PC_Q = 1792, PC_KD = 2304, PC_VD = 2368, PC_QI = 2432, PC_KI = 2688, PC_WI = 2752;
struct F_P1 { bf16* P1; const float* SS;
    __device__ __forceinline__ void operator()(const pg8::Unit& u, int r, int c, float (&v)[8], float rs) const { const int row = u.pm * 256 + r;
#pragma unroll
        for (int j = 0; j < 8; ++j) v[j] *= rs;
        store8_bf16(P1 + (size_t)row * P1_LD + u.pn * 256 + c, v); } };
struct F_LORA { bf16* LORA; const float* w0; const float* a0;
    static constexpr int MB = 4; struct Pre {}; struct Hoist { f32x4 w[2][2]; };
    __device__ __forceinline__ void hoist(const pg8::Unit& u, int wc, int fq, Hoist& h) const { const int seg = u.pn >> 1; const float* src = (seg == 0) ? w0 : a0 - 512;
#pragma unroll
        for (int bj = 0; bj < 2; ++bj) { const int col = (seg < 2) ? (u.pn * 256 + bj * 128 + wc * 32 + 8 * fq) : 512; h.w[bj][0] = *(const f32x4*)(src + col); h.w[bj][1] = *(const f32x4*)(src + col + 4); } }
    __device__ __forceinline__ void load(const pg8::Unit&, int, int, Pre&) const {}
    __device__ __forceinline__ void apply(const pg8::Unit& u, int r, int c, float (&v)[8], const Pre&, const Hoist& h, int bj) const {
        const int row = u.pm * 256 + r, col = u.pn * 256 + c, seg = u.pn >> 1;
        const float wv[8] = {h.w[bj][0].x, h.w[bj][0].y, h.w[bj][0].z, h.w[bj][0].w, h.w[bj][1].x, h.w[bj][1].y, h.w[bj][1].z, h.w[bj][1].w};
        const float sc = (seg == 0) ? -0.6065306597126334f : 1.0f;
#pragma unroll
        for (int j = 0; j < 8; ++j) { const float sg = sc * sigmoidf_(wv[j] + v[j]); v[j] = (seg < 2) ? sg : v[j]; }
        store8_bf16(LORA + (size_t)row * 1536 + col, v); }
};
struct F_MOEGU { unsigned char* ACTQ; int rt0; int probe = 0;
    __device__ __forceinline__ void operator()(const pg8::Unit& u, int r, int c, float (&g)[8], float (&p)[8]) const {
        float o[8];
#pragma unroll
        for (int j = 0; j < 8; ++j) { const float gg = g[j] * (1.0f / MOE_WGU_SCALE); o[j] = gg * sigmoidf_(gg) * (p[j] * (1.0f / MOE_WGU_SCALE)); }
        if (probe == 2) { if (o[0] == 1.2345e-30f) ACTQ[0] = 1; return; }
        *(v2u*)(ACTQ + (size_t)((probe ? 0 : (u.pm - rt0)) * 256 + r) * FEXP + (probe ? 0 : u.aux) * 128 + c) = (v2u){pk4_fp8(o[0], o[1], o[2], o[3]), pk4_fp8(o[4], o[5], o[6], o[7])}; }
};
struct F_MOED { bf16* YS; int probe = 0;
    __device__ __forceinline__ void operator()(const pg8::Unit& u, int r, int c, float (&v)[8], int) const {
#pragma unroll
        for (int j = 0; j < 8; ++j) v[j] *= (1.0f / MOE_WD_SCALE);
        if (probe == 2) { if (v[0] == 1.2345e-30f) YS[0] = 1; return; }
        store8_bf16(YS + (size_t)((probe ? 0 : u.aux) * 256 + r) * 1024 + (u.pn & 3) * 256 + c, v); } };
struct SchedMoeGU { const int* tile_exp; int rt0, ntq, G, c;
    __device__ __forceinline__ bool next(int i, pg8::Unit& u) const { const int L = i * G + c; if (L >= ntq * 28) return false; const int rt = rt0 + L % ntq, pn = L / ntq; const int e = tile_exp[rt]; u.pm = rt; u.pn = e * 28 + pn; u.aux = pn; return true; }
    __device__ __forceinline__ void a_ready(const pg8::Unit&) const {}
    __device__ __forceinline__ void done(const pg8::Unit&) const {} };
struct SchedMoeD { const int* tile_exp; int rt0, ntq, G, c;
    __device__ __forceinline__ bool next(int i, pg8::Unit& u) const { const int L = i * G + c; if (L >= ntq * 4) return false; const int rt = rt0 + L % ntq, pn = L / ntq; const int e = tile_exp[rt]; u.pm = rt - rt0; u.pn = e * 4 + pn; u.aux = rt; return true; }
    __device__ __forceinline__ void a_ready(const pg8::Unit&) const {}
    __device__ __forceinline__ void done(const pg8::Unit&) const {} };

__device__ __forceinline__ void rope8_x1(float (&v)[8], int d0, const float* cs) {
    float o[8];
#pragma unroll
    for (int j = 0; j < 8; ++j) o[j] = __shfl_xor(v[j], 1);
    if (d0 < 16) { const f32x4 c0 = *(const f32x4*)cs, c1 = *(const f32x4*)(cs + 4), s0 = *(const f32x4*)(cs + 8), s1 = *(const f32x4*)(cs + 12);
        const float cv[8] = {c0.x, c0.y, c0.z, c0.w, c1.x, c1.y, c1.z, c1.w}, sv[8] = {s0.x, s0.y, s0.z, s0.w, s1.x, s1.y, s1.z, s1.w};
        const float sgn = (d0 == 0) ? -1.0f : 1.0f;
#pragma unroll
        for (int j = 0; j < 8; ++j) v[j] = v[j] * cv[j] + sgn * o[j] * sv[j]; }
}
__device__ __forceinline__ void rope8_pre(float (&v)[8], int d0, const f32x4 (&cs)[4]) {
    float o[8];
#pragma unroll
    for (int j = 0; j < 8; ++j) o[j] = __shfl_xor(v[j], 1);
    const float cv[8] = {cs[0].x, cs[0].y, cs[0].z, cs[0].w, cs[1].x, cs[1].y, cs[1].z, cs[1].w}, sv[8] = {cs[2].x, cs[2].y, cs[2].z, cs[2].w, cs[3].x, cs[3].y, cs[3].z, cs[3].w};
    const float sgn = (d0 == 0) ? -1.0f : 1.0f;
#pragma unroll
    for (int j = 0; j < 8; ++j) v[j] = (d0 < 16) ? v[j] * cv[j] + sgn * o[j] * sv[j] : v[j];
}
__device__ __forceinline__ void l1_prep_phase(Frame& F) {
    const int gw = blockIdx.x * NWAVES + F.wave, NGW = F.G * NWAVES, lane = mk_lane();
    const bf16* P1 = (const bf16*)(F.ws + WS_P1); const float* mu = F.in[I_RWKV_MU]; const float* rope = (const float*)(F.ws + WS_ROPE);
    bf16* ALORA = (bf16*)(F.ws + WS_ALORA); bf16* QD = (bf16*)(F.ws + WS_QD); bf16* KD = (bf16*)(F.ws + WS_KD); bf16* KI = (bf16*)(F.ws + WS_KI); bf16* QI = (bf16*)(F.ws + WS_QI); float* WI = (float*)(F.ws + WS_WI);
    const int colA = PC_WD + 8 * (lane & 31); float muv[8];
#pragma unroll
    for (int j = 0; j < 8; ++j) muv[j] = mu[colA + j];
    const int src3 = (lane < 32) ? (PC_QI + 8 * lane) : ((lane < 40) ? (PC_KD + 8 * (lane - 32)) : ((lane < 48) ? (PC_KI + 8 * (lane & 7)) : (PC_VD + 8 * (lane & 7))));
    bf16* VD = (bf16*)(F.ws + WS_VD);
    for (int t0 = gw; t0 < T_TOK; t0 += 4 * NGW) { v4u cur[4], prv[4], qv[4], s3[4]; f32x4 cs[4][4]; unsigned short wi[4];
#pragma unroll
        for (int r = 0; r < 4; ++r) { const int tok = t0 + r * NGW, tc = tok < T_TOK ? tok : t0; const bf16* row = P1 + (size_t)tc * P1_LD; const int pos = tc & (SEQL - 1); const f32x4* csp = (const f32x4*)(rope + (size_t)pos * 16);
            cur[r] = *(const v4u*)(row + colA); prv[r] = *(const v4u*)((pos != 0 ? row - P1_LD : row) + colA); qv[r] = *(const v4u*)(row + PC_Q + 8 * lane); s3[r] = *(const v4u*)(row + src3);
            cs[r][0] = csp[0]; cs[r][1] = csp[1]; cs[r][2] = csp[2]; cs[r][3] = csp[3]; wi[r] = row[PC_WI + (lane & 3)]; }
#pragma unroll
        for (int r = 0; r < 4; ++r) { const int tok = t0 + r * NGW; const int pos = tok & (SEQL - 1);
            if (tok < T_TOK) {
                { float c8[8], p8[8]; unpack8(cur[r], c8); unpack8(prv[r], p8);
#pragma unroll
                  for (int j = 0; j < 8; ++j) { const float pv = (pos != 0) ? p8[j] : 0.f; const float x = c8[j] + (pv - c8[j]) * muv[j];
                      c8[j] = (lane < 8) ? tanhf(x) : ((lane < 16) ? x : sigmoidf_(x)); }
                  if (lane < 32) store8_bf16(ALORA + (size_t)tok * 256 + 8 * lane, c8); }
                { float v[8]; unpack8(qv[r], v); rope8_pre(v, 8 * (lane & 7), cs[r]);
#pragma unroll
                  for (int j = 0; j < 8; ++j) v[j] *= ATT_C2;
                  store8_bf16(QD + (size_t)tok * 512 + 8 * lane, v); }
                { float v[8]; unpack8(s3[r], v); rope8_pre(v, 8 * (lane & 7), cs[r]);
                  if (lane >= 48 && lane < 56) *(v4u*)(VD + (size_t)tok * 64 + 8 * (lane - 48)) = s3[r];
                  if (lane < 32) store8_bf16(QI + (size_t)tok * 256 + 8 * lane, v);
                  else if (lane < 40) store8_bf16(KD + (size_t)tok * 64 + 8 * (lane - 32), v);
                  else if (lane < 48) store8_bf16(KI + (size_t)tok * 64 + 8 * (lane - 40), v); }
                if (lane < 4) WI[(size_t)tok * 4 + lane] = bf2f(wi[r]) * 0.0625f; } } }
}
#ifndef RP_NB
#define RP_NB 4
#endif
__device__ __forceinline__ void rwkv_post_phase(Frame& F) {
    const int gw = blockIdx.x * NWAVES + F.wave, NGW = F.G * NWAVES, lane = mk_lane(), c0 = 8 * lane;
    const bf16* P1 = (const bf16*)(F.ws + WS_P1); const bf16* LORA = (const bf16*)(F.ws + WS_LORA); const bf16* YR = (const bf16*)(F.ws + WS_YR); bf16* CAT2 = (bf16*)(F.ws + WS_CAT);
    float mur[8], muk[8], muv[8], ka[8], rk[8], lnw[8], lnb[8];
#pragma unroll
    for (int j = 0; j < 8; ++j) { mur[j] = F.in[I_RWKV_MU][PC_R + c0 + j]; muk[j] = F.in[I_RWKV_MU][PC_K + c0 + j]; muv[j] = F.in[I_RWKV_MU][PC_V + c0 + j];
        ka[j] = F.in[I_RWKV_K_A][c0 + j]; rk[j] = F.in[I_RWKV_R_K][c0 + j]; lnw[j] = F.in[I_RWKV_LN_W][c0 + j]; lnb[j] = F.in[I_RWKV_LN_B][c0 + j]; }
    for (int t0 = gw; t0 < T_TOK; t0 += RP_NB * NGW) { v4u L[RP_NB][9];
#pragma unroll
        for (int r = 0; r < RP_NB; ++r) { const int tok = t0 + r * NGW, tc = tok < T_TOK ? tok : t0; const bool first = (tc & (SEQL - 1)) == 0; const bf16* row = P1 + (size_t)tc * P1_LD; const bf16* prow = first ? row : (row - P1_LD);
            L[r][0] = *(const v4u*)(row + PC_R + c0); L[r][1] = *(const v4u*)(row + PC_K + c0); L[r][2] = *(const v4u*)(row + PC_V + c0);
            L[r][3] = *(const v4u*)(prow + PC_R + c0); L[r][4] = *(const v4u*)(prow + PC_K + c0); L[r][5] = *(const v4u*)(prow + PC_V + c0);
            L[r][6] = *(const v4u*)(LORA + (size_t)tc * 1536 + 512 + c0); L[r][7] = *(const v4u*)(LORA + (size_t)tc * 1536 + 1024 + c0); L[r][8] = *(const v4u*)(YR + (size_t)tc * 512 + c0); }
#pragma unroll
        for (int r = 0; r < RP_NB; ++r) { const int tok = t0 + r * NGW; const bool first = (tok & (SEQL - 1)) == 0;
            float rc[8], kc[8], vc[8], rp[8], kp[8], vp[8], a[8], g[8], y[8];
            unpack8(L[r][0], rc); unpack8(L[r][1], kc); unpack8(L[r][2], vc); unpack8(L[r][3], rp); unpack8(L[r][4], kp); unpack8(L[r][5], vp); unpack8(L[r][6], a); unpack8(L[r][7], g); unpack8(L[r][8], y);
            float sy = 0.f, sb = 0.f; float v[8];
#pragma unroll
            for (int j = 0; j < 8; ++j) { const float rr = rc[j] + ((first ? 0.f : rp[j]) - rc[j]) * mur[j], k0 = kc[j] + ((first ? 0.f : kp[j]) - kc[j]) * muk[j]; v[j] = vc[j] + ((first ? 0.f : vp[j]) - vc[j]) * muv[j];
                const float k = k0 * (1.0f + (a[j] - 1.0f) * ka[j]); sb += rr * k * rk[j]; sy += y[j]; }
            const float mean = dpp_sum8(sy) * (1.0f / 64.0f); float sq = 0.f;
#pragma unroll
            for (int j = 0; j < 8; ++j) { y[j] -= mean; sq += y[j] * y[j]; }
            const float rstd = __builtin_amdgcn_rsqf(dpp_sum8(sq) * (1.0f / 64.0f) + 64e-5f), bonus = dpp_sum8(sb);
            float o[8];
#pragma unroll
            for (int j = 0; j < 8; ++j) o[j] = ABL_RWKV ? 0.f : (y[j] * rstd * lnw[j] + lnb[j] + bonus * v[j]) * g[j];
            if (tok < T_TOK) { store8_bf16(CAT2 + (size_t)tok * 1024 + c0, o);
                if (SKIP_DSA) { float z[8] = {0.f, 0.f, 0.f, 0.f, 0.f, 0.f, 0.f, 0.f}; store8_bf16(CAT2 + (size_t)tok * 1024 + 512 + c0, z); } } } }
}
__device__ __forceinline__ void moe_convert_phase(Frame& F) {
    LAS unsigned char* scr = (LAS unsigned char*)(F.lds + F.wave * 16384); const int lane = mk_lane();
    const int gw = blockIdx.x * NWAVES + F.wave, NGW = F.G * NWAVES;
    constexpr int PER = 896, NIT = 3 * 8 * PER;
    unsigned char* WGU = F.ws + WS_WMOE_GU; unsigned char* WD = F.ws + WS_WMOE_D;
#define MC_LOAD(it_, buf) do { const int m_ = (it_) / (8 * PER), r_ = (it_) % (8 * PER), e_ = r_ / PER, q_ = r_ % PER; \
        if (m_ == 0) tr64_load(F.in[I_MOE_GATE] + (size_t)e_ * 1024 * FEXP, FEXP, q_ / 56, q_ % 56, lane, buf); \
        else if (m_ == 1) tr64_load(F.in[I_MOE_UP] + (size_t)e_ * 1024 * FEXP, FEXP, q_ / 56, q_ % 56, lane, buf); \
        else tr64_load(F.in[I_MOE_DOWN] + (size_t)e_ * FEXP * 1024, 1024, q_ / 16, q_ % 16, lane, buf); } while (0)
#define MC_FIN(it_, buf) do { const int m_ = (it_) / (8 * PER), r_ = (it_) % (8 * PER), e_ = r_ / PER, q_ = r_ % PER; \
        if (m_ == 0) tr64_f8_finish<1>(buf, WGU, 1024, e_ * 7168, F.in[I_O_NORM_FFN], MOE_WGU_SCALE, scr, q_ / 56, q_ % 56, lane); \
        else if (m_ == 1) tr64_f8_finish<1>(buf, WGU, 1024, e_ * 7168 + 128, F.in[I_O_NORM_FFN], MOE_WGU_SCALE, scr, q_ / 56, q_ % 56, lane); \
        else tr64_f8_finish<0>(buf, WD, FEXP, e_ * 1024, nullptr, MOE_WD_SCALE, scr, q_ / 16, q_ % 16, lane); } while (0)
    f32x4 va[16], vb[16];
    int it = gw; if (it < NIT) MC_LOAD(it, va);
    for (; it < NIT; it += 2 * NGW) { const int it2 = it + NGW, it3 = it + 2 * NGW;
        if (it2 < NIT) MC_LOAD(it2, vb);
        MC_FIN(it, va);
        if (it3 < NIT) MC_LOAD(it3, va);
        if (it2 < NIT) MC_FIN(it2, vb); }
#undef MC_LOAD
#undef MC_FIN
}
__device__ __forceinline__ f32x4 ld_res4(const bf16* RESb, int tok, int lane, int j) {
    const v2u w = ((const v2u*)(RESb + (size_t)tok * RES_LD))[lane + 64 * j]; return (f32x4){bflo(w.x), bfhi(w.x), bflo(w.y), bfhi(w.y)}; }
__device__ __forceinline__ void router_phase(Frame& F, int cnt_off = 0) {
    const int lane = mk_lane(), tid = F.wave * 64 + lane;
    const float* gn = F.in[I_O_NORM_FFN]; const float* rt = F.in[I_MOE_ROUTER]; unsigned* cnt = (unsigned*)(F.ws + WS_CTL) + CW_EXPCNT + cnt_off; v2u* info = (v2u*)(F.ws + WS_TOKINFO);
    LAS unsigned* lcnt = (LAS unsigned*)F.lds; LAS unsigned* gbase = lcnt + 8; LAS v4u* lrec = (LAS v4u*)(F.lds + 64);
    for (int tb = blockIdx.x * 128; tb < T_TOK; tb += F.G * 128) {
        if (tid < 8) lcnt[tid] = 0u;
        __syncthreads();
        f32x4 vn[4];
        {
#pragma unroll
          for (int j = 0; j < 4; ++j) vn[j] = ld_res4((const bf16*)F.out, tb + F.wave * 16, lane, j); }
#pragma unroll 1
        for (int i = 0; i < 16; ++i) { const int tl = F.wave * 16 + i, tok = tb + tl; f32x4 v[4]; float s = 0.f;
#pragma unroll
            for (int j = 0; j < 4; ++j) v[j] = vn[j];
            {
#pragma unroll
              for (int j = 0; j < 4; ++j) vn[j] = ld_res4((const bf16*)F.out, tok + (i < 15 ? 1 : 0), lane, j); }
#pragma unroll
            for (int j = 0; j < 4; ++j) s += (v[j].x * v[j].x + v[j].y * v[j].y) + (v[j].z * v[j].z + v[j].w * v[j].w);
            const float rstd = __builtin_amdgcn_rsqf(wave_sum(s) * (1.f / DMODEL) + NORM_EPS);
            float lg[8] = {0.f, 0.f, 0.f, 0.f, 0.f, 0.f, 0.f, 0.f};
#pragma unroll
            for (int j = 0; j < 4; ++j) { const int k0 = 4 * (lane + 64 * j); const f32x4 gg = *(const f32x4*)(gn + k0); const float xv[4] = {v[j].x * rstd * gg.x, v[j].y * rstd * gg.y, v[j].z * rstd * gg.z, v[j].w * rstd * gg.w};
#pragma unroll
                for (int q = 0; q < 4; ++q) { const f32x4 w0 = *(const f32x4*)(rt + (size_t)(k0 + q) * 8), w1 = *(const f32x4*)(rt + (size_t)(k0 + q) * 8 + 4);
                    lg[0] += xv[q] * w0.x; lg[1] += xv[q] * w0.y; lg[2] += xv[q] * w0.z; lg[3] += xv[q] * w0.w; lg[4] += xv[q] * w1.x; lg[5] += xv[q] * w1.y; lg[6] += xv[q] * w1.z; lg[7] += xv[q] * w1.w; } }
#pragma unroll
            for (int e = 0; e < 8; ++e) lg[e] = wave_sum(lg[e]);
            int e1 = 0; float l1 = lg[0];
#pragma unroll
            for (int e = 1; e < 8; ++e) if (lg[e] > l1) { l1 = lg[e]; e1 = e; }
            int e2 = -1; float l2 = -INFINITY;
#pragma unroll
            for (int e = 0; e < 8; ++e) if (e != e1 && lg[e] > l2) { l2 = lg[e]; e2 = e; }
            const float g1 = 1.0f / (1.0f + __expf(l2 - l1)), g2 = 1.0f - g1;
            if (lane == 0) { const unsigned r1 = __hip_atomic_fetch_add(lcnt + e1, 1u, __ATOMIC_RELAXED, __HIP_MEMORY_SCOPE_WORKGROUP), r2 = __hip_atomic_fetch_add(lcnt + e2, 1u, __ATOMIC_RELAXED, __HIP_MEMORY_SCOPE_WORKGROUP);
                lrec[tl] = (v4u){((unsigned)e1 << 24) | r1, __builtin_bit_cast(unsigned, g1), ((unsigned)e2 << 24) | r2, __builtin_bit_cast(unsigned, g2)}; } }
        __syncthreads();
        if (tid < 8) gbase[tid] = atomicAdd(cnt + 64 * tid, lcnt[tid]);
        __syncthreads();
        if (tid < 128) { const v4u r = lrec[tid]; const unsigned b1 = gbase[r.x >> 24], b2 = gbase[r.z >> 24];
            ((v4u*)info)[(size_t)(tb + tid)] = (v4u){r.x + b1, r.y, r.z + b2, r.w}; }
        __syncthreads(); }
}
__device__ __forceinline__ void moe_scatter_phase(Frame& F) {
    const int gw = blockIdx.x * NWAVES + F.wave, NGW = F.G * NWAVES, lane = mk_lane();
    const unsigned* cnt = (const unsigned*)(F.ws + WS_CTL) + CW_EXPCNT; const v2u* info = (const v2u*)(F.ws + WS_TOKINFO); int* tokslot = (int*)(F.ws + WS_TOKSLOT); int* tile_exp = (int*)(F.ws + WS_TILEEXP);
    int pstart[8]; int acc = 0;
#pragma unroll
    for (int e = 0; e < 8; ++e) { const int c = (int)__hip_atomic_load(cnt + 64 * e, __ATOMIC_RELAXED, __HIP_MEMORY_SCOPE_AGENT); pstart[e] = acc; acc += (c + 255) & ~255; }
    const int ntiles = acc >> 8;
    if (blockIdx.x == 0 && F.wave == 0) { for (int t = lane; t < 512; t += 64) { int e = 7;
#pragma unroll
            for (int q = 7; q >= 1; --q) if (t * 256 < pstart[q]) e = q - 1;
            tile_exp[t] = (t == 511) ? ntiles : e; } }
    unsigned char* XG = F.ws + WS_XG;
    for (int t0 = gw; t0 < T_TOK; t0 += 4 * NGW) { f32x4 v[4][4]; v2u inf[4][2];
#pragma unroll
        for (int r = 0; r < 4; ++r) { const int tok = t0 + r * NGW, tc = tok < T_TOK ? tok : t0;
#pragma unroll
            for (int j = 0; j < 4; ++j) v[r][j] = ld_res4((const bf16*)F.out, tc, lane, j);
            inf[r][0] = info[(size_t)tc * 2]; inf[r][1] = info[(size_t)tc * 2 + 1]; }
#pragma unroll
        for (int r = 0; r < 4; ++r) { const int tok = t0 + r * NGW; float s = 0.f;
#pragma unroll
            for (int j = 0; j < 4; ++j) s += (v[r][j].x * v[r][j].x + v[r][j].y * v[r][j].y) + (v[r][j].z * v[r][j].z + v[r][j].w * v[r][j].w);
            const float rstd = __builtin_amdgcn_rsqf(wave_sum(s) * (1.f / DMODEL) + NORM_EPS);
            unsigned w[4];
#pragma unroll
            for (int j = 0; j < 4; ++j) w[j] = pk4_fp8(v[r][j].x * rstd, v[r][j].y * rstd, v[r][j].z * rstd, v[r][j].w * rstd);
            if (tok < T_TOK) {
#pragma unroll
                for (int k = 0; k < 2; ++k) { const int e = (int)(inf[r][k].x >> 24), rank = (int)(inf[r][k].x & 0xffffffu);
                    int ps = 0;
#pragma unroll
                    for (int q = 0; q < 8; ++q) ps = (e == q) ? pstart[q] : ps;
                    const int slot = ps + rank; unsigned* o4 = (unsigned*)(XG + (size_t)slot * 1024) + lane;
#pragma unroll
                    for (int j = 0; j < 4; ++j) o4[64 * j] = w[j];
                    if (lane == 0) tokslot[(size_t)tok * 2 + k] = slot; } } } }
}
__device__ __forceinline__ void moe_combine_final_phase(Frame& F, float* outp = nullptr) {
    if (outp == nullptr) outp = F.out;
    const int gw = blockIdx.x * NWAVES + F.wave, NGW = F.G * NWAVES, lane = mk_lane(); const float* gn = F.in[I_FINAL_NORM];
    const v2u* info = (const v2u*)(F.ws + WS_TOKINFO); const int* tokslot = (const int*)(F.ws + WS_TOKSLOT); const bf16* YS = (const bf16*)(F.ws + WS_YS);
    f32x4 gv[4];
#pragma unroll
    for (int j = 0; j < 4; ++j) gv[j] = ((const f32x4*)gn)[lane + 64 * j];
#if RWKV_DBG
    { const unsigned long long* ck = (const unsigned long long*)(F.ws + WS_CTL) + 200; int code = 0;
      for (int arr = 3; arr >= 0; --arr) if (ck[arr] != ck[4 + arr]) code = arr + 1;
      const float ds = 1.0f + 0.5f * code; for (int j = 0; j < 4; ++j) gv[j] = gv[j] * ds; }
#endif
#if STAMP_KA >= 0
    { const float fr = ((const float*)(F.ws + WS_TILEEXP + 4096))[0]; const float ds = 1.0f + 0.08f * sqrtf(fminf(fmaxf(fr, 0.f), 1.f));
      for (int j = 0; j < 4; ++j) gv[j] = gv[j] * ds; }
#endif
    for (int t0 = gw; t0 < T_TOK; t0 += 4 * NGW) { f32x4 v[4][4]; float gk[4][2]; int sl[4][2]; v2u ys[4][2][4];
#pragma unroll
        for (int r = 0; r < 4; ++r) { const int tok = t0 + r * NGW, tc = tok < T_TOK ? tok : t0;
#pragma unroll
            for (int j = 0; j < 4; ++j) v[r][j] = ld_res4((const bf16*)F.out, tc, lane, j);
#pragma unroll
            for (int k = 0; k < 2; ++k) { const unsigned gkb = info[(size_t)tc * 2 + k].y; gk[r][k] = MOE_SCALE * __builtin_bit_cast(float, gkb); sl[r][k] = tokslot[(size_t)tc * 2 + k]; } }
#pragma unroll
        for (int r = 0; r < 4; ++r)
#pragma unroll
            for (int k = 0; k < 2; ++k) { const v2u* yr = (const v2u*)(YS + (size_t)sl[r][k] * 1024) + lane;
#pragma unroll
                for (int j = 0; j < 4; ++j) ys[r][k][j] = yr[64 * j]; }
#pragma unroll
        for (int r = 0; r < 4; ++r) { const int tok = t0 + r * NGW;
#pragma unroll
            for (int k = 0; k < 2; ++k)
#pragma unroll
                for (int j = 0; j < 4; ++j) { v2u w = ys[r][k][j]; if (ABL_MOE) w = (v2u){0u, 0u}; v[r][j].x += gk[r][k] * bflo(w.x); v[r][j].y += gk[r][k] * bfhi(w.x); v[r][j].z += gk[r][k] * bflo(w.y); v[r][j].w += gk[r][k] * bfhi(w.y); }
            float s = 0.f;
#pragma unroll
            for (int j = 0; j < 4; ++j) s += (v[r][j].x * v[r][j].x + v[r][j].y * v[r][j].y) + (v[r][j].z * v[r][j].z + v[r][j].w * v[r][j].w);
            const float rstd = __builtin_amdgcn_rsqf(wave_sum(s) * (1.f / DMODEL) + NORM_EPS);
            if (tok < T_TOK) { f32x4* xo = (f32x4*)(outp + (size_t)tok * DMODEL) + lane;
#pragma unroll
                for (int j = 0; j < 4; ++j) xo[64 * j] = v[r][j] * rstd * gv[j]; } } }
}

constexpr int RW_BLOCKS = 64;
constexpr int RW_STEPS = 32, RW_REC = 5 * 64, RW_BUF_FLOATS = RW_STEPS * RW_REC + RW_STEPS * 32;
__device__ __forceinline__ void rwkv_produce(Frame& F, LAS float* buf, int b, int h, int half, int j, int pw, int lane) {
    const bf16* P1 = (const bf16*)(F.ws + WS_P1); const bf16* LORA = (const bf16*)(F.ws + WS_LORA);
    const float* mu = F.in[I_RWKV_MU]; const int ch = h * 64 + lane;
    const float mu_r = mu[PC_R + ch], mu_k = mu[PC_K + ch], mu_v = mu[PC_V + ch], kkw = F.in[I_RWKV_K_K][ch], kaw = F.in[I_RWKV_K_A][ch];
    float rc[8], kc[8], vc[8], rp[8], kp[8], vp[8], lw[8], al[8];
#pragma unroll
    for (int i = 0; i < 8; ++i) { const int tt = 8 * pw + i, pos = 32 * j + tt; const size_t tok = (size_t)b * SEQL + pos; const bf16* row = P1 + tok * P1_LD; const bf16* prow = (pos == 0) ? row : (row - P1_LD);
        rc[i] = bf2f(row[PC_R + ch]); kc[i] = bf2f(row[PC_K + ch]); vc[i] = bf2f(row[PC_V + ch]);
        rp[i] = bf2f(prow[PC_R + ch]); kp[i] = bf2f(prow[PC_K + ch]); vp[i] = bf2f(prow[PC_V + ch]);
        lw[i] = bf2f(LORA[tok * 1536 + ch]); al[i] = bf2f(LORA[tok * 1536 + 512 + ch]); }
#pragma unroll
    for (int i = 0; i < 8; ++i) { const int tt = 8 * pw + i, pos = 32 * j + tt; const bool first = (pos == 0);
        const float r = rc[i] + ((first ? 0.f : rp[i]) - rc[i]) * mu_r, k0 = kc[i] + ((first ? 0.f : kp[i]) - kc[i]) * mu_k, v = vc[i] + ((first ? 0.f : vp[i]) - vc[i]) * mu_v;
        const float kkv = k0 * kkw; const float nrm = sqrtf(wave_sum(kkv * kkv)); const float kk = kkv / fmaxf(nrm, 1e-12f);
        const float a = al[i]; LAS float* rec = buf + tt * RW_REC;
        rec[lane] = __expf(lw[i]); rec[64 + lane] = -kk; rec[128 + lane] = kk * a; rec[192 + lane] = k0 * (1.0f + (a - 1.0f) * kaw); rec[256 + lane] = r;
        if ((lane >> 5) == half) buf[RW_STEPS * RW_REC + tt * 32 + (lane & 31)] = v; }
}
__device__ __forceinline__ void rwkv_seq_block(Frame& F, int blk) {
    const int bh = blk >> 1, half = blk & 1, b = bh >> 3, h = bh & 7; const int lane = mk_lane(), wave = F.wave;
    LAS float* buf0 = (LAS float*)F.lds; LAS float* buf1 = buf0 + RW_BUF_FLOATS;
    bf16* YR = (bf16*)(F.ws + WS_YR);
    const int rowl = 8 * (wave & 3) + (lane >> 3), kg = lane & 7;
    f32x2 s[4] = {{0.f, 0.f}, {0.f, 0.f}, {0.f, 0.f}, {0.f, 0.f}};
    if (wave >= 4) rwkv_produce(F, buf0, b, h, half, 0, wave - 4, lane);
    __syncthreads();
    for (int j = 0; j < SEQL / RW_STEPS; ++j) { LAS float* cur = (j & 1) ? buf1 : buf0; LAS float* nxt = (j & 1) ? buf0 : buf1;
        if (wave >= 4) { if (j + 1 < SEQL / RW_STEPS) rwkv_produce(F, nxt, b, h, half, j + 1, wave - 4, lane); }
        else { bf16* yo = YR + ((size_t)b * SEQL + 32 * j) * 512 + h * 64 + 32 * half + rowl;
#pragma unroll 4
            for (int t = 0; t < RW_STEPS; ++t) { const LAS float* rec = cur + t * RW_REC + 8 * kg;
                const f32x4 w0 = *(const LAS f32x4*)(rec), w1 = *(const LAS f32x4*)(rec + 4), a0 = *(const LAS f32x4*)(rec + 64), a1 = *(const LAS f32x4*)(rec + 68);
                const f32x4 b0 = *(const LAS f32x4*)(rec + 128), b1 = *(const LAS f32x4*)(rec + 132), k0 = *(const LAS f32x4*)(rec + 192), k1 = *(const LAS f32x4*)(rec + 196);
                const f32x4 r0 = *(const LAS f32x4*)(rec + 256), r1 = *(const LAS f32x4*)(rec + 260);
                const float vv = cur[RW_STEPS * RW_REC + t * 32 + rowl];
                f32x2 sa2 = s[0] * (f32x2){a0.x, a0.y} + s[1] * (f32x2){a0.z, a0.w} + s[2] * (f32x2){a1.x, a1.y} + s[3] * (f32x2){a1.z, a1.w};
                const float sa = dpp_sum8(sa2.x + sa2.y); const f32x2 sav = {sa, sa}, vvv = {vv, vv};
                s[0] = s[0] * (f32x2){w0.x, w0.y} + sav * (f32x2){b0.x, b0.y} + vvv * (f32x2){k0.x, k0.y};
                s[1] = s[1] * (f32x2){w0.z, w0.w} + sav * (f32x2){b0.z, b0.w} + vvv * (f32x2){k0.z, k0.w};
                s[2] = s[2] * (f32x2){w1.x, w1.y} + sav * (f32x2){b1.x, b1.y} + vvv * (f32x2){k1.x, k1.y};
                s[3] = s[3] * (f32x2){w1.z, w1.w} + sav * (f32x2){b1.z, b1.w} + vvv * (f32x2){k1.z, k1.w};
                f32x2 y2 = s[0] * (f32x2){r0.x, r0.y} + s[1] * (f32x2){r0.z, r0.w} + s[2] * (f32x2){r1.x, r1.y} + s[3] * (f32x2){r1.z, r1.w};
                const float y = dpp_sum8(y2.x + y2.y);
                if (kg == 0) yo[(size_t)t * 512] = (bf16)f2bf(y); } }
        __syncthreads(); }
}

typedef float f32x4_t __attribute__((ext_vector_type(4)));
constexpr int DSA_SEL_OFF = 131072 + 1024, DSA_META_OFF = DSA_SEL_OFF + 16 * 256 * 2, DSA_CAND_CAP = 1024;
constexpr int CW_DSAQ = CW_EXPCNT + 8 * 64;
static_assert(DSA_META_OFF + 512 <= MISC_OFF && (CW_DSAQ + 128) * 4 <= (int)CTL_ZERO_BYTES, "dsa lds / ctl map");
__device__ __forceinline__ unsigned f32_order_key(float x) { x = x + 0.0f; const unsigned u = __builtin_bit_cast(unsigned, x); return (u & 0x80000000u) ? ~u : (u | 0x80000000u); }
template <int MODE, bool DRY = false>
__device__ __forceinline__ void dsa_score_pass(const bf16* __restrict__ KIb, const bf16x8 (&qa)[4][2], const float (&wq)[4][4], int t0, int ktb, int nkt, int wave, int lane,
                                               LAS unsigned* hist, LAS unsigned short* sel, LAS int* meta, bool use_lo) {
    const int g = lane >> 4, c = lane & 15;
    int bst[4] = {0, 0, 0, 0};
#pragma unroll
    for (int m = 0; m < 4; ++m) bst[m] = (MODE == 1) ? meta[4 * m + g] : (use_lo ? meta[64 + 4 * m + g] : 0);
#define DSA_LOADK(dst, kt0_) do { _Pragma("unroll") for (int u = 0; u < 4; ++u) { const int kt = (kt0_) + 8 * u, ktc = kt < nkt ? kt : (nkt - 1); const bf16* kp = KIb + (size_t)(16 * ktc + c) * 64 + 8 * g; \
        dst[u][0] = *(const bf16x8*)kp; dst[u][1] = *(const bf16x8*)(kp + 32); } } while (0)
#define DSA_TRIP(kb, kt0_) do { _Pragma("unroll") for (int u = 0; u < 4; ++u) { const int kt = (kt0_) + 8 * u; if (kt < nkt) { const int key = 16 * kt + c; const bool full = (16 * kt + 15 <= t0); \
        f32x4_t accm[4]; \
        _Pragma("unroll") for (int m = 0; m < 4; ++m) { f32x4_t z_ = {0.f, 0.f, 0.f, 0.f}; z_ = __builtin_amdgcn_mfma_f32_16x16x32_bf16(qa[m][0], kb[u][0], z_, 0, 0, 0); accm[m] = __builtin_amdgcn_mfma_f32_16x16x32_bf16(qa[m][1], kb[u][1], z_, 0, 0, 0); } \
        _Pragma("unroll") for (int m = 0; m < 4; ++m) { \
            float sc = __builtin_fmaf(__builtin_amdgcn_fmed3f(accm[m][0], 0.f, 3.0e38f), wq[m][0], 0.0f); sc = __builtin_fmaf(__builtin_amdgcn_fmed3f(accm[m][1], 0.f, 3.0e38f), wq[m][1], sc); \
            sc = __builtin_fmaf(__builtin_amdgcn_fmed3f(accm[m][2], 0.f, 3.0e38f), wq[m][2], sc); sc = __builtin_fmaf(__builtin_amdgcn_fmed3f(accm[m][3], 0.f, 3.0e38f), wq[m][3], sc); \
            const int q = 4 * m + g; const unsigned ub = __builtin_bit_cast(unsigned, sc); const unsigned uk = ub ^ ((unsigned)((int)ub >> 31) | 0x80000000u); \
            if (full || key <= t0 + q) { \
                if (MODE == 2) { dry += uk; } else if (MODE == 0) { if (uk >= bstk[m]) __hip_atomic_fetch_add(hist + q * 2048 + (uk >> 21), DRY ? 0u : (1u << ((uk >> 16) & 16u)), __ATOMIC_RELAXED, __HIP_MEMORY_SCOPE_WORKGROUP); } \
                else { if (uk >= bstk[m] + 0x100000u) { const int p = __hip_atomic_fetch_add((LAS unsigned*)(meta + 32 + q), DRY ? 0u : 1u, __ATOMIC_RELAXED, __HIP_MEMORY_SCOPE_WORKGROUP); if (p < (DRY ? dryz : 256)) sel[q * 256 + p] = (unsigned short)key; } \
                       else if (uk >= bstk[m]) { const int p = __hip_atomic_fetch_add((LAS unsigned*)(meta + 48 + q), DRY ? 0u : 1u, __ATOMIC_RELAXED, __HIP_MEMORY_SCOPE_WORKGROUP); \
                           if (p < (DRY ? dryz : DSA_CAND_CAP)) { hist[(q * DSA_CAND_CAP + p) * 2] = uk; hist[(q * DSA_CAND_CAP + p) * 2 + 1] = (unsigned)key; } } } } } } } } while (0)
    unsigned bstk[4]; unsigned dry = 0; const int dryz = meta[126];
#pragma unroll
    for (int m = 0; m < 4; ++m) bstk[m] = (unsigned)bst[m] << 20;
    bf16x8 kbA[4][2], kbB[4][2];
    DSA_LOADK(kbA, ktb + wave);
    for (int kt0 = ktb + wave; kt0 < nkt; kt0 += 64) {
        if (kt0 + 32 < nkt) DSA_LOADK(kbB, kt0 + 32);
        DSA_TRIP(kbA, kt0);
        if (kt0 + 32 < nkt) { if (kt0 + 64 < nkt) DSA_LOADK(kbA, kt0 + 64); DSA_TRIP(kbB, kt0 + 32); } }
#undef DSA_LOADK
#undef DSA_TRIP
    if (MODE == 2 && dry == 0x12345678u) meta[127] = 1;
}
__device__ __forceinline__ void dsa_tile(Frame& F, int item) {
    const int lane = mk_lane(), wave = F.wave, tid = wave * 64 + lane;
    const int b = item & 3, ti = 511 - (item >> 2), t0 = 16 * ti, nkt = ti + 1; const size_t tok0 = (size_t)b * SEQL + t0;
    LAS unsigned* hist = (LAS unsigned*)F.lds; LAS unsigned short* sel = (LAS unsigned short*)(F.lds + DSA_SEL_OFF); LAS int* meta = (LAS int*)(F.lds + DSA_META_OFF);
    const bf16* QI = (const bf16*)(F.ws + WS_QI); const bf16* KIb = (const bf16*)(F.ws + WS_KI) + (size_t)b * SEQL * 64; const float* WI = (const float*)(F.ws + WS_WI);
    const int g = lane >> 4, c = lane & 15;
    if (ti >= 16) {
        for (int i = tid; i < 32768 / 4; i += 512) ((LAS v4u*)hist)[i] = (v4u){0u, 0u, 0u, 0u};
        if (tid < 96 || tid == 126) meta[tid] = 0;
        bf16x8 qa[4][2]; float wq[4][4];
#pragma unroll
        for (int m = 0; m < 4; ++m) { const bf16* qp = QI + (tok0 + 4 * m + (c >> 2)) * 256 + (c & 3) * 64 + 8 * g; qa[m][0] = *(const bf16x8*)qp; qa[m][1] = *(const bf16x8*)(qp + 32);
            const f32x4 w4 = *(const f32x4*)(WI + (tok0 + 4 * m + g) * 4); wq[m][0] = w4.x; wq[m][1] = w4.y; wq[m][2] = w4.z; wq[m][3] = w4.w; }
        __syncthreads();
#define DSA_BOUNDARY(OUT_BIN, OUT_NA) do { _Pragma("unroll 1") for (int qq = 0; qq < 2; ++qq) { const int q = 2 * wave + qq; const LAS v4u* hw = (const LAS v4u*)(hist + q * 2048 + 32 * lane); unsigned s_ = 0; \
            _Pragma("unroll") for (int i = 0; i < 8; ++i) { const v4u w = hw[i]; s_ += (w.x & 0xffffu) + (w.x >> 16) + (w.y & 0xffffu) + (w.y >> 16) + (w.z & 0xffffu) + (w.z >> 16) + (w.w & 0xffffu) + (w.w >> 16); } \
            unsigned tsum = s_; \
            _Pragma("unroll") for (int off = 1; off < 64; off <<= 1) { const unsigned o = __shfl_down(tsum, off); tsum += (lane + off < 64) ? o : 0u; } \
            const unsigned above = tsum - s_; \
            const unsigned long long hit = __ballot(above < 256u && tsum >= 256u); const int Lh = hit ? (int)__builtin_ctzll(hit) : 0; \
            const unsigned aboveL = (unsigned)__shfl((int)above, Lh); \
            const int bin = 64 * Lh + lane; const unsigned wv = hist[q * 2048 + (bin >> 1)]; const unsigned cn = (bin & 1) ? (wv >> 16) : (wv & 0xffffu); \
            unsigned t2 = cn; \
            _Pragma("unroll") for (int off = 1; off < 64; off <<= 1) { const unsigned o = __shfl_down(t2, off); t2 += (lane + off < 64) ? o : 0u; } \
            const unsigned ab2 = t2 - cn + aboveL; \
            if (ab2 < 256u && ab2 + cn >= 256u) { meta[(OUT_BIN) + q] = bin; if ((OUT_NA) >= 0) meta[(OUT_NA) + q] = (int)ab2; } } } while (0)
        const int npre = (nkt >= 64) ? (((nkt >> 3) + 7) & ~7) < 32 ? 32 : (((nkt >> 3) + 7) & ~7) : nkt;
        dsa_score_pass<0>(KIb, qa, wq, t0, 0, npre, wave, lane, hist, sel, meta, false);
        __syncthreads();
        if (npre < nkt) { DSA_BOUNDARY(64, -1); __syncthreads();
            dsa_score_pass<0>(KIb, qa, wq, t0, npre, nkt, wave, lane, hist, sel, meta, true);
            __syncthreads(); }
        DSA_BOUNDARY(0, 16);
        __syncthreads();
        if (DSA_DUP_KIND & 1) { dsa_score_pass<0, true>(KIb, qa, wq, t0, 0, npre, wave, lane, hist, sel, meta, false); __syncthreads(); }
        if ((DSA_DUP_KIND & 2) && npre < nkt) { dsa_score_pass<0, true>(KIb, qa, wq, t0, npre, nkt, wave, lane, hist, sel, meta, true); __syncthreads(); }
        if (DSA_DUP_KIND & 16) { DSA_BOUNDARY(0, 16); __syncthreads(); DSA_BOUNDARY(0, 16); __syncthreads(); }
#undef DSA_BOUNDARY
        if (DSA_DUP_PASS) dsa_score_pass<2>(KIb, qa, wq, t0, 0, nkt, wave, lane, hist, sel, meta, false);
        dsa_score_pass<1>(KIb, qa, wq, t0, 0, nkt, wave, lane, hist, sel, meta, false);
        __syncthreads();
        if (DSA_DUP_KIND & 4) { dsa_score_pass<1, true>(KIb, qa, wq, t0, 0, nkt, wave, lane, hist, sel, meta, false); __syncthreads(); }
#pragma unroll 1
        for (int qq0 = 0; qq0 < ((DSA_DUP_KIND & 8) ? 4 : 2); ++qq0) { const int qq = qq0 & 1; const bool rdry = qq0 >= 2; const int q = 2 * wave + qq;
            int n = __builtin_amdgcn_readfirstlane(meta[48 + q]); n = n < DSA_CAND_CAP ? n : DSA_CAND_CAP; const int nab = __builtin_amdgcn_readfirstlane(meta[16 + q]); const int R = 256 - nab;
            const LAS v2u* cd = (const LAS v2u*)(hist + (size_t)q * DSA_CAND_CAP * 2);
            unsigned ck[16], ci[16];
#pragma unroll
            for (int j2 = 0; j2 < 16; ++j2) { const int c_ = lane + 64 * j2; v2u e = {0u, 0u}; if (c_ < n) e = cd[c_]; ck[j2] = (c_ < n) ? (e.x & 0xFFFFFu) + 1u : 0u; ci[j2] = e.y; }
            unsigned T = 0;
#pragma unroll 1
            for (int bit = 20; bit >= 0; --bit) { const unsigned trial = T | (1u << bit); int cnt = 0;
#pragma unroll
                for (int j2 = 0; j2 < 16; ++j2) cnt += __builtin_popcountll(__ballot(ck[j2] >= trial));
                if (cnt >= R) T = trial; }
            int cgt = 0, ceq = 0;
#pragma unroll
            for (int j2 = 0; j2 < 16; ++j2) { cgt += __builtin_popcountll(__ballot(ck[j2] > T)); ceq += __builtin_popcountll(__ballot(ck[j2] == T)); }
            const int need = R - cgt; unsigned I = 0xFFFFu;
            if (ceq > need) { I = 0;
#pragma unroll 1
                for (int bit = 12; bit >= 0; --bit) { const unsigned trial = I | (1u << bit); int cnt = 0;
#pragma unroll
                    for (int j2 = 0; j2 < 16; ++j2) cnt += __builtin_popcountll(__ballot(ck[j2] == T && ci[j2] < trial));
                    if (cnt < need) I = trial; } }
            int base = nab;
#pragma unroll
            for (int j2 = 0; j2 < 16; ++j2) { const bool s_ = (ck[j2] > T) || (ck[j2] == T && ci[j2] <= I); const unsigned long long m_ = __ballot(s_);
                const int p = base + (int)__builtin_amdgcn_mbcnt_hi((unsigned)(m_ >> 32), __builtin_amdgcn_mbcnt_lo((unsigned)m_, 0u));
                if (s_ && p < 256 && !rdry) sel[q * 256 + p] = (unsigned short)ci[j2];
                base += __builtin_popcountll(m_); } }
    } else {
        for (int i = tid; i < 16 * 256; i += 512) sel[i] = (unsigned short)(i & 255);
    }
    __syncthreads();
    const bf16* QD = (const bf16*)(F.ws + WS_QD); const bf16* KD = (const bf16*)(F.ws + WS_KD) + (size_t)b * SEQL * 64; const bf16* VDb = (const bf16*)(F.ws + WS_VD) + (size_t)b * SEQL * 64;
    bf16* CAT2 = (bf16*)(F.ws + WS_CAT);
    bf16x8 esel[2];
#pragma unroll
    for (int d = 0; d < 2; ++d)
#pragma unroll
        for (int j = 0; j < 8; ++j) esel[d][j] = (8 * g + j == 16 * d + c) ? (short)0x3F80 : (short)0;
#pragma unroll 1
    for (int qq0 = 0; qq0 < ((DSA_DUP_ATT || (DSA_DUP_KIND & 32)) ? 4 : 2); ++qq0) { const int qq = qq0 & 1; const int q = 2 * wave + qq; const int pos = t0 + q; const size_t tok = tok0 + q; const int nsel = (pos + 1 < 256) ? (pos + 1) : 256;
        bf16x8 qb[2];
        { const bf16* qp = QD + tok * 512 + (c & 7) * 64 + 8 * g; qb[0] = *(const bf16x8*)qp; qb[1] = *(const bf16x8*)(qp + 32);
          if (c >= 8) { qb[0] = (bf16x8){0, 0, 0, 0, 0, 0, 0, 0}; qb[1] = qb[0]; } }
        f32x4_t st[16];
        {
            bf16x8 kaA[4][2], kaB[4][2];
#define DSA_LDK(dst, bt) do { _Pragma("unroll") for (int i = 0; i < 4; ++i) { const int idx = 16 * (4 * (bt) + i) + c; const int key = (idx < nsel) ? (int)sel[q * 256 + idx] : 0; const bf16* kp = KD + (size_t)key * 64 + 8 * g; \
                dst[i][0] = *(const bf16x8*)kp; dst[i][1] = *(const bf16x8*)(kp + 32); } } while (0)
#define DSA_MMK(src, bt) do { _Pragma("unroll") for (int i = 0; i < 4; ++i) { f32x4_t a = {0.f, 0.f, 0.f, 0.f}; \
                a = __builtin_amdgcn_mfma_f32_16x16x32_bf16(src[i][0], qb[0], a, 0, 0, 0); a = __builtin_amdgcn_mfma_f32_16x16x32_bf16(src[i][1], qb[1], a, 0, 0, 0); \
                _Pragma("unroll") for (int j = 0; j < 4; ++j) if (16 * (4 * (bt) + i) + 4 * g + j >= nsel) a[j] = -INFINITY; \
                st[4 * (bt) + i] = a; } } while (0)
            bf16x8 kaC[4][2];
            DSA_LDK(kaA, 0); DSA_LDK(kaB, 1); DSA_LDK(kaC, 2); DSA_MMK(kaA, 0); DSA_LDK(kaA, 3); DSA_MMK(kaB, 1); DSA_MMK(kaC, 2); DSA_MMK(kaA, 3);
#undef DSA_LDK
#undef DSA_MMK
        }
        float mx = -INFINITY;
#pragma unroll
        for (int i = 0; i < 16; ++i) mx = fmaxf(fmaxf(mx, fmaxf(st[i][0], st[i][1])), fmaxf(st[i][2], st[i][3]));
        mx = fmaxf(mx, __shfl_xor(mx, 16)); mx = fmaxf(mx, __shfl_xor(mx, 32));
        float ls = 0.f;
#pragma unroll
        for (int i = 0; i < 16; ++i) {
#pragma unroll
            for (int j = 0; j < 4; ++j) { const float p = __builtin_amdgcn_exp2f(st[i][j] - mx); st[i][j] = p; ls += p; } }
        ls += __shfl_xor(ls, 16); ls += __shfl_xor(ls, 32);
        f32x4_t o[4] = {{0.f, 0.f, 0.f, 0.f}, {0.f, 0.f, 0.f, 0.f}, {0.f, 0.f, 0.f, 0.f}, {0.f, 0.f, 0.f, 0.f}};
        bf16x8 vnx[2][2];
#pragma unroll
        for (int tt = 0; tt < 2; ++tt) { const int idx = 16 * tt + c; const int key = (idx < nsel) ? (int)sel[q * 256 + idx] : 0; const bf16* vp = VDb + (size_t)key * 64 + 8 * g; vnx[tt][0] = *(const bf16x8*)vp; vnx[tt][1] = *(const bf16x8*)(vp + 32); }
#pragma unroll
        for (int ks = 0; ks < 8; ++ks) { v4u pw; pw.x = pk2(st[2 * ks][0], st[2 * ks][1]); pw.y = pk2(st[2 * ks][2], st[2 * ks][3]); pw.z = pk2(st[2 * ks + 1][0], st[2 * ks + 1][1]); pw.w = pk2(st[2 * ks + 1][2], st[2 * ks + 1][3]);
            const bf16x8 pa = __builtin_bit_cast(bf16x8, pw);
            bf16x8 vcur[2][2];
#pragma unroll
            for (int tt = 0; tt < 2; ++tt) { vcur[tt][0] = vnx[tt][0]; vcur[tt][1] = vnx[tt][1]; }
            if (ks < 7) {
#pragma unroll
                for (int tt = 0; tt < 2; ++tt) { const int idx = 16 * (2 * ks + 2 + tt) + c; const int key = (idx < nsel) ? (int)sel[q * 256 + idx] : 0; const bf16* vp = VDb + (size_t)key * 64 + 8 * g; vnx[tt][0] = *(const bf16x8*)vp; vnx[tt][1] = *(const bf16x8*)(vp + 32); } }
            f32x4_t tr[2][4];
#pragma unroll
            for (int tt = 0; tt < 2; ++tt) { const f32x4_t z = {0.f, 0.f, 0.f, 0.f};
                tr[tt][0] = __builtin_amdgcn_mfma_f32_16x16x32_bf16(vcur[tt][0], esel[0], z, 0, 0, 0); tr[tt][1] = __builtin_amdgcn_mfma_f32_16x16x32_bf16(vcur[tt][0], esel[1], z, 0, 0, 0);
                tr[tt][2] = __builtin_amdgcn_mfma_f32_16x16x32_bf16(vcur[tt][1], esel[0], z, 0, 0, 0); tr[tt][3] = __builtin_amdgcn_mfma_f32_16x16x32_bf16(vcur[tt][1], esel[1], z, 0, 0, 0); }
#pragma unroll
            for (int db = 0; db < 4; ++db) { v4u vw; vw.x = pk2(tr[0][db][0], tr[0][db][1]); vw.y = pk2(tr[0][db][2], tr[0][db][3]); vw.z = pk2(tr[1][db][0], tr[1][db][1]); vw.w = pk2(tr[1][db][2], tr[1][db][3]);
                o[db] = __builtin_amdgcn_mfma_f32_16x16x32_bf16(pa, __builtin_bit_cast(bf16x8, vw), o[db], 0, 0, 0); } }
        float li[4];
#pragma unroll
        for (int j = 0; j < 4; ++j) li[j] = 1.0f / __shfl(ls, (4 * g + j) & 15);
        if (g < 2) { bf16* op = CAT2 + tok * 1024 + 512 + c;
#pragma unroll
            for (int j = 0; j < 4; ++j)
#pragma unroll
                for (int db = 0; db < 4; ++db) op[(4 * g + j) * 64 + 16 * db] = ABL_DSA ? (bf16)0 : (bf16)f2bf(o[db][j] * li[j]); } }
    __syncthreads();
}
__device__ __forceinline__ void dsa_phase(Frame& F, int qi, int item0, int nitems) {
    unsigned* qhead = (unsigned*)(F.ws + WS_CTL) + CW_DSAQ + 64 * qi; LAS int* meta = (LAS int*)(F.lds + DSA_META_OFF);
    for (;;) { if (F.wave == 0 && mk_lane() == 0) meta[100] = (int)atomicAdd(qhead, 1u);
        __syncthreads(); const int it = meta[100]; __syncthreads();
        if (it >= nitems) break;
        const int v = (item0 == 0) ? (it < 768 ? it : it + 1024) : it + 768;
        dsa_tile(F, v); }
}

constexpr int RC_PT = 72, RC_MS = 64 * RC_PT;
constexpr size_t WS_RWS = 5 * MiB;
constexpr size_t WS_WO_OUT2 = 3 * MiB;
constexpr size_t RWS_WY = 0, RWS_MC = 16 * MiB, RWS_NC = 32 * MiB;
typedef float rc_f32x2 __attribute__((ext_vector_type(2))); typedef __bf16 rc_bf16x2 __attribute__((ext_vector_type(2)));
__device__ __forceinline__ unsigned cvtpk(float lo, float hi) { const rc_f32x2 v = {lo, hi}; const rc_bf16x2 b = __builtin_convertvector(v, rc_bf16x2); return __builtin_bit_cast(unsigned, b); }
__device__ __forceinline__ f32x4 rc_ld4(const LAS bf16* M, int n, int m0) { const v2u w = *(const LAS v2u*)(M + n * RC_PT + m0); return (f32x4){bflo(w.x), bfhi(w.x), bflo(w.y), bfhi(w.y)}; }
__device__ __forceinline__ void rc_st4(LAS bf16* M, int n, int m0, const f32x4 v) { *(LAS v2u*)(M + n * RC_PT + m0) = (v2u){cvtpk(v.x, v.y), cvtpk(v.z, v.w)}; }
template <class Init, class Out>
__device__ __forceinline__ void rc_pset(const LAS bf16* X, const LAS bf16* Y, int wave, int lane, Init init, Out out) {
    const int g = lane >> 4, c = lane & 15;
#pragma unroll
    for (int u = 0; u < 2; ++u) { const int tl = 2 * wave + u, mt = tl >> 2, nt = tl & 3;
        f32x4 acc = init(mt, nt, g, c);
#pragma unroll
        for (int ks = 0; ks < 2; ++ks) { const bf16x8 a = *(const LAS bf16x8*)(X + (16 * mt + c) * RC_PT + 32 * ks + 8 * g), b = *(const LAS bf16x8*)(Y + (16 * nt + c) * RC_PT + 32 * ks + 8 * g);
            acc = __builtin_amdgcn_mfma_f32_16x16x32_bf16(a, b, acc, 0, 0, 0); }
        out(mt, nt, g, c, acc); }
}
#define RC_SYNC() __syncthreads()
__device__ __forceinline__ void rwkv_chunk_unit(Frame& F, int b, int h, int hl, int ch) {
    const int lane = mk_lane(), wave = F.wave;
    LAS bf16* L0 = (LAS bf16*)F.lds;
#define SLOT(i) (L0 + (i) * RC_MS)
    LAS float* gC = (LAS float*)(L0 + 15 * RC_MS);
    LAS float* segs = gC + 64;
    const bf16* P1 = (const bf16*)(F.ws + WS_P1); const bf16* LORA = (const bf16*)(F.ws + WS_LORA);
    const size_t tok0 = (size_t)b * SEQL + 64 * ch; const int chn = h * 64 + lane;
    { const float* mu = F.in[I_RWKV_MU]; const float mu_r = mu[PC_R + chn], mu_k = mu[PC_K + chn], mu_v = mu[PC_V + chn], kkw = F.in[I_RWKV_K_K][chn], kaw = F.in[I_RWKV_K_A][chn];
      float rr[8], kmod[8], vv[8], lw[8], kk[8], al[8]; float tot = 0.f;
#pragma unroll
      for (int i = 0; i < 8; ++i) { const int tt = 8 * wave + i; const size_t tok = tok0 + tt; const bool first = (ch == 0 && tt == 0); const bf16* row = P1 + tok * P1_LD; const bf16* prow = first ? row : (row - P1_LD);
          const float rc = bf2f(row[PC_R + chn]), kc = bf2f(row[PC_K + chn]), vc = bf2f(row[PC_V + chn]);
          const float rp = first ? 0.f : bf2f(prow[PC_R + chn]), kp = first ? 0.f : bf2f(prow[PC_K + chn]), vp = first ? 0.f : bf2f(prow[PC_V + chn]);
          lw[i] = bf2f(LORA[tok * 1536 + chn]); al[i] = bf2f(LORA[tok * 1536 + 512 + chn]);
          rr[i] = rc + (rp - rc) * mu_r; const float k0 = kc + (kp - kc) * mu_k; vv[i] = vc + (vp - vc) * mu_v;
          const float kkv = k0 * kkw; const float nrm = sqrtf(wave_sum(kkv * kkv)); kk[i] = kkv / fmaxf(nrm, 1e-12f);
          kmod[i] = k0 * (1.0f + (al[i] - 1.0f) * kaw); tot += lw[i]; }
      segs[wave * 64 + lane] = tot;
      RC_SYNC();
      float off = 0.f;
#pragma unroll
      for (int w2 = 0; w2 < 8; ++w2) off += (w2 < wave) ? segs[w2 * 64 + lane] : 0.f;
#pragma unroll
      for (int i = 0; i < 8; ++i) { const int tt = 8 * wave + i; const float Lm = off; off += lw[i]; const float Lc = off;
          const float eL = __expf(Lc), eLm = __expf(Lm), enL = __expf(-Lc);
          const bf16 va = (bf16)f2bf(-kk[i] * eLm), vb = (bf16)f2bf(kk[i] * al[i] * enL), vk = (bf16)f2bf(kmod[i] * enL), vr = (bf16)f2bf(rr[i] * eL), vvv = (bf16)f2bf(vv[i]);
          SLOT(0)[tt * RC_PT + lane] = va; SLOT(1)[tt * RC_PT + lane] = vb; SLOT(2)[tt * RC_PT + lane] = vk; SLOT(3)[tt * RC_PT + lane] = vr;
          SLOT(4)[lane * RC_PT + tt] = va; SLOT(5)[lane * RC_PT + tt] = vb; SLOT(6)[lane * RC_PT + tt] = vvv;
          if (tt == 63) gC[lane] = eL; }
      RC_SYNC(); }
    const auto zero = [](int, int, int, int) { return (f32x4){0.f, 0.f, 0.f, 0.f}; };
    rc_pset(SLOT(1), SLOT(0), wave, lane, zero, [&](int mt, int nt, int g, int c, f32x4 a) { const int m0 = 16 * mt + 4 * g, n = 16 * nt + c;
        rc_st4(SLOT(9), n, m0, (f32x4){m0 < n ? a.x : 0.f, m0 + 1 < n ? a.y : 0.f, m0 + 2 < n ? a.z : 0.f, m0 + 3 < n ? a.w : 0.f}); });
    rc_pset(SLOT(0), SLOT(1), wave, lane, zero, [&](int mt, int nt, int g, int c, f32x4 a) { const int m0 = 16 * mt + 4 * g, n = 16 * nt + c;
        rc_st4(SLOT(10), n, m0, (f32x4){n < m0 ? a.x : 0.f, n < m0 + 1 ? a.y : 0.f, n < m0 + 2 ? a.z : 0.f, n < m0 + 3 ? a.w : 0.f}); });
    rc_pset(SLOT(0), SLOT(2), wave, lane, zero, [&](int mt, int nt, int g, int c, f32x4 a) { const int m0 = 16 * mt + 4 * g, n = 16 * nt + c;
        rc_st4(SLOT(7), n, m0, (f32x4){n < m0 ? a.x : 0.f, n < m0 + 1 ? a.y : 0.f, n < m0 + 2 ? a.z : 0.f, n < m0 + 3 ? a.w : 0.f}); });
    rc_pset(SLOT(1), SLOT(3), wave, lane, zero, [&](int mt, int nt, int g, int c, f32x4 a) { const int m0 = 16 * mt + 4 * g, n = 16 * nt + c;
        rc_st4(SLOT(8), n, m0, (f32x4){m0 <= n ? a.x : 0.f, m0 + 1 <= n ? a.y : 0.f, m0 + 2 <= n ? a.z : 0.f, m0 + 3 <= n ? a.w : 0.f}); });
    RC_SYNC();
#define RC_NEU(sN, sNT, sM, sMT, dN, dNT, dM, dMT, LAST) do { \
    if (!(LAST)) rc_pset(SLOT(sNT), SLOT(sM), wave, lane, [&](int mt, int nt, int g, int c) { return rc_ld4(SLOT(sN), 16 * nt + c, 16 * mt + 4 * g); }, \
                         [&](int mt, int nt, int g, int c, f32x4 a) { rc_st4(SLOT(dN), 16 * nt + c, 16 * mt + 4 * g, a); });                   \
    rc_pset(SLOT(sM), SLOT(sNT), wave, lane, [&](int mt, int nt, int g, int c) { return rc_ld4(SLOT(sNT), 16 * nt + c, 16 * mt + 4 * g); }, \
            [&](int mt, int nt, int g, int c, f32x4 a) { rc_st4(SLOT(dNT), 16 * nt + c, 16 * mt + 4 * g, a); });                             \
    if (!(LAST)) { rc_pset(SLOT(sMT), SLOT(sM), wave, lane, zero, [&](int mt, int nt, int g, int c, f32x4 a) { rc_st4(SLOT(dM), 16 * nt + c, 16 * mt + 4 * g, a); });     \
                   rc_pset(SLOT(sM), SLOT(sMT), wave, lane, zero, [&](int mt, int nt, int g, int c, f32x4 a) { rc_st4(SLOT(dMT), 16 * nt + c, 16 * mt + 4 * g, a); }); } \
    RC_SYNC(); } while (0)
    RC_NEU(9, 10, 9, 10, 11, 12, 13, 14, false);
    RC_NEU(11, 12, 13, 14, 9, 10, 0, 1, false);
    RC_NEU(9, 10, 0, 1, 11, 12, 13, 14, false);
    RC_NEU(11, 12, 13, 14, 9, 10, 0, 1, false);
    RC_NEU(9, 10, 0, 1, 11, 12, 13, 14, false);
    RC_NEU(11, 12, 13, 14, 9, 10, 0, 1, true);
#undef RC_NEU
    rc_pset(SLOT(10), SLOT(8), wave, lane, [&](int mt, int nt, int g, int c) { return rc_ld4(SLOT(8), 16 * nt + c, 16 * mt + 4 * g); },
            [&](int mt, int nt, int g, int c, f32x4 a) { rc_st4(SLOT(9), 16 * nt + c, 16 * mt + 4 * g, a); });
    rc_pset(SLOT(10), SLOT(5), wave, lane, [&](int mt, int nt, int g, int c) { return rc_ld4(SLOT(5), 16 * nt + c, 16 * mt + 4 * g); },
            [&](int mt, int nt, int g, int c, f32x4 a) { rc_st4(SLOT(11), 16 * nt + c, 16 * mt + 4 * g, a); });
    RC_SYNC();
    const int ul = ((b * 4 + hl) * 128 + ch);
    bf16* WY = (bf16*)(F.ws + WS_RWS) + (size_t)ul * 12288; bf16* MC = WY + 4096; bf16* NC = WY + 8192;
    rc_pset(SLOT(4), SLOT(9), wave, lane, [&](int mt, int nt, int g, int c) { return rc_ld4(SLOT(3), 16 * nt + c, 16 * mt + 4 * g); },
            [&](int mt, int nt, int g, int c, f32x4 a) { *(v2u*)(WY + ((nt * 2 + (mt >> 1)) * 64 + g * 16 + c) * 8 + 4 * (mt & 1)) = (v2u){cvtpk(a.x, a.y), cvtpk(a.z, a.w)}; });
    { const int g = lane >> 4, c = lane & 15;
#pragma unroll
      for (int u = 0; u < 2; ++u) { const int tl = 2 * wave + u, mt = tl >> 2, nt = tl & 3, m0 = 16 * mt + 4 * g, n = 16 * nt + c; f32x4 acc = {0.f, 0.f, 0.f, 0.f};
#pragma unroll
          for (int ks = 0; ks < 2; ++ks) acc = __builtin_amdgcn_mfma_f32_16x16x32_bf16(*(const LAS bf16x8*)(SLOT(2) + (16 * mt + c) * RC_PT + 32 * ks + 8 * g), *(const LAS bf16x8*)(SLOT(3) + (16 * nt + c) * RC_PT + 32 * ks + 8 * g), acc, 0, 0, 0);
          acc = (f32x4){m0 <= n ? acc.x : 0.f, m0 + 1 <= n ? acc.y : 0.f, m0 + 2 <= n ? acc.z : 0.f, m0 + 3 <= n ? acc.w : 0.f};
#pragma unroll
          for (int ks = 0; ks < 2; ++ks) acc = __builtin_amdgcn_mfma_f32_16x16x32_bf16(*(const LAS bf16x8*)(SLOT(7) + (16 * mt + c) * RC_PT + 32 * ks + 8 * g), *(const LAS bf16x8*)(SLOT(9) + (16 * nt + c) * RC_PT + 32 * ks + 8 * g), acc, 0, 0, 0);
          rc_st4(SLOT(13), n, m0, acc); } }
    rc_pset(SLOT(4), SLOT(11), wave, lane, zero, [&](int mt, int nt, int g, int c, f32x4 a) { const int m0 = 16 * mt + 4 * g, n = 16 * nt + c; const float gg = gC[n];
        const f32x4 o = {gg * (a.x + (m0 == n ? 1.f : 0.f)), gg * (a.y + (m0 + 1 == n ? 1.f : 0.f)), gg * (a.z + (m0 + 2 == n ? 1.f : 0.f)), gg * (a.w + (m0 + 3 == n ? 1.f : 0.f))};
        *(v2u*)(MC + ((nt * 2 + (mt >> 1)) * 64 + g * 16 + c) * 8 + 4 * (mt & 1)) = (v2u){cvtpk(o.x, o.y), cvtpk(o.z, o.w)}; });
    rc_pset(SLOT(7), SLOT(11), wave, lane, [&](int mt, int nt, int g, int c) { const int m0 = 16 * mt + 4 * g, n = 16 * nt + c;
                return (f32x4){bf2f(SLOT(2)[m0 * RC_PT + n]), bf2f(SLOT(2)[(m0 + 1) * RC_PT + n]), bf2f(SLOT(2)[(m0 + 2) * RC_PT + n]), bf2f(SLOT(2)[(m0 + 3) * RC_PT + n])}; },
            [&](int mt, int nt, int g, int c, f32x4 a) { rc_st4(SLOT(14), 16 * nt + c, 16 * mt + 4 * g, a); });
    RC_SYNC();
    rc_pset(SLOT(14), SLOT(6), wave, lane, zero, [&](int mt, int nt, int g, int c, f32x4 a) { const int m0 = 16 * mt + 4 * g; const f32x4 gg = *(const LAS f32x4*)(gC + m0);
        *(v2u*)(NC + ((nt * 4 + mt) * 64 + lane) * 4) = (v2u){cvtpk(a.x * gg.x, a.y * gg.y), cvtpk(a.z * gg.z, a.w * gg.w)}; });
    { bf16* YR = (bf16*)(F.ws + WS_YR);
      rc_pset(SLOT(13), SLOT(6), wave, lane, zero, [&](int mt, int nt, int g, int c, f32x4 a) { bf16* yp = YR + (tok0 + 16 * mt + 4 * g) * 512 + h * 64 + 16 * nt + c;
          yp[0] = (bf16)f2bf(a.x); yp[512] = (bf16)f2bf(a.y); yp[1024] = (bf16)f2bf(a.z); yp[1536] = (bf16)f2bf(a.w); }); }
    RC_SYNC();
#undef SLOT
}
__device__ __forceinline__ void rwkv_chunk_passA(Frame& F, int half) {
    for (int un = blockIdx.x; un < 2048; un += F.G) { const int ch = un & 127, hl = (un >> 7) & 3, b = un >> 9; rwkv_chunk_unit(F, b, 4 * half + hl, hl, ch); }
}
constexpr int RB_SLOT = 32768, RB_R = 4, RB_D = 3;
template <bool STORE> __device__ __forceinline__ void rwkv_chunk_passB(Frame& F, int half) {
    const int lane = mk_lane(), wave = F.wave, g = lane >> 4, c = lane & 15; const int sq = (int)blockIdx.x, b = sq >> 2, hl = sq & 3, h = 4 * half + hl;
    const bf16* UB = (const bf16*)(F.ws + WS_RWS) + (size_t)sq * 128 * 12288;
    bf16* YRb = (bf16*)(F.ws + WS_YR) + (size_t)b * SEQL * 512 + h * 64;
    LAS unsigned char* ring = F.lds;
    const bool loader = wave >= 4; const int lw = wave & 3;
#define RB_ISSUE(ch_) do { const int ch2 = (ch_); LAS unsigned char* sl = ring + (ch2 % RB_R) * RB_SLOT; const char* ub = (const char*)(UB + (size_t)ch2 * 12288); \
        _Pragma("unroll") for (int q = 0; q < 6; ++q) { const int i = lw * 6 + q; __builtin_amdgcn_global_load_lds((const unsigned*)(ub + i * 1024 + lane * 16), (LAS unsigned*)(sl + i * 1024), 16, 0, 0); } \
        _Pragma("unroll") for (int q = 0; q < 2; ++q) { const int i2 = lw * 2 + q; const char* yp = (const char*)(YRb + (size_t)(64 * ch2 + 8 * i2 + (lane >> 3)) * 512) + (lane & 7) * 16; \
            __builtin_amdgcn_global_load_lds((const unsigned*)yp, (LAS unsigned*)(sl + 24576 + i2 * 1024), 16, 0, 0); } } while (0)
    if (loader) { RB_ISSUE(0); RB_ISSUE(1); RB_ISSUE(2); }
    bf16x8 sB[2] = {{0, 0, 0, 0, 0, 0, 0, 0}, {0, 0, 0, 0, 0, 0, 0, 0}};
    for (int ch = 0; ch < 128; ++ch) {
        if (loader) { if (ch + 2 < 128) asm volatile("s_waitcnt vmcnt(16)" ::: "memory"); else asm volatile("s_waitcnt vmcnt(0)" ::: "memory"); }
        else asm volatile("s_waitcnt lgkmcnt(0)" ::: "memory");
        asm volatile("" ::: "memory"); __builtin_amdgcn_s_barrier(); asm volatile("" ::: "memory");
        if (loader) { if (ch + RB_D < 128) RB_ISSUE(ch + RB_D); }
        else { const LAS unsigned char* sl = ring + (ch % RB_R) * RB_SLOT; const int vg = wave;
            bf16x8 wa[4][2], ma[4][2]; v2u nf[4]; float yl[4][4];
#pragma unroll
            for (int mt = 0; mt < 4; ++mt) {
#pragma unroll
                for (int ks = 0; ks < 2; ++ks) { wa[mt][ks] = *(const LAS bf16x8*)(sl + ((mt * 2 + ks) * 64 + lane) * 16); ma[mt][ks] = *(const LAS bf16x8*)(sl + 8192 + ((mt * 2 + ks) * 64 + lane) * 16); }
                nf[mt] = *(const LAS v2u*)(sl + 16384 + ((vg * 4 + mt) * 64 + lane) * 8);
#pragma unroll
                for (int j = 0; j < 4; ++j) yl[mt][j] = bf2f(*(const LAS unsigned short*)(sl + 24576 + (16 * mt + 4 * g + j) * 128 + (16 * vg + c) * 2)); }
            f32x4 ns[4];
#pragma unroll
            for (int mt = 0; mt < 4; ++mt) { f32x4 y = {yl[mt][0], yl[mt][1], yl[mt][2], yl[mt][3]};
                y = __builtin_amdgcn_mfma_f32_16x16x32_bf16(wa[mt][0], sB[0], y, 0, 0, 0); y = __builtin_amdgcn_mfma_f32_16x16x32_bf16(wa[mt][1], sB[1], y, 0, 0, 0);
                bf16* yp = YRb + (size_t)(64 * ch + 16 * mt + 4 * g) * 512 + 16 * vg + c; if (STORE) { yp[0] = (bf16)f2bf(y.x); yp[512] = (bf16)f2bf(y.y); yp[1024] = (bf16)f2bf(y.z); yp[1536] = (bf16)f2bf(y.w); } else if (y.x == 123456.f) yp[0] = 0;
                f32x4 s = {bflo(nf[mt].x), bfhi(nf[mt].x), bflo(nf[mt].y), bfhi(nf[mt].y)};
                s = __builtin_amdgcn_mfma_f32_16x16x32_bf16(ma[mt][0], sB[0], s, 0, 0, 0); s = __builtin_amdgcn_mfma_f32_16x16x32_bf16(ma[mt][1], sB[1], s, 0, 0, 0); ns[mt] = s; }
            { v4u w0, w1; w0.x = cvtpk(ns[0].x, ns[0].y); w0.y = cvtpk(ns[0].z, ns[0].w); w0.z = cvtpk(ns[1].x, ns[1].y); w0.w = cvtpk(ns[1].z, ns[1].w);
              w1.x = cvtpk(ns[2].x, ns[2].y); w1.y = cvtpk(ns[2].z, ns[2].w); w1.z = cvtpk(ns[3].x, ns[3].y); w1.w = cvtpk(ns[3].z, ns[3].w);
              sB[0] = __builtin_bit_cast(bf16x8, w0); sB[1] = __builtin_bit_cast(bf16x8, w1); } } }
    asm volatile("s_waitcnt vmcnt(0) lgkmcnt(0)" ::: "memory"); __builtin_amdgcn_s_barrier(); asm volatile("" ::: "memory");
#undef RB_ISSUE
}

__device__ __forceinline__ void final_norm_phase(Frame& F) {
    const int gw = blockIdx.x * NWAVES + F.wave, NGW = F.G * NWAVES, lane = mk_lane(); const float* gn = F.in[I_FINAL_NORM];
    f32x4 gv[4];
#pragma unroll
    for (int j = 0; j < 4; ++j) gv[j] = ((const f32x4*)gn)[lane + 64 * j];
    for (int m = gw; m < T_TOK; m += NGW) { f32x4* xr = (f32x4*)(F.out + (size_t)m * DMODEL) + lane; f32x4 v[4]; float s = 0.f;
#pragma unroll
        for (int j = 0; j < 4; ++j) { v[j] = xr[64 * j]; s += (v[j].x * v[j].x + v[j].y * v[j].y) + (v[j].z * v[j].z + v[j].w * v[j].w); }
        const float rstd = 1.0f / sqrtf(wave_sum(s) * (1.f / DMODEL) + NORM_EPS);
#pragma unroll
        for (int j = 0; j < 4; ++j) xr[64 * j] = v[j] * rstd * gv[j]; }
}

constexpr int NPHASE = 29;
__global__ void __launch_bounds__(NWAVES * 64, 2) mega_fwd(Args args) {
    extern __shared__ __attribute__((aligned(16))) unsigned char lds[];
    Frame F;
    F.lds = (LAS unsigned char*)lds;
    F.wave = __builtin_amdgcn_readfirstlane((int)threadIdx.x >> 6); F.G = gridDim.x;
    F.in = args.in; F.out = args.out; F.ws = args.ws;
    unsigned char* ws = args.ws;
    for (int u = threadIdx.x; u < (LDS_BYTES - RING_BYTES) / 4; u += NWAVES * 64) ((LAS unsigned*)(F.lds + RING_BYTES))[u] = 0u;
    __syncthreads();
    XcdBarrier bar = xcd_barrier_post((unsigned*)(ws + WS_CTL) + CW_BAR + args.li * XCD_BAR_WORDS, (volatile LAS unsigned*)(F.lds + MISC_OFF));
    const int lo = args.ph_lo, hi = args.ph_hi;
#if STAMP_KA >= 0
    volatile LAS unsigned long long* stl = (volatile LAS unsigned long long*)(F.lds + MISC_OFF + 32);
    const bool stamper = (blockIdx.x == 0 && threadIdx.x == 0);
    if (stamper) stl[0] = __builtin_amdgcn_s_memrealtime();
#define STAMP_AT(k) do { if (stamper) { if ((k) == STAMP_KA) stl[1] = __builtin_amdgcn_s_memrealtime(); if ((k) == STAMP_KB) stl[2] = __builtin_amdgcn_s_memrealtime(); \
        if ((k) == 27) { const unsigned long long now = __builtin_amdgcn_s_memrealtime(); ((float*)(ws + WS_TILEEXP + 4096))[0] = (float)(stl[2] - stl[1]) / (float)(now - stl[0]); } } } while (0)
#else
#define STAMP_AT(k) do {} while (0)
#endif
#define IN(k) (lo <= (k) && (k) < hi)
#ifndef P8_DUP_MODE
#define P8_DUP_MODE 0
#endif
#ifndef P8_SP2
#define P8_SP2 true
#endif
#ifndef MFMA_SPIN
#define MFMA_SPIN 0
#endif
#ifndef P8_DUP_LD0
#define P8_DUP_LD0 0
#endif
#ifndef E1_OLD
#define E1_OLD 0
#endif
#ifndef P8_DUP_ZERO
#define P8_DUP_ZERO 0
#endif
#ifndef EXTRA_BAR
#define EXTRA_BAR 0
#endif
#ifndef P8_DUP_LDV
#define P8_DUP_LDV 0
#endif
#ifndef P9_DUP_LDV
#define P9_DUP_LDV 0
#endif
#ifndef P9_DUP_SKIP
#define P9_DUP_SKIP 0
#endif
#ifndef DUP_SKIP_EPI
#define DUP_SKIP_EPI 0
#endif
#ifndef P8_DUP_F8
#define P8_DUP_F8 0
#endif
#ifndef P8_ORDER
#define P8_ORDER pg8::StaticOrder
#endif
#ifndef GEMM_ORDER
#define GEMM_ORDER pg8::StaticOrder
#endif
#ifndef MOE_PROBE
#define MOE_PROBE 0
#endif
#ifndef MOE_PROBE_OFF
#define MOE_PROBE_OFF 470
#endif
#ifndef MOE_ALIGN
#define MOE_ALIGN true
#endif
#ifndef DUPSET
#define DUPSET 0ull
#endif
#define PHB(k) if (IN(k)) { const int nrep_ = 1 + (int)(((unsigned long long)(DUPSET) >> (k)) & 1ull); for (int rep_ = 0; rep_ < nrep_; ++rep_) { const bool last_ = (rep_ + 1 == nrep_); (void)last_;
#define PHE(k) if (!last_) xcd_barrier(bar, F.wave == 0 && mk_lane() == 0); } }
#define SEAM(k) do { if (IN(k) && IN((k) + 1)) { xcd_barrier(bar, F.wave == 0 && mk_lane() == 0); if (EXTRA_BAR) xcd_barrier(bar, F.wave == 0 && mk_lane() == 0); } } while (0)
#define SEAM2(k, kn) do { if (IN(k) && IN(kn)) xcd_barrier(bar, F.wave == 0 && mk_lane() == 0); } while (0)
    bf16* XN = (bf16*)(ws + WS_XN); bf16* CAT = (bf16*)(ws + WS_CAT); bf16* UG = (bf16*)(ws + WS_UG);
    bf16* Q0 = (bf16*)(ws + WS_Q0); bf16* K0 = (bf16*)(ws + WS_K0); bf16* V0 = (bf16*)(ws + WS_V0); bf16* YA = (bf16*)(ws + WS_YA);

#if MFMA_SPIN
    {
        typedef short s8_t __attribute__((ext_vector_type(8)));
        f32x4 a8[8]; s8_t xa, xb;
#pragma unroll
        for (int j = 0; j < 8; ++j) { a8[j] = (f32x4){0.f, 0.f, 0.f, 0.f}; xa[j] = (short)(0x3c00 + mk_lane() + j); xb[j] = (short)(0x3b80 + 3 * j); }
#pragma unroll 1
        for (int i = 0; i < MFMA_SPIN; ++i) {
#pragma unroll
            for (int j = 0; j < 8; ++j) a8[j] = __builtin_amdgcn_mfma_f32_16x16x32_bf16(xa, xb, a8[j], 0, 0, 0); }
        float sm = 0.f;
#pragma unroll
        for (int j = 0; j < 8; ++j) sm += a8[j][0] + a8[j][1] + a8[j][2] + a8[j][3];
        if (sm == 1.2345e-30f) ((float*)(ws + WS_TILEEXP))[1000] = sm;
    }
#endif
    PHB(0) p0_prologue(F, last_ ? 15 : (int)(((unsigned long long)(DUPSET) >> 46) & 15ull)); PHE(0) SEAM(0);
    PHB(1) pg8::Gemm g{XN, (const bf16*)(ws + WS_WE_IN), 1024, 1024, 1024}; GEMM_ORDER S; S.init(T_TOK, 2048, F.G, (int)blockIdx.x);
        #if E1_OLD
        pg8::Epi8<F_E1> E{{UG, Q0, K0, V0, (const float*)(ws + WS_ROPE)}};
        pg8::gemm_phase<pg8::Epi8<F_E1>, pg8::StaticOrder, true, true>(F.lds, g, S, E, F.wave, !last_ && DUP_SKIP_EPI); PHE(1) SEAM(1);
#else
        EpiE1 E{UG, Q0, K0, V0, (const float*)(ws + WS_ROPE)};
        pg8::gemm_phase<EpiE1, GEMM_ORDER, true, true>(F.lds, g, S, E, F.wave, !last_ && DUP_SKIP_EPI); PHE(1) SEAM(1);
#endif
    PHB(2) pg8::Gemm g{UG, (const bf16*)(ws + WS_S5BEND), 640, 512, 512}; SchedXend S{F.G, (int)blockIdx.x};
        pg8::Epi8<F_XEND> E{{(float*)(ws + WS_XEND)}};
        if (last_ || ((DUPSET >> 44) & 1ull)) pg8::gemm_phase<pg8::Epi8<F_XEND>, SchedXend, true, true>(F.lds, g, S, E, F.wave, !last_ && DUP_SKIP_EPI);
        if (last_ || ((DUPSET >> 45) & 1ull)) kmean_phase(F); PHE(2) SEAM(2);
    PHB(3) s5_carry_phase(F); moba_select_phase(F); PHE(3) SEAM(3);
    PHB(4) if (last_ || (DUPSET & (1ull << 40))) { pg8::Gemm g{UG, (const bf16*)(ws + WS_S5MT), 640, 640, 640}; SchedS5Y S{F.G, (int)blockIdx.x};
          pg8::Epi8L<F_S5Y> E{{UG, F.in[I_S5_D], YA}};
          pg8::gemm_phase<pg8::Epi8L<F_S5Y>, SchedS5Y, true, true>(F.lds, g, S, E, F.wave, !last_ && DUP_SKIP_EPI); }
        if (F.G == 256 && (last_ || (DUPSET & (1ull << 41)))) { const attn_body::AttnTensors AT{(const attn_body::bf16*)Q0, (const attn_body::bf16*)K0, (const attn_body::bf16*)V0, (attn_body::bf16*)(CAT + 512), (const unsigned*)(ws + WS_SELM)};
          const attn_body::StaticOrder S((int)F.G, (int)blockIdx.x);
          attn_body::attn_phase<attn_body::StaticOrder>((char*)lds, AT, S, F.wave); } PHE(4) SEAM(4);
    PHB(5) pg8::Gemm g{YA, (const bf16*)(ws + WS_WGLU), 512, 512, 512}; pg8::StaticOrder S; S.init(T_TOK, 512, F.G, (int)blockIdx.x);
        pg8::Epi8L<F_GLU> E{{YA, F.in[I_S5_GLU_B], CAT}};
        pg8::gemm_phase<pg8::Epi8L<F_GLU>, pg8::StaticOrder, true, true>(F.lds, g, S, E, F.wave, !last_ && DUP_SKIP_EPI); PHE(5) SEAM(5);
    PHB(6) pg8::Gemm g{CAT, (const bf16*)(ws + WS_WE_OUT), 1024, 1024, 1024}; GEMM_ORDER S; S.init(T_TOK, 1024, F.G, (int)blockIdx.x);
        EpiResNorm<false> E{(const void*)F.in[I_X], (bf16*)(ws + WS_HB1), nullptr, (float*)(ws + WS_SS1)};
        pg8::gemm_phase<EpiResNorm<false>, GEMM_ORDER, true, true>(F.lds, g, S, E, F.wave, !last_ && DUP_SKIP_EPI); PHE(6) SEAM2(6, 8);
    PHB(8) pg8::Gemm g{(const bf16*)(ws + WS_HB1), (const bf16*)(ws + WS_WFFN_GU), 1024, 1024, 1024}; P8_ORDER S; S.init(T_TOK, 2 * FFN_D, F.G, (int)blockIdx.x);
        pg8::EpiGUR<F_SWIGLU> E{{(bf16*)(ws + WS_ACT), FFN_D, (const float*)(ws + WS_SS1), last_ ? 0 : P8_DUP_MODE}};
        pg8::gemm_phase<pg8::EpiGUR<F_SWIGLU>, P8_ORDER, true, P8_SP2>(F.lds, g, S, E, F.wave, !last_ && DUP_SKIP_EPI); PHE(8) SEAM(8);
    PHB(9) pg8::Gemm g{(const bf16*)(ws + WS_ACT), (const bf16*)(ws + WS_WFFN_D), (!last_ && P9_DUP_LDV) ? P9_DUP_LDV : FFN_D, (!last_ && P9_DUP_LDV) ? P9_DUP_LDV : FFN_D, FFN_D}; GEMM_ORDER S; S.init(T_TOK, 1024, F.G, (int)blockIdx.x);
        EpiResNorm<true> E{(const void*)(ws + WS_HB1), XN, (bf16*)F.out, (float*)(ws + WS_SS2), (!last_ && P9_DUP_SKIP) ? 1 : 0};
        pg8::gemm_phase<EpiResNorm<true>, GEMM_ORDER, true, true>(F.lds, g, S, E, F.wave, !last_ && DUP_SKIP_EPI); PHE(9) SEAM2(9, 11);
    PHB(11) pg8::Gemm g{XN, (const bf16*)(ws + WS_WO_IN), 1024, 1024, 1024}; GEMM_ORDER S; S.init(T_TOK, ODD_PAD, F.G, (int)blockIdx.x);
        pg8::Epi8R<F_P1> E{{(bf16*)(ws + WS_P1), (const float*)(ws + WS_SS2)}};
        pg8::gemm_phase<pg8::Epi8R<F_P1>, GEMM_ORDER, true, true>(F.lds, g, S, E, F.wave, !last_ && DUP_SKIP_EPI); PHE(11) SEAM(11);
    PHB(12) l1_prep_phase(F); PHE(12) SEAM(12);
    PHB(13) pg8::Gemm g{(const bf16*)(ws + WS_ALORA), (const bf16*)(ws + WS_WLORA), 256, 256, 256}; pg8::StaticOrder S; S.init(T_TOK, 1536, F.G, (int)blockIdx.x);
        pg8::Epi8L<F_LORA> E{{(bf16*)(ws + WS_LORA), F.in[I_RWKV_W0], F.in[I_RWKV_A0]}};
        pg8::gemm_phase<pg8::Epi8L<F_LORA>, pg8::StaticOrder, true, true>(F.lds, g, S, E, F.wave, !last_ && DUP_SKIP_EPI);
        { LAS bf16* scr = (LAS bf16*)(F.lds + F.wave * 16384); const int lane = mk_lane();
          for (int it = blockIdx.x * NWAVES + F.wave; it < 256; it += F.G * NWAVES) tr_item64<0>(F.in[I_O_W_OUT], 1024, 1024, (bf16*)(ws + WS_WO_OUT2), 1024, 0, nullptr, scr, it / 16, it % 16, lane); } PHE(13) SEAM(13);
    PHB(14) rwkv_chunk_passA(F, 0); PHE(14) SEAM(14);
    PHB(15) if (F.G == 256) { if ((int)blockIdx.x < 16) { if (last_) rwkv_chunk_passB<true>(F, 0); else rwkv_chunk_passB<false>(F, 0); } dsa_phase(F, last_ ? 0 : 2, 0, 1024); } PHE(15) SEAM(15);
    PHB(16) rwkv_chunk_passA(F, 1); PHE(16) SEAM(16);
    PHB(17) if (F.G == 256) { if ((int)blockIdx.x < 16) { if (last_) rwkv_chunk_passB<true>(F, 1); else rwkv_chunk_passB<false>(F, 1); } dsa_phase(F, last_ ? 1 : 3, 1024, 1024); } PHE(17) SEAM(17);
    PHB(18) rwkv_post_phase(F); PHE(18) SEAM(18);
    PHB(19) if (last_ || (DUPSET & (1ull << 42))) { pg8::Gemm g{CAT, (const bf16*)(ws + WS_WO_OUT2), 1024, 1024, 1024}; GEMM_ORDER S; S.init(T_TOK, 1024, F.G, (int)blockIdx.x);
          pg8::Epi8L<F_RES> E{{(const bf16*)F.out, last_ ? (bf16*)F.out : (bf16*)(ws + 130 * MiB)}};
          pg8::gemm_phase<pg8::Epi8L<F_RES>, GEMM_ORDER, true, true>(F.lds, g, S, E, F.wave, !last_ && DUP_SKIP_EPI); }
        if (last_ || (DUPSET & (1ull << 43))) moe_convert_phase(F); PHE(19) SEAM(19);
    PHB(20) router_phase(F, last_ ? 0 : 2048); PHE(20) SEAM(20);
    PHB(21) moe_scatter_phase(F); PHE(21) SEAM(21);
#define MOE_CHUNK_PHASES(PH, Q) \
    PHB(PH) const int* te = (const int*)(ws + WS_TILEEXP); const int ntl = te[511]; int ntq = ntl - MOE_CHUNK * (Q); ntq = ntq < 0 ? 0 : (ntq > MOE_CHUNK ? MOE_CHUNK : ntq); \
        pg8::Gemm g{(const bf16*)(ws + WS_XG), (const bf16*)(ws + WS_WMOE_GU), 512, 512, 512}; SchedMoeGU S{te, MOE_CHUNK * (Q), ntq, F.G, (int)blockIdx.x}; \
        pg8::EpiGU<F_MOEGU> E{{last_ ? ws + WS_ACTQ : ws + MOE_PROBE_OFF * MiB, MOE_CHUNK * (Q), last_ ? 0 : MOE_PROBE}}; \
        pg8::gemm_phase<pg8::EpiGU<F_MOEGU>, SchedMoeGU, MOE_ALIGN, true, true>(F.lds, g, S, E, F.wave, !last_ && DUP_SKIP_EPI); PHE(PH) SEAM(PH); \
    PHB((PH) + 1) const int* te = (const int*)(ws + WS_TILEEXP); const int ntl = te[511]; int ntq = ntl - MOE_CHUNK * (Q); ntq = ntq < 0 ? 0 : (ntq > MOE_CHUNK ? MOE_CHUNK : ntq); \
        pg8::Gemm g{(const bf16*)(ws + WS_ACTQ), (const bf16*)(ws + WS_WMOE_D), FEXP / 2, FEXP / 2, FEXP / 2}; SchedMoeD S{te, MOE_CHUNK * (Q), ntq, F.G, (int)blockIdx.x}; \
        pg8::Epi8<F_MOED> E{{last_ ? (bf16*)(ws + WS_YS) : (bf16*)(ws + MOE_PROBE_OFF * MiB), last_ ? 0 : MOE_PROBE}}; \
        pg8::gemm_phase<pg8::Epi8<F_MOED>, SchedMoeD, MOE_ALIGN, true, true>(F.lds, g, S, E, F.wave, !last_ && DUP_SKIP_EPI); PHE((PH) + 1) SEAM((PH) + 1);
    MOE_CHUNK_PHASES(22, 0)
    MOE_CHUNK_PHASES(24, 1)
    MOE_CHUNK_PHASES(26, 2)
#undef MOE_CHUNK_PHASES
    PHB(28) moe_combine_final_phase(F, last_ ? F.out : (float*)(ws + 346 * MiB)); PHE(28)
#undef IN
#undef SEAM
#undef SEAM2
}

#ifndef MK_ONE_LAUNCH
#define MK_ONE_LAUNCH 1
#endif
extern "C" void kernel_launch(void* const* d_in, const int* in_sizes, int n_in, void* d_out, int out_size, void* d_ws, size_t ws_size, hipStream_t stream) {
    static int grid = 0;
    if (grid == 0) {
        if (n_in != 38 || in_sizes[0] != T_TOK * DMODEL || out_size != T_TOK * DMODEL || ws_size < WS_NEED) { fprintf(stderr, "kernel_launch: unexpected shapes (n_in %d, in0 %d, out %d, ws %zu); nothing launched\n", n_in, n_in > 0 ? in_sizes[0] : -1, out_size, ws_size); grid = -1; return; }
        int dev = 0, cus = 0, per_cu = 0;
        if (hipGetDevice(&dev) != hipSuccess || hipDeviceGetAttribute(&cus, hipDeviceAttributeMultiprocessorCount, dev) != hipSuccess) { grid = -1; return; }
        if (hipFuncSetAttribute((const void*)mega_fwd, hipFuncAttributeMaxDynamicSharedMemorySize, LDS_BYTES) != hipSuccess) { fprintf(stderr, "kernel_launch: hipFuncSetAttribute failed\n"); grid = -1; return; }
        if (hipOccupancyMaxActiveBlocksPerMultiprocessor(&per_cu, (const void*)mega_fwd, NWAVES * 64, LDS_BYTES) != hipSuccess || per_cu < 1) fprintf(stderr, "kernel_launch: occupancy query reports %d\n", per_cu);
        (void)hipGetLastError();
        grid = cus;
    }
    if (grid < 0) return;
    if (hipMemsetAsync((char*)d_ws + WS_CTL, 0, CTL_ZERO_BYTES, stream) != hipSuccess) return;
    Args a{};
    for (int i = 0; i < 38; ++i) a.in[i] = (const float*)d_in[i];
    a.out = (float*)d_out; a.ws = (unsigned char*)d_ws; a.pad = 0;
#if MK_ONE_LAUNCH
    a.ph_lo = 0; a.ph_hi = NPHASE; a.li = 0;
    hipLaunchKernelGGL(mega_fwd, dim3(grid), dim3(NWAVES * 64), LDS_BYTES, stream, a);
#else
    for (int p = 0; p < NPHASE; ++p) { a.ph_lo = p; a.ph_hi = p + 1; a.li = p;
        hipLaunchKernelGGL(mega_fwd, dim3(grid), dim3(NWAVES * 64), LDS_BYTES, stream, a);
        if (hipPeekAtLastError() != hipSuccess) { fprintf(stderr, "kernel_launch: launch %d failed\n", p); break; } }
#endif
}
```

```cpp
#include <hip/hip_runtime.h>
#include <hip/hip_bf16.h>
#include <cstdio>
#include <cstdint>
#include <cmath>
#ifndef ABL_MOBA
#define ABL_MOBA 0
#endif
__device__ __forceinline__ int mk_lane() { int l; asm volatile("v_mbcnt_lo_u32_b32 %0, -1, 0\n\tv_mbcnt_hi_u32_b32 %0, -1, %0" : "=v"(l)); return l; }
namespace pg8 {
#define PG8_LAS __attribute__((address_space(3)))
typedef unsigned short bf16_t;
typedef short bf16x8 __attribute__((ext_vector_type(8)));
typedef float f32x4 __attribute__((ext_vector_type(4)));
typedef unsigned u32x4 __attribute__((ext_vector_type(4)));
typedef int i32x4 __attribute__((ext_vector_type(4)));
typedef int i32x8 __attribute__((ext_vector_type(8)));
constexpr int BM = 256, BK = 64, HALF = 128, HTB = HALF * BK * 2  , STAGE_BYTES = 8 * HTB, NXCD = 8, WGM = 8;

__host__ __device__ __forceinline__ int lds_byte(int r, int c) { const int st = (r >> 4) * 2 + (c >> 5), rr = r & 15, cc = c & 31, ob = rr * 64 + cc * 2; return st * 1024 + (ob ^ (((ob >> 9) & 1) << 5)); }
__host__ __device__ __forceinline__ void stage_rc(int b, int& R, int& C) { const int st = b / 1024, sb = b % 1024, swz = sb ^ (((sb >> 9) & 1) << 5); R = (st >> 1) * 16 + swz / 64; C = (st & 1) * 32 + (swz % 64) / 2; }
__host__ __device__ __forceinline__ int perm32(int rho) { const int n = rho >> 4, i = rho & 15; return 8 * (i >> 2) + 4 * n + (i & 3); }

struct Unit { int pm, pn, aux; };
struct Gemm { const bf16_t* A; const bf16_t* Bt; int lda, ldb, K; };

struct StaticOrder {
    int nM, nN, nwg, G, c, zero;
    __host__ __device__ void init(int M, int N, int G_, int c_) { nM = M / BM; nN = N / BM; nwg = nM * nN; G = G_; c = c_; zero = 0; }
    __host__ __device__ bool next(int i, Unit& u) const {
        const long L = (long)i * G + c; if (L >= nwg) return false;
        int wgid = (int)L; { const int q = nwg / NXCD, r = nwg % NXCD, xcd = wgid % NXCD, off = wgid / NXCD; wgid = (xcd < r ? xcd * (q + 1) : r * (q + 1) + (xcd - r) * q) + off; }
        const int nig = WGM * nN, gid = wgid / nig, fm = gid * WGM, gsz = (nM - fm) < WGM ? (nM - fm) : WGM;
        u.pm = fm + ((wgid % nig) % gsz); u.pn = (wgid % nig) / gsz; u.aux = 0; if (zero) { u.pm &= (zero - 1); u.pn &= (zero - 1); } return true;
    }
    __device__ __forceinline__ void a_ready(const Unit&) const {}
    __device__ __forceinline__ void done(const Unit&) const {}
};

struct ColPanelOrder {
    int nM, nN, nwg, G, c;
    __host__ __device__ void init(int M, int N, int G_, int c_) { nM = M / BM; nN = N / BM; nwg = nM * nN; G = G_; c = c_; }
    __host__ __device__ bool next(int i, Unit& u) const { const int L = i * G + c; if (L >= nwg) return false; u.pm = L % nM; u.pn = L / nM; u.aux = 0; return true; }
    __device__ __forceinline__ void a_ready(const Unit&) const {}
    __device__ __forceinline__ void done(const Unit&) const {}
};
__device__ __forceinline__ unsigned cvt_pk_bf16(float lo, float hi) { unsigned r; asm volatile("v_cvt_pk_bf16_f32 %0, %1, %2" : "=v"(r) : "v"(lo), "v"(hi)); return r; }

template <class F> struct Epi8 {
    static constexpr bool PERM = true, AFTER_DRAIN = false;
    F f;
    __device__ __forceinline__ void operator()(const f32x4 (&acc)[2][2][4][2], const Unit& u, int wr, int wc, int fr, int fq) const {
#pragma unroll
        for (int ai = 0; ai < 2; ++ai)
#pragma unroll
            for (int m = 0; m < 4; ++m) { const int r = ai * HALF + wr * 64 + m * 16 + fr;
#pragma unroll
                for (int bj = 0; bj < 2; ++bj) { const int c = bj * HALF + wc * 32 + 8 * fq;
                    float v[8] = {acc[ai][bj][m][0][0], acc[ai][bj][m][0][1], acc[ai][bj][m][0][2], acc[ai][bj][m][0][3], acc[ai][bj][m][1][0], acc[ai][bj][m][1][1], acc[ai][bj][m][1][2], acc[ai][bj][m][1][3]};
                    f(u, r, c, v, wc); } }
    }
};
template <class F> struct EpiGU {
    static constexpr bool PERM = true, AFTER_DRAIN = false;
    F f;
    __device__ __forceinline__ void operator()(const f32x4 (&acc)[2][2][4][2], const Unit& u, int wr, int wc, int fr, int fq) const {
#pragma unroll
        for (int ai = 0; ai < 2; ++ai)
#pragma unroll
            for (int m = 0; m < 4; ++m) { const int r = ai * HALF + wr * 64 + m * 16 + fr; const int c = wc * 32 + 8 * fq;
                float g[8] = {acc[ai][0][m][0][0], acc[ai][0][m][0][1], acc[ai][0][m][0][2], acc[ai][0][m][0][3], acc[ai][0][m][1][0], acc[ai][0][m][1][1], acc[ai][0][m][1][2], acc[ai][0][m][1][3]};
                float p[8] = {acc[ai][1][m][0][0], acc[ai][1][m][0][1], acc[ai][1][m][0][2], acc[ai][1][m][0][3], acc[ai][1][m][1][0], acc[ai][1][m][1][1], acc[ai][1][m][1][2], acc[ai][1][m][1][3]};
                f(u, r, c, g, p); }
    }
};

template <class F> struct Epi8L {
    static constexpr bool PERM = true, AFTER_DRAIN = false;
    F f;
    __device__ __forceinline__ void operator()(const f32x4 (&acc)[2][2][4][2], const Unit& u, int wr, int wc, int fr, int fq) const {
        constexpr int MB = F::MB, NB = 8 / MB;
        typename F::Hoist h; f.hoist(u, wc, fq, h);
        typename F::Pre pre[2][MB][2];
#pragma unroll
        for (int mm = 0; mm < MB; ++mm)
#pragma unroll
            for (int bj = 0; bj < 2; ++bj) { const int ri = mm; f.load(u, (ri >> 2) * HALF + wr * 64 + (ri & 3) * 16 + fr, bj * HALF + wc * 32 + 8 * fq, pre[0][mm][bj]); }
#pragma unroll
        for (int b = 0; b < NB; ++b) {
            if (b + 1 < NB) {
#pragma unroll
                for (int mm = 0; mm < MB; ++mm)
#pragma unroll
                    for (int bj = 0; bj < 2; ++bj) { const int ri = (b + 1) * MB + mm; f.load(u, (ri >> 2) * HALF + wr * 64 + (ri & 3) * 16 + fr, bj * HALF + wc * 32 + 8 * fq, pre[(b + 1) & 1][mm][bj]); } }
#pragma unroll
            for (int mm = 0; mm < MB; ++mm)
#pragma unroll
                for (int bj = 0; bj < 2; ++bj) { const int ri = b * MB + mm, ai = ri >> 2, m = ri & 3;
                    float v[8] = {acc[ai][bj][m][0][0], acc[ai][bj][m][0][1], acc[ai][bj][m][0][2], acc[ai][bj][m][0][3], acc[ai][bj][m][1][0], acc[ai][bj][m][1][1], acc[ai][bj][m][1][2], acc[ai][bj][m][1][3]};
                    f.apply(u, ai * HALF + wr * 64 + m * 16 + fr, bj * HALF + wc * 32 + 8 * fq, v, pre[b & 1][mm][bj], h, bj); } }
    }
};
__device__ __forceinline__ void rows_rstd(const float* SS, int row0, int wr, int fr, int fq, float (&rs)[2][4]) {
    f32x4 pp[2][4];
#pragma unroll
    for (int ai = 0; ai < 2; ++ai)
#pragma unroll
        for (int m = 0; m < 4; ++m) pp[ai][m] = ((const f32x4*)(SS + (size_t)(row0 + ai * HALF + wr * 64 + m * 16 + fr) * 16))[fq];
#pragma unroll
    for (int ai = 0; ai < 2; ++ai)
#pragma unroll
        for (int m = 0; m < 4; ++m) { float s = (pp[ai][m][0] + pp[ai][m][1]) + (pp[ai][m][2] + pp[ai][m][3]); s += __shfl_xor(s, 16); s += __shfl_xor(s, 32); rs[ai][m] = __builtin_amdgcn_rsqf(s * (1.f / 1024.f) + 1e-6f); }
}
template <class F> struct Epi8R {
    static constexpr bool PERM = true, AFTER_DRAIN = false;
    F f;
    __device__ __forceinline__ void operator()(const f32x4 (&acc)[2][2][4][2], const Unit& u, int wr, int wc, int fr, int fq) const {
        float rs[2][4]; rows_rstd(f.SS, u.pm * 256, wr, fr, fq, rs);
#pragma unroll
        for (int ai = 0; ai < 2; ++ai)
#pragma unroll
            for (int m = 0; m < 4; ++m) { const int r = ai * HALF + wr * 64 + m * 16 + fr;
#pragma unroll
                for (int bj = 0; bj < 2; ++bj) { const int c = bj * HALF + wc * 32 + 8 * fq;
                    float v[8] = {acc[ai][bj][m][0][0], acc[ai][bj][m][0][1], acc[ai][bj][m][0][2], acc[ai][bj][m][0][3], acc[ai][bj][m][1][0], acc[ai][bj][m][1][1], acc[ai][bj][m][1][2], acc[ai][bj][m][1][3]};
                    f(u, r, c, v, rs[ai][m]); } }
    }
};
template <class F> struct EpiGUR {
    static constexpr bool PERM = true, AFTER_DRAIN = false;
    F f;
    __device__ __forceinline__ void operator()(const f32x4 (&acc)[2][2][4][2], const Unit& u, int wr, int wc, int fr, int fq) const {
        if (f.mode == 2) return;
        float rs[2][4]; rows_rstd(f.SS, u.pm * 256, wr, fr, fq, rs);
#pragma unroll
        for (int ai = 0; ai < 2; ++ai)
#pragma unroll
            for (int m = 0; m < 4; ++m) { const int r = ai * HALF + wr * 64 + m * 16 + fr; const int c = wc * 32 + 8 * fq;
                float g[8] = {acc[ai][0][m][0][0], acc[ai][0][m][0][1], acc[ai][0][m][0][2], acc[ai][0][m][0][3], acc[ai][0][m][1][0], acc[ai][0][m][1][1], acc[ai][0][m][1][2], acc[ai][0][m][1][3]};
                float p[8] = {acc[ai][1][m][0][0], acc[ai][1][m][0][1], acc[ai][1][m][0][2], acc[ai][1][m][0][3], acc[ai][1][m][1][0], acc[ai][1][m][1][1], acc[ai][1][m][1][2], acc[ai][1][m][1][3]};
                f(u, r, c, g, p, rs[ai][m]); }
    }
};

template <class Epi, class Sched, bool ALIGN_EPI = false, bool SP2 = false, bool F8 = false>
__device__ __forceinline__ void gemm_phase(PG8_LAS unsigned char* lds, const Gemm g, const Sched& S, const Epi& E, const int wave_s, const bool skip_epi = false) {
    const int wid = wave_s, lane = mk_lane(), tid = wid * 64 + lane, wr = wid >> 2, wc = wid & 3, fr = lane & 15, fq = lane >> 4;
    const int K = g.K, nt = K / BK;
    unsigned voffA[2], voffB[2];
#pragma unroll
    for (int i = 0; i < 2; ++i) { int R, C; stage_rc(tid * 16 + i * 8192, R, C); const int Rb = Epi::PERM ? ((R & ~31) + perm32(R & 31)) : R;
        voffA[i] = (unsigned)(R * g.lda + C) * 2u; voffB[i] = (unsigned)(Rb * g.ldb + C) * 2u; }
    const size_t kstep = (size_t)(BK * 2);
    const size_t hstepA = (size_t)HALF * g.lda * 2, hstepB = (size_t)HALF * g.ldb * 2;
    const size_t tstepA = 2 * hstepA, tstepB = 2 * hstepB;
    const unsigned ldsw = (unsigned)wid * 1024u;
    const int aoff = lds_byte(wr * 64 + fr, fq * 8), boff = lds_byte(wc * 32 + fr, fq * 8);
    const int f8_scale = 0x7F7F7F7F; (void)f8_scale;
    int aoffv = aoff, boffv = boff + 4 * HTB; if constexpr (F8) { asm volatile("" : "+v"(aoffv), "+v"(boffv)); } (void)aoffv; (void)boffv;
#define PG8_SA(b, h) (((b) * 2 + (h)) * HTB)
#define PG8_SB(b, h) ((4 + (b) * 2 + (h)) * HTB)
#define PG8_STAGE(bufoff, gbase, voff) do { _Pragma("unroll") for (int _i = 0; _i < 2; ++_i) \
        __builtin_amdgcn_global_load_lds((const unsigned*)((const char*)(gbase) + (voff)[_i]), (PG8_LAS unsigned*)(lds + (bufoff) + ldsw + _i * 8192), 16, 0, 0); } while (0)
#define PG8_LD16A(off) (*(const PG8_LAS i32x4*)(lds + aoffv + (off)))
#define PG8_LD16B(off) (*(const PG8_LAS i32x4*)(lds + boffv + (off)))
#define PG8_LDA(dst, b, h) do { if constexpr (F8) { _Pragma("unroll") for (int m = 0; m < 4; ++m) dst##8[m] = __builtin_shufflevector(PG8_LD16A(((b) * 2 + (h)) * HTB + m * 2048), PG8_LD16A(((b) * 2 + (h)) * HTB + m * 2048 + 1024), 0, 1, 2, 3, 4, 5, 6, 7); } \
    else { _Pragma("unroll") for (int m = 0; m < 4; ++m) _Pragma("unroll") for (int k = 0; k < 2; ++k) dst[m][k] = *(const PG8_LAS bf16x8*)(lds + PG8_SA(b, h) + aoff + m * 2048 + k * 1024); } } while (0)
#define PG8_LDB(dst, b, h) do { if constexpr (F8) { _Pragma("unroll") for (int n = 0; n < 2; ++n) dst##8[n] = __builtin_shufflevector(PG8_LD16B(((b) * 2 + (h)) * HTB + n * 2048), PG8_LD16B(((b) * 2 + (h)) * HTB + n * 2048 + 1024), 0, 1, 2, 3, 4, 5, 6, 7); } \
    else { _Pragma("unroll") for (int n = 0; n < 2; ++n) _Pragma("unroll") for (int k = 0; k < 2; ++k) dst[n][k] = *(const PG8_LAS bf16x8*)(lds + PG8_SB(b, h) + boff + n * 2048 + k * 1024); } } while (0)
#define PG8_MMA(ai, bj, At, Bt) do { __builtin_amdgcn_s_setprio(1); if constexpr (F8) { _Pragma("unroll") for (int m = 0; m < 4; ++m) _Pragma("unroll") for (int n = 0; n < 2; ++n) \
            asm volatile("v_mfma_scale_f32_16x16x128_f8f6f4 %0, %1, %2, %0, %3, %3 op_sel_hi:[0,0,0]" : "+v"(acc[ai][bj][m][n]) : "v"(Bt##8[n]), "v"(At##8[m]), "v"(f8_scale)); } \
        else { _Pragma("unroll") for (int m = 0; m < 4; ++m) _Pragma("unroll") for (int n = 0; n < 2; ++n) _Pragma("unroll") for (int k = 0; k < 2; ++k) \
        acc[ai][bj][m][n] = __builtin_amdgcn_mfma_f32_16x16x32_bf16(Bt[n][k], At[m][k], acc[ai][bj][m][n], 0, 0, 0); } __builtin_amdgcn_s_setprio(0); } while (0)
#define PG8_WAIT_V(n) asm volatile("s_waitcnt vmcnt(" #n ")" ::: "memory")
#define PG8_WAIT_L(n) asm volatile("s_waitcnt lgkmcnt(" #n ")" ::: "memory")
#define PG8_BAR __builtin_amdgcn_s_barrier()
#define PG8_SCHED __builtin_amdgcn_sched_barrier(0)
    Unit cur, nxt; int ui = 0;
    if (!S.next(0, cur)) return;
    f32x4 acc[2][2][4][2];
#pragma unroll
    for (int a = 0; a < 2; ++a)
#pragma unroll
        for (int b = 0; b < 2; ++b)
#pragma unroll
            for (int m = 0; m < 4; ++m)
#pragma unroll
                for (int n = 0; n < 2; ++n) acc[a][b][m][n] = (f32x4){0.f, 0.f, 0.f, 0.f};
    bf16x8 At[4][2], B0[2][2], B1[2][2]; i32x8 At8[4], B08[2], B18[2]; (void)At; (void)B0; (void)B1; (void)At8; (void)B08; (void)B18;
    const char* cA = (const char*)g.A + (size_t)cur.pm * tstepA; const char* cB = (const char*)g.Bt + (size_t)cur.pn * tstepB;
    S.a_ready(cur);
    if constexpr (SP2) {
        PG8_STAGE(PG8_SB(0, 0), cB, voffB); PG8_STAGE(PG8_SB(0, 1), cB + hstepB, voffB); PG8_STAGE(PG8_SA(0, 0), cA, voffA); PG8_STAGE(PG8_SA(0, 1), cA + hstepA, voffA);
        if (wr == 1) PG8_BAR;
        PG8_WAIT_V(2); PG8_BAR;
        PG8_STAGE(PG8_SB(1, 0), cB + kstep, voffB); PG8_STAGE(PG8_SA(1, 0), cA + kstep, voffA); PG8_STAGE(PG8_SB(1, 1), cB + hstepB + kstep, voffB);
        PG8_WAIT_V(6); PG8_BAR;
    } else {
        PG8_STAGE(PG8_SB(0, 0), cB, voffB); PG8_STAGE(PG8_SA(0, 0), cA, voffA); PG8_STAGE(PG8_SB(0, 1), cB + hstepB, voffB); PG8_STAGE(PG8_SA(0, 1), cA + hstepA, voffA);
        if (wr == 1) PG8_BAR;
        PG8_WAIT_V(4); PG8_BAR;
        PG8_STAGE(PG8_SB(1, 0), cB + kstep, voffB); PG8_STAGE(PG8_SA(1, 0), cA + kstep, voffA); PG8_STAGE(PG8_SB(1, 1), cB + hstepB + kstep, voffB);
        PG8_WAIT_V(6); PG8_BAR;
    }
    for (;;) {
        const bool has_next = S.next(ui + 1, nxt);
        const char* nA = has_next ? (const char*)g.A + (size_t)nxt.pm * tstepA : cA; const char* nB = has_next ? (const char*)g.Bt + (size_t)nxt.pn * tstepB : cB;
        if constexpr (F8) {
            _Pragma("unroll") for (int a = 0; a < 2; ++a) _Pragma("unroll") for (int b = 0; b < 2; ++b) _Pragma("unroll") for (int m = 0; m < 4; ++m) _Pragma("unroll") for (int n = 0; n < 2; ++n) asm volatile("" : "+v"(acc[a][b][m][n])); }
        _Pragma("clang loop unroll(disable)")
        for (int t = 0; t < nt; t += 2) {
            const bool last = (t == nt - 2);
            const char* a1 = cA + (size_t)(t + 1) * kstep;
            const char* a2 = last ? nA : cA + (size_t)(t + 2) * kstep; const char* b2 = last ? nB : cB + (size_t)(t + 2) * kstep;
            const char* a3 = a2 + kstep; const char* b3 = b2 + kstep;
            if (last && has_next) S.a_ready(nxt);
            if constexpr (SP2) {
            PG8_LDB(B0, 0, 0); PG8_LDB(B1, 0, 1); PG8_SCHED; PG8_LDA(At, 0, 0); PG8_STAGE(PG8_SA(1, 1), a1 + hstepA, voffA);
            PG8_WAIT_V(8); PG8_WAIT_L(0); PG8_BAR; PG8_MMA(0, 0, At, B0); PG8_MMA(0, 1, At, B1); PG8_BAR; PG8_SCHED;
            PG8_LDA(At, 0, 1); PG8_STAGE(PG8_SB(0, 0), b2, voffB); PG8_STAGE(PG8_SB(0, 1), b2 + hstepB, voffB); PG8_STAGE(PG8_SA(0, 0), a2, voffA);
            PG8_WAIT_V(8); PG8_WAIT_L(0); PG8_BAR; PG8_MMA(1, 0, At, B0); PG8_MMA(1, 1, At, B1); PG8_BAR; PG8_SCHED;
            PG8_LDB(B0, 1, 0); PG8_LDB(B1, 1, 1); PG8_SCHED; PG8_LDA(At, 1, 0); PG8_STAGE(PG8_SA(0, 1), a2 + hstepA, voffA);
            PG8_WAIT_V(8); PG8_WAIT_L(0); PG8_BAR; PG8_MMA(0, 0, At, B0); PG8_MMA(0, 1, At, B1); PG8_BAR; PG8_SCHED;
            PG8_LDA(At, 1, 1); PG8_STAGE(PG8_SB(1, 0), b3, voffB); PG8_STAGE(PG8_SB(1, 1), b3 + hstepB, voffB); PG8_STAGE(PG8_SA(1, 0), a3, voffA);
            PG8_WAIT_V(8); PG8_WAIT_L(0); PG8_BAR; PG8_MMA(1, 0, At, B0); PG8_MMA(1, 1, At, B1); PG8_BAR; PG8_SCHED;
            } else {
            PG8_LDB(B0, 0, 0); PG8_SCHED; PG8_LDA(At, 0, 0); PG8_STAGE(PG8_SA(1, 1), a1 + hstepA, voffA);
            PG8_WAIT_L(8); PG8_BAR; PG8_WAIT_L(0); PG8_MMA(0, 0, At, B0); PG8_BAR; PG8_SCHED;
            PG8_LDB(B1, 0, 1); PG8_STAGE(PG8_SB(0, 0), b2, voffB);
            PG8_BAR; PG8_WAIT_L(0); PG8_MMA(0, 1, At, B1); PG8_BAR;
            PG8_LDA(At, 0, 1); PG8_STAGE(PG8_SA(0, 0), a2, voffA);
            PG8_BAR; PG8_WAIT_L(0); PG8_MMA(1, 0, At, B0); PG8_BAR; PG8_SCHED;
            PG8_STAGE(PG8_SB(0, 1), b2 + hstepB, voffB);
            PG8_WAIT_V(6); PG8_BAR; PG8_MMA(1, 1, At, B1); PG8_BAR;
            PG8_LDB(B0, 1, 0); PG8_SCHED; PG8_LDA(At, 1, 0); PG8_STAGE(PG8_SA(0, 1), a2 + hstepA, voffA);
            PG8_WAIT_L(8); PG8_BAR; PG8_WAIT_L(0); PG8_MMA(0, 0, At, B0); PG8_BAR; PG8_SCHED;
            PG8_LDB(B1, 1, 1); PG8_STAGE(PG8_SB(1, 0), b3, voffB);
            PG8_BAR; PG8_WAIT_L(0); PG8_MMA(0, 1, At, B1); PG8_BAR;
            PG8_LDA(At, 1, 1); PG8_STAGE(PG8_SA(1, 0), a3, voffA);
            PG8_BAR; PG8_WAIT_L(0); PG8_MMA(1, 0, At, B0); PG8_BAR; PG8_SCHED;
            PG8_STAGE(PG8_SB(1, 1), b3 + hstepB, voffB);
            PG8_WAIT_V(6); PG8_BAR; PG8_MMA(1, 1, At, B1); PG8_BAR;
            }
        }
        if constexpr (F8) { asm volatile("s_nop 15\n\ts_nop 15" ::: "memory"); }
        if constexpr (ALIGN_EPI) { if (wr == 0) PG8_BAR; }
        if constexpr (!Epi::AFTER_DRAIN) { if (!skip_epi) E(acc, cur, wr, wc, fr, fq); S.done(cur); }
        if (!has_next) break;
#pragma unroll
        for (int a = 0; a < 2; ++a)
#pragma unroll
            for (int b = 0; b < 2; ++b)
#pragma unroll
                for (int m = 0; m < 4; ++m)
#pragma unroll
                    for (int n = 0; n < 2; ++n) acc[a][b][m][n] = (f32x4){0.f, 0.f, 0.f, 0.f};
        cur = nxt; cA = nA; cB = nB; ++ui;
        if constexpr (ALIGN_EPI) { if (wr == 1) PG8_BAR; }
    }
    PG8_WAIT_V(0);
    if constexpr (!ALIGN_EPI) { if (wr == 0) PG8_BAR; }
    PG8_BAR;
    if constexpr (Epi::AFTER_DRAIN) { E.fused(acc, cur, wr, wc, fr, fq, lds, wid, lane); S.done(cur); }
#undef PG8_SA
#undef PG8_SB
#undef PG8_STAGE
#undef PG8_LD16A
#undef PG8_LD16B
#undef PG8_LDA
#undef PG8_LDB
#undef PG8_MMA
#undef PG8_WAIT_V
#undef PG8_WAIT_L
#undef PG8_BAR
#undef PG8_SCHED
}
}

namespace attn_body {
using bf16=__hip_bfloat16;
using bf16x8=__attribute__((ext_vector_type(8)))short;
using s16x4=__attribute__((ext_vector_type(4)))short;
using f32x16=__attribute__((ext_vector_type(16)))float;
using u32x4=__attribute__((ext_vector_type(4)))unsigned;
constexpr int BATCH=4,NHEAD=8,SEQ=8192,D=64,DM=NHEAD*D,ODM=1024;
constexpr int NW=8,QBLK=32,QB=QBLK*NW,KVBLK=64,NQB=SEQ/QB;
constexpr int ATTN_PITCH=DM, ATTN_UNIT_ROWS=QB;
__device__ __forceinline__ int crow(int r,int hi){return (r&3)+8*(r>>2)+4*hi;}
#define SBAR() __builtin_amdgcn_sched_barrier(0)
__device__ __forceinline__ void cmask(f32x16&p0,f32x16&p1,int jb,int qrel,int hi){
  const float NEG=-INFINITY; int kb=64*jb+4*hi;
  #pragma unroll
  for(int r=0;r<16;++r){int kv=kb+(r&3)+8*(r>>2); if(kv>qrel)p0[r]=NEG; if(kv+32>qrel)p1[r]=NEG;}
}

constexpr int NSLOT=3, SLOTB=8192;
constexpr int LDS_K=0, LDS_V=NSLOT*SLOTB, LDS_WS=2*NSLOT*SLOTB, LDS_OST=LDS_WS+NW*64*4, LDS_BYTES=LDS_OST+NW*4096;
constexpr float C2=0.125f*1.4426950408889634f;
__device__ __forceinline__ void glds16(const void*gsrc,unsigned lds_dst){unsigned keep;
  asm volatile("s_mov_b32 %0, m0\n\ts_mov_b32 m0, %2\n\ts_nop 0\n\tglobal_load_lds_dwordx4 %1, off\n\ts_mov_b32 m0, %0":"=&s"(keep):"v"(gsrc),"s"(lds_dst):"memory");}
__device__ __forceinline__ float max3f(float a,float b,float c){float r;asm("v_max3_f32 %0, %1, %2, %3":"=v"(r):"v"(a),"v"(b),"v"(c));return r;}
__device__ __forceinline__ float max2f(float a,float b){float r;asm("v_max_f32_e32 %0, %1, %2":"=v"(r):"v"(a),"v"(b));return r;}
__device__ __forceinline__ float fadd_s(float a,float b){float r;asm("v_add_f32_e32 %0, %1, %2":"=v"(r):"v"(a),"v"(b));return r;}
__device__ __forceinline__ float fsub_s(float a,float b){float r;asm("v_sub_f32_e32 %0, %1, %2":"=v"(r):"v"(a),"v"(b));return r;}
typedef float f32x2_t __attribute__((ext_vector_type(2))); typedef __bf16 bf16x2_t __attribute__((ext_vector_type(2)));
__device__ __forceinline__ unsigned cvtpk_s(float lo,float hi){f32x2_t v={lo,hi};bf16x2_t b=__builtin_convertvector(v,bf16x2_t);return __builtin_bit_cast(unsigned,b);}
#define WAIT_BAR(N) asm volatile("s_waitcnt vmcnt(" #N ") lgkmcnt(0)\n\ts_barrier":::"memory")

__device__ __forceinline__ void qkt(f32x16&p0,f32x16&p1,const char*Kslot,const bf16x8*qr,const f32x16&negm,int r32,int hi){
  const char*kb=Kslot+hi*1024+r32*16;
  #pragma unroll
  for(int d0=0;d0<4;++d0){
    const bf16x8 b0=*reinterpret_cast<const bf16x8*>(kb+d0*2048);
    const bf16x8 b1=*reinterpret_cast<const bf16x8*>(kb+d0*2048+512);
    if(d0==0){p0=__builtin_amdgcn_mfma_f32_32x32x16_bf16(b0,qr[0],negm,0,0,0);p1=__builtin_amdgcn_mfma_f32_32x32x16_bf16(b1,qr[0],negm,0,0,0);}
    else{p0=__builtin_amdgcn_mfma_f32_32x32x16_bf16(b0,qr[d0],p0,0,0,0);p1=__builtin_amdgcn_mfma_f32_32x32x16_bf16(b1,qr[d0],p1,0,0,0);}}
}
typedef __attribute__((address_space(3))) const char* lds_cptr;
typedef short v4i16_t __attribute__((ext_vector_type(4)));
__device__ __forceinline__ void kload8(bf16x8*kf,lds_cptr kp){
  kf[0]=*(const __attribute__((address_space(3))) bf16x8*)(kp);      kf[1]=*(const __attribute__((address_space(3))) bf16x8*)(kp+512);
  kf[2]=*(const __attribute__((address_space(3))) bf16x8*)(kp+2048); kf[3]=*(const __attribute__((address_space(3))) bf16x8*)(kp+2560);
  kf[4]=*(const __attribute__((address_space(3))) bf16x8*)(kp+4096); kf[5]=*(const __attribute__((address_space(3))) bf16x8*)(kp+4608);
  kf[6]=*(const __attribute__((address_space(3))) bf16x8*)(kp+6144); kf[7]=*(const __attribute__((address_space(3))) bf16x8*)(kp+6656);
}
__device__ __forceinline__ void kload2(bf16x8*kf,lds_cptr kp,int j){ kf[2*j]=*(const __attribute__((address_space(3))) bf16x8*)(kp+j*2048); kf[2*j+1]=*(const __attribute__((address_space(3))) bf16x8*)(kp+j*2048+512); }
__device__ __forceinline__ s16x4 vtr(lds_cptr p){ return __builtin_bit_cast(s16x4,__builtin_amdgcn_ds_read_tr16_b64_v4i16((__attribute__((address_space(3))) v4i16_t*)p)); }
__device__ __forceinline__ float rowmax(const f32x16&p0,const f32x16&p1){
  float a=max3f(p0[0],p0[1],p1[0]),b=max3f(p0[2],p0[3],p1[1]);a=max3f(a,p1[2],p1[3]);
  #pragma unroll
  for(int r=4;r<16;r+=4){a=max3f(a,p0[r],p0[r+1]);b=max3f(b,p0[r+2],p0[r+3]);a=max3f(a,p1[r],p1[r+1]);b=max3f(b,p1[r+2],p1[r+3]);}
  const float m=max2f(a,b);
  auto rr=__builtin_amdgcn_permlane32_swap(__float_as_uint(m),__float_as_uint(m),false,false);
  return max2f(__uint_as_float(rr[0]),__uint_as_float(rr[1]));
}
__device__ __forceinline__ void pv(f32x16*o,int vb,bf16x8 pa0,bf16x8 pa1,bf16x8 pa2,bf16x8 pa3){
  #pragma unroll
  for(int d0=0;d0<2;++d0){s16x4 lo[4],hi[4];
    #pragma unroll
    for(int ks=0;ks<4;++ks){
      asm volatile("ds_read_b64_tr_b16 %0,%1 offset:%c2":"=&v"(lo[ks]):"v"(vb),"i"(d0*4096+ks*1024):"memory");
      asm volatile("ds_read_b64_tr_b16 %0,%1 offset:%c2":"=&v"(hi[ks]):"v"(vb),"i"(d0*4096+ks*1024+512):"memory");}
    asm volatile("s_waitcnt lgkmcnt(0)":::"memory");SBAR();
    #define PK(k) (bf16x8){lo[k][0],lo[k][1],lo[k][2],lo[k][3],hi[k][0],hi[k][1],hi[k][2],hi[k][3]}
    o[d0]=__builtin_amdgcn_mfma_f32_32x32x16_bf16(pa0,PK(0),o[d0],0,0,0);
    o[d0]=__builtin_amdgcn_mfma_f32_32x32x16_bf16(pa1,PK(1),o[d0],0,0,0);
    o[d0]=__builtin_amdgcn_mfma_f32_32x32x16_bf16(pa2,PK(2),o[d0],0,0,0);
    o[d0]=__builtin_amdgcn_mfma_f32_32x32x16_bf16(pa3,PK(3),o[d0],0,0,0);
    #undef PK
  }
}

#ifndef ATTN_STORE16
#define ATTN_STORE16(p,v) (*(u32x4*)(p)=(v))
#endif
template<int THRL> __device__ __forceinline__ void attn_unit(int b,int h,int qb,const bf16*Q,const bf16*__restrict__ K,const bf16*__restrict__ V,bf16*O,const unsigned*__restrict__ SEL,char*shm,const int wave_s){
  const int wid=wave_s,lane=mk_lane(),r32=lane&31,hi=lane>>5;
  const long rowbase=(long)b*SEQ; const int q0=qb*QB;
  const bf16*Qw=Q+(rowbase+q0+wid*QBLK)*DM+h*D;
  const bf16*Kh=K+rowbase*DM+h*D,*Vh=V+rowbase*DM+h*D;
  const unsigned lds0=(unsigned)(uintptr_t)shm;
  float*wsf=(float*)(shm+LDS_WS)+wid*64;
  const bf16*ksrc=Kh+(long)lane*DM+wid*8;
  const bf16*vsrc=Vh+(long)(16*(wid&3)+(lane>>2))*DM+(wid>>2)*32+(lane&3)*8;
  const unsigned kdst=lds0+LDS_K+wid*1024, vdst=lds0+LDS_V+wid*1024;
  #define TAU(t) (((t)<4)?(NT-4+(t)):((t)-4))
  #define DMA_K(t,slot) glds16(ksrc+(long)TAU(t)*KVBLK*DM,(unsigned)__builtin_amdgcn_readfirstlane(kdst+(slot)))
  #define DMA_V(t,slot) glds16(vsrc+(long)TAU(t)*KVBLK*DM,(unsigned)__builtin_amdgcn_readfirstlane(vdst+(slot)))
  const int vb0=(int)(lds0+LDS_V)+((lane>>4)&1)*32+(lane&3)*8+(4*hi+((lane&15)>>2))*64;
  const char*Kbase=shm+LDS_K; bf16x8 kf[8];
  const lds_cptr shm3=(lds_cptr)shm; const lds_cptr kp0=shm3+LDS_K+hi*1024+r32*16; const lds_cptr vp0=shm3+LDS_V+((lane>>4)&1)*32+(lane&3)*8+(4*hi+((lane&15)>>2))*64;
  const int NT=(q0+QB)/KVBLK;
  DMA_K(0,0);DMA_V(0,0);DMA_K(1,SLOTB);
  bf16x8 qr[4];
  #pragma unroll
  for(int d0=0;d0<4;++d0)qr[d0]=*reinterpret_cast<const bf16x8*>(&Qw[(long)r32*DM+d0*16+hi*8]);
  float mhat=0.f,l_reg=0.f;f32x16 o[2];o[0]=f32x16{};o[1]=f32x16{};const f32x16 negm=f32x16{};
  const int qrel=wid*QBLK+r32;
  const unsigned selw_addr=lds0+LDS_BYTES+wid*128+r32*4;
  { const unsigned sm0_=SEL[(size_t)(b*NHEAD+h)*SEQ+q0+qrel]; if(hi==0){ asm volatile("ds_write_b32 %0, %1"::"v"(selw_addr),"v"(sm0_):"memory"); } }
  #define CMASK(P0,P1,t) do{ unsigned sm_; asm volatile("ds_read_b32 %0, %1\n\ts_waitcnt lgkmcnt(0)":"=v"(sm_):"v"(selw_addr):"memory"); const int pt_=((t)<4)?0:((t)-4)>>2; const int lim_=((t)<4)?(qrel-64*(t)):((((sm_>>pt_)&1u)!=0u)?64:-1); cmask(P0,P1,0,lim_,hi); }while(0)
  bool resc=false;
  #define START(P0,P1) do{ const float rm=rowmax(P0,P1); resc=false; \
    { const float dl=rm; mhat=fadd_s(mhat,dl); \
      _Pragma("unroll") for(int r=0;r<16;++r){P0[r]=fsub_s(P0[r],dl);P1[r]=fsub_s(P1[r],dl);} \
    } \
    _Pragma("unroll") for(int r=0;r<16;++r)P0[r]=__builtin_amdgcn_exp2f(P0[r]); }while(0)
  #define RESC() do{ if(resc){ asm volatile("s_waitcnt lgkmcnt(0)":::"memory"); \
      _Pragma("unroll") for(int d_=0;d_<2;++d_) _Pragma("unroll") for(int r=0;r<16;++r)o[d_][r]*=wsf[crow(r,hi)]; } }while(0)
  f32x16 pA0,pA1,pB0,pB1;
  int sl_prev=0,sl_cur=0,sl_next=SLOTB;
  #define ROT() do{sl_prev=sl_cur;sl_cur=sl_next;sl_next=(sl_next==(NSLOT-1)*SLOTB)?0:sl_next+SLOTB;}while(0)
  DMA_K(2,2*SLOTB);
  WAIT_BAR(3);
  qkt(pA0,pA1,Kbase,qr,negm,r32,hi);asm volatile("s_nop 15\n\ts_nop 7":"+v"(pA0),"+v"(pA1));CMASK(pA0,pA1,0);
  START(pA0,pA1);
  _Pragma("unroll") for(int r=0;r<16;++r)pA1[r]=__builtin_amdgcn_exp2f(pA1[r]);
  WAIT_BAR(0);
  DMA_K(3,0);DMA_V(1,SLOTB);
  ROT();
  kload8(kf,kp0+sl_cur);
  WAIT_BAR(2);
  s16x4 vlo[8],vhi[8]; u32x4 pw0,pw1,pw2,pw3;
  #define PKW(P,B) cvtpk_s(P[B],P[B+1])
  #define PAF(k) __builtin_bit_cast(bf16x8,pw##k)
  #define VFR(i) (bf16x8){vlo[i][0],vlo[i][1],vlo[i][2],vlo[i][3],vhi[i][0],vhi[i][1],vhi[i][2],vhi[i][3]}
  #define PIN(x) asm volatile("":"+v"(x))
  #define MX3(a,b,c) __builtin_fmaxf(__builtin_fmaxf((a),(b)),(c))
  #define GAPA(MF,A0,A1,A2,A3,W0,W1,PW) do{ MF; sacc+=A0; sacc+=A1; sacc+=A2; sacc+=A3; PIN(sacc); W0; W1; PIN(PW); SBAR(); }while(0)
  #define EX(v) __builtin_amdgcn_exp2f(v)
  #define GAPB(MF,X,B) do{ MF; X[B]=EX(X[B]); X[B+1]=EX(X[B+1]); X[B+2]=EX(X[B+2]); X[B+3]=EX(X[B+3]); PIN(X); SBAR(); }while(0)
  #define VRD(i) do{ vlo[i]=vtr(vp_+(((i)>>2)*4096+((i)&3)*1024)); vhi[i]=vtr(vp_+(((i)>>2)*4096+((i)&3)*1024+512)); }while(0)
  #define KRD(G,j) do{ if(G){ kload2(kf,kp0+sl_next,j); SBAR(); } }while(0)
  #define STEP(C0,C1,P0,P1,t,GK,GV,GL) do{ SBAR(); \
    const lds_cptr vp_=vp0+sl_prev; \
    VRD(0); SBAR(); float sacc=(P0[0]+P0[1]); \
    GAPA(C0=__builtin_amdgcn_mfma_f32_32x32x16_bf16(kf[0],qr[0],negm,0,0,0), P0[2],P0[3],P0[4],P0[5],     pw0[0]=PKW(P0,0), pw0[1]=PKW(P0,2), pw0); \
    VRD(4); SBAR(); GAPA(C1=__builtin_amdgcn_mfma_f32_32x32x16_bf16(kf[1],qr[0],negm,0,0,0), P0[6],P0[7],P0[8],P0[9],     pw0[2]=PKW(P0,4), pw0[3]=PKW(P0,6), pw0); \
    VRD(1); SBAR(); GAPA(C0=__builtin_amdgcn_mfma_f32_32x32x16_bf16(kf[2],qr[1],C0,0,0,0),   P0[10],P0[11],P0[12],P0[13], pw1[0]=PKW(P0,8), pw1[1]=PKW(P0,10), pw1); \
    VRD(5); SBAR(); GAPA(C1=__builtin_amdgcn_mfma_f32_32x32x16_bf16(kf[3],qr[1],C1,0,0,0),   P0[14],P0[15],P1[0],P1[1],   pw1[2]=PKW(P0,12),pw1[3]=PKW(P0,14), pw1); \
    VRD(2); SBAR(); GAPA(C0=__builtin_amdgcn_mfma_f32_32x32x16_bf16(kf[4],qr[2],C0,0,0,0),   P1[2],P1[3],P1[4],P1[5],     pw2[0]=PKW(P1,0), pw2[1]=PKW(P1,2), pw2); \
    VRD(6); SBAR(); GAPA(C1=__builtin_amdgcn_mfma_f32_32x32x16_bf16(kf[5],qr[2],C1,0,0,0),   P1[6],P1[7],P1[8],P1[9],     pw2[2]=PKW(P1,4), pw2[3]=PKW(P1,6), pw2); \
    VRD(3); SBAR(); GAPA(C0=__builtin_amdgcn_mfma_f32_32x32x16_bf16(kf[6],qr[3],C0,0,0,0),   P1[10],P1[11],P1[12],P1[13], pw3[0]=PKW(P1,8), pw3[1]=PKW(P1,10), pw3); \
    VRD(7); SBAR(); GAPA(C1=__builtin_amdgcn_mfma_f32_32x32x16_bf16(kf[7],qr[3],C1,0,0,0),   P1[14],P1[15],0.f,0.f,       pw3[2]=PKW(P1,12),pw3[3]=PKW(P1,14), pw3); \
    l_reg+=sacc; \
    if(GK){DMA_K((t)+3,sl_cur);} if(GV){DMA_V((t)+1,sl_next);} \
    _Pragma("unroll") for(int r=0;r<16;++r){C0[r]-=mhat;C1[r]-=mhat;} \
    CMASK(C0,C1,t); \
    { float a=MX3(C0[0],C0[1],C1[0]),b=MX3(C0[2],C0[3],C1[1]); a=MX3(a,C1[2],C1[3]); \
      _Pragma("unroll") for(int r=4;r<16;r+=4){a=MX3(a,C0[r],C0[r+1]);b=MX3(b,C0[r+2],C0[r+3]);a=MX3(a,C1[r],C1[r+1]);b=MX3(b,C1[r+2],C1[r+3]);} \
      float rm=__builtin_fmaxf(a,b); { auto rr=__builtin_amdgcn_permlane32_swap(__float_as_uint(rm),__float_as_uint(rm),false,false); rm=__builtin_fmaxf(__uint_as_float(rr[0]),__uint_as_float(rr[1])); } \
      resc=false; \
      if(__builtin_expect(__any(rm>(float)THRL),0)){ const float dl=__builtin_fmaxf(rm,0.f); mhat+=dl; \
        _Pragma("unroll") for(int r=0;r<16;++r){C0[r]-=dl;C1[r]-=dl;} \
        const float f=__builtin_amdgcn_exp2f(-dl); l_reg*=f; if(hi==0)wsf[r32]=f; resc=true; } } \
    SBAR(); \
    GAPB(o[0]=__builtin_amdgcn_mfma_f32_32x32x16_bf16(PAF(0),VFR(0),o[0],0,0,0), C0,0); \
    GAPB(o[1]=__builtin_amdgcn_mfma_f32_32x32x16_bf16(PAF(0),VFR(4),o[1],0,0,0), C0,4); \
    KRD(GL,0); GAPB(o[0]=__builtin_amdgcn_mfma_f32_32x32x16_bf16(PAF(1),VFR(1),o[0],0,0,0), C0,8); \
    KRD(GL,1); GAPB(o[1]=__builtin_amdgcn_mfma_f32_32x32x16_bf16(PAF(1),VFR(5),o[1],0,0,0), C0,12); \
    KRD(GL,2); GAPB(o[0]=__builtin_amdgcn_mfma_f32_32x32x16_bf16(PAF(2),VFR(2),o[0],0,0,0), C1,0); \
    KRD(GL,3); GAPB(o[1]=__builtin_amdgcn_mfma_f32_32x32x16_bf16(PAF(2),VFR(6),o[1],0,0,0), C1,4); \
    GAPB(o[0]=__builtin_amdgcn_mfma_f32_32x32x16_bf16(PAF(3),VFR(3),o[0],0,0,0), C1,8); \
    GAPB(o[1]=__builtin_amdgcn_mfma_f32_32x32x16_bf16(PAF(3),VFR(7),o[1],0,0,0), C1,12); \
    }while(0)
  int t=1;
  #undef CMASK
  #define CMASK(P0,P1,t) do{ unsigned sm_; asm volatile("ds_read_b32 %0, %1\n\ts_waitcnt lgkmcnt(0)":"=v"(sm_):"v"(selw_addr):"memory"); const int pt_=((t)<4)?0:((t)-4)>>2; const int lim_=((t)<4)?(qrel-64*(t)):((((sm_>>pt_)&1u)!=0u)?64:-1); cmask(P0,P1,0,lim_,hi); }while(0)
  for(;t+5<NT;t+=2){
    STEP(pB0,pB1,pA0,pA1,t,true,true,true);     WAIT_BAR(2); RESC(); ROT();
    STEP(pA0,pA1,pB0,pB1,t+1,true,true,true);   WAIT_BAR(2); RESC(); ROT();
  }
  #undef CMASK
  #define CMASK(P0,P1,t) do{ unsigned sm_; asm volatile("ds_read_b32 %0, %1\n\ts_waitcnt lgkmcnt(0)":"=v"(sm_):"v"(selw_addr):"memory"); const int pt_=((t)<4)?0:((t)-4)>>2; const int lim_=((t)<4)?(qrel-64*(t)):((((sm_>>pt_)&1u)!=0u)?64:-1); cmask(P0,P1,0,lim_,hi); }while(0)
  #define ENDW(tt) do{ if((tt)+3<NT){WAIT_BAR(2);} else if((tt)+2<NT){WAIT_BAR(1);} else {WAIT_BAR(0);} }while(0)
  for(;t+1<NT;t+=2){
    STEP(pB0,pB1,pA0,pA1,t,(t+3<NT),(t+1<NT),(t+1<NT));       ENDW(t);   RESC(); ROT();
    STEP(pA0,pA1,pB0,pB1,t+1,(t+4<NT),(t+2<NT),(t+2<NT));     ENDW(t+1); RESC(); ROT();
  }
  STEP(pB0,pB1,pA0,pA1,NT-1,false,false,false); RESC();
  { float sacc=pB0[0]+pB0[1]; _Pragma("unroll") for(int r=2;r<16;++r)sacc+=pB0[r]; _Pragma("unroll") for(int r=0;r<16;++r)sacc+=pB1[r]; l_reg+=sacc;
    pw0=(u32x4){PKW(pB0,0),PKW(pB0,2),PKW(pB0,4),PKW(pB0,6)};pw1=(u32x4){PKW(pB0,8),PKW(pB0,10),PKW(pB0,12),PKW(pB0,14)};pw2=(u32x4){PKW(pB1,0),PKW(pB1,2),PKW(pB1,4),PKW(pB1,6)};pw3=(u32x4){PKW(pB1,8),PKW(pB1,10),PKW(pB1,12),PKW(pB1,14)};
    SBAR(); pv(o,vb0+sl_cur,PAF(0),PAF(1),PAF(2),PAF(3)); }
  #undef PKW
  #undef PAF
  #undef VFR
  #undef PIN
  #undef MX3
  #undef GAPA
  #undef GAPB
  #undef EX
  #undef VRD
  #undef KRD
  #undef STEP
  #undef ENDW
  {auto rr=__builtin_amdgcn_permlane32_swap(__float_as_uint(l_reg),__float_as_uint(l_reg),false,false);l_reg=__uint_as_float(rr[0])+__uint_as_float(rr[1]);}
  if(hi==0)wsf[32+r32]=l_reg;asm volatile("s_waitcnt lgkmcnt(0)":::"memory");
  float rli[16];
  #pragma unroll
  for(int r=0;r<16;++r)rli[r]=__builtin_amdgcn_rcpf(wsf[32+crow(r,hi)]);
  bf16*Ow=O+(rowbase+q0+wid*QBLK)*ODM+h*D;
  { bf16*stg=(bf16*)(shm+LDS_OST)+wid*2048;
    #pragma unroll
    for(int r=0;r<16;++r){const int orow=crow(r,hi);
      #pragma unroll
      for(int d0=0;d0<2;++d0)stg[orow*64+d0*32+r32]=__float2bfloat16(ABL_MOBA?0.f:o[d0][r]*rli[r]);}
    asm volatile("s_waitcnt lgkmcnt(0)":::"memory");
    #pragma unroll
    for(int i=0;i<4;++i){const int row=i*8+(lane>>3),ch=lane&7; const u32x4 v=*(const u32x4*)(stg+row*64+ch*8); ATTN_STORE16(Ow+(long)row*ODM+ch*8,v);} }
  asm volatile("s_waitcnt lgkmcnt(0)\n\ts_barrier":::"memory");
  #undef DMA_K
  #undef DMA_V
  #undef CMASK
  #undef START
  #undef RESC
  #undef ROT
}
constexpr int ATTN_LDS_BYTES=LDS_BYTES;
struct AttnTensors { const bf16* Q; const bf16* K; const bf16* V; bf16* O; const unsigned* SEL; };
struct AttnUnit { int bh; int qb; };
struct StaticOrder {
  int vcu;
  __device__ __forceinline__ explicit StaticOrder(int grid,int block):vcu((block%8)*(grid/8)+block/8){}
  __device__ __forceinline__ bool next(int i,AttnUnit&u)const{ if(i>=4)return false; const int s=vcu&7; u.bh=vcu>>3; u.qb=(i==0)?s:(i==1)?15-s:(i==2)?16+s:31-s; return true; }
  __device__ __forceinline__ void a_ready(const AttnUnit&)const{}
  __device__ __forceinline__ void done(const AttnUnit&)const{}
};
template<class Sched,int THRL=8> __device__ __forceinline__ void attn_phase(char*lds,const AttnTensors&T,const Sched&S,const int wave_s){
  AttnUnit u;
  for(int i=0;S.next(i,u);++i){ S.a_ready(u); attn_unit<THRL>(u.bh/NHEAD,u.bh%NHEAD,u.qb,T.Q,T.K,T.V,T.O,T.SEL,lds,wave_s); S.done(u); }
}
#undef SBAR
#undef WAIT_BAR
}

#define LAS __attribute__((address_space(3)))
#define XB_TMO      128
#define XB_XCNT(j)  (256  + 64 * (j))
#define XB_XSUB(j)  (1280 + 64 * (j))
#define XB_XGEN(j)  (2304 + 64 * (j))
#define XB_TOP      3328
#define XB_TOPGEN   3392
#define XCD_BAR_WORDS 3456
#define XB_SPIN_CAP (1u << 18)

__device__ __forceinline__ unsigned xb_ld(unsigned* p)              { return __hip_atomic_load(p, __ATOMIC_RELAXED, __HIP_MEMORY_SCOPE_AGENT); }
__device__ __forceinline__ unsigned xb_add(unsigned* p, unsigned v) { return __hip_atomic_fetch_add(p, v, __ATOMIC_RELAXED, __HIP_MEMORY_SCOPE_AGENT); }
__device__ __forceinline__ unsigned xb_xcc_id() { return (unsigned)__builtin_amdgcn_s_getreg((3 << 11) | 20) & 0xFu; }
#define XB_SPIN(cond, bar) do { unsigned _sp = 0; while (cond) { __builtin_amdgcn_s_sleep(1); \
    if ((++_sp & 255u) == 0u) { if (xb_ld(&(bar)[XB_TMO])) break; if (_sp > XB_SPIN_CAP) { atomicAdd(&(bar)[XB_TMO], 1u); break; } } } } while (0)

struct XcdBarrier {
    unsigned* bar; unsigned x;
    volatile LAS unsigned* st;
};

__device__ __forceinline__ XcdBarrier xcd_barrier_post(unsigned* bar, volatile LAS unsigned* st) {
    XcdBarrier b; b.bar = bar; b.x = xb_xcc_id(); b.st = st;
    if (threadIdx.x == 0) (void)xb_add(&bar[XB_XCNT(b.x)], 1u);
    return b;
}
__device__ __forceinline__ void xcd_barrier_complete(unsigned* bar, unsigned x, unsigned& nloc, unsigned& nx) {
    const unsigned G = gridDim.x * gridDim.y * gridDim.z;
    unsigned sum, cnt, mine, sp = 0u;
    for (;;) {
        sum = 0u; cnt = 0u; mine = 0u;
#pragma unroll
        for (unsigned j = 0; j < 16; ++j) { const unsigned c = xb_ld(&bar[XB_XCNT(j)]); sum += c; cnt += (c > 0u) ? 1u : 0u; mine = (j == x) ? c : mine; }
        if (sum == G) break;
        __builtin_amdgcn_s_sleep(1);
        if ((++sp & 255u) == 0u) { if (xb_ld(&bar[XB_TMO])) break; if (sp > XB_SPIN_CAP) { atomicAdd(&bar[XB_TMO], 1u); break; } }
    }
    nloc = mine > 0u ? mine : 1u; nx = cnt > 0u ? cnt : 1u;
}

__device__ __forceinline__ void xcd_barrier(const XcdBarrier& b, const bool is_t0) {
    asm volatile("s_waitcnt vmcnt(0)" ::: "memory");
    __syncthreads();
    if (is_t0) {
        unsigned* bar = b.bar;
        __builtin_amdgcn_s_waitcnt(0);
        unsigned nloc = b.st[0], nx = b.st[1];
        if (nloc == 0u) { xcd_barrier_complete(bar, b.x, nloc, nx); b.st[0] = nloc; b.st[1] = nx; }
        const unsigned old = xb_add(&bar[XB_XSUB(b.x)], 1u);
        const unsigned gen = old / nloc;
        if (old + 1u == (gen + 1u) * nloc) {
            __builtin_amdgcn_fence(__ATOMIC_RELEASE, "agent");
            asm volatile("s_waitcnt vmcnt(0)" ::: "memory");
            const unsigned og = xb_add(&bar[XB_TOP], 1u);
            const unsigned tg = og / nx;
            if (og + 1u == (tg + 1u) * nx) xb_add(&bar[XB_TOPGEN], 1u);
            else XB_SPIN(xb_ld(&bar[XB_TOPGEN]) == tg, bar);
            __builtin_amdgcn_fence(__ATOMIC_ACQUIRE, "agent");
            xb_add(&bar[XB_XGEN(b.x)], 1u);
            asm volatile("s_waitcnt vmcnt(0)" ::: "memory");
        } else {
            XB_SPIN(xb_ld(&bar[XB_XGEN(b.x)]) == gen, bar);
            __builtin_amdgcn_fence(__ATOMIC_ACQUIRE, "agent");
            asm volatile("s_waitcnt vmcnt(0)" ::: "memory");
        }
    }
    __syncthreads();
}

#ifndef STAMP_KA
#define STAMP_KA -1
#define STAMP_KB -1
#endif
#ifndef DUP_RWKV
#define DUP_RWKV 0
#endif
#ifndef DUPMASK
#define DUPMASK 0
#endif
#ifndef RWKV_SEQ_OVERRIDE
#define RWKV_SEQ_OVERRIDE 0
#endif
#ifndef RWKV_DBG
#define RWKV_DBG 0
#endif
#ifndef SKIP_DSA
#define SKIP_DSA 0
#endif
#ifndef DSA_DUP_ATT
#define DSA_DUP_ATT 0
#endif
#ifndef DSA_DUP_PASS
#define DSA_DUP_PASS 0
#endif
#ifndef DSA_DUP_KIND
#define DSA_DUP_KIND 0
#endif
#ifndef MOE_SCALE
#define MOE_SCALE 1.0f
#endif
#ifndef DIAG
#define DIAG 0
#endif
#ifndef ABL_MOE
#define ABL_MOE 0
#endif
#ifndef ABL_RWKV
#define ABL_RWKV 0
#endif
#ifndef ABL_DSA
#define ABL_DSA 0
#endif
#ifndef ABL_S5
#define ABL_S5 0
#endif
#ifndef ABL_MOBA
#define ABL_MOBA 0
#endif
#ifndef ABL_FFN0
#define ABL_FFN0 0
#endif
constexpr int NWAVES = 8;
constexpr int T_TOK = 32768, DMODEL = 1024, SEQL = 8192, NBATCH = 4;
constexpr int FFN_D = 2816, ODD_PROJ = 2756, ODD_PAD = 2816, FEXP = 3584, NEXP = 8;
constexpr float NORM_EPS = 1e-6f;
constexpr size_t MiB = 1u << 20;
constexpr size_t WS_CTL = 0, CTL_ZERO_BYTES = 1 * MiB;
constexpr size_t WS_ROPE = 1 * MiB;
constexpr size_t WS_KMEAN = WS_ROPE + 512 * 1024;
constexpr size_t WS_TOKINFO = 2 * MiB;
constexpr size_t WS_TOKSLOT = WS_TOKINFO + 512 * 1024;
constexpr size_t WS_TILEEXP = WS_TOKSLOT + 256 * 1024;
constexpr size_t WS_WE_IN = 3 * MiB;
constexpr size_t WS_WGLU = WS_WE_IN + 4 * MiB;
constexpr size_t WS_WE_OUT = WS_WGLU + MiB / 2;
constexpr size_t WS_WFFN_GU = WS_WE_OUT + 2 * MiB;
constexpr size_t WS_WFFN_D = WS_WFFN_GU + 11 * MiB;
constexpr size_t WS_WO_IN = WS_WFFN_D + 11 * MiB / 2;
constexpr size_t WS_WLORA = WS_WO_IN + 11 * MiB / 2;
constexpr size_t WS_WO_OUT = WS_WLORA + 3 * MiB / 4;
constexpr size_t WS_S5MT = 35 * MiB;
constexpr size_t WS_S5BEND = 55 * MiB;
static_assert(WS_WO_OUT + 2 * MiB <= WS_S5MT, "weights map");
constexpr size_t WS_XN = 64 * MiB;
constexpr size_t WS_CAT = WS_XN;
constexpr size_t WS_UG = 128 * MiB;
constexpr size_t WS_Q0 = 168 * MiB, WS_K0 = 200 * MiB, WS_V0 = 232 * MiB;
constexpr size_t WS_XEND = 264 * MiB;
constexpr size_t WS_YA = 280 * MiB;
constexpr size_t WS_SELM = 312 * MiB;
constexpr size_t WS_SS1 = 314 * MiB, WS_SS2 = 316 * MiB;
constexpr size_t WS_HB1 = 320 * MiB;
constexpr size_t WS_ACT = 128 * MiB;
constexpr size_t WS_P1 = 128 * MiB;
constexpr size_t WS_LORA = 304 * MiB;
constexpr size_t WS_QD = 400 * MiB;
constexpr size_t WS_KD = 432 * MiB;
constexpr size_t WS_KI = 436 * MiB;
constexpr size_t WS_QI = 440 * MiB;
constexpr size_t WS_WI = 456 * MiB;
constexpr size_t WS_VD = 490 * MiB;
constexpr size_t WS_ALORA = 457 * MiB;
constexpr size_t WS_YR = 457 * MiB;
constexpr int MOE_MAXTILES = 264, MOE_CHUNK = 128;
constexpr size_t WS_XG = 64 * MiB;
constexpr size_t WS_YS = 130 * MiB;
constexpr size_t WS_WMOE_GU = 262 * MiB;
constexpr size_t WS_WMOE_D = 318 * MiB;
constexpr size_t WS_ACTQ = 346 * MiB;
constexpr float MOE_WGU_SCALE = 32.0f, MOE_WD_SCALE = 64.0f, FFN_WGU_SCALE = 32.0f, FFN_WD_SCALE = 64.0f;
constexpr size_t WS_NEED = 494 * MiB;
constexpr int CW_BAR = 4096;
constexpr int MAX_LAUNCH = 36;
constexpr int CW_EXPCNT = 196608;
static_assert((CW_BAR + MAX_LAUNCH * 3456) <= CW_EXPCNT && (CW_EXPCNT + 8 * 64) * 4 <= (int)CTL_ZERO_BYTES, "ctl map");

constexpr int RING_BYTES = 131072;
constexpr int MISC_OFF = 147200;
constexpr int LDS_BYTES = 147456;

#define GAS __attribute__((address_space(1)))
typedef unsigned short bf16;
typedef unsigned v4u __attribute__((ext_vector_type(4)));
typedef unsigned v2u __attribute__((ext_vector_type(2)));
typedef float f32x4 __attribute__((ext_vector_type(4)));
typedef float f32x2 __attribute__((ext_vector_type(2)));
typedef short bf16x8 __attribute__((ext_vector_type(8)));
#define LDS_WAIT() asm volatile("s_waitcnt lgkmcnt(0)" ::: "memory")
#define VM_WAIT() asm volatile("s_waitcnt vmcnt(0)" ::: "memory")
typedef float cv_f32x2 __attribute__((ext_vector_type(2))); typedef __bf16 cv_bf16x2 __attribute__((ext_vector_type(2)));
__device__ __forceinline__ unsigned pk2(float lo, float hi) { const cv_f32x2 v = {lo, hi}; const cv_bf16x2 b = __builtin_convertvector(v, cv_bf16x2); return __builtin_bit_cast(unsigned, b); }
__device__ __forceinline__ unsigned f2bf(float f) { return pk2(f, 0.f) & 0xffffu; }
__device__ __forceinline__ float clamp448(float x) { return __builtin_amdgcn_fmed3f(x, -448.0f, 448.0f); }
__device__ __forceinline__ unsigned pk4_fp8(float a, float b, float c, float d) {
    unsigned w = __builtin_amdgcn_cvt_pk_fp8_f32(clamp448(a), clamp448(b), 0u, false); return __builtin_amdgcn_cvt_pk_fp8_f32(clamp448(c), clamp448(d), w, true); }
__device__ __forceinline__ float bf2f(unsigned short b) { return __builtin_bit_cast(float, (unsigned)b << 16); }
__device__ __forceinline__ float bflo(unsigned w) { return __builtin_bit_cast(float, w << 16); }
__device__ __forceinline__ float bfhi(unsigned w) { return __builtin_bit_cast(float, w & 0xffff0000u); }
__device__ __forceinline__ void unpack8(const v4u w, float (&o)[8]) { o[0] = bflo(w.x); o[1] = bfhi(w.x); o[2] = bflo(w.y); o[3] = bfhi(w.y); o[4] = bflo(w.z); o[5] = bfhi(w.z); o[6] = bflo(w.w); o[7] = bfhi(w.w); }
__device__ __forceinline__ v4u pack8(const float (&v)[8]) { v4u w; w.x = pk2(v[0], v[1]); w.y = pk2(v[2], v[3]); w.z = pk2(v[4], v[5]); w.w = pk2(v[6], v[7]); return w; }
__device__ __forceinline__ void store8_bf16(bf16* dst, const float (&v)[8]) { *(v4u*)dst = pack8(v); }
__device__ __forceinline__ void load8_bf16(const bf16* src, float (&o)[8]) { const v4u w = *(const v4u*)src; unpack8(w, o); }
__device__ __forceinline__ float wave_sum(float v) {
#pragma unroll
    for (int o = 1; o < 64; o <<= 1) v += __shfl_xor(v, o);
    return v;
}
__device__ __forceinline__ float sigmoidf_(float x) { return __builtin_amdgcn_rcpf(1.0f + __expf(-x)); }
__device__ __forceinline__ float gelu_tanh(float x) { const float z = 0.7978845608028654f * (x + 0.044715f * x * x * x); const float t = 1.0f - 2.0f * __builtin_amdgcn_rcpf(1.0f + __expf(2.0f * z)); return 0.5f * x * (1.0f + t); }


__device__ __forceinline__ float dpp_sum8(float x) {
    x += __builtin_bit_cast(float, __builtin_amdgcn_mov_dpp(__builtin_bit_cast(int, x), 0xB1, 0xf, 0xf, true));
    x += __builtin_bit_cast(float, __builtin_amdgcn_mov_dpp(__builtin_bit_cast(int, x), 0x4E, 0xf, 0xf, true));
    x += __builtin_bit_cast(float, __builtin_amdgcn_mov_dpp(__builtin_bit_cast(int, x), 0x141, 0xf, 0xf, true));
    return x;
}

struct Args { const float* in[38]; float* out; unsigned char* ws; int ph_lo, ph_hi, li, pad; };
struct Frame {
    LAS unsigned char* lds;
    int wave, G;
    const float* const* in; float* out; unsigned char* ws;
};
enum InIdx { I_X = 0, I_E_NORM_MIX, I_E_W_IN, I_S5_A_RE, I_S5_A_IM, I_S5_LOG_DT, I_S5_B_RE, I_S5_B_IM, I_S5_C_RE, I_S5_C_IM, I_S5_D, I_S5_GLU_W, I_S5_GLU_B, I_E_W_OUT, I_E_NORM_FFN,
             I_FFN_GATE, I_FFN_UP, I_FFN_DOWN, I_O_NORM_MIX, I_O_W_IN, I_RWKV_MU, I_RWKV_W0, I_RWKV_W_UP, I_RWKV_A0, I_RWKV_A_UP, I_RWKV_G_UP, I_RWKV_K_K, I_RWKV_K_A, I_RWKV_R_K,
             I_RWKV_LN_W, I_RWKV_LN_B, I_O_W_OUT, I_O_NORM_FFN, I_MOE_ROUTER, I_MOE_GATE, I_MOE_UP, I_MOE_DOWN, I_FINAL_NORM };

template <int MODE>
__device__ __forceinline__ void tr_item(const float* __restrict__ W, int K, int N, bf16* __restrict__ WT, int ldo, int row_off, const float* __restrict__ gain, LAS float* scr, int kb, int nb, int lane) {
    const int k0 = 64 * kb, n0 = 32 * nb; const int nn = n0 + (lane & 31);
#pragma unroll 8
    for (int i = 0; i < 32; ++i) { const int kk = 2 * i + (lane >> 5); float w = (nn < N) ? W[(size_t)(k0 + kk) * N + nn] : 0.f; if (gain) w *= gain[k0 + kk]; scr[kk * 33 + (lane & 31)] = w; }
    LDS_WAIT(); asm volatile("" ::: "memory");
    const int c = lane & 7;
#pragma unroll
    for (int j = 0; j < 4; ++j) { const int nl = (lane >> 3) + 8 * j; const int n = n0 + nl; const LAS float* s = scr + (8 * c) * 33 + nl;
        v4u o; o.x = pk2(s[0 * 33], s[1 * 33]); o.y = pk2(s[2 * 33], s[3 * 33]); o.z = pk2(s[4 * 33], s[5 * 33]); o.w = pk2(s[6 * 33], s[7 * 33]);
        const int row = (MODE == 0) ? (row_off + n) : (row_off + (n >> 7) * 256 + (n & 127));
        if (n < N) *(v4u*)(WT + (size_t)row * ldo + k0 + 8 * c) = o; }
    LDS_WAIT(); asm volatile("" ::: "memory");
}
template <int MODE>
__device__ __forceinline__ void tr_item64(const float* __restrict__ W, int K, int N, bf16* __restrict__ WT, int ldo, int row_off, const float* __restrict__ gain, LAS bf16* scr, int kb, int nb, int lane) {
    const int k0 = 64 * kb, n0 = 64 * nb, n4 = (lane & 15) * 4, kr = lane >> 4; const bool ok = (n0 + n4) < N;
    f32x4 v[16];
#pragma unroll
    for (int i = 0; i < 16; ++i) v[i] = ok ? *(const f32x4*)(W + (size_t)(k0 + 4 * i + kr) * N + n0 + n4) : (f32x4){0.f, 0.f, 0.f, 0.f};
#pragma unroll
    for (int i = 0; i < 16; ++i) { const int k = 4 * i + kr; const float gg = gain ? gain[k0 + k] : 1.0f; LAS bf16* d = scr + n4 * 72 + k;
        d[0] = (bf16)f2bf(v[i].x * gg); d[72] = (bf16)f2bf(v[i].y * gg); d[144] = (bf16)f2bf(v[i].z * gg); d[216] = (bf16)f2bf(v[i].w * gg); }
    LDS_WAIT(); asm volatile("" ::: "memory");
    const int c = lane & 7;
#pragma unroll
    for (int j = 0; j < 8; ++j) { const int nl = (lane >> 3) + 8 * j, n = n0 + nl; const v4u o = *(const LAS v4u*)(scr + nl * 72 + 8 * c);
        const int row = (MODE == 0) ? (row_off + n) : (row_off + (n >> 7) * 256 + (n & 127));
        if (n < N) *(v4u*)(WT + (size_t)row * ldo + k0 + 8 * c) = o; }
    LDS_WAIT(); asm volatile("" ::: "memory");
}
__device__ __forceinline__ void tr64_load(const float* __restrict__ W, int N, int kb, int nb, int lane, f32x4 (&v)[16]) {
    const int k0 = 64 * kb, n0 = 64 * nb, n4 = (lane & 15) * 4, kr = lane >> 4;
#pragma unroll
    for (int i = 0; i < 16; ++i) v[i] = *(const f32x4*)(W + (size_t)(k0 + 16 * (i >> 2) + 4 * kr + (i & 3)) * N + n0 + n4);
}
template <int MODE>
__device__ __forceinline__ void tr64_f8_finish(const f32x4 (&v)[16], unsigned char* __restrict__ WT, int ldo, int row_off, const float* __restrict__ gain, float scale, LAS unsigned char* scr, int kb, int nb, int lane) {
    const int k0 = 64 * kb, n0 = 64 * nb, n4 = (lane & 15) * 4, kr = lane >> 4;
#pragma unroll
    for (int i = 0; i < 16; ++i) { const int k = 16 * (i >> 2) + 4 * kr + (i & 3); const float gg = (gain ? gain[k0 + k] : 1.0f) * scale; const unsigned w = pk4_fp8(v[i].x * gg, v[i].y * gg, v[i].z * gg, v[i].w * gg); LAS unsigned char* d = scr + n4 * 68 + k;
        d[0] = (unsigned char)w; d[68] = (unsigned char)(w >> 8); d[136] = (unsigned char)(w >> 16); d[204] = (unsigned char)(w >> 24); }
    LDS_WAIT(); asm volatile("" ::: "memory");
    const int c = lane & 3;
#pragma unroll
    for (int j = 0; j < 4; ++j) { const int nl = (lane >> 2) + 16 * j, n = n0 + nl; const LAS unsigned* sp = (const LAS unsigned*)(scr + nl * 68 + 16 * c); const v4u o = {sp[0], sp[1], sp[2], sp[3]};
        const int row = (MODE == 0) ? (row_off + n) : (row_off + (n >> 7) * 256 + (n & 127));
        *(v4u*)(WT + (size_t)row * ldo + k0 + 16 * c) = o; }
    LDS_WAIT(); asm volatile("" ::: "memory");
}
template <int MODE>
__device__ __forceinline__ void tr_item64_f8(const float* __restrict__ W, int K, int N, unsigned char* __restrict__ WT, int ldo, int row_off, const float* __restrict__ gain, float scale, LAS unsigned char* scr, int kb, int nb, int lane) {
    f32x4 v[16]; tr64_load(W, N, kb, nb, lane, v); tr64_f8_finish<MODE>(v, WT, ldo, row_off, gain, scale, scr, kb, nb, lane);
}
__device__ __forceinline__ void rms_row_to_bf16(const float* xrow, bf16* orow, int lane) {
    const f32x4* xr = (const f32x4*)xrow + lane;
    f32x4 v[4]; float s = 0.f;
#pragma unroll
    for (int j = 0; j < 4; ++j) { v[j] = xr[64 * j]; s += (v[j].x * v[j].x + v[j].y * v[j].y) + (v[j].z * v[j].z + v[j].w * v[j].w); }
    const float rstd = __builtin_amdgcn_rsqf(wave_sum(s) * (1.f / DMODEL) + NORM_EPS);
    unsigned long long* o8 = (unsigned long long*)orow + lane;
#pragma unroll
    for (int j = 0; j < 4; ++j) o8[64 * j] = (unsigned long long)pk2(v[j].x * rstd, v[j].y * rstd) | ((unsigned long long)pk2(v[j].z * rstd, v[j].w * rstd) << 32);
}
__device__ __forceinline__ void norm_phase(Frame& F, const float* src, bf16* dst, int hb, int HG) {
    const int gw = hb * NWAVES + F.wave, NGW = HG * NWAVES, lane = mk_lane();
    for (int m0 = gw; m0 < T_TOK; m0 += 4 * NGW) { f32x4 v[4][4];
#pragma unroll
        for (int r = 0; r < 4; ++r) { const int m = m0 + r * NGW; const f32x4* xr = (const f32x4*)(src + (size_t)(m < T_TOK ? m : m0) * DMODEL) + lane;
#pragma unroll
            for (int j = 0; j < 4; ++j) v[r][j] = xr[64 * j]; }
#pragma unroll
        for (int r = 0; r < 4; ++r) { const int m = m0 + r * NGW; float s = 0.f;
#pragma unroll
            for (int j = 0; j < 4; ++j) s += (v[r][j].x * v[r][j].x + v[r][j].y * v[r][j].y) + (v[r][j].z * v[r][j].z + v[r][j].w * v[r][j].w);
            const float rstd = __builtin_amdgcn_rsqf(wave_sum(s) * (1.f / DMODEL) + NORM_EPS);
            if (m < T_TOK) { unsigned long long* o8 = (unsigned long long*)(dst + (size_t)m * DMODEL) + lane;
#pragma unroll
                for (int j = 0; j < 4; ++j) o8[64 * j] = (unsigned long long)pk2(v[r][j].x * rstd, v[r][j].y * rstd) | ((unsigned long long)pk2(v[r][j].z * rstd, v[r][j].w * rstd) << 32); } } }
}

__device__ __forceinline__ void s5_build_group(Frame& F, int g) {
    LAS float* pw_re = (LAS float*)F.lds;
    LAS float* pw_im = pw_re + 33 * 64;
    LAS float* bb_re = pw_im + 33 * 64;
    LAS float* bb_im = bb_re + 1024;
    LAS float* cc_re = bb_im + 1024;
    LAS float* cc_im = cc_re + 1024;
    LAS float* klag = cc_im + 1024;
    LAS float* lm = klag + 8192;
    LAS float* th = lm + 64;
    LAS float* fr = th + 64;
    LAS float* fi = fr + 64;
    const float* a_re = F.in[I_S5_A_RE]; const float* a_im = F.in[I_S5_A_IM]; const float* log_dt = F.in[I_S5_LOG_DT];
    const float* b_re = F.in[I_S5_B_RE]; const float* b_im = F.in[I_S5_B_IM]; const float* c_re = F.in[I_S5_C_RE]; const float* c_im = F.in[I_S5_C_IM];
    const int tid = F.wave * 64 + mk_lane();
    if (tid < 64) { const int p = tid; const float ar = a_re[g * 64 + p], ai = a_im[g * 64 + p], dt = expf(log_dt[g]);
        const float mag = expf(dt * ar); float sn, cs; sincosf(dt * ai, &sn, &cs); const float abr = mag * cs, abi = mag * sn;
        const float den = ar * ar + ai * ai, xr = abr - 1.0f, xi = abi;
        lm[p] = dt * ar; th[p] = dt * ai; fr[p] = (xr * ar + xi * ai) / den; fi[p] = (xi * ar - xr * ai) / den; }
    __syncthreads();
    for (int idx = tid; idx < 33 * 64; idx += 512) { const int tau = idx >> 6, p = idx & 63; const float mag = expf((float)tau * lm[p]); float sn, cs; sincosf((float)tau * th[p], &sn, &cs); pw_re[idx] = mag * cs; pw_im[idx] = mag * sn; }
    for (int idx = tid; idx < 1024; idx += 512) { const int p = idx >> 4; const float br = b_re[(size_t)g * 1024 + idx], bi = b_im[(size_t)g * 1024 + idx];
        bb_re[idx] = fr[p] * br - fi[p] * bi; bb_im[idx] = fr[p] * bi + fi[p] * br;
        cc_re[idx] = c_re[(size_t)g * 1024 + idx]; cc_im[idx] = c_im[(size_t)g * 1024 + idx]; }
    __syncthreads();
    for (int idx = tid; idx < 8192; idx += 512) { const int tau = idx >> 8, c = (idx >> 4) & 15, c2 = idx & 15; float s = 0.f;
        for (int p = 0; p < 64; ++p) { const float cr = cc_re[c * 64 + p], ci = cc_im[c * 64 + p], pr = pw_re[tau * 64 + p], pi = pw_im[tau * 64 + p];
            const float er = cr * pr - ci * pi, ei = cr * pi + ci * pr; s += er * bb_re[p * 16 + c2] - ei * bb_im[p * 16 + c2]; }
        klag[idx] = s; }
    __syncthreads();
    bf16* MT = (bf16*)(F.ws + WS_S5MT) + (size_t)g * 512 * 640;
    for (int ch = tid; ch < 512 * 80; ch += 512) { const int n = ch / 80, kc = ch % 80, t = n >> 4, c = n & 15, k0 = 8 * kc; float v[8];
        if (k0 < 512) { const int s = k0 >> 4, c0 = k0 & 15;
#pragma unroll
            for (int j = 0; j < 8; ++j) v[j] = (s <= t) ? klag[((t - s) * 16 + c) * 16 + c0 + j] : 0.f;
        } else {
#pragma unroll
            for (int j = 0; j < 8; ++j) { const int jj = k0 - 512 + j, p = jj >> 1; const float cr = cc_re[c * 64 + p], ci = cc_im[c * 64 + p], pr = pw_re[(t + 1) * 64 + p], pi = pw_im[(t + 1) * 64 + p];
                v[j] = (jj & 1) ? -(cr * pi + ci * pr) : (cr * pr - ci * pi); }
        }
        store8_bf16(MT + (size_t)n * 640 + k0, v); }
    bf16* BE = (bf16*)(F.ws + WS_S5BEND) + (size_t)g * 256 * 512;
    for (int ch = tid; ch < 256 * 64; ch += 512) { const int n = ch >> 6, kc = ch & 63, k0 = 8 * kc, s = k0 >> 4, c0 = k0 & 15; float v[8];
        if (n < 128) { const int p = n >> 1; const float pr = pw_re[(31 - s) * 64 + p], pi = pw_im[(31 - s) * 64 + p];
#pragma unroll
            for (int j = 0; j < 8; ++j) { const float br = bb_re[p * 16 + c0 + j], bi = bb_im[p * 16 + c0 + j]; v[j] = (n & 1) ? (pr * bi + pi * br) : (pr * br - pi * bi); }
        } else {
#pragma unroll
            for (int j = 0; j < 8; ++j) v[j] = 0.f;
        }
        store8_bf16(BE + (size_t)n * 512 + k0, v); }
    __syncthreads();
}

__device__ __forceinline__ void p0_prologue(Frame& F, int parts = 15) {
    if (parts & 1) { if ((int)blockIdx.x < 32) s5_build_group(F, (int)blockIdx.x);
        if (F.G < 32) { for (int g = F.G + (int)blockIdx.x; g < 32; g += F.G) s5_build_group(F, g); } }
    if (!(parts & 14)) return;
    LAS bf16* scr = (LAS bf16*)(F.lds + F.wave * 16384);
    const int lane = mk_lane(), tid = F.wave * 64 + lane;
    const bool sep = F.G >= 64; if (sep && (int)blockIdx.x < 32) return;
    const int hb = sep ? (int)blockIdx.x - 32 : (int)blockIdx.x, HG = sep ? F.G - 32 : F.G;
    const int gw = hb * NWAVES + F.wave, NGW = HG * NWAVES;
    constexpr int J0 = 16 * 32, J1 = 8 * 8, J2 = 16 * 16, J3 = 16 * 44, J4 = J3, J5 = 44 * 16, J6 = 16 * 44, J7 = 16 * 16;
    constexpr int NIT = J0 + J1 + J2 + J3 + J4 + J5 + J6; (void)J7;
    unsigned char* ws = F.ws;
    if (parts & 2) for (int it = gw; it < NIT; it += NGW) {
        int r = it;
        if (r < J0) { tr_item64<0>(F.in[I_E_W_IN], 1024, 2048, (bf16*)(ws + WS_WE_IN), 1024, 0, F.in[I_E_NORM_MIX], scr, r / 32, r % 32, lane); continue; } r -= J0;
        if (r < J1) { tr_item64<0>(F.in[I_S5_GLU_W], 512, 512, (bf16*)(ws + WS_WGLU), 512, 0, nullptr, scr, r / 8, r % 8, lane); continue; } r -= J1;
        if (r < J2) { tr_item64<0>(F.in[I_E_W_OUT], 1024, 1024, (bf16*)(ws + WS_WE_OUT), 1024, 0, nullptr, scr, r / 16, r % 16, lane); continue; } r -= J2;
        if (r < J3) { tr_item64<1>(F.in[I_FFN_GATE], 1024, FFN_D, (bf16*)(ws + WS_WFFN_GU), 1024, 0, F.in[I_E_NORM_FFN], scr, r / 44, r % 44, lane); continue; } r -= J3;
        if (r < J4) { tr_item64<1>(F.in[I_FFN_UP], 1024, FFN_D, (bf16*)(ws + WS_WFFN_GU), 1024, 128, F.in[I_E_NORM_FFN], scr, r / 44, r % 44, lane); continue; } r -= J4;
        if (r < J5) { tr_item64<0>(F.in[I_FFN_DOWN], FFN_D, 1024, (bf16*)(ws + WS_WFFN_D), FFN_D, 0, nullptr, scr, r / 16, r % 16, lane); continue; } r -= J5;
        tr_item64<0>(F.in[I_O_W_IN], 1024, ODD_PROJ, (bf16*)(ws + WS_WO_IN), 1024, 0, F.in[I_O_NORM_MIX], scr, r / 44, r % 44, lane);
    }
    const int gt = hb * 512 + tid, NGT = HG * 512;
    if (parts & 4) {
    { bf16* w = (bf16*)(ws + WS_WO_IN) + (size_t)ODD_PROJ * 1024; for (int i = gt; i < (ODD_PAD - ODD_PROJ) * 1024 / 8; i += NGT) *(v4u*)(w + (size_t)i * 8) = (v4u){0u, 0u, 0u, 0u}; }
    { bf16* w = (bf16*)(ws + WS_WLORA); const float* wu = F.in[I_RWKV_W_UP]; const float* au = F.in[I_RWKV_A_UP]; const float* gu = F.in[I_RWKV_G_UP];
      for (int i = gt; i < 1536 * 256; i += NGT) { const int n = i >> 8, k = i & 255; float v = 0.f;
          if (n < 512) { if (k < 64) v = wu[k * 512 + n]; } else if (n < 1024) { if (k >= 64 && k < 128) v = au[(k - 64) * 512 + (n - 512)]; } else { if (k >= 128) v = gu[(k - 128) * 512 + (n - 1024)]; }
          w[i] = (bf16)f2bf(v); } }
    { float* rp = (float*)(ws + WS_ROPE); for (int i = gt; i < 8192 * 8; i += NGT) { const int pos = i >> 3, j = i & 7; const float inv = powf(500000.0f, -(float)j / 8.0f); const float ang = (float)pos * inv;
          rp[pos * 16 + j] = cosf(ang); rp[pos * 16 + 8 + j] = sinf(ang); } }
    }
    if (parts & 8) norm_phase(F, F.in[I_X], (bf16*)(ws + WS_XN), hb, HG);
}

constexpr float ATT_C2 = 0.125f * 1.4426950408889634f;
struct F_E1 {
    bf16* UG; bf16* Q0; bf16* K0; bf16* V0; const float* rope;
    __device__ __forceinline__ void operator()(const pg8::Unit& u, int r, int c, float (&v)[8], int wc) const {
        const int row = u.pm * 256 + r, col = u.pn * 256 + c, seg = u.pn >> 1;
        if (seg == 0) { const int g = col >> 4, c0 = col & 15; store8_bf16(UG + ((size_t)(g * 1024 + (row >> 5)) * 640 + (row & 31) * 16 + c0), v); }
        else if (seg == 3) { store8_bf16(V0 + (size_t)row * 512 + (col - 1536), v); }
        else { const int ch = col - seg * 512;
            if ((wc & 1) == 0) { float o[8];
#pragma unroll
                for (int j = 0; j < 8; ++j) o[j] = __shfl_xor(v[j], 16);
                const int d = ch & 63;
                if (d < 16) { const float* cs = rope + (size_t)(row & 8191) * 16; const f32x4 c0 = *(const f32x4*)cs, c1 = *(const f32x4*)(cs + 4), s0 = *(const f32x4*)(cs + 8), s1 = *(const f32x4*)(cs + 12);
                    const float cv[8] = {c0.x, c0.y, c0.z, c0.w, c1.x, c1.y, c1.z, c1.w}, sv[8] = {s0.x, s0.y, s0.z, s0.w, s1.x, s1.y, s1.z, s1.w};
                    const float sgn = (d == 0) ? -1.0f : 1.0f;
#pragma unroll
                    for (int j = 0; j < 8; ++j) v[j] = v[j] * cv[j] + sgn * o[j] * sv[j]; } }
            if (seg == 1) {
#pragma unroll
                for (int j = 0; j < 8; ++j) v[j] *= ATT_C2;
                store8_bf16(Q0 + (size_t)row * 512 + ch, v); }
            else store8_bf16(K0 + (size_t)row * 512 + ch, v); }
    }
};
struct EpiE1 {
    static constexpr bool PERM = true, AFTER_DRAIN = false;
    bf16* UG; bf16* Q0; bf16* K0; bf16* V0; const float* rope;
    __device__ __forceinline__ void operator()(const pg8::f32x4 (&acc)[2][2][4][2], const pg8::Unit& u, int wr, int wc, int fr, int fq) const {
        const int seg = u.pn >> 1;
        if (seg == 0 || seg == 3) {
#pragma unroll
            for (int ai = 0; ai < 2; ++ai)
#pragma unroll
                for (int m = 0; m < 4; ++m) { const int row = u.pm * 256 + ai * 128 + wr * 64 + m * 16 + fr;
#pragma unroll
                    for (int bj = 0; bj < 2; ++bj) { const int col = u.pn * 256 + bj * 128 + wc * 32 + 8 * fq;
                        float v[8] = {acc[ai][bj][m][0][0], acc[ai][bj][m][0][1], acc[ai][bj][m][0][2], acc[ai][bj][m][0][3], acc[ai][bj][m][1][0], acc[ai][bj][m][1][1], acc[ai][bj][m][1][2], acc[ai][bj][m][1][3]};
                        if (seg == 0) { const int g = col >> 4, c0 = col & 15; store8_bf16(UG + ((size_t)(g * 1024 + (row >> 5)) * 640 + (row & 31) * 16 + c0), v); }
                        else store8_bf16(V0 + (size_t)row * 512 + (col - 1536), v); } }
            return; }
        bf16* dst = (seg == 1) ? Q0 : K0; const float osc = (seg == 1) ? ATT_C2 : 1.0f;
        const bool ropew = (wc & 1) == 0;
        if (!ropew) {
#pragma unroll
            for (int ai = 0; ai < 2; ++ai)
#pragma unroll
                for (int m = 0; m < 4; ++m) { const int row = u.pm * 256 + ai * 128 + wr * 64 + m * 16 + fr;
#pragma unroll
                    for (int bj = 0; bj < 2; ++bj) { const int ch = (u.pn & 1) * 256 + bj * 128 + wc * 32 + 8 * fq;
                        float v[8] = {acc[ai][bj][m][0][0] * osc, acc[ai][bj][m][0][1] * osc, acc[ai][bj][m][0][2] * osc, acc[ai][bj][m][0][3] * osc, acc[ai][bj][m][1][0] * osc, acc[ai][bj][m][1][1] * osc, acc[ai][bj][m][1][2] * osc, acc[ai][bj][m][1][3] * osc};
                        store8_bf16(dst + (size_t)row * 512 + ch, v); } }
            return; }
        const float sgn = (fq == 0) ? -osc : osc; const float keep = (fq < 2) ? 0.0f : osc;
        f32x4 pr[2][2][4];
#define E1_LOAD(b, buf) do { _Pragma("unroll") for (int mm = 0; mm < 2; ++mm) { const int ri = (b) * 2 + mm; const int row = u.pm * 256 + (ri >> 2) * 128 + wr * 64 + (ri & 3) * 16 + fr; \
            const f32x4* cs = (const f32x4*)(rope + (size_t)(row & 8191) * 16); pr[buf][mm][0] = cs[0]; pr[buf][mm][1] = cs[1]; pr[buf][mm][2] = cs[2]; pr[buf][mm][3] = cs[3]; } } while (0)
        E1_LOAD(0, 0);
#pragma unroll
        for (int b = 0; b < 4; ++b) {
            if (b + 1 < 4) E1_LOAD(b + 1, (b + 1) & 1);
#pragma unroll
            for (int mm = 0; mm < 2; ++mm) { const int ri = b * 2 + mm, ai = ri >> 2, m = ri & 3; const int row = u.pm * 256 + ai * 128 + wr * 64 + m * 16 + fr;
                const f32x4 c0 = pr[b & 1][mm][0], c1 = pr[b & 1][mm][1], s0 = pr[b & 1][mm][2], s1 = pr[b & 1][mm][3];
                float cv[8] = {c0.x, c0.y, c0.z, c0.w, c1.x, c1.y, c1.z, c1.w}, sv[8] = {s0.x, s0.y, s0.z, s0.w, s1.x, s1.y, s1.z, s1.w};
#pragma unroll
                for (int j = 0; j < 8; ++j) { cv[j] = (fq < 2) ? cv[j] * osc : keep; sv[j] = (fq < 2) ? sv[j] * sgn : 0.0f; }
#pragma unroll
                for (int bj = 0; bj < 2; ++bj) { const int ch = (u.pn & 1) * 256 + bj * 128 + wc * 32 + 8 * fq;
                    float v[8] = {acc[ai][bj][m][0][0], acc[ai][bj][m][0][1], acc[ai][bj][m][0][2], acc[ai][bj][m][0][3], acc[ai][bj][m][1][0], acc[ai][bj][m][1][1], acc[ai][bj][m][1][2], acc[ai][bj][m][1][3]};
                    float o[8];
#pragma unroll
                    for (int j = 0; j < 8; ++j) o[j] = __shfl_xor(v[j], 16);
#pragma unroll
                    for (int j = 0; j < 8; ++j) v[j] = v[j] * cv[j] + o[j] * sv[j];
                    store8_bf16(dst + (size_t)row * 512 + ch, v); } } }
#undef E1_LOAD
    }
};
struct F_XEND { float* XEND;
    __device__ __forceinline__ void operator()(const pg8::Unit& u, int r, int c, float (&v)[8], int) const {
        if (c < 128) { float* d = XEND + (size_t)(u.pm * 256 + r) * 128 + c; *(f32x4*)d = (f32x4){v[0], v[1], v[2], v[3]}; *(f32x4*)(d + 4) = (f32x4){v[4], v[5], v[6], v[7]}; } }
};
struct F_S5Y { const bf16* UG; const float* dsk; bf16* YA;
    static constexpr int MB = 4; typedef v4u Pre; struct Hoist { f32x4 d[2]; };
    __device__ __forceinline__ void hoist(const pg8::Unit& u, int, int fq, Hoist& h) const { const int ch = (u.pm >> 2) * 16 + ((8 * fq) & 15); h.d[0] = *(const f32x4*)(dsk + ch); h.d[1] = *(const f32x4*)(dsk + ch + 4); }
    __device__ __forceinline__ void load(const pg8::Unit& u, int r, int c, Pre& p) const { p = *(const v4u*)(UG + (size_t)(u.pm * 256 + r) * 640 + (u.pn & 1) * 256 + c); }
    __device__ __forceinline__ void apply(const pg8::Unit& u, int r, int c, float (&v)[8], const Pre& p, const Hoist& h, int) const {
        const int row = u.pm * 256 + r, lc = (u.pn & 1) * 256 + c, g = u.pm >> 2, t = lc >> 4, c0 = lc & 15;
        const int token = (row & 1023) * 32 + t, ch = g * 16 + c0;
        float uu[8]; unpack8(p, uu);
        const float dv[8] = {h.d[0].x, h.d[0].y, h.d[0].z, h.d[0].w, h.d[1].x, h.d[1].y, h.d[1].z, h.d[1].w};
#pragma unroll
        for (int j = 0; j < 8; ++j) v[j] = gelu_tanh(v[j] + dv[j] * uu[j]);
        store8_bf16(YA + (size_t)token * 512 + ch, v); }
};
struct F_GLU { const bf16* YA; const float* gb; bf16* CAT;
    static constexpr int MB = 4; typedef v4u Pre; struct Hoist { f32x4 b[2][2]; };
    __device__ __forceinline__ void hoist(const pg8::Unit& u, int wc, int fq, Hoist& h) const {
#pragma unroll
        for (int bj = 0; bj < 2; ++bj) { const int col = u.pn * 256 + bj * 128 + wc * 32 + 8 * fq; h.b[bj][0] = *(const f32x4*)(gb + col); h.b[bj][1] = *(const f32x4*)(gb + col + 4); } }
    __device__ __forceinline__ void load(const pg8::Unit& u, int r, int c, Pre& p) const { p = *(const v4u*)(YA + (size_t)(u.pm * 256 + r) * 512 + u.pn * 256 + c); }
    __device__ __forceinline__ void apply(const pg8::Unit& u, int r, int c, float (&v)[8], const Pre& p, const Hoist& h, int bj) const {
        const int row = u.pm * 256 + r, col = u.pn * 256 + c;
        float ya[8]; unpack8(p, ya);
        const f32x4 b0 = h.b[bj][0], b1 = h.b[bj][1]; const float bv[8] = {b0.x, b0.y, b0.z, b0.w, b1.x, b1.y, b1.z, b1.w};
#pragma unroll
        for (int j = 0; j < 8; ++j) v[j] = ABL_S5 ? 0.f : ya[j] * sigmoidf_(v[j] + bv[j]);
        store8_bf16(CAT + (size_t)row * 1024 + col, v); }
};
constexpr int RES_LD = 2 * DMODEL;
struct F_RES { const bf16* base; bf16* out;
    static constexpr int MB = 4; typedef v4u Pre; struct Hoist {};
    __device__ __forceinline__ void hoist(const pg8::Unit&, int, int, Hoist&) const {}
    __device__ __forceinline__ void load(const pg8::Unit& u, int r, int c, Pre& p) const { p = *(const v4u*)(base + (size_t)(u.pm * 256 + r) * RES_LD + u.pn * 256 + c); }
    __device__ __forceinline__ void apply(const pg8::Unit& u, int r, int c, float (&v)[8], const Pre& p, const Hoist&, int) const {
        float b[8]; unpack8(p, b);
#pragma unroll
        for (int j = 0; j < 8; ++j) v[j] += b[j];
        store8_bf16(out + (size_t)(u.pm * 256 + r) * RES_LD + u.pn * 256 + c, v); }
};
__device__ __forceinline__ float row_rstd16(const float* SS, int row) {
    const f32x4* p = (const f32x4*)(SS + (size_t)row * 16); const f32x4 a = p[0], b = p[1], c = p[2], d = p[3];
    const float s = ((a.x + a.y) + (a.z + a.w)) + ((b.x + b.y) + (b.z + b.w)) + ((c.x + c.y) + (c.z + c.w)) + ((d.x + d.y) + (d.z + d.w));
    return __builtin_amdgcn_rsqf(s * (1.f / DMODEL) + NORM_EPS); }
struct F_SWIGLU { bf16* ACT; int ld; const float* SS; int mode = 0;
    __device__ __forceinline__ void operator()(const pg8::Unit& u, int r, int c, float (&g)[8], float (&p)[8], float rs) const {
        const int row = u.pm * 256 + r;
        float o[8];
#pragma unroll
        for (int j = 0; j < 8; ++j) { const float gg = g[j] * rs; o[j] = ABL_FFN0 ? 0.f : gg * sigmoidf_(gg) * (p[j] * rs); }
        if (mode == 0 || o[0] == 1.2345e-30f) store8_bf16(ACT + (size_t)row * ld + u.pn * 128 + c, o); }
};
template <bool BASE_BF16> struct EpiResNorm {
    static constexpr bool PERM = true, AFTER_DRAIN = false;
    const void* base; bf16* HB; bf16* RES; float* SS; int skip = 0;
    __device__ __forceinline__ void operator()(const pg8::f32x4 (&acc)[2][2][4][2], const pg8::Unit& u, int wr, int wc, int fr, int fq) const {
        if (skip) return;
        f32x4 pa[2][2][2][2];
#define ERN_LOAD(b, buf) do { _Pragma("unroll") for (int mm = 0; mm < 2; ++mm) { const int ri = (b) * 2 + mm; const int row = u.pm * 256 + (ri >> 2) * 128 + wr * 64 + (ri & 3) * 16 + fr; \
            _Pragma("unroll") for (int bj = 0; bj < 2; ++bj) { const size_t o = (size_t)row * 1024 + u.pn * 256 + bj * 128 + wc * 32 + 8 * fq; \
                if (BASE_BF16) pa[buf][mm][bj][0] = __builtin_bit_cast(f32x4, *(const v4u*)((const bf16*)base + o)); \
                else { pa[buf][mm][bj][0] = *(const f32x4*)((const float*)base + o); pa[buf][mm][bj][1] = *(const f32x4*)((const float*)base + o + 4); } } } } while (0)
        ERN_LOAD(0, 0);
#pragma unroll
        for (int b = 0; b < 4; ++b) {
            if (b + 1 < 4) ERN_LOAD(b + 1, (b + 1) & 1);
#pragma unroll
            for (int mm = 0; mm < 2; ++mm) { const int ri = b * 2 + mm, ai = ri >> 2, m = ri & 3; const int row = u.pm * 256 + ai * 128 + wr * 64 + m * 16 + fr; float ss = 0.f;
#pragma unroll
                for (int bj = 0; bj < 2; ++bj) { const int col = u.pn * 256 + bj * 128 + wc * 32 + 8 * fq;
                    float bv[8];
                    if (BASE_BF16) unpack8(__builtin_bit_cast(v4u, pa[b & 1][mm][bj][0]), bv);
                    else { const f32x4 a = pa[b & 1][mm][bj][0], bb = pa[b & 1][mm][bj][1]; bv[0] = a.x; bv[1] = a.y; bv[2] = a.z; bv[3] = a.w; bv[4] = bb.x; bv[5] = bb.y; bv[6] = bb.z; bv[7] = bb.w; }
                    float v[8] = {bv[0] + acc[ai][bj][m][0][0], bv[1] + acc[ai][bj][m][0][1], bv[2] + acc[ai][bj][m][0][2], bv[3] + acc[ai][bj][m][0][3],
                                  bv[4] + acc[ai][bj][m][1][0], bv[5] + acc[ai][bj][m][1][1], bv[6] + acc[ai][bj][m][1][2], bv[7] + acc[ai][bj][m][1][3]};
                    const v4u pk = pack8(v);
                    *(v4u*)(HB + (size_t)row * 1024 + col) = pk;
                    if (RES) *(v4u*)(RES + (size_t)row * RES_LD + col) = pk;
#pragma unroll
                    for (int j = 0; j < 8; ++j) ss += v[j] * v[j]; }
                ss += __shfl_xor(ss, 16); ss += __shfl_xor(ss, 32);
                if (fq == 0) SS[(size_t)row * 16 + u.pn * 4 + wc] = ss; } }
#undef ERN_LOAD
    }
};
struct SchedXend { int G, c;
    __device__ __forceinline__ bool next(int i, pg8::Unit& u) const { const int L = i * G + c; if (L >= 128) return false; u.pm = L; u.pn = L >> 2; u.aux = 0; return true; }
    __device__ __forceinline__ void a_ready(const pg8::Unit&) const {}
    __device__ __forceinline__ void done(const pg8::Unit&) const {} };
struct SchedS5Y { int G, c;
    __device__ __forceinline__ bool next(int i, pg8::Unit& u) const { const int L = i * G + c; if (L >= 256) return false; const int g = L >> 3; u.pm = g * 4 + ((L >> 1) & 3); u.pn = g * 2 + (L & 1); u.aux = 0; return true; }
    __device__ __forceinline__ void a_ready(const pg8::Unit&) const {}
    __device__ __forceinline__ void done(const pg8::Unit&) const {} };

__device__ __forceinline__ void kmean_phase(Frame& F) {
    const bf16* K0 = (const bf16*)(F.ws + WS_K0); float* km = (float*)(F.ws + WS_KMEAN); const int lane = mk_lane(), tid = F.wave * 64 + lane; LAS float* red = (LAS float*)F.lds;
    for (int un = ((int)blockIdx.x + F.G - (128 % F.G)) % F.G; un < 128; un += F.G) { const int b = un >> 5, n = un & 31; const bf16* src = K0 + ((size_t)b * SEQL + n * 256 + F.wave) * 512 + 8 * lane;
        float s[8] = {0.f, 0.f, 0.f, 0.f, 0.f, 0.f, 0.f, 0.f};
#pragma unroll 8
        for (int i = 0; i < 32; ++i) { float t[8]; load8_bf16(src + (size_t)i * 8 * 512, t);
#pragma unroll
            for (int e = 0; e < 8; ++e) s[e] += t[e]; }
        *(LAS f32x4*)(red + F.wave * 512 + 8 * lane) = (f32x4){s[0], s[1], s[2], s[3]}; *(LAS f32x4*)(red + F.wave * 512 + 8 * lane + 4) = (f32x4){s[4], s[5], s[6], s[7]};
        __syncthreads();
        float a = 0.f;
#pragma unroll
        for (int w = 0; w < 8; ++w) a += red[w * 512 + tid];
        const int h = tid >> 6, d = tid & 63; km[((size_t)(b * 8 + h) * 32 + n) * 64 + d] = a * (1.0f / 256.0f);
        __syncthreads(); }
}
__device__ __forceinline__ void s5_carry_phase(Frame& F) {
    const int lane = mk_lane(), tid = F.wave * 64 + lane; LAS float* xs = (LAS float*)F.lds;
    for (int un = blockIdx.x; un < 128; un += F.G) { const int g = un >> 2, b = un & 3;
        const f32x4* src = (const f32x4*)((const float*)(F.ws + WS_XEND) + (size_t)(g * 1024 + b * 256) * 128);
#pragma unroll 4
        for (int i = tid; i < 8192; i += 512) ((LAS f32x4*)xs)[i] = src[i];
        __syncthreads();
        if (F.wave == 0) { const int p = lane;
            const float ar = F.in[I_S5_A_RE][g * 64 + p], ai = F.in[I_S5_A_IM][g * 64 + p], dt = expf(F.in[I_S5_LOG_DT][g]);
            const float mag = expf(32.0f * dt * ar); float sn, cs; sincosf(32.0f * dt * ai, &sn, &cs); const float a_r = mag * cs, a_i = mag * sn;
            unsigned* __restrict__ ug = (unsigned*)((bf16*)(F.ws + WS_UG) + (size_t)(g * 1024 + b * 256) * 640 + 512 + 2 * p);
            float cr = 0.f, ci = 0.f;
#pragma unroll 8
            for (int c = 0; c < 256; ++c) { const f32x2 x = *(const LAS f32x2*)(xs + c * 128 + 2 * p); ug[(size_t)c * 320] = pk2(cr, ci);
                const float nr = a_r * cr - a_i * ci + x.x, ni = a_r * ci + a_i * cr + x.y; cr = nr; ci = ni; } }
        __syncthreads(); }
}
__device__ __forceinline__ void moba_select_phase(Frame& F) {
    LAS float* km = (LAS float*)F.lds;
    const bf16* Q0 = (const bf16*)(F.ws + WS_Q0); const float* kmg = (const float*)(F.ws + WS_KMEAN); unsigned* SELM = (unsigned*)(F.ws + WS_SELM); const int tid = F.wave * 64 + mk_lane();
    const bool split = (F.G == 256); const int ufirst = split ? ((int)blockIdx.x < 128 ? (int)blockIdx.x : 128 + ((int)blockIdx.x - 128) * 3) : (int)blockIdx.x;
    const int ucount = split ? ((int)blockIdx.x < 128 ? 1 : 3) : (512 - (int)blockIdx.x + F.G - 1) / F.G;
    for (int ui = 0; ui < ucount; ++ui) { const int un = split ? ufirst + ui : ufirst + ui * F.G; const int b = un >> 7, qb = (un >> 2) & 31, hp = un & 3;
        for (int i = tid; i < 4096; i += 512) km[i] = kmg[(size_t)(b * 8 + hp * 2 + (i >> 11)) * 2048 + (i & 2047)];
        __syncthreads();
        const int hl = tid >> 8, tl = tid & 255, h = hp * 2 + hl, t = qb * 256 + tl;
        float q[64]; const bf16* qp = Q0 + ((size_t)b * SEQL + t) * 512 + h * 64;
#pragma unroll
        for (int j = 0; j < 8; ++j) { float tmp[8]; load8_bf16(qp + 8 * j, tmp);
#pragma unroll
            for (int e = 0; e < 8; ++e) q[8 * j + e] = tmp[e]; }
        float v1 = -INFINITY, v2 = -INFINITY, v3 = -INFINITY; int i1 = -1, i2 = -1, i3 = -1;
        for (int n = 0; n < qb; ++n) { const LAS float* kp = km + (hl * 32 + n) * 64; float s = 0.f;
#pragma unroll
            for (int d = 0; d < 64; d += 4) { const f32x4 kv = *(const LAS f32x4*)(kp + d); s += q[d] * kv.x + q[d + 1] * kv.y + q[d + 2] * kv.z + q[d + 3] * kv.w; }
            if (s > v1) { v3 = v2; i3 = i2; v2 = v1; i2 = i1; v1 = s; i1 = n; } else if (s > v2) { v3 = v2; i3 = i2; v2 = s; i2 = n; } else if (s > v3) { v3 = s; i3 = n; } }
        unsigned m = 1u << qb; if (i1 >= 0) m |= 1u << i1; if (i2 >= 0) m |= 1u << i2; if (i3 >= 0) m |= 1u << i3;
        SELM[(size_t)(b * 8 + h) * SEQL + t] = m;
        __syncthreads(); }
}

constexpr int P1_LD = ODD_PAD;
constexpr int PC_R = 0, PC_K = 512, PC_V = 1024, PC_WD = 1536, PC_AD = 1600, PC_GD = 1664, PC_Q = 1792, PC_KD = 2304, PC_VD = 2368, PC_QI = 2432, PC_KI = 2688, PC_WI = 2752;
struct F_P1 { bf16* P1; const float* SS;
    __device__ __forceinline__ void operator()(const pg8::Unit& u, int r, int c, float (&v)[8], float rs) const { const int row = u.pm * 256 + r;
#pragma unroll
        for (int j = 0; j < 8; ++j) v[j] *= rs;
        store8_bf16(P1 + (size_t)row * P1_LD + u.pn * 256 + c, v); } };
struct F_LORA { bf16* LORA; const float* w0; const float* a0;
    static constexpr int MB = 4; struct Pre {}; struct Hoist { f32x4 w[2][2]; };
    __device__ __forceinline__ void hoist(const pg8::Unit& u, int wc, int fq, Hoist& h) const { const int seg = u.pn >> 1; const float* src = (seg == 0) ? w0 : a0 - 512;
#pragma unroll
        for (int bj = 0; bj < 2; ++bj) { const int col = (seg < 2) ? (u.pn * 256 + bj * 128 + wc * 32 + 8 * fq) : 512; h.w[bj][0] = *(const f32x4*)(src + col); h.w[bj][1] = *(const f32x4*)(src + col + 4); } }
    __device__ __forceinline__ void load(const pg8::Unit&, int, int, Pre&) const {}
    __device__ __forceinline__ void apply(const pg8::Unit& u, int r, int c, float (&v)[8], const Pre&, const Hoist& h, int bj) const {
        const int row = u.pm * 256 + r, col = u.pn * 256 + c, seg = u.pn >> 1;
        const float wv[8] = {h.w[bj][0].x, h.w[bj][0].y, h.w[bj][0].z, h.w[bj][0].w, h.w[bj][1].x, h.w[bj][1].y, h.w[bj][1].z, h.w[bj][1].w};
        const float sc = (seg == 0) ? -0.6065306597126334f : 1.0f;
#pragma unroll
        for (int j = 0; j < 8; ++j) { const float sg = sc * sigmoidf_(wv[j] + v[j]); v[j] = (seg < 2) ? sg : v[j]; }
        store8_bf16(LORA + (size_t)row * 1536 + col, v); }
};
struct F_MOEGU { unsigned char* ACTQ; int rt0; int probe = 0;
    __device__ __forceinline__ void operator()(const pg8::Unit& u, int r, int c, float (&g)[8], float (&p)[8]) const {
        float o[8];
#pragma unroll
        for (int j = 0; j < 8; ++j) { const float gg = g[j] * (1.0f / MOE_WGU_SCALE); o[j] = gg * sigmoidf_(gg) * (p[j] * (1.0f / MOE_WGU_SCALE)); }
        if (probe == 2) { if (o[0] == 1.2345e-30f) ACTQ[0] = 1; return; }
        *(v2u*)(ACTQ + (size_t)((probe ? 0 : (u.pm - rt0)) * 256 + r) * FEXP + (probe ? 0 : u.aux) * 128 + c) = (v2u){pk4_fp8(o[0], o[1], o[2], o[3]), pk4_fp8(o[4], o[5], o[6], o[7])}; }
};
struct F_MOED { bf16* YS; int probe = 0;
    __device__ __forceinline__ void operator()(const pg8::Unit& u, int r, int c, float (&v)[8], int) const {
#pragma unroll
        for (int j = 0; j < 8; ++j) v[j] *= (1.0f / MOE_WD_SCALE);
        if (probe == 2) { if (v[0] == 1.2345e-30f) YS[0] = 1; return; }
        store8_bf16(YS + (size_t)((probe ? 0 : u.aux) * 256 + r) * 1024 + (u.pn & 3) * 256 + c, v); } };
struct SchedMoeGU { const int* tile_exp; int rt0, ntq, G, c;
    __device__ __forceinline__ bool next(int i, pg8::Unit& u) const { const int L = i * G + c; if (L >= ntq * 28) return false; const int rt = rt0 + L % ntq, pn = L / ntq; const int e = tile_exp[rt]; u.pm = rt; u.pn = e * 28 + pn; u.aux = pn; return true; }
    __device__ __forceinline__ void a_ready(const pg8::Unit&) const {}
    __device__ __forceinline__ void done(const pg8::Unit&) const {} };
struct SchedMoeD { const int* tile_exp; int rt0, ntq, G, c;
    __device__ __forceinline__ bool next(int i, pg8::Unit& u) const { const int L = i * G + c; if (L >= ntq * 4) return false; const int rt = rt0 + L % ntq, pn = L / ntq; const int e = tile_exp[rt]; u.pm = rt - rt0; u.pn = e * 4 + pn; u.aux = rt; return true; }
    __device__ __forceinline__ void a_ready(const pg8::Unit&) const {}
    __device__ __forceinline__ void done(const pg8::Unit&) const {} };

__device__ __forceinline__ void rope8_x1(float (&v)[8], int d0, const float* cs) {
    float o[8];
#pragma unroll
    for (int j = 0; j < 8; ++j) o[j] = __shfl_xor(v[j], 1);
    if (d0 < 16) { const f32x4 c0 = *(const f32x4*)cs, c1 = *(const f32x4*)(cs + 4), s0 = *(const f32x4*)(cs + 8), s1 = *(const f32x4*)(cs + 12);
        const float cv[8] = {c0.x, c0.y, c0.z, c0.w, c1.x, c1.y, c1.z, c1.w}, sv[8] = {s0.x, s0.y, s0.z, s0.w, s1.x, s1.y, s1.z, s1.w};
        const float sgn = (d0 == 0) ? -1.0f : 1.0f;
#pragma unroll
        for (int j = 0; j < 8; ++j) v[j] = v[j] * cv[j] + sgn * o[j] * sv[j]; }
}
__device__ __forceinline__ void rope8_pre(float (&v)[8], int d0, const f32x4 (&cs)[4]) {
    float o[8];
#pragma unroll
    for (int j = 0; j < 8; ++j) o[j] = __shfl_xor(v[j], 1);
    const float cv[8] = {cs[0].x, cs[0].y, cs[0].z, cs[0].w, cs[1].x, cs[1].y, cs[1].z, cs[1].w}, sv[8] = {cs[2].x, cs[2].y, cs[2].z, cs[2].w, cs[3].x, cs[3].y, cs[3].z, cs[3].w};
    const float sgn = (d0 == 0) ? -1.0f : 1.0f;
#pragma unroll
    for (int j = 0; j < 8; ++j) v[j] = (d0 < 16) ? v[j] * cv[j] + sgn * o[j] * sv[j] : v[j];
}
__device__ __forceinline__ void l1_prep_phase(Frame& F) {
    const int gw = blockIdx.x * NWAVES + F.wave, NGW = F.G * NWAVES, lane = mk_lane();
    const bf16* P1 = (const bf16*)(F.ws + WS_P1); const float* mu = F.in[I_RWKV_MU]; const float* rope = (const float*)(F.ws + WS_ROPE);
    bf16* ALORA = (bf16*)(F.ws + WS_ALORA); bf16* QD = (bf16*)(F.ws + WS_QD); bf16* KD = (bf16*)(F.ws + WS_KD); bf16* KI = (bf16*)(F.ws + WS_KI); bf16* QI = (bf16*)(F.ws + WS_QI); float* WI = (float*)(F.ws + WS_WI);
    const int colA = PC_WD + 8 * (lane & 31); float muv[8];
#pragma unroll
    for (int j = 0; j < 8; ++j) muv[j] = mu[colA + j];
    const int src3 = (lane < 32) ? (PC_QI + 8 * lane) : ((lane < 40) ? (PC_KD + 8 * (lane - 32)) : ((lane < 48) ? (PC_KI + 8 * (lane & 7)) : (PC_VD + 8 * (lane & 7))));
    bf16* VD = (bf16*)(F.ws + WS_VD);
    for (int t0 = gw; t0 < T_TOK; t0 += 4 * NGW) { v4u cur[4], prv[4], qv[4], s3[4]; f32x4 cs[4][4]; unsigned short wi[4];
#pragma unroll
        for (int r = 0; r < 4; ++r) { const int tok = t0 + r * NGW, tc = tok < T_TOK ? tok : t0; const bf16* row = P1 + (size_t)tc * P1_LD; const int pos = tc & (SEQL - 1); const f32x4* csp = (const f32x4*)(rope + (size_t)pos * 16);
            cur[r] = *(const v4u*)(row + colA); prv[r] = *(const v4u*)((pos != 0 ? row - P1_LD : row) + colA); qv[r] = *(const v4u*)(row + PC_Q + 8 * lane); s3[r] = *(const v4u*)(row + src3);
            cs[r][0] = csp[0]; cs[r][1] = csp[1]; cs[r][2] = csp[2]; cs[r][3] = csp[3]; wi[r] = row[PC_WI + (lane & 3)]; }
#pragma unroll
        for (int r = 0; r < 4; ++r) { const int tok = t0 + r * NGW; const int pos = tok & (SEQL - 1);
            if (tok < T_TOK) {
                { float c8[8], p8[8]; unpack8(cur[r], c8); unpack8(prv[r], p8);
#pragma unroll
                  for (int j = 0; j < 8; ++j) { const float pv = (pos != 0) ? p8[j] : 0.f; const float x = c8[j] + (pv - c8[j]) * muv[j];
                      c8[j] = (lane < 8) ? tanhf(x) : ((lane < 16) ? x : sigmoidf_(x)); }
                  if (lane < 32) store8_bf16(ALORA + (size_t)tok * 256 + 8 * lane, c8); }
                { float v[8]; unpack8(qv[r], v); rope8_pre(v, 8 * (lane & 7), cs[r]);
#pragma unroll
                  for (int j = 0; j < 8; ++j) v[j] *= ATT_C2;
                  store8_bf16(QD + (size_t)tok * 512 + 8 * lane, v); }
                { float v[8]; unpack8(s3[r], v); rope8_pre(v, 8 * (lane & 7), cs[r]);
                  if (lane >= 48 && lane < 56) *(v4u*)(VD + (size_t)tok * 64 + 8 * (lane - 48)) = s3[r];
                  if (lane < 32) store8_bf16(QI + (size_t)tok * 256 + 8 * lane, v);
                  else if (lane < 40) store8_bf16(KD + (size_t)tok * 64 + 8 * (lane - 32), v);
                  else if (lane < 48) store8_bf16(KI + (size_t)tok * 64 + 8 * (lane - 40), v); }
                if (lane < 4) WI[(size_t)tok * 4 + lane] = bf2f(wi[r]) * 0.0625f; } } }
}
#ifndef RP_NB
#define RP_NB 4
#endif
__device__ __forceinline__ void rwkv_post_phase(Frame& F) {
    const int gw = blockIdx.x * NWAVES + F.wave, NGW = F.G * NWAVES, lane = mk_lane(), c0 = 8 * lane;
    const bf16* P1 = (const bf16*)(F.ws + WS_P1); const bf16* LORA = (const bf16*)(F.ws + WS_LORA); const bf16* YR = (const bf16*)(F.ws + WS_YR); bf16* CAT2 = (bf16*)(F.ws + WS_CAT);
    float mur[8], muk[8], muv[8], ka[8], rk[8], lnw[8], lnb[8];
#pragma unroll
    for (int j = 0; j < 8; ++j) { mur[j] = F.in[I_RWKV_MU][PC_R + c0 + j]; muk[j] = F.in[I_RWKV_MU][PC_K + c0 + j]; muv[j] = F.in[I_RWKV_MU][PC_V + c0 + j];
        ka[j] = F.in[I_RWKV_K_A][c0 + j]; rk[j] = F.in[I_RWKV_R_K][c0 + j]; lnw[j] = F.in[I_RWKV_LN_W][c0 + j]; lnb[j] = F.in[I_RWKV_LN_B][c0 + j]; }
    for (int t0 = gw; t0 < T_TOK; t0 += RP_NB * NGW) { v4u L[RP_NB][9];
#pragma unroll
        for (int r = 0; r < RP_NB; ++r) { const int tok = t0 + r * NGW, tc = tok < T_TOK ? tok : t0; const bool first = (tc & (SEQL - 1)) == 0; const bf16* row = P1 + (size_t)tc * P1_LD; const bf16* prow = first ? row : (row - P1_LD);
            L[r][0] = *(const v4u*)(row + PC_R + c0); L[r][1] = *(const v4u*)(row + PC_K + c0); L[r][2] = *(const v4u*)(row + PC_V + c0);
            L[r][3] = *(const v4u*)(prow + PC_R + c0); L[r][4] = *(const v4u*)(prow + PC_K + c0); L[r][5] = *(const v4u*)(prow + PC_V + c0);
            L[r][6] = *(const v4u*)(LORA + (size_t)tc * 1536 + 512 + c0); L[r][7] = *(const v4u*)(LORA + (size_t)tc * 1536 + 1024 + c0); L[r][8] = *(const v4u*)(YR + (size_t)tc * 512 + c0); }
#pragma unroll
        for (int r = 0; r < RP_NB; ++r) { const int tok = t0 + r * NGW; const bool first = (tok & (SEQL - 1)) == 0;
            float rc[8], kc[8], vc[8], rp[8], kp[8], vp[8], a[8], g[8], y[8];
            unpack8(L[r][0], rc); unpack8(L[r][1], kc); unpack8(L[r][2], vc); unpack8(L[r][3], rp); unpack8(L[r][4], kp); unpack8(L[r][5], vp); unpack8(L[r][6], a); unpack8(L[r][7], g); unpack8(L[r][8], y);
            float sy = 0.f, sb = 0.f; float v[8];
#pragma unroll
            for (int j = 0; j < 8; ++j) { const float rr = rc[j] + ((first ? 0.f : rp[j]) - rc[j]) * mur[j], k0 = kc[j] + ((first ? 0.f : kp[j]) - kc[j]) * muk[j]; v[j] = vc[j] + ((first ? 0.f : vp[j]) - vc[j]) * muv[j];
                const float k = k0 * (1.0f + (a[j] - 1.0f) * ka[j]); sb += rr * k * rk[j]; sy += y[j]; }
            const float mean = dpp_sum8(sy) * (1.0f / 64.0f); float sq = 0.f;
#pragma unroll
            for (int j = 0; j < 8; ++j) { y[j] -= mean; sq += y[j] * y[j]; }
            const float rstd = __builtin_amdgcn_rsqf(dpp_sum8(sq) * (1.0f / 64.0f) + 64e-5f), bonus = dpp_sum8(sb);
            float o[8];
#pragma unroll
            for (int j = 0; j < 8; ++j) o[j] = ABL_RWKV ? 0.f : (y[j] * rstd * lnw[j] + lnb[j] + bonus * v[j]) * g[j];
            if (tok < T_TOK) { store8_bf16(CAT2 + (size_t)tok * 1024 + c0, o);
                if (SKIP_DSA) { float z[8] = {0.f, 0.f, 0.f, 0.f, 0.f, 0.f, 0.f, 0.f}; store8_bf16(CAT2 + (size_t)tok * 1024 + 512 + c0, z); } } } }
}
__device__ __forceinline__ void moe_convert_phase(Frame& F) {
    LAS unsigned char* scr = (LAS unsigned char*)(F.lds + F.wave * 16384); const int lane = mk_lane();
    const int gw = blockIdx.x * NWAVES + F.wave, NGW = F.G * NWAVES;
    constexpr int PER = 896, NIT = 3 * 8 * PER;
    unsigned char* WGU = F.ws + WS_WMOE_GU; unsigned char* WD = F.ws + WS_WMOE_D;
#define MC_LOAD(it_, buf) do { const int m_ = (it_) / (8 * PER), r_ = (it_) % (8 * PER), e_ = r_ / PER, q_ = r_ % PER; \
        if (m_ == 0) tr64_load(F.in[I_MOE_GATE] + (size_t)e_ * 1024 * FEXP, FEXP, q_ / 56, q_ % 56, lane, buf); \
        else if (m_ == 1) tr64_load(F.in[I_MOE_UP] + (size_t)e_ * 1024 * FEXP, FEXP, q_ / 56, q_ % 56, lane, buf); \
        else tr64_load(F.in[I_MOE_DOWN] + (size_t)e_ * FEXP * 1024, 1024, q_ / 16, q_ % 16, lane, buf); } while (0)
#define MC_FIN(it_, buf) do { const int m_ = (it_) / (8 * PER), r_ = (it_) % (8 * PER), e_ = r_ / PER, q_ = r_ % PER; \
        if (m_ == 0) tr64_f8_finish<1>(buf, WGU, 1024, e_ * 7168, F.in[I_O_NORM_FFN], MOE_WGU_SCALE, scr, q_ / 56, q_ % 56, lane); \
        else if (m_ == 1) tr64_f8_finish<1>(buf, WGU, 1024, e_ * 7168 + 128, F.in[I_O_NORM_FFN], MOE_WGU_SCALE, scr, q_ / 56, q_ % 56, lane); \
        else tr64_f8_finish<0>(buf, WD, FEXP, e_ * 1024, nullptr, MOE_WD_SCALE, scr, q_ / 16, q_ % 16, lane); } while (0)
    f32x4 va[16], vb[16];
    int it = gw; if (it < NIT) MC_LOAD(it, va);
    for (; it < NIT; it += 2 * NGW) { const int it2 = it + NGW, it3 = it + 2 * NGW;
        if (it2 < NIT) MC_LOAD(it2, vb);
        MC_FIN(it, va);
        if (it3 < NIT) MC_LOAD(it3, va);
        if (it2 < NIT) MC_FIN(it2, vb); }
#undef MC_LOAD
#undef MC_FIN
}
__device__ __forceinline__ f32x4 ld_res4(const bf16* RESb, int tok, int lane, int j) {
    const v2u w = ((const v2u*)(RESb + (size_t)tok * RES_LD))[lane + 64 * j]; return (f32x4){bflo(w.x), bfhi(w.x), bflo(w.y), bfhi(w.y)}; }
__device__ __forceinline__ void router_phase(Frame& F, int cnt_off = 0) {
    const int lane = mk_lane(), tid = F.wave * 64 + lane;
    const float* gn = F.in[I_O_NORM_FFN]; const float* rt = F.in[I_MOE_ROUTER]; unsigned* cnt = (unsigned*)(F.ws + WS_CTL) + CW_EXPCNT + cnt_off; v2u* info = (v2u*)(F.ws + WS_TOKINFO);
    LAS unsigned* lcnt = (LAS unsigned*)F.lds; LAS unsigned* gbase = lcnt + 8; LAS v4u* lrec = (LAS v4u*)(F.lds + 64);
    for (int tb = blockIdx.x * 128; tb < T_TOK; tb += F.G * 128) {
        if (tid < 8) lcnt[tid] = 0u;
        __syncthreads();
        f32x4 vn[4];
        {
#pragma unroll
          for (int j = 0; j < 4; ++j) vn[j] = ld_res4((const bf16*)F.out, tb + F.wave * 16, lane, j); }
#pragma unroll 1
        for (int i = 0; i < 16; ++i) { const int tl = F.wave * 16 + i, tok = tb + tl; f32x4 v[4]; float s = 0.f;
#pragma unroll
            for (int j = 0; j < 4; ++j) v[j] = vn[j];
            {
#pragma unroll
              for (int j = 0; j < 4; ++j) vn[j] = ld_res4((const bf16*)F.out, tok + (i < 15 ? 1 : 0), lane, j); }
#pragma unroll
            for (int j = 0; j < 4; ++j) s += (v[j].x * v[j].x + v[j].y * v[j].y) + (v[j].z * v[j].z + v[j].w * v[j].w);
            const float rstd = __builtin_amdgcn_rsqf(wave_sum(s) * (1.f / DMODEL) + NORM_EPS);
            float lg[8] = {0.f, 0.f, 0.f, 0.f, 0.f, 0.f, 0.f, 0.f};
#pragma unroll
            for (int j = 0; j < 4; ++j) { const int k0 = 4 * (lane + 64 * j); const f32x4 gg = *(const f32x4*)(gn + k0); const float xv[4] = {v[j].x * rstd * gg.x, v[j].y * rstd * gg.y, v[j].z * rstd * gg.z, v[j].w * rstd * gg.w};
#pragma unroll
                for (int q = 0; q < 4; ++q) { const f32x4 w0 = *(const f32x4*)(rt + (size_t)(k0 + q) * 8), w1 = *(const f32x4*)(rt + (size_t)(k0 + q) * 8 + 4);
                    lg[0] += xv[q] * w0.x; lg[1] += xv[q] * w0.y; lg[2] += xv[q] * w0.z; lg[3] += xv[q] * w0.w; lg[4] += xv[q] * w1.x; lg[5] += xv[q] * w1.y; lg[6] += xv[q] * w1.z; lg[7] += xv[q] * w1.w; } }
#pragma unroll
            for (int e = 0; e < 8; ++e) lg[e] = wave_sum(lg[e]);
            int e1 = 0; float l1 = lg[0];
#pragma unroll
            for (int e = 1; e < 8; ++e) if (lg[e] > l1) { l1 = lg[e]; e1 = e; }
            int e2 = -1; float l2 = -INFINITY;
#pragma unroll
            for (int e = 0; e < 8; ++e) if (e != e1 && lg[e] > l2) { l2 = lg[e]; e2 = e; }
            const float g1 = 1.0f / (1.0f + __expf(l2 - l1)), g2 = 1.0f - g1;
            if (lane == 0) { const unsigned r1 = __hip_atomic_fetch_add(lcnt + e1, 1u, __ATOMIC_RELAXED, __HIP_MEMORY_SCOPE_WORKGROUP), r2 = __hip_atomic_fetch_add(lcnt + e2, 1u, __ATOMIC_RELAXED, __HIP_MEMORY_SCOPE_WORKGROUP);
                lrec[tl] = (v4u){((unsigned)e1 << 24) | r1, __builtin_bit_cast(unsigned, g1), ((unsigned)e2 << 24) | r2, __builtin_bit_cast(unsigned, g2)}; } }
        __syncthreads();
        if (tid < 8) gbase[tid] = atomicAdd(cnt + 64 * tid, lcnt[tid]);
        __syncthreads();
        if (tid < 128) { const v4u r = lrec[tid]; const unsigned b1 = gbase[r.x >> 24], b2 = gbase[r.z >> 24];
            ((v4u*)info)[(size_t)(tb + tid)] = (v4u){r.x + b1, r.y, r.z + b2, r.w}; }
        __syncthreads(); }
}
__device__ __forceinline__ void moe_scatter_phase(Frame& F) {
    const int gw = blockIdx.x * NWAVES + F.wave, NGW = F.G * NWAVES, lane = mk_lane();
    const unsigned* cnt = (const unsigned*)(F.ws + WS_CTL) + CW_EXPCNT; const v2u* info = (const v2u*)(F.ws + WS_TOKINFO); int* tokslot = (int*)(F.ws + WS_TOKSLOT); int* tile_exp = (int*)(F.ws + WS_TILEEXP);
    int pstart[8]; int acc = 0;
#pragma unroll
    for (int e = 0; e < 8; ++e) { const int c = (int)__hip_atomic_load(cnt + 64 * e, __ATOMIC_RELAXED, __HIP_MEMORY_SCOPE_AGENT); pstart[e] = acc; acc += (c + 255) & ~255; }
    const int ntiles = acc >> 8;
    if (blockIdx.x == 0 && F.wave == 0) { for (int t = lane; t < 512; t += 64) { int e = 7;
#pragma unroll
            for (int q = 7; q >= 1; --q) if (t * 256 < pstart[q]) e = q - 1;
            tile_exp[t] = (t == 511) ? ntiles : e; } }
    unsigned char* XG = F.ws + WS_XG;
    for (int t0 = gw; t0 < T_TOK; t0 += 4 * NGW) { f32x4 v[4][4]; v2u inf[4][2];
#pragma unroll
        for (int r = 0; r < 4; ++r) { const int tok = t0 + r * NGW, tc = tok < T_TOK ? tok : t0;
#pragma unroll
            for (int j = 0; j < 4; ++j) v[r][j] = ld_res4((const bf16*)F.out, tc, lane, j);
            inf[r][0] = info[(size_t)tc * 2]; inf[r][1] = info[(size_t)tc * 2 + 1]; }
#pragma unroll
        for (int r = 0; r < 4; ++r) { const int tok = t0 + r * NGW; float s = 0.f;
#pragma unroll
            for (int j = 0; j < 4; ++j) s += (v[r][j].x * v[r][j].x + v[r][j].y * v[r][j].y) + (v[r][j].z * v[r][j].z + v[r][j].w * v[r][j].w);
            const float rstd = __builtin_amdgcn_rsqf(wave_sum(s) * (1.f / DMODEL) + NORM_EPS);
            unsigned w[4];
#pragma unroll
            for (int j = 0; j < 4; ++j) w[j] = pk4_fp8(v[r][j].x * rstd, v[r][j].y * rstd, v[r][j].z * rstd, v[r][j].w * rstd);
            if (tok < T_TOK) {
#pragma unroll
                for (int k = 0; k < 2; ++k) { const int e = (int)(inf[r][k].x >> 24), rank = (int)(inf[r][k].x & 0xffffffu);
                    int ps = 0;
#pragma unroll
                    for (int q = 0; q < 8; ++q) ps = (e == q) ? pstart[q] : ps;
                    const int slot = ps + rank; unsigned* o4 = (unsigned*)(XG + (size_t)slot * 1024) + lane;
#pragma unroll
                    for (int j = 0; j < 4; ++j) o4[64 * j] = w[j];
                    if (lane == 0) tokslot[(size_t)tok * 2 + k] = slot; } } } }
}
__device__ __forceinline__ void moe_combine_final_phase(Frame& F, float* outp = nullptr) {
    if (outp == nullptr) outp = F.out;
    const int gw = blockIdx.x * NWAVES + F.wave, NGW = F.G * NWAVES, lane = mk_lane(); const float* gn = F.in[I_FINAL_NORM];
    const v2u* info = (const v2u*)(F.ws + WS_TOKINFO); const int* tokslot = (const int*)(F.ws + WS_TOKSLOT); const bf16* YS = (const bf16*)(F.ws + WS_YS);
    f32x4 gv[4];
#pragma unroll
    for (int j = 0; j < 4; ++j) gv[j] = ((const f32x4*)gn)[lane + 64 * j];
#if RWKV_DBG
    { const unsigned long long* ck = (const unsigned long long*)(F.ws + WS_CTL) + 200; int code = 0;
      for (int arr = 3; arr >= 0; --arr) if (ck[arr] != ck[4 + arr]) code = arr + 1;
      const float ds = 1.0f + 0.5f * code; for (int j = 0; j < 4; ++j) gv[j] = gv[j] * ds; }
#endif
#if STAMP_KA >= 0
    { const float fr = ((const float*)(F.ws + WS_TILEEXP + 4096))[0]; const float ds = 1.0f + 0.08f * sqrtf(fminf(fmaxf(fr, 0.f), 1.f));
      for (int j = 0; j < 4; ++j) gv[j] = gv[j] * ds; }
#endif
    for (int t0 = gw; t0 < T_TOK; t0 += 4 * NGW) { f32x4 v[4][4]; float gk[4][2]; int sl[4][2]; v2u ys[4][2][4];
#pragma unroll
        for (int r = 0; r < 4; ++r) { const int tok = t0 + r * NGW, tc = tok < T_TOK ? tok : t0;
#pragma unroll
            for (int j = 0; j < 4; ++j) v[r][j] = ld_res4((const bf16*)F.out, tc, lane, j);
#pragma unroll
            for (int k = 0; k < 2; ++k) { const unsigned gkb = info[(size_t)tc * 2 + k].y; gk[r][k] = MOE_SCALE * __builtin_bit_cast(float, gkb); sl[r][k] = tokslot[(size_t)tc * 2 + k]; } }
#pragma unroll
        for (int r = 0; r < 4; ++r)
#pragma unroll
            for (int k = 0; k < 2; ++k) { const v2u* yr = (const v2u*)(YS + (size_t)sl[r][k] * 1024) + lane;
#pragma unroll
                for (int j = 0; j < 4; ++j) ys[r][k][j] = yr[64 * j]; }
#pragma unroll
        for (int r = 0; r < 4; ++r) { const int tok = t0 + r * NGW;
#pragma unroll
            for (int k = 0; k < 2; ++k)
#pragma unroll
                for (int j = 0; j < 4; ++j) { v2u w = ys[r][k][j]; if (ABL_MOE) w = (v2u){0u, 0u}; v[r][j].x += gk[r][k] * bflo(w.x); v[r][j].y += gk[r][k] * bfhi(w.x); v[r][j].z += gk[r][k] * bflo(w.y); v[r][j].w += gk[r][k] * bfhi(w.y); }
            float s = 0.f;
#pragma unroll
            for (int j = 0; j < 4; ++j) s += (v[r][j].x * v[r][j].x + v[r][j].y * v[r][j].y) + (v[r][j].z * v[r][j].z + v[r][j].w * v[r][j].w);
            const float rstd = __builtin_amdgcn_rsqf(wave_sum(s) * (1.f / DMODEL) + NORM_EPS);
            if (tok < T_TOK) { f32x4* xo = (f32x4*)(outp + (size_t)tok * DMODEL) + lane;
#pragma unroll
                for (int j = 0; j < 4; ++j) xo[64 * j] = v[r][j] * rstd * gv[j]; } } }
}

constexpr int RW_BLOCKS = 64;
constexpr int RW_STEPS = 32, RW_REC = 5 * 64, RW_BUF_FLOATS = RW_STEPS * RW_REC + RW_STEPS * 32;
__device__ __forceinline__ void rwkv_produce(Frame& F, LAS float* buf, int b, int h, int half, int j, int pw, int lane) {
    const bf16* P1 = (const bf16*)(F.ws + WS_P1); const bf16* LORA = (const bf16*)(F.ws + WS_LORA);
    const float* mu = F.in[I_RWKV_MU]; const int ch = h * 64 + lane;
    const float mu_r = mu[PC_R + ch], mu_k = mu[PC_K + ch], mu_v = mu[PC_V + ch], kkw = F.in[I_RWKV_K_K][ch], kaw = F.in[I_RWKV_K_A][ch];
    float rc[8], kc[8], vc[8], rp[8], kp[8], vp[8], lw[8], al[8];
#pragma unroll
    for (int i = 0; i < 8; ++i) { const int tt = 8 * pw + i, pos = 32 * j + tt; const size_t tok = (size_t)b * SEQL + pos; const bf16* row = P1 + tok * P1_LD; const bf16* prow = (pos == 0) ? row : (row - P1_LD);
        rc[i] = bf2f(row[PC_R + ch]); kc[i] = bf2f(row[PC_K + ch]); vc[i] = bf2f(row[PC_V + ch]);
        rp[i] = bf2f(prow[PC_R + ch]); kp[i] = bf2f(prow[PC_K + ch]); vp[i] = bf2f(prow[PC_V + ch]);
        lw[i] = bf2f(LORA[tok * 1536 + ch]); al[i] = bf2f(LORA[tok * 1536 + 512 + ch]); }
#pragma unroll
    for (int i = 0; i < 8; ++i) { const int tt = 8 * pw + i, pos = 32 * j + tt; const bool first = (pos == 0);
        const float r = rc[i] + ((first ? 0.f : rp[i]) - rc[i]) * mu_r, k0 = kc[i] + ((first ? 0.f : kp[i]) - kc[i]) * mu_k, v = vc[i] + ((first ? 0.f : vp[i]) - vc[i]) * mu_v;
        const float kkv = k0 * kkw; const float nrm = sqrtf(wave_sum(kkv * kkv)); const float kk = kkv / fmaxf(nrm, 1e-12f);
        const float a = al[i]; LAS float* rec = buf + tt * RW_REC;
        rec[lane] = __expf(lw[i]); rec[64 + lane] = -kk; rec[128 + lane] = kk * a; rec[192 + lane] = k0 * (1.0f + (a - 1.0f) * kaw); rec[256 + lane] = r;
        if ((lane >> 5) == half) buf[RW_STEPS * RW_REC + tt * 32 + (lane & 31)] = v; }
}
__device__ __forceinline__ void rwkv_seq_block(Frame& F, int blk) {
    const int bh = blk >> 1, half = blk & 1, b = bh >> 3, h = bh & 7; const int lane = mk_lane(), wave = F.wave;
    LAS float* buf0 = (LAS float*)F.lds; LAS float* buf1 = buf0 + RW_BUF_FLOATS;
    bf16* YR = (bf16*)(F.ws + WS_YR);
    const int rowl = 8 * (wave & 3) + (lane >> 3), kg = lane & 7;
    f32x2 s[4] = {{0.f, 0.f}, {0.f, 0.f}, {0.f, 0.f}, {0.f, 0.f}};
    if (wave >= 4) rwkv_produce(F, buf0, b, h, half, 0, wave - 4, lane);
    __syncthreads();
    for (int j = 0; j < SEQL / RW_STEPS; ++j) { LAS float* cur = (j & 1) ? buf1 : buf0; LAS float* nxt = (j & 1) ? buf0 : buf1;
        if (wave >= 4) { if (j + 1 < SEQL / RW_STEPS) rwkv_produce(F, nxt, b, h, half, j + 1, wave - 4, lane); }
        else { bf16* yo = YR + ((size_t)b * SEQL + 32 * j) * 512 + h * 64 + 32 * half + rowl;
#pragma unroll 4
            for (int t = 0; t < RW_STEPS; ++t) { const LAS float* rec = cur + t * RW_REC + 8 * kg;
                const f32x4 w0 = *(const LAS f32x4*)(rec), w1 = *(const LAS f32x4*)(rec + 4), a0 = *(const LAS f32x4*)(rec + 64), a1 = *(const LAS f32x4*)(rec + 68);
                const f32x4 b0 = *(const LAS f32x4*)(rec + 128), b1 = *(const LAS f32x4*)(rec + 132), k0 = *(const LAS f32x4*)(rec + 192), k1 = *(const LAS f32x4*)(rec + 196);
                const f32x4 r0 = *(const LAS f32x4*)(rec + 256), r1 = *(const LAS f32x4*)(rec + 260);
                const float vv = cur[RW_STEPS * RW_REC + t * 32 + rowl];
                f32x2 sa2 = s[0] * (f32x2){a0.x, a0.y} + s[1] * (f32x2){a0.z, a0.w} + s[2] * (f32x2){a1.x, a1.y} + s[3] * (f32x2){a1.z, a1.w};
                const float sa = dpp_sum8(sa2.x + sa2.y); const f32x2 sav = {sa, sa}, vvv = {vv, vv};
                s[0] = s[0] * (f32x2){w0.x, w0.y} + sav * (f32x2){b0.x, b0.y} + vvv * (f32x2){k0.x, k0.y};
                s[1] = s[1] * (f32x2){w0.z, w0.w} + sav * (f32x2){b0.z, b0.w} + vvv * (f32x2){k0.z, k0.w};
                s[2] = s[2] * (f32x2){w1.x, w1.y} + sav * (f32x2){b1.x, b1.y} + vvv * (f32x2){k1.x, k1.y};
                s[3] = s[3] * (f32x2){w1.z, w1.w} + sav * (f32x2){b1.z, b1.w} + vvv * (f32x2){k1.z, k1.w};
                f32x2 y2 = s[0] * (f32x2){r0.x, r0.y} + s[1] * (f32x2){r0.z, r0.w} + s[2] * (f32x2){r1.x, r1.y} + s[3] * (f32x2){r1.z, r1.w};
                const float y = dpp_sum8(y2.x + y2.y);
                if (kg == 0) yo[(size_t)t * 512] = (bf16)f2bf(y); } }
        __syncthreads(); }
}

typedef float f32x4_t __attribute__((ext_vector_type(4)));
constexpr int DSA_SEL_OFF = 131072 + 1024, DSA_META_OFF = DSA_SEL_OFF + 16 * 256 * 2, DSA_CAND_CAP = 1024;
constexpr int CW_DSAQ = CW_EXPCNT + 8 * 64;
static_assert(DSA_META_OFF + 512 <= MISC_OFF && (CW_DSAQ + 128) * 4 <= (int)CTL_ZERO_BYTES, "dsa lds / ctl map");
__device__ __forceinline__ unsigned f32_order_key(float x) { x = x + 0.0f; const unsigned u = __builtin_bit_cast(unsigned, x); return (u & 0x80000000u) ? ~u : (u | 0x80000000u); }
template <int MODE, bool DRY = false>
__device__ __forceinline__ void dsa_score_pass(const bf16* __restrict__ KIb, const bf16x8 (&qa)[4][2], const float (&wq)[4][4], int t0, int ktb, int nkt, int wave, int lane,
                                               LAS unsigned* hist, LAS unsigned short* sel, LAS int* meta, bool use_lo) {
    const int g = lane >> 4, c = lane & 15;
    int bst[4] = {0, 0, 0, 0};
#pragma unroll
    for (int m = 0; m < 4; ++m) bst[m] = (MODE == 1) ? meta[4 * m + g] : (use_lo ? meta[64 + 4 * m + g] : 0);
#define DSA_LOADK(dst, kt0_) do { _Pragma("unroll") for (int u = 0; u < 4; ++u) { const int kt = (kt0_) + 8 * u, ktc = kt < nkt ? kt : (nkt - 1); const bf16* kp = KIb + (size_t)(16 * ktc + c) * 64 + 8 * g; \
        dst[u][0] = *(const bf16x8*)kp; dst[u][1] = *(const bf16x8*)(kp + 32); } } while (0)
#define DSA_TRIP(kb, kt0_) do { _Pragma("unroll") for (int u = 0; u < 4; ++u) { const int kt = (kt0_) + 8 * u; if (kt < nkt) { const int key = 16 * kt + c; const bool full = (16 * kt + 15 <= t0); \
        f32x4_t accm[4]; \
        _Pragma("unroll") for (int m = 0; m < 4; ++m) { f32x4_t z_ = {0.f, 0.f, 0.f, 0.f}; z_ = __builtin_amdgcn_mfma_f32_16x16x32_bf16(qa[m][0], kb[u][0], z_, 0, 0, 0); accm[m] = __builtin_amdgcn_mfma_f32_16x16x32_bf16(qa[m][1], kb[u][1], z_, 0, 0, 0); } \
        _Pragma("unroll") for (int m = 0; m < 4; ++m) { \
            float sc = __builtin_fmaf(__builtin_amdgcn_fmed3f(accm[m][0], 0.f, 3.0e38f), wq[m][0], 0.0f); sc = __builtin_fmaf(__builtin_amdgcn_fmed3f(accm[m][1], 0.f, 3.0e38f), wq[m][1], sc); \
            sc = __builtin_fmaf(__builtin_amdgcn_fmed3f(accm[m][2], 0.f, 3.0e38f), wq[m][2], sc); sc = __builtin_fmaf(__builtin_amdgcn_fmed3f(accm[m][3], 0.f, 3.0e38f), wq[m][3], sc); \
            const int q = 4 * m + g; const unsigned ub = __builtin_bit_cast(unsigned, sc); const unsigned uk = ub ^ ((unsigned)((int)ub >> 31) | 0x80000000u); \
            if (full || key <= t0 + q) { \
                if (MODE == 2) { dry += uk; } else if (MODE == 0) { if (uk >= bstk[m]) __hip_atomic_fetch_add(hist + q * 2048 + (uk >> 21), DRY ? 0u : (1u << ((uk >> 16) & 16u)), __ATOMIC_RELAXED, __HIP_MEMORY_SCOPE_WORKGROUP); } \
                else { if (uk >= bstk[m] + 0x100000u) { const int p = __hip_atomic_fetch_add((LAS unsigned*)(meta + 32 + q), DRY ? 0u : 1u, __ATOMIC_RELAXED, __HIP_MEMORY_SCOPE_WORKGROUP); if (p < (DRY ? dryz : 256)) sel[q * 256 + p] = (unsigned short)key; } \
                       else if (uk >= bstk[m]) { const int p = __hip_atomic_fetch_add((LAS unsigned*)(meta + 48 + q), DRY ? 0u : 1u, __ATOMIC_RELAXED, __HIP_MEMORY_SCOPE_WORKGROUP); \
                           if (p < (DRY ? dryz : DSA_CAND_CAP)) { hist[(q * DSA_CAND_CAP + p) * 2] = uk; hist[(q * DSA_CAND_CAP + p) * 2 + 1] = (unsigned)key; } } } } } } } } while (0)
    unsigned bstk[4]; unsigned dry = 0; const int dryz = meta[126];
#pragma unroll
    for (int m = 0; m < 4; ++m) bstk[m] = (unsigned)bst[m] << 20;
    bf16x8 kbA[4][2], kbB[4][2];
    DSA_LOADK(kbA, ktb + wave);
    for (int kt0 = ktb + wave; kt0 < nkt; kt0 += 64) {
        if (kt0 + 32 < nkt) DSA_LOADK(kbB, kt0 + 32);
        DSA_TRIP(kbA, kt0);
        if (kt0 + 32 < nkt) { if (kt0 + 64 < nkt) DSA_LOADK(kbA, kt0 + 64); DSA_TRIP(kbB, kt0 + 32); } }
#undef DSA_LOADK
#undef DSA_TRIP
    if (MODE == 2 && dry == 0x12345678u) meta[127] = 1;
}
__device__ __forceinline__ void dsa_tile(Frame& F, int item) {
    const int lane = mk_lane(), wave = F.wave, tid = wave * 64 + lane;
    const int b = item & 3, ti = 511 - (item >> 2), t0 = 16 * ti, nkt = ti + 1; const size_t tok0 = (size_t)b * SEQL + t0;
    LAS unsigned* hist = (LAS unsigned*)F.lds; LAS unsigned short* sel = (LAS unsigned short*)(F.lds + DSA_SEL_OFF); LAS int* meta = (LAS int*)(F.lds + DSA_META_OFF);
    const bf16* QI = (const bf16*)(F.ws + WS_QI); const bf16* KIb = (const bf16*)(F.ws + WS_KI) + (size_t)b * SEQL * 64; const float* WI = (const float*)(F.ws + WS_WI);
    const int g = lane >> 4, c = lane & 15;
    if (ti >= 16) {
        for (int i = tid; i < 32768 / 4; i += 512) ((LAS v4u*)hist)[i] = (v4u){0u, 0u, 0u, 0u};
        if (tid < 96 || tid == 126) meta[tid] = 0;
        bf16x8 qa[4][2]; float wq[4][4];
#pragma unroll
        for (int m = 0; m < 4; ++m) { const bf16* qp = QI + (tok0 + 4 * m + (c >> 2)) * 256 + (c & 3) * 64 + 8 * g; qa[m][0] = *(const bf16x8*)qp; qa[m][1] = *(const bf16x8*)(qp + 32);
            const f32x4 w4 = *(const f32x4*)(WI + (tok0 + 4 * m + g) * 4); wq[m][0] = w4.x; wq[m][1] = w4.y; wq[m][2] = w4.z; wq[m][3] = w4.w; }
        __syncthreads();
#define DSA_BOUNDARY(OUT_BIN, OUT_NA) do { _Pragma("unroll 1") for (int qq = 0; qq < 2; ++qq) { const int q = 2 * wave + qq; const LAS unsigned* hw = hist + q * 2048 + 32 * lane; unsigned s_ = 0; \
              \
            _Pragma("unroll") for (int i = 0; i < 32; ++i) { const unsigned w = hw[(i + lane) & 31]; s_ += (w & 0xffffu) + (w >> 16); } \
            unsigned tsum = s_; \
            _Pragma("unroll") for (int off = 1; off < 64; off <<= 1) { const unsigned o = __shfl_down(tsum, off); tsum += (lane + off < 64) ? o : 0u; } \
            const unsigned above = tsum - s_; \
            const unsigned long long hit = __ballot(above < 256u && tsum >= 256u); const int Lh = hit ? (int)__builtin_ctzll(hit) : 0; \
            const unsigned aboveL = (unsigned)__shfl((int)above, Lh); \
            const int bin = 64 * Lh + lane; const unsigned wv = hist[q * 2048 + (bin >> 1)]; const unsigned cn = (bin & 1) ? (wv >> 16) : (wv & 0xffffu); \
            unsigned t2 = cn; \
            _Pragma("unroll") for (int off = 1; off < 64; off <<= 1) { const unsigned o = __shfl_down(t2, off); t2 += (lane + off < 64) ? o : 0u; } \
            const unsigned ab2 = t2 - cn + aboveL; \
            if (ab2 < 256u && ab2 + cn >= 256u) { meta[(OUT_BIN) + q] = bin; if ((OUT_NA) >= 0) meta[(OUT_NA) + q] = (int)ab2; } } } while (0)
        const int npre = (nkt >= 64) ? (((nkt >> 3) + 7) & ~7) < 32 ? 32 : (((nkt >> 3) + 7) & ~7) : nkt;
        dsa_score_pass<0>(KIb, qa, wq, t0, 0, npre, wave, lane, hist, sel, meta, false);
        __syncthreads();
        if (npre < nkt) { DSA_BOUNDARY(64, -1); __syncthreads();
            dsa_score_pass<0>(KIb, qa, wq, t0, npre, nkt, wave, lane, hist, sel, meta, true);
            __syncthreads(); }
        DSA_BOUNDARY(0, 16);
        __syncthreads();
        if (DSA_DUP_KIND & 1) { dsa_score_pass<0, true>(KIb, qa, wq, t0, 0, npre, wave, lane, hist, sel, meta, false); __syncthreads(); }
        if ((DSA_DUP_KIND & 2) && npre < nkt) { dsa_score_pass<0, true>(KIb, qa, wq, t0, npre, nkt, wave, lane, hist, sel, meta, true); __syncthreads(); }
        if (DSA_DUP_KIND & 16) { DSA_BOUNDARY(0, 16); __syncthreads(); DSA_BOUNDARY(0, 16); __syncthreads(); }
#undef DSA_BOUNDARY
        if (DSA_DUP_PASS) dsa_score_pass<2>(KIb, qa, wq, t0, 0, nkt, wave, lane, hist, sel, meta, false);
        dsa_score_pass<1>(KIb, qa, wq, t0, 0, nkt, wave, lane, hist, sel, meta, false);
        __syncthreads();
        if (DSA_DUP_KIND & 4) { dsa_score_pass<1, true>(KIb, qa, wq, t0, 0, nkt, wave, lane, hist, sel, meta, false); __syncthreads(); }
#pragma unroll 1
        for (int qq0 = 0; qq0 < ((DSA_DUP_KIND & 8) ? 4 : 2); ++qq0) { const int qq = qq0 & 1; const bool rdry = qq0 >= 2; const int q = 2 * wave + qq;
            int n = __builtin_amdgcn_readfirstlane(meta[48 + q]); n = n < DSA_CAND_CAP ? n : DSA_CAND_CAP; const int nab = __builtin_amdgcn_readfirstlane(meta[16 + q]); const int R = 256 - nab;
            const LAS v2u* cd = (const LAS v2u*)(hist + (size_t)q * DSA_CAND_CAP * 2);
            unsigned ck[16], ci[16];
#pragma unroll
            for (int j2 = 0; j2 < 16; ++j2) { const int c_ = lane + 64 * j2; v2u e = {0u, 0u}; if (c_ < n) e = cd[c_]; ck[j2] = (c_ < n) ? (e.x & 0xFFFFFu) + 1u : 0u; ci[j2] = e.y; }
            unsigned T = 0;
#pragma unroll 1
            for (int bit = 20; bit >= 0; --bit) { const unsigned trial = T | (1u << bit); int cnt = 0;
#pragma unroll
                for (int j2 = 0; j2 < 16; ++j2) cnt += __builtin_popcountll(__ballot(ck[j2] >= trial));
                if (cnt >= R) T = trial; }
            int cgt = 0, ceq = 0;
#pragma unroll
            for (int j2 = 0; j2 < 16; ++j2) { cgt += __builtin_popcountll(__ballot(ck[j2] > T)); ceq += __builtin_popcountll(__ballot(ck[j2] == T)); }
            const int need = R - cgt; unsigned I = 0xFFFFu;
            if (ceq > need) { I = 0;
#pragma unroll 1
                for (int bit = 12; bit >= 0; --bit) { const unsigned trial = I | (1u << bit); int cnt = 0;
#pragma unroll
                    for (int j2 = 0; j2 < 16; ++j2) cnt += __builtin_popcountll(__ballot(ck[j2] == T && ci[j2] < trial));
                    if (cnt < need) I = trial; } }
            int base = nab;
#pragma unroll
            for (int j2 = 0; j2 < 16; ++j2) { const bool s_ = (ck[j2] > T) || (ck[j2] == T && ci[j2] <= I); const unsigned long long m_ = __ballot(s_);
                const int p = base + (int)__builtin_amdgcn_mbcnt_hi((unsigned)(m_ >> 32), __builtin_amdgcn_mbcnt_lo((unsigned)m_, 0u));
                if (s_ && p < 256 && !rdry) sel[q * 256 + p] = (unsigned short)ci[j2];
                base += __builtin_popcountll(m_); } }
    } else {
        for (int i = tid; i < 16 * 256; i += 512) sel[i] = (unsigned short)(i & 255);
    }
    __syncthreads();
    const bf16* QD = (const bf16*)(F.ws + WS_QD); const bf16* KD = (const bf16*)(F.ws + WS_KD) + (size_t)b * SEQL * 64; const bf16* VDb = (const bf16*)(F.ws + WS_VD) + (size_t)b * SEQL * 64;
    bf16* CAT2 = (bf16*)(F.ws + WS_CAT);
    bf16x8 esel[2];
#pragma unroll
    for (int d = 0; d < 2; ++d)
#pragma unroll
        for (int j = 0; j < 8; ++j) esel[d][j] = (8 * g + j == 16 * d + c) ? (short)0x3F80 : (short)0;
#pragma unroll 1
    for (int qq0 = 0; qq0 < ((DSA_DUP_ATT || (DSA_DUP_KIND & 32)) ? 4 : 2); ++qq0) { const int qq = qq0 & 1; const int q = 2 * wave + qq; const int pos = t0 + q; const size_t tok = tok0 + q; const int nsel = (pos + 1 < 256) ? (pos + 1) : 256;
        bf16x8 qb[2];
        { const bf16* qp = QD + tok * 512 + (c & 7) * 64 + 8 * g; qb[0] = *(const bf16x8*)qp; qb[1] = *(const bf16x8*)(qp + 32);
          if (c >= 8) { qb[0] = (bf16x8){0, 0, 0, 0, 0, 0, 0, 0}; qb[1] = qb[0]; } }
        f32x4_t st[16];
        {
            bf16x8 kaA[4][2], kaB[4][2];
#define DSA_LDK(dst, bt) do { _Pragma("unroll") for (int i = 0; i < 4; ++i) { const int idx = 16 * (4 * (bt) + i) + c; const int key = (idx < nsel) ? (int)sel[q * 256 + idx] : 0; const bf16* kp = KD + (size_t)key * 64 + 8 * g; \
                dst[i][0] = *(const bf16x8*)kp; dst[i][1] = *(const bf16x8*)(kp + 32); } } while (0)
#define DSA_MMK(src, bt) do { _Pragma("unroll") for (int i = 0; i < 4; ++i) { f32x4_t a = {0.f, 0.f, 0.f, 0.f}; \
                a = __builtin_amdgcn_mfma_f32_16x16x32_bf16(src[i][0], qb[0], a, 0, 0, 0); a = __builtin_amdgcn_mfma_f32_16x16x32_bf16(src[i][1], qb[1], a, 0, 0, 0); \
                _Pragma("unroll") for (int j = 0; j < 4; ++j) if (16 * (4 * (bt) + i) + 4 * g + j >= nsel) a[j] = -INFINITY; \
                st[4 * (bt) + i] = a; } } while (0)
            bf16x8 kaC[4][2];
            DSA_LDK(kaA, 0); DSA_LDK(kaB, 1); DSA_LDK(kaC, 2); DSA_MMK(kaA, 0); DSA_LDK(kaA, 3); DSA_MMK(kaB, 1); DSA_MMK(kaC, 2); DSA_MMK(kaA, 3);
#undef DSA_LDK
#undef DSA_MMK
        }
        float mx = -INFINITY;
#pragma unroll
        for (int i = 0; i < 16; ++i) mx = fmaxf(fmaxf(mx, fmaxf(st[i][0], st[i][1])), fmaxf(st[i][2], st[i][3]));
        mx = fmaxf(mx, __shfl_xor(mx, 16)); mx = fmaxf(mx, __shfl_xor(mx, 32));
        float ls = 0.f;
#pragma unroll
        for (int i = 0; i < 16; ++i) {
#pragma unroll
            for (int j = 0; j < 4; ++j) { const float p = __builtin_amdgcn_exp2f(st[i][j] - mx); st[i][j] = p; ls += p; } }
        ls += __shfl_xor(ls, 16); ls += __shfl_xor(ls, 32);
        f32x4_t o[4] = {{0.f, 0.f, 0.f, 0.f}, {0.f, 0.f, 0.f, 0.f}, {0.f, 0.f, 0.f, 0.f}, {0.f, 0.f, 0.f, 0.f}};
        bf16x8 vnx[2][2];
#pragma unroll
        for (int tt = 0; tt < 2; ++tt) { const int idx = 16 * tt + c; const int key = (idx < nsel) ? (int)sel[q * 256 + idx] : 0; const bf16* vp = VDb + (size_t)key * 64 + 8 * g; vnx[tt][0] = *(const bf16x8*)vp; vnx[tt][1] = *(const bf16x8*)(vp + 32); }
#pragma unroll
        for (int ks = 0; ks < 8; ++ks) { v4u pw; pw.x = pk2(st[2 * ks][0], st[2 * ks][1]); pw.y = pk2(st[2 * ks][2], st[2 * ks][3]); pw.z = pk2(st[2 * ks + 1][0], st[2 * ks + 1][1]); pw.w = pk2(st[2 * ks + 1][2], st[2 * ks + 1][3]);
            const bf16x8 pa = __builtin_bit_cast(bf16x8, pw);
            bf16x8 vcur[2][2];
#pragma unroll
            for (int tt = 0; tt < 2; ++tt) { vcur[tt][0] = vnx[tt][0]; vcur[tt][1] = vnx[tt][1]; }
            if (ks < 7) {
#pragma unroll
                for (int tt = 0; tt < 2; ++tt) { const int idx = 16 * (2 * ks + 2 + tt) + c; const int key = (idx < nsel) ? (int)sel[q * 256 + idx] : 0; const bf16* vp = VDb + (size_t)key * 64 + 8 * g; vnx[tt][0] = *(const bf16x8*)vp; vnx[tt][1] = *(const bf16x8*)(vp + 32); } }
            f32x4_t tr[2][4];
#pragma unroll
            for (int tt = 0; tt < 2; ++tt) { const f32x4_t z = {0.f, 0.f, 0.f, 0.f};
                tr[tt][0] = __builtin_amdgcn_mfma_f32_16x16x32_bf16(vcur[tt][0], esel[0], z, 0, 0, 0); tr[tt][1] = __builtin_amdgcn_mfma_f32_16x16x32_bf16(vcur[tt][0], esel[1], z, 0, 0, 0);
                tr[tt][2] = __builtin_amdgcn_mfma_f32_16x16x32_bf16(vcur[tt][1], esel[0], z, 0, 0, 0); tr[tt][3] = __builtin_amdgcn_mfma_f32_16x16x32_bf16(vcur[tt][1], esel[1], z, 0, 0, 0); }
#pragma unroll
            for (int db = 0; db < 4; ++db) { v4u vw; vw.x = pk2(tr[0][db][0], tr[0][db][1]); vw.y = pk2(tr[0][db][2], tr[0][db][3]); vw.z = pk2(tr[1][db][0], tr[1][db][1]); vw.w = pk2(tr[1][db][2], tr[1][db][3]);
                o[db] = __builtin_amdgcn_mfma_f32_16x16x32_bf16(pa, __builtin_bit_cast(bf16x8, vw), o[db], 0, 0, 0); } }
        float li[4];
#pragma unroll
        for (int j = 0; j < 4; ++j) li[j] = 1.0f / __shfl(ls, (4 * g + j) & 15);
        if (g < 2) { bf16* op = CAT2 + tok * 1024 + 512 + c;
#pragma unroll
            for (int j = 0; j < 4; ++j)
#pragma unroll
                for (int db = 0; db < 4; ++db) op[(4 * g + j) * 64 + 16 * db] = ABL_DSA ? (bf16)0 : (bf16)f2bf(o[db][j] * li[j]); } }
    __syncthreads();
}
__device__ __forceinline__ void dsa_phase(Frame& F, int qi, int item0, int nitems) {
    unsigned* qhead = (unsigned*)(F.ws + WS_CTL) + CW_DSAQ + 64 * qi; LAS int* meta = (LAS int*)(F.lds + DSA_META_OFF);
    for (;;) { if (F.wave == 0 && mk_lane() == 0) meta[100] = (int)atomicAdd(qhead, 1u);
        __syncthreads(); const int it = meta[100]; __syncthreads();
        if (it >= nitems) break;
        const int v = (item0 == 0) ? (it < 768 ? it : it + 1024) : it + 768;
        dsa_tile(F, v); }
}

constexpr int RC_PT = 72, RC_MS = 64 * RC_PT;
constexpr size_t WS_RWS = 5 * MiB;
constexpr size_t WS_WO_OUT2 = 3 * MiB;
constexpr size_t RWS_WY = 0, RWS_MC = 16 * MiB, RWS_NC = 32 * MiB;
typedef float rc_f32x2 __attribute__((ext_vector_type(2))); typedef __bf16 rc_bf16x2 __attribute__((ext_vector_type(2)));
__device__ __forceinline__ unsigned cvtpk(float lo, float hi) { const rc_f32x2 v = {lo, hi}; const rc_bf16x2 b = __builtin_convertvector(v, rc_bf16x2); return __builtin_bit_cast(unsigned, b); }
__device__ __forceinline__ f32x4 rc_ld4(const LAS bf16* M, int n, int m0) { const v2u w = *(const LAS v2u*)(M + n * RC_PT + m0); return (f32x4){bflo(w.x), bfhi(w.x), bflo(w.y), bfhi(w.y)}; }
__device__ __forceinline__ void rc_st4(LAS bf16* M, int n, int m0, const f32x4 v) { *(LAS v2u*)(M + n * RC_PT + m0) = (v2u){cvtpk(v.x, v.y), cvtpk(v.z, v.w)}; }
template <class Init, class Out>
__device__ __forceinline__ void rc_pset(const LAS bf16* X, const LAS bf16* Y, int wave, int lane, Init init, Out out) {
    const int g = lane >> 4, c = lane & 15;
#pragma unroll
    for (int u = 0; u < 2; ++u) { const int tl = 2 * wave + u, mt = tl >> 2, nt = tl & 3;
        f32x4 acc = init(mt, nt, g, c);
#pragma unroll
        for (int ks = 0; ks < 2; ++ks) { const bf16x8 a = *(const LAS bf16x8*)(X + (16 * mt + c) * RC_PT + 32 * ks + 8 * g), b = *(const LAS bf16x8*)(Y + (16 * nt + c) * RC_PT + 32 * ks + 8 * g);
            acc = __builtin_amdgcn_mfma_f32_16x16x32_bf16(a, b, acc, 0, 0, 0); }
        out(mt, nt, g, c, acc); }
}
#define RC_SYNC() __syncthreads()
__device__ __forceinline__ void rwkv_chunk_unit(Frame& F, int b, int h, int hl, int ch) {
    const int lane = mk_lane(), wave = F.wave;
    LAS bf16* L0 = (LAS bf16*)F.lds;
#define SLOT(i) (L0 + (i) * RC_MS)
    LAS float* gC = (LAS float*)(L0 + 15 * RC_MS);
    LAS float* segs = gC + 64;
    const bf16* P1 = (const bf16*)(F.ws + WS_P1); const bf16* LORA = (const bf16*)(F.ws + WS_LORA);
    const size_t tok0 = (size_t)b * SEQL + 64 * ch; const int chn = h * 64 + lane;
    { const float* mu = F.in[I_RWKV_MU]; const float mu_r = mu[PC_R + chn], mu_k = mu[PC_K + chn], mu_v = mu[PC_V + chn], kkw = F.in[I_RWKV_K_K][chn], kaw = F.in[I_RWKV_K_A][chn];
      float rr[8], kmod[8], vv[8], lw[8], kk[8], al[8]; float tot = 0.f;
#pragma unroll
      for (int i = 0; i < 8; ++i) { const int tt = 8 * wave + i; const size_t tok = tok0 + tt; const bool first = (ch == 0 && tt == 0); const bf16* row = P1 + tok * P1_LD; const bf16* prow = first ? row : (row - P1_LD);
          const float rc = bf2f(row[PC_R + chn]), kc = bf2f(row[PC_K + chn]), vc = bf2f(row[PC_V + chn]);
          const float rp = first ? 0.f : bf2f(prow[PC_R + chn]), kp = first ? 0.f : bf2f(prow[PC_K + chn]), vp = first ? 0.f : bf2f(prow[PC_V + chn]);
          lw[i] = bf2f(LORA[tok * 1536 + chn]); al[i] = bf2f(LORA[tok * 1536 + 512 + chn]);
          rr[i] = rc + (rp - rc) * mu_r; const float k0 = kc + (kp - kc) * mu_k; vv[i] = vc + (vp - vc) * mu_v;
          const float kkv = k0 * kkw; const float nrm = sqrtf(wave_sum(kkv * kkv)); kk[i] = kkv / fmaxf(nrm, 1e-12f);
          kmod[i] = k0 * (1.0f + (al[i] - 1.0f) * kaw); tot += lw[i]; }
      segs[wave * 64 + lane] = tot;
      RC_SYNC();
      float off = 0.f;
#pragma unroll
      for (int w2 = 0; w2 < 8; ++w2) off += (w2 < wave) ? segs[w2 * 64 + lane] : 0.f;
#pragma unroll
      for (int i = 0; i < 8; ++i) { const int tt = 8 * wave + i; const float Lm = off; off += lw[i]; const float Lc = off;
          const float eL = __expf(Lc), eLm = __expf(Lm), enL = __expf(-Lc);
          const bf16 va = (bf16)f2bf(-kk[i] * eLm), vb = (bf16)f2bf(kk[i] * al[i] * enL), vk = (bf16)f2bf(kmod[i] * enL), vr = (bf16)f2bf(rr[i] * eL), vvv = (bf16)f2bf(vv[i]);
          SLOT(0)[tt * RC_PT + lane] = va; SLOT(1)[tt * RC_PT + lane] = vb; SLOT(2)[tt * RC_PT + lane] = vk; SLOT(3)[tt * RC_PT + lane] = vr;
          SLOT(4)[lane * RC_PT + tt] = va; SLOT(5)[lane * RC_PT + tt] = vb; SLOT(6)[lane * RC_PT + tt] = vvv;
          if (tt == 63) gC[lane] = eL; }
      RC_SYNC(); }
    const auto zero = [](int, int, int, int) { return (f32x4){0.f, 0.f, 0.f, 0.f}; };
    rc_pset(SLOT(1), SLOT(0), wave, lane, zero, [&](int mt, int nt, int g, int c, f32x4 a) { const int m0 = 16 * mt + 4 * g, n = 16 * nt + c;
        rc_st4(SLOT(9), n, m0, (f32x4){m0 < n ? a.x : 0.f, m0 + 1 < n ? a.y : 0.f, m0 + 2 < n ? a.z : 0.f, m0 + 3 < n ? a.w : 0.f}); });
    rc_pset(SLOT(0), SLOT(1), wave, lane, zero, [&](int mt, int nt, int g, int c, f32x4 a) { const int m0 = 16 * mt + 4 * g, n = 16 * nt + c;
        rc_st4(SLOT(10), n, m0, (f32x4){n < m0 ? a.x : 0.f, n < m0 + 1 ? a.y : 0.f, n < m0 + 2 ? a.z : 0.f, n < m0 + 3 ? a.w : 0.f}); });
    rc_pset(SLOT(0), SLOT(2), wave, lane, zero, [&](int mt, int nt, int g, int c, f32x4 a) { const int m0 = 16 * mt + 4 * g, n = 16 * nt + c;
        rc_st4(SLOT(7), n, m0, (f32x4){n < m0 ? a.x : 0.f, n < m0 + 1 ? a.y : 0.f, n < m0 + 2 ? a.z : 0.f, n < m0 + 3 ? a.w : 0.f}); });
    rc_pset(SLOT(1), SLOT(3), wave, lane, zero, [&](int mt, int nt, int g, int c, f32x4 a) { const int m0 = 16 * mt + 4 * g, n = 16 * nt + c;
        rc_st4(SLOT(8), n, m0, (f32x4){m0 <= n ? a.x : 0.f, m0 + 1 <= n ? a.y : 0.f, m0 + 2 <= n ? a.z : 0.f, m0 + 3 <= n ? a.w : 0.f}); });
    RC_SYNC();
#define RC_NEU(sN, sNT, sM, sMT, dN, dNT, dM, dMT, LAST) do { \
    if (!(LAST)) rc_pset(SLOT(sNT), SLOT(sM), wave, lane, [&](int mt, int nt, int g, int c) { return rc_ld4(SLOT(sN), 16 * nt + c, 16 * mt + 4 * g); }, \
                         [&](int mt, int nt, int g, int c, f32x4 a) { rc_st4(SLOT(dN), 16 * nt + c, 16 * mt + 4 * g, a); });                   \
    rc_pset(SLOT(sM), SLOT(sNT), wave, lane, [&](int mt, int nt, int g, int c) { return rc_ld4(SLOT(sNT), 16 * nt + c, 16 * mt + 4 * g); }, \
            [&](int mt, int nt, int g, int c, f32x4 a) { rc_st4(SLOT(dNT), 16 * nt + c, 16 * mt + 4 * g, a); });                             \
    if (!(LAST)) { rc_pset(SLOT(sMT), SLOT(sM), wave, lane, zero, [&](int mt, int nt, int g, int c, f32x4 a) { rc_st4(SLOT(dM), 16 * nt + c, 16 * mt + 4 * g, a); });     \
                   rc_pset(SLOT(sM), SLOT(sMT), wave, lane, zero, [&](int mt, int nt, int g, int c, f32x4 a) { rc_st4(SLOT(dMT), 16 * nt + c, 16 * mt + 4 * g, a); }); } \
    RC_SYNC(); } while (0)
    RC_NEU(9, 10, 9, 10, 11, 12, 13, 14, false);
    RC_NEU(11, 12, 13, 14, 9, 10, 0, 1, false);
    RC_NEU(9, 10, 0, 1, 11, 12, 13, 14, false);
    RC_NEU(11, 12, 13, 14, 9, 10, 0, 1, false);
    RC_NEU(9, 10, 0, 1, 11, 12, 13, 14, false);
    RC_NEU(11, 12, 13, 14, 9, 10, 0, 1, true);
#undef RC_NEU
    rc_pset(SLOT(10), SLOT(8), wave, lane, [&](int mt, int nt, int g, int c) { return rc_ld4(SLOT(8), 16 * nt + c, 16 * mt + 4 * g); },
            [&](int mt, int nt, int g, int c, f32x4 a) { rc_st4(SLOT(9), 16 * nt + c, 16 * mt + 4 * g, a); });
    rc_pset(SLOT(10), SLOT(5), wave, lane, [&](int mt, int nt, int g, int c) { return rc_ld4(SLOT(5), 16 * nt + c, 16 * mt + 4 * g); },
            [&](int mt, int nt, int g, int c, f32x4 a) { rc_st4(SLOT(11), 16 * nt + c, 16 * mt + 4 * g, a); });
    RC_SYNC();
    const int ul = ((b * 4 + hl) * 128 + ch);
    bf16* WY = (bf16*)(F.ws + WS_RWS) + (size_t)ul * 12288; bf16* MC = WY + 4096; bf16* NC = WY + 8192;
    rc_pset(SLOT(4), SLOT(9), wave, lane, [&](int mt, int nt, int g, int c) { return rc_ld4(SLOT(3), 16 * nt + c, 16 * mt + 4 * g); },
            [&](int mt, int nt, int g, int c, f32x4 a) { *(v2u*)(WY + ((nt * 2 + (mt >> 1)) * 64 + g * 16 + c) * 8 + 4 * (mt & 1)) = (v2u){cvtpk(a.x, a.y), cvtpk(a.z, a.w)}; });
    { const int g = lane >> 4, c = lane & 15;
#pragma unroll
      for (int u = 0; u < 2; ++u) { const int tl = 2 * wave + u, mt = tl >> 2, nt = tl & 3, m0 = 16 * mt + 4 * g, n = 16 * nt + c; f32x4 acc = {0.f, 0.f, 0.f, 0.f};
#pragma unroll
          for (int ks = 0; ks < 2; ++ks) acc = __builtin_amdgcn_mfma_f32_16x16x32_bf16(*(const LAS bf16x8*)(SLOT(2) + (16 * mt + c) * RC_PT + 32 * ks + 8 * g), *(const LAS bf16x8*)(SLOT(3) + (16 * nt + c) * RC_PT + 32 * ks + 8 * g), acc, 0, 0, 0);
          acc = (f32x4){m0 <= n ? acc.x : 0.f, m0 + 1 <= n ? acc.y : 0.f, m0 + 2 <= n ? acc.z : 0.f, m0 + 3 <= n ? acc.w : 0.f};
#pragma unroll
          for (int ks = 0; ks < 2; ++ks) acc = __builtin_amdgcn_mfma_f32_16x16x32_bf16(*(const LAS bf16x8*)(SLOT(7) + (16 * mt + c) * RC_PT + 32 * ks + 8 * g), *(const LAS bf16x8*)(SLOT(9) + (16 * nt + c) * RC_PT + 32 * ks + 8 * g), acc, 0, 0, 0);
          rc_st4(SLOT(13), n, m0, acc); } }
    rc_pset(SLOT(4), SLOT(11), wave, lane, zero, [&](int mt, int nt, int g, int c, f32x4 a) { const int m0 = 16 * mt + 4 * g, n = 16 * nt + c; const float gg = gC[n];
        const f32x4 o = {gg * (a.x + (m0 == n ? 1.f : 0.f)), gg * (a.y + (m0 + 1 == n ? 1.f : 0.f)), gg * (a.z + (m0 + 2 == n ? 1.f : 0.f)), gg * (a.w + (m0 + 3 == n ? 1.f : 0.f))};
        *(v2u*)(MC + ((nt * 2 + (mt >> 1)) * 64 + g * 16 + c) * 8 + 4 * (mt & 1)) = (v2u){cvtpk(o.x, o.y), cvtpk(o.z, o.w)}; });
    rc_pset(SLOT(7), SLOT(11), wave, lane, [&](int mt, int nt, int g, int c) { const int m0 = 16 * mt + 4 * g, n = 16 * nt + c;
                return (f32x4){bf2f(SLOT(2)[m0 * RC_PT + n]), bf2f(SLOT(2)[(m0 + 1) * RC_PT + n]), bf2f(SLOT(2)[(m0 + 2) * RC_PT + n]), bf2f(SLOT(2)[(m0 + 3) * RC_PT + n])}; },
            [&](int mt, int nt, int g, int c, f32x4 a) { rc_st4(SLOT(14), 16 * nt + c, 16 * mt + 4 * g, a); });
    RC_SYNC();
    rc_pset(SLOT(14), SLOT(6), wave, lane, zero, [&](int mt, int nt, int g, int c, f32x4 a) { const int m0 = 16 * mt + 4 * g; const f32x4 gg = *(const LAS f32x4*)(gC + m0);
        *(v2u*)(NC + ((nt * 4 + mt) * 64 + lane) * 4) = (v2u){cvtpk(a.x * gg.x, a.y * gg.y), cvtpk(a.z * gg.z, a.w * gg.w)}; });
    { bf16* YR = (bf16*)(F.ws + WS_YR);
      rc_pset(SLOT(13), SLOT(6), wave, lane, zero, [&](int mt, int nt, int g, int c, f32x4 a) { bf16* yp = YR + (tok0 + 16 * mt + 4 * g) * 512 + h * 64 + 16 * nt + c;
          yp[0] = (bf16)f2bf(a.x); yp[512] = (bf16)f2bf(a.y); yp[1024] = (bf16)f2bf(a.z); yp[1536] = (bf16)f2bf(a.w); }); }
    RC_SYNC();
#undef SLOT
}
__device__ __forceinline__ void rwkv_chunk_passA(Frame& F, int half) {
    for (int un = blockIdx.x; un < 2048; un += F.G) { const int ch = un & 127, hl = (un >> 7) & 3, b = un >> 9; rwkv_chunk_unit(F, b, 4 * half + hl, hl, ch); }
}
constexpr int RB_SLOT = 32768, RB_R = 4, RB_D = 3;
template <bool STORE> __device__ __forceinline__ void rwkv_chunk_passB(Frame& F, int half) {
    const int lane = mk_lane(), wave = F.wave, g = lane >> 4, c = lane & 15; const int sq = (int)blockIdx.x, b = sq >> 2, hl = sq & 3, h = 4 * half + hl;
    const bf16* UB = (const bf16*)(F.ws + WS_RWS) + (size_t)sq * 128 * 12288;
    bf16* YRb = (bf16*)(F.ws + WS_YR) + (size_t)b * SEQL * 512 + h * 64;
    LAS unsigned char* ring = F.lds;
    const bool loader = wave >= 4; const int lw = wave & 3;
#define RB_ISSUE(ch_) do { const int ch2 = (ch_); LAS unsigned char* sl = ring + (ch2 % RB_R) * RB_SLOT; const char* ub = (const char*)(UB + (size_t)ch2 * 12288); \
        _Pragma("unroll") for (int q = 0; q < 6; ++q) { const int i = lw * 6 + q; __builtin_amdgcn_global_load_lds((const unsigned*)(ub + i * 1024 + lane * 16), (LAS unsigned*)(sl + i * 1024), 16, 0, 0); } \
        _Pragma("unroll") for (int q = 0; q < 2; ++q) { const int i2 = lw * 2 + q; const char* yp = (const char*)(YRb + (size_t)(64 * ch2 + 8 * i2 + (lane >> 3)) * 512) + (lane & 7) * 16; \
            __builtin_amdgcn_global_load_lds((const unsigned*)yp, (LAS unsigned*)(sl + 24576 + i2 * 1024), 16, 0, 0); } } while (0)
    if (loader) { RB_ISSUE(0); RB_ISSUE(1); RB_ISSUE(2); }
    bf16x8 sB[2] = {{0, 0, 0, 0, 0, 0, 0, 0}, {0, 0, 0, 0, 0, 0, 0, 0}};
    for (int ch = 0; ch < 128; ++ch) {
        if (loader) { if (ch + 2 < 128) asm volatile("s_waitcnt vmcnt(16)" ::: "memory"); else asm volatile("s_waitcnt vmcnt(0)" ::: "memory"); }
        else asm volatile("s_waitcnt lgkmcnt(0)" ::: "memory");
        asm volatile("" ::: "memory"); __builtin_amdgcn_s_barrier(); asm volatile("" ::: "memory");
        if (loader) { if (ch + RB_D < 128) RB_ISSUE(ch + RB_D); }
        else { const LAS unsigned char* sl = ring + (ch % RB_R) * RB_SLOT; const int vg = wave;
            bf16x8 wa[4][2], ma[4][2]; v2u nf[4]; float yl[4][4];
#pragma unroll
            for (int mt = 0; mt < 4; ++mt) {
#pragma unroll
                for (int ks = 0; ks < 2; ++ks) { wa[mt][ks] = *(const LAS bf16x8*)(sl + ((mt * 2 + ks) * 64 + lane) * 16); ma[mt][ks] = *(const LAS bf16x8*)(sl + 8192 + ((mt * 2 + ks) * 64 + lane) * 16); }
                nf[mt] = *(const LAS v2u*)(sl + 16384 + ((vg * 4 + mt) * 64 + lane) * 8);
#pragma unroll
                for (int j = 0; j < 4; ++j) yl[mt][j] = bf2f(*(const LAS unsigned short*)(sl + 24576 + (16 * mt + 4 * g + j) * 128 + (16 * vg + c) * 2)); }
            f32x4 ns[4];
#pragma unroll
            for (int mt = 0; mt < 4; ++mt) { f32x4 y = {yl[mt][0], yl[mt][1], yl[mt][2], yl[mt][3]};
                y = __builtin_amdgcn_mfma_f32_16x16x32_bf16(wa[mt][0], sB[0], y, 0, 0, 0); y = __builtin_amdgcn_mfma_f32_16x16x32_bf16(wa[mt][1], sB[1], y, 0, 0, 0);
                bf16* yp = YRb + (size_t)(64 * ch + 16 * mt + 4 * g) * 512 + 16 * vg + c; if (STORE) { yp[0] = (bf16)f2bf(y.x); yp[512] = (bf16)f2bf(y.y); yp[1024] = (bf16)f2bf(y.z); yp[1536] = (bf16)f2bf(y.w); } else if (y.x == 123456.f) yp[0] = 0;
                f32x4 s = {bflo(nf[mt].x), bfhi(nf[mt].x), bflo(nf[mt].y), bfhi(nf[mt].y)};
                s = __builtin_amdgcn_mfma_f32_16x16x32_bf16(ma[mt][0], sB[0], s, 0, 0, 0); s = __builtin_amdgcn_mfma_f32_16x16x32_bf16(ma[mt][1], sB[1], s, 0, 0, 0); ns[mt] = s; }
            { v4u w0, w1; w0.x = cvtpk(ns[0].x, ns[0].y); w0.y = cvtpk(ns[0].z, ns[0].w); w0.z = cvtpk(ns[1].x, ns[1].y); w0.w = cvtpk(ns[1].z, ns[1].w);
              w1.x = cvtpk(ns[2].x, ns[2].y); w1.y = cvtpk(ns[2].z, ns[2].w); w1.z = cvtpk(ns[3].x, ns[3].y); w1.w = cvtpk(ns[3].z, ns[3].w);
              sB[0] = __builtin_bit_cast(bf16x8, w0); sB[1] = __builtin_bit_cast(bf16x8, w1); } } }
    asm volatile("s_waitcnt vmcnt(0) lgkmcnt(0)" ::: "memory"); __builtin_amdgcn_s_barrier(); asm volatile("" ::: "memory");
#undef RB_ISSUE
}

__device__ __forceinline__ void final_norm_phase(Frame& F) {
    const int gw = blockIdx.x * NWAVES + F.wave, NGW = F.G * NWAVES, lane = mk_lane(); const float* gn = F.in[I_FINAL_NORM];
    f32x4 gv[4];
#pragma unroll
    for (int j = 0; j < 4; ++j) gv[j] = ((const f32x4*)gn)[lane + 64 * j];
    for (int m = gw; m < T_TOK; m += NGW) { f32x4* xr = (f32x4*)(F.out + (size_t)m * DMODEL) + lane; f32x4 v[4]; float s = 0.f;
#pragma unroll
        for (int j = 0; j < 4; ++j) { v[j] = xr[64 * j]; s += (v[j].x * v[j].x + v[j].y * v[j].y) + (v[j].z * v[j].z + v[j].w * v[j].w); }
        const float rstd = 1.0f / sqrtf(wave_sum(s) * (1.f / DMODEL) + NORM_EPS);
#pragma unroll
        for (int j = 0; j < 4; ++j) xr[64 * j] = v[j] * rstd * gv[j]; }
}

constexpr int NPHASE = 29;
__global__ void __launch_bounds__(NWAVES * 64, 2) mega_fwd(Args args) {
    extern __shared__ __attribute__((aligned(16))) unsigned char lds[];
    Frame F;
    F.lds = (LAS unsigned char*)lds;
    F.wave = __builtin_amdgcn_readfirstlane((int)threadIdx.x >> 6); F.G = gridDim.x;
    F.in = args.in; F.out = args.out; F.ws = args.ws;
    unsigned char* ws = args.ws;
    for (int u = threadIdx.x; u < (LDS_BYTES - RING_BYTES) / 4; u += NWAVES * 64) ((LAS unsigned*)(F.lds + RING_BYTES))[u] = 0u;
    __syncthreads();
    XcdBarrier bar = xcd_barrier_post((unsigned*)(ws + WS_CTL) + CW_BAR + args.li * XCD_BAR_WORDS, (volatile LAS unsigned*)(F.lds + MISC_OFF));
    const int lo = args.ph_lo, hi = args.ph_hi;
#if STAMP_KA >= 0
    volatile LAS unsigned long long* stl = (volatile LAS unsigned long long*)(F.lds + MISC_OFF + 32);
    const bool stamper = (blockIdx.x == 0 && threadIdx.x == 0);
    if (stamper) stl[0] = __builtin_amdgcn_s_memrealtime();
#define STAMP_AT(k) do { if (stamper) { if ((k) == STAMP_KA) stl[1] = __builtin_amdgcn_s_memrealtime(); if ((k) == STAMP_KB) stl[2] = __builtin_amdgcn_s_memrealtime(); \
        if ((k) == 27) { const unsigned long long now = __builtin_amdgcn_s_memrealtime(); ((float*)(ws + WS_TILEEXP + 4096))[0] = (float)(stl[2] - stl[1]) / (float)(now - stl[0]); } } } while (0)
#else
#define STAMP_AT(k) do {} while (0)
#endif
#define IN(k) (lo <= (k) && (k) < hi)
#ifndef P8_DUP_MODE
#define P8_DUP_MODE 0
#endif
#ifndef P8_SP2
#define P8_SP2 true
#endif
#ifndef MFMA_SPIN
#define MFMA_SPIN 0
#endif
#ifndef P8_DUP_LD0
#define P8_DUP_LD0 0
#endif
#ifndef E1_OLD
#define E1_OLD 0
#endif
#ifndef P8_DUP_ZERO
#define P8_DUP_ZERO 0
#endif
#ifndef EXTRA_BAR
#define EXTRA_BAR 0
#endif
#ifndef P8_DUP_LDV
#define P8_DUP_LDV 0
#endif
#ifndef P9_DUP_LDV
#define P9_DUP_LDV 0
#endif
#ifndef P9_DUP_SKIP
#define P9_DUP_SKIP 0
#endif
#ifndef DUP_SKIP_EPI
#define DUP_SKIP_EPI 0
#endif
#ifndef P8_DUP_F8
#define P8_DUP_F8 0
#endif
#ifndef P8_ORDER
#define P8_ORDER pg8::StaticOrder
#endif
#ifndef GEMM_ORDER
#define GEMM_ORDER pg8::StaticOrder
#endif
#ifndef MOE_PROBE
#define MOE_PROBE 0
#endif
#ifndef MOE_PROBE_OFF
#define MOE_PROBE_OFF 470
#endif
#ifndef MOE_ALIGN
#define MOE_ALIGN true
#endif
#ifndef DUPSET
#define DUPSET 0ull
#endif
#define PHB(k) if (IN(k)) { const int nrep_ = 1 + (int)(((unsigned long long)(DUPSET) >> (k)) & 1ull); for (int rep_ = 0; rep_ < nrep_; ++rep_) { const bool last_ = (rep_ + 1 == nrep_); (void)last_;
#define PHE(k) if (!last_) xcd_barrier(bar, F.wave == 0 && mk_lane() == 0); } }
#define SEAM(k) do { if (IN(k) && IN((k) + 1)) { xcd_barrier(bar, F.wave == 0 && mk_lane() == 0); if (EXTRA_BAR) xcd_barrier(bar, F.wave == 0 && mk_lane() == 0); } } while (0)
#define SEAM2(k, kn) do { if (IN(k) && IN(kn)) xcd_barrier(bar, F.wave == 0 && mk_lane() == 0); } while (0)
    bf16* XN = (bf16*)(ws + WS_XN); bf16* CAT = (bf16*)(ws + WS_CAT); bf16* UG = (bf16*)(ws + WS_UG);
    bf16* Q0 = (bf16*)(ws + WS_Q0); bf16* K0 = (bf16*)(ws + WS_K0); bf16* V0 = (bf16*)(ws + WS_V0); bf16* YA = (bf16*)(ws + WS_YA);

#if MFMA_SPIN
    {
        typedef short s8_t __attribute__((ext_vector_type(8)));
        f32x4 a8[8]; s8_t xa, xb;
#pragma unroll
        for (int j = 0; j < 8; ++j) { a8[j] = (f32x4){0.f, 0.f, 0.f, 0.f}; xa[j] = (short)(0x3c00 + mk_lane() + j); xb[j] = (short)(0x3b80 + 3 * j); }
#pragma unroll 1
        for (int i = 0; i < MFMA_SPIN; ++i) {
#pragma unroll
            for (int j = 0; j < 8; ++j) a8[j] = __builtin_amdgcn_mfma_f32_16x16x32_bf16(xa, xb, a8[j], 0, 0, 0); }
        float sm = 0.f;
#pragma unroll
        for (int j = 0; j < 8; ++j) sm += a8[j][0] + a8[j][1] + a8[j][2] + a8[j][3];
        if (sm == 1.2345e-30f) ((float*)(ws + WS_TILEEXP))[1000] = sm;
    }
#endif
    PHB(0) p0_prologue(F, last_ ? 15 : (int)(((unsigned long long)(DUPSET) >> 46) & 15ull)); PHE(0) SEAM(0);
    PHB(1) pg8::Gemm g{XN, (const bf16*)(ws + WS_WE_IN), 1024, 1024, 1024}; GEMM_ORDER S; S.init(T_TOK, 2048, F.G, (int)blockIdx.x);
        #if E1_OLD
        pg8::Epi8<F_E1> E{{UG, Q0, K0, V0, (const float*)(ws + WS_ROPE)}};
        pg8::gemm_phase<pg8::Epi8<F_E1>, pg8::StaticOrder, true, true>(F.lds, g, S, E, F.wave, !last_ && DUP_SKIP_EPI); PHE(1) SEAM(1);
#else
        EpiE1 E{UG, Q0, K0, V0, (const float*)(ws + WS_ROPE)};
        pg8::gemm_phase<EpiE1, GEMM_ORDER, true, true>(F.lds, g, S, E, F.wave, !last_ && DUP_SKIP_EPI); PHE(1) SEAM(1);
#endif
    PHB(2) pg8::Gemm g{UG, (const bf16*)(ws + WS_S5BEND), 640, 512, 512}; SchedXend S{F.G, (int)blockIdx.x};
        pg8::Epi8<F_XEND> E{{(float*)(ws + WS_XEND)}};
        if (last_ || ((DUPSET >> 44) & 1ull)) pg8::gemm_phase<pg8::Epi8<F_XEND>, SchedXend, true, true>(F.lds, g, S, E, F.wave, !last_ && DUP_SKIP_EPI);
        if (last_ || ((DUPSET >> 45) & 1ull)) kmean_phase(F); PHE(2) SEAM(2);
    PHB(3) s5_carry_phase(F); moba_select_phase(F); PHE(3) SEAM(3);
    PHB(4) if (last_ || (DUPSET & (1ull << 40))) { pg8::Gemm g{UG, (const bf16*)(ws + WS_S5MT), 640, 640, 640}; SchedS5Y S{F.G, (int)blockIdx.x};
          pg8::Epi8L<F_S5Y> E{{UG, F.in[I_S5_D], YA}};
          pg8::gemm_phase<pg8::Epi8L<F_S5Y>, SchedS5Y, true, true>(F.lds, g, S, E, F.wave, !last_ && DUP_SKIP_EPI); }
        if (F.G == 256 && (last_ || (DUPSET & (1ull << 41)))) { const attn_body::AttnTensors AT{(const attn_body::bf16*)Q0, (const attn_body::bf16*)K0, (const attn_body::bf16*)V0, (attn_body::bf16*)(CAT + 512), (const unsigned*)(ws + WS_SELM)};
          const attn_body::StaticOrder S((int)F.G, (int)blockIdx.x);
          attn_body::attn_phase<attn_body::StaticOrder>((char*)lds, AT, S, F.wave); } PHE(4) SEAM(4);
    PHB(5) pg8::Gemm g{YA, (const bf16*)(ws + WS_WGLU), 512, 512, 512}; pg8::StaticOrder S; S.init(T_TOK, 512, F.G, (int)blockIdx.x);
        pg8::Epi8L<F_GLU> E{{YA, F.in[I_S5_GLU_B], CAT}};
        pg8::gemm_phase<pg8::Epi8L<F_GLU>, pg8::StaticOrder, true, true>(F.lds, g, S, E, F.wave, !last_ && DUP_SKIP_EPI); PHE(5) SEAM(5);
    PHB(6) pg8::Gemm g{CAT, (const bf16*)(ws + WS_WE_OUT), 1024, 1024, 1024}; GEMM_ORDER S; S.init(T_TOK, 1024, F.G, (int)blockIdx.x);
        EpiResNorm<false> E{(const void*)F.in[I_X], (bf16*)(ws + WS_HB1), nullptr, (float*)(ws + WS_SS1)};
        pg8::gemm_phase<EpiResNorm<false>, GEMM_ORDER, true, true>(F.lds, g, S, E, F.wave, !last_ && DUP_SKIP_EPI); PHE(6) SEAM2(6, 8);
    PHB(8) pg8::Gemm g{(const bf16*)(ws + WS_HB1), (const bf16*)(ws + WS_WFFN_GU), 1024, 1024, 1024}; P8_ORDER S; S.init(T_TOK, 2 * FFN_D, F.G, (int)blockIdx.x);
        pg8::EpiGUR<F_SWIGLU> E{{(bf16*)(ws + WS_ACT), FFN_D, (const float*)(ws + WS_SS1), last_ ? 0 : P8_DUP_MODE}};
        pg8::gemm_phase<pg8::EpiGUR<F_SWIGLU>, P8_ORDER, true, P8_SP2>(F.lds, g, S, E, F.wave, !last_ && DUP_SKIP_EPI); PHE(8) SEAM(8);
    PHB(9) pg8::Gemm g{(const bf16*)(ws + WS_ACT), (const bf16*)(ws + WS_WFFN_D), (!last_ && P9_DUP_LDV) ? P9_DUP_LDV : FFN_D, (!last_ && P9_DUP_LDV) ? P9_DUP_LDV : FFN_D, FFN_D}; GEMM_ORDER S; S.init(T_TOK, 1024, F.G, (int)blockIdx.x);
        EpiResNorm<true> E{(const void*)(ws + WS_HB1), XN, (bf16*)F.out, (float*)(ws + WS_SS2), (!last_ && P9_DUP_SKIP) ? 1 : 0};
        pg8::gemm_phase<EpiResNorm<true>, GEMM_ORDER, true, true>(F.lds, g, S, E, F.wave, !last_ && DUP_SKIP_EPI); PHE(9) SEAM2(9, 11);
    PHB(11) pg8::Gemm g{XN, (const bf16*)(ws + WS_WO_IN), 1024, 1024, 1024}; GEMM_ORDER S; S.init(T_TOK, ODD_PAD, F.G, (int)blockIdx.x);
        pg8::Epi8R<F_P1> E{{(bf16*)(ws + WS_P1), (const float*)(ws + WS_SS2)}};
        pg8::gemm_phase<pg8::Epi8R<F_P1>, GEMM_ORDER, true, true>(F.lds, g, S, E, F.wave, !last_ && DUP_SKIP_EPI); PHE(11) SEAM(11);
    PHB(12) l1_prep_phase(F); PHE(12) SEAM(12);
    PHB(13) pg8::Gemm g{(const bf16*)(ws + WS_ALORA), (const bf16*)(ws + WS_WLORA), 256, 256, 256}; pg8::StaticOrder S; S.init(T_TOK, 1536, F.G, (int)blockIdx.x);
        pg8::Epi8L<F_LORA> E{{(bf16*)(ws + WS_LORA), F.in[I_RWKV_W0], F.in[I_RWKV_A0]}};
        pg8::gemm_phase<pg8::Epi8L<F_LORA>, pg8::StaticOrder, true, true>(F.lds, g, S, E, F.wave, !last_ && DUP_SKIP_EPI);
        { LAS bf16* scr = (LAS bf16*)(F.lds + F.wave * 16384); const int lane = mk_lane();
          for (int it = blockIdx.x * NWAVES + F.wave; it < 256; it += F.G * NWAVES) tr_item64<0>(F.in[I_O_W_OUT], 1024, 1024, (bf16*)(ws + WS_WO_OUT2), 1024, 0, nullptr, scr, it / 16, it % 16, lane); } PHE(13) SEAM(13);
    PHB(14) rwkv_chunk_passA(F, 0); PHE(14) SEAM(14);
    PHB(15) if (F.G == 256) { if ((int)blockIdx.x < 16) { if (last_) rwkv_chunk_passB<true>(F, 0); else rwkv_chunk_passB<false>(F, 0); } dsa_phase(F, last_ ? 0 : 2, 0, 1024); } PHE(15) SEAM(15);
    PHB(16) rwkv_chunk_passA(F, 1); PHE(16) SEAM(16);
    PHB(17) if (F.G == 256) { if ((int)blockIdx.x < 16) { if (last_) rwkv_chunk_passB<true>(F, 1); else rwkv_chunk_passB<false>(F, 1); } dsa_phase(F, last_ ? 1 : 3, 1024, 1024); } PHE(17) SEAM(17);
    PHB(18) rwkv_post_phase(F); PHE(18) SEAM(18);
    PHB(19) if (last_ || (DUPSET & (1ull << 42))) { pg8::Gemm g{CAT, (const bf16*)(ws + WS_WO_OUT2), 1024, 1024, 1024}; GEMM_ORDER S; S.init(T_TOK, 1024, F.G, (int)blockIdx.x);
          pg8::Epi8L<F_RES> E{{(const bf16*)F.out, last_ ? (bf16*)F.out : (bf16*)(ws + 130 * MiB)}};
          pg8::gemm_phase<pg8::Epi8L<F_RES>, GEMM_ORDER, true, true>(F.lds, g, S, E, F.wave, !last_ && DUP_SKIP_EPI); }
        if (last_ || (DUPSET & (1ull << 43))) moe_convert_phase(F); PHE(19) SEAM(19);
    PHB(20) router_phase(F, last_ ? 0 : 2048); PHE(20) SEAM(20);
    PHB(21) moe_scatter_phase(F); PHE(21) SEAM(21);
#define MOE_CHUNK_PHASES(PH, Q) \
    PHB(PH) const int* te = (const int*)(ws + WS_TILEEXP); const int ntl = te[511]; int ntq = ntl - MOE_CHUNK * (Q); ntq = ntq < 0 ? 0 : (ntq > MOE_CHUNK ? MOE_CHUNK : ntq); \
        pg8::Gemm g{(const bf16*)(ws + WS_XG), (const bf16*)(ws + WS_WMOE_GU), 512, 512, 512}; SchedMoeGU S{te, MOE_CHUNK * (Q), ntq, F.G, (int)blockIdx.x}; \
        pg8::EpiGU<F_MOEGU> E{{last_ ? ws + WS_ACTQ : ws + MOE_PROBE_OFF * MiB, MOE_CHUNK * (Q), last_ ? 0 : MOE_PROBE}}; \
        pg8::gemm_phase<pg8::EpiGU<F_MOEGU>, SchedMoeGU, MOE_ALIGN, true, true>(F.lds, g, S, E, F.wave, !last_ && DUP_SKIP_EPI); PHE(PH) SEAM(PH); \
    PHB((PH) + 1) const int* te = (const int*)(ws + WS_TILEEXP); const int ntl = te[511]; int ntq = ntl - MOE_CHUNK * (Q); ntq = ntq < 0 ? 0 : (ntq > MOE_CHUNK ? MOE_CHUNK : ntq); \
        pg8::Gemm g{(const bf16*)(ws + WS_ACTQ), (const bf16*)(ws + WS_WMOE_D), FEXP / 2, FEXP / 2, FEXP / 2}; SchedMoeD S{te, MOE_CHUNK * (Q), ntq, F.G, (int)blockIdx.x}; \
        pg8::Epi8<F_MOED> E{{last_ ? (bf16*)(ws + WS_YS) : (bf16*)(ws + MOE_PROBE_OFF * MiB), last_ ? 0 : MOE_PROBE}}; \
        pg8::gemm_phase<pg8::Epi8<F_MOED>, SchedMoeD, MOE_ALIGN, true, true>(F.lds, g, S, E, F.wave, !last_ && DUP_SKIP_EPI); PHE((PH) + 1) SEAM((PH) + 1);
    MOE_CHUNK_PHASES(22, 0)
    MOE_CHUNK_PHASES(24, 1)
    MOE_CHUNK_PHASES(26, 2)
#undef MOE_CHUNK_PHASES
    PHB(28) moe_combine_final_phase(F, last_ ? F.out : (float*)(ws + 346 * MiB)); PHE(28)
#undef IN
#undef SEAM
#undef SEAM2
}

#ifndef MK_ONE_LAUNCH
#define MK_ONE_LAUNCH 1
#endif
extern "C" void kernel_launch(void* const* d_in, const int* in_sizes, int n_in, void* d_out, int out_size, void* d_ws, size_t ws_size, hipStream_t stream) {
    static int grid = 0;
    if (grid == 0) {
        if (n_in != 38 || in_sizes[0] != T_TOK * DMODEL || out_size != T_TOK * DMODEL || ws_size < WS_NEED) { fprintf(stderr, "kernel_launch: unexpected shapes (n_in %d, in0 %d, out %d, ws %zu); nothing launched\n", n_in, n_in > 0 ? in_sizes[0] : -1, out_size, ws_size); grid = -1; return; }
        int dev = 0, cus = 0, per_cu = 0;
        if (hipGetDevice(&dev) != hipSuccess || hipDeviceGetAttribute(&cus, hipDeviceAttributeMultiprocessorCount, dev) != hipSuccess) { grid = -1; return; }
        if (hipFuncSetAttribute((const void*)mega_fwd, hipFuncAttributeMaxDynamicSharedMemorySize, LDS_BYTES) != hipSuccess) { fprintf(stderr, "kernel_launch: hipFuncSetAttribute failed\n"); grid = -1; return; }
        if (hipOccupancyMaxActiveBlocksPerMultiprocessor(&per_cu, (const void*)mega_fwd, NWAVES * 64, LDS_BYTES) != hipSuccess || per_cu < 1) fprintf(stderr, "kernel_launch: occupancy query reports %d\n", per_cu);
        (void)hipGetLastError();
        grid = cus > 256 ? 256 : cus;
    }
    if (grid < 0) return;
    if (hipMemsetAsync((char*)d_ws + WS_CTL, 0, CTL_ZERO_BYTES, stream) != hipSuccess) return;
    Args a{};
    for (int i = 0; i < 38; ++i) a.in[i] = (const float*)d_in[i];
    a.out = (float*)d_out; a.ws = (unsigned char*)d_ws; a.pad = 0;
#if MK_ONE_LAUNCH
    a.ph_lo = 0; a.ph_hi = NPHASE; a.li = 0;
    hipLaunchKernelGGL(mega_fwd, dim3(grid), dim3(NWAVES * 64), LDS_BYTES, stream, a);
#else
    for (int p = 0; p < NPHASE; ++p) { a.ph_lo = p; a.ph_hi = p + 1; a.li = p;
        hipLaunchKernelGGL(mega_fwd, dim3(grid), dim3(NWAVES * 64), LDS_BYTES, stream, a);
        if (hipPeekAtLastError() != hipSuccess) { fprintf(stderr, "kernel_launch: launch %d failed\n", p); break; } }
#endif
}
```

```cpp
#include <hip/hip_runtime.h>
#include <hip/hip_bf16.h>
#include <cstdio>
#include <cstdint>
#include <cmath>
#ifndef ABL_MOBA
#define ABL_MOBA 0
#endif
__device__ __forceinline__ int mk_lane() { int l; asm volatile("v_mbcnt_lo_u32_b32 %0, -1, 0\n\tv_mbcnt_hi_u32_b32 %0, -1, %0" : "=v"(l)); return l; }
namespace pg8 {
#define PG8_LAS __attribute__((address_space(3)))
typedef unsigned short bf16_t;
typedef short bf16x8 __attribute__((ext_vector_type(8)));
typedef float f32x4 __attribute__((ext_vector_type(4)));
typedef unsigned u32x4 __attribute__((ext_vector_type(4)));
typedef int i32x4 __attribute__((ext_vector_type(4)));
typedef int i32x8 __attribute__((ext_vector_type(8)));
constexpr int BM = 256, BK = 64, HALF = 128, HTB = HALF * BK * 2  , STAGE_BYTES = 8 * HTB, NXCD = 8, WGM = 8;

__host__ __device__ __forceinline__ int lds_byte(int r, int c) { const int st = (r >> 4) * 2 + (c >> 5), rr = r & 15, cc = c & 31, ob = rr * 64 + cc * 2; return st * 1024 + (ob ^ (((ob >> 9) & 1) << 5)); }
__host__ __device__ __forceinline__ void stage_rc(int b, int& R, int& C) { const int st = b / 1024, sb = b % 1024, swz = sb ^ (((sb >> 9) & 1) << 5); R = (st >> 1) * 16 + swz / 64; C = (st & 1) * 32 + (swz % 64) / 2; }
__host__ __device__ __forceinline__ int perm32(int rho) { const int n = rho >> 4, i = rho & 15; return 8 * (i >> 2) + 4 * n + (i & 3); }

struct Unit { int pm, pn, aux; };
struct Gemm { const bf16_t* A; const bf16_t* Bt; int lda, ldb, K; };

struct StaticOrder {
    int nM, nN, nwg, G, c, zero;
    __host__ __device__ void init(int M, int N, int G_, int c_) { nM = M / BM; nN = N / BM; nwg = nM * nN; G = G_; c = c_; zero = 0; }
    __host__ __device__ bool next(int i, Unit& u) const {
        const long L = (long)i * G + c; if (L >= nwg) return false;
        int wgid = (int)L; { const int q = nwg / NXCD, r = nwg % NXCD, xcd = wgid % NXCD, off = wgid / NXCD; wgid = (xcd < r ? xcd * (q + 1) : r * (q + 1) + (xcd - r) * q) + off; }
        const int nig = WGM * nN, gid = wgid / nig, fm = gid * WGM, gsz = (nM - fm) < WGM ? (nM - fm) : WGM;
        u.pm = fm + ((wgid % nig) % gsz); u.pn = (wgid % nig) / gsz; u.aux = 0; if (zero) { u.pm &= (zero - 1); u.pn &= (zero - 1); } return true;
    }
    __device__ __forceinline__ void a_ready(const Unit&) const {}
    __device__ __forceinline__ void done(const Unit&) const {}
};

struct ColPanelOrder {
    int nM, nN, nwg, G, c;
    __host__ __device__ void init(int M, int N, int G_, int c_) { nM = M / BM; nN = N / BM; nwg = nM * nN; G = G_; c = c_; }
    __host__ __device__ bool next(int i, Unit& u) const { const int L = i * G + c; if (L >= nwg) return false; u.pm = L % nM; u.pn = L / nM; u.aux = 0; return true; }
    __device__ __forceinline__ void a_ready(const Unit&) const {}
    __device__ __forceinline__ void done(const Unit&) const {}
};
__device__ __forceinline__ unsigned cvt_pk_bf16(float lo, float hi) { unsigned r; asm volatile("v_cvt_pk_bf16_f32 %0, %1, %2" : "=v"(r) : "v"(lo), "v"(hi)); return r; }

template <class F> struct Epi8 {
    static constexpr bool PERM = true, AFTER_DRAIN = false;
    F f;
    __device__ __forceinline__ void operator()(const f32x4 (&acc)[2][2][4][2], const Unit& u, int wr, int wc, int fr, int fq) const {
#pragma unroll
        for (int ai = 0; ai < 2; ++ai)
#pragma unroll
            for (int m = 0; m < 4; ++m) { const int r = ai * HALF + wr * 64 + m * 16 + fr;
#pragma unroll
                for (int bj = 0; bj < 2; ++bj) { const int c = bj * HALF + wc * 32 + 8 * fq;
                    float v[8] = {acc[ai][bj][m][0][0], acc[ai][bj][m][0][1], acc[ai][bj][m][0][2], acc[ai][bj][m][0][3], acc[ai][bj][m][1][0], acc[ai][bj][m][1][1], acc[ai][bj][m][1][2], acc[ai][bj][m][1][3]};
                    f(u, r, c, v, wc); } }
    }
};
template <class F> struct EpiGU {
    static constexpr bool PERM = true, AFTER_DRAIN = false;
    F f;
    __device__ __forceinline__ void operator()(const f32x4 (&acc)[2][2][4][2], const Unit& u, int wr, int wc, int fr, int fq) const {
#pragma unroll
        for (int ai = 0; ai < 2; ++ai)
#pragma unroll
            for (int m = 0; m < 4; ++m) { const int r = ai * HALF + wr * 64 + m * 16 + fr; const int c = wc * 32 + 8 * fq;
                float g[8] = {acc[ai][0][m][0][0], acc[ai][0][m][0][1], acc[ai][0][m][0][2], acc[ai][0][m][0][3], acc[ai][0][m][1][0], acc[ai][0][m][1][1], acc[ai][0][m][1][2], acc[ai][0][m][1][3]};
                float p[8] = {acc[ai][1][m][0][0], acc[ai][1][m][0][1], acc[ai][1][m][0][2], acc[ai][1][m][0][3], acc[ai][1][m][1][0], acc[ai][1][m][1][1], acc[ai][1][m][1][2], acc[ai][1][m][1][3]};
                f(u, r, c, g, p); }
    }
};

template <class F> struct Epi8L {
    static constexpr bool PERM = true, AFTER_DRAIN = false;
    F f;
    __device__ __forceinline__ void operator()(const f32x4 (&acc)[2][2][4][2], const Unit& u, int wr, int wc, int fr, int fq) const {
        constexpr int MB = F::MB, NB = 8 / MB;
        typename F::Hoist h; f.hoist(u, wc, fq, h);
        typename F::Pre pre[2][MB][2];
#pragma unroll
        for (int mm = 0; mm < MB; ++mm)
#pragma unroll
            for (int bj = 0; bj < 2; ++bj) { const int ri = mm; f.load(u, (ri >> 2) * HALF + wr * 64 + (ri & 3) * 16 + fr, bj * HALF + wc * 32 + 8 * fq, pre[0][mm][bj]); }
#pragma unroll
        for (int b = 0; b < NB; ++b) {
            if (b + 1 < NB) {
#pragma unroll
                for (int mm = 0; mm < MB; ++mm)
#pragma unroll
                    for (int bj = 0; bj < 2; ++bj) { const int ri = (b + 1) * MB + mm; f.load(u, (ri >> 2) * HALF + wr * 64 + (ri & 3) * 16 + fr, bj * HALF + wc * 32 + 8 * fq, pre[(b + 1) & 1][mm][bj]); } }
#pragma unroll
            for (int mm = 0; mm < MB; ++mm)
#pragma unroll
                for (int bj = 0; bj < 2; ++bj) { const int ri = b * MB + mm, ai = ri >> 2, m = ri & 3;
                    float v[8] = {acc[ai][bj][m][0][0], acc[ai][bj][m][0][1], acc[ai][bj][m][0][2], acc[ai][bj][m][0][3], acc[ai][bj][m][1][0], acc[ai][bj][m][1][1], acc[ai][bj][m][1][2], acc[ai][bj][m][1][3]};
                    f.apply(u, ai * HALF + wr * 64 + m * 16 + fr, bj * HALF + wc * 32 + 8 * fq, v, pre[b & 1][mm][bj], h, bj); } }
    }
};
__device__ __forceinline__ void rows_rstd(const float* SS, int row0, int wr, int fr, int fq, float (&rs)[2][4]) {
    f32x4 pp[2][4];
#pragma unroll
    for (int ai = 0; ai < 2; ++ai)
#pragma unroll
        for (int m = 0; m < 4; ++m) pp[ai][m] = ((const f32x4*)(SS + (size_t)(row0 + ai * HALF + wr * 64 + m * 16 + fr) * 16))[fq];
#pragma unroll
    for (int ai = 0; ai < 2; ++ai)
#pragma unroll
        for (int m = 0; m < 4; ++m) { float s = (pp[ai][m][0] + pp[ai][m][1]) + (pp[ai][m][2] + pp[ai][m][3]); s += __shfl_xor(s, 16); s += __shfl_xor(s, 32); rs[ai][m] = __builtin_amdgcn_rsqf(s * (1.f / 1024.f) + 1e-6f); }
}
template <class F> struct Epi8R {
    static constexpr bool PERM = true, AFTER_DRAIN = false;
    F f;
    __device__ __forceinline__ void operator()(const f32x4 (&acc)[2][2][4][2], const Unit& u, int wr, int wc, int fr, int fq) const {
        float rs[2][4]; rows_rstd(f.SS, u.pm * 256, wr, fr, fq, rs);
#pragma unroll
        for (int ai = 0; ai < 2; ++ai)
#pragma unroll
            for (int m = 0; m < 4; ++m) { const int r = ai * HALF + wr * 64 + m * 16 + fr;
#pragma unroll
                for (int bj = 0; bj < 2; ++bj) { const int c = bj * HALF + wc * 32 + 8 * fq;
                    float v[8] = {acc[ai][bj][m][0][0], acc[ai][bj][m][0][1], acc[ai][bj][m][0][2], acc[ai][bj][m][0][3], acc[ai][bj][m][1][0], acc[ai][bj][m][1][1], acc[ai][bj][m][1][2], acc[ai][bj][m][1][3]};
                    f(u, r, c, v, rs[ai][m]); } }
    }
};
template <class F> struct EpiGUR {
    static constexpr bool PERM = true, AFTER_DRAIN = false;
    F f;
    __device__ __forceinline__ void operator()(const f32x4 (&acc)[2][2][4][2], const Unit& u, int wr, int wc, int fr, int fq) const {
        if (f.mode == 2) return;
        float rs[2][4]; rows_rstd(f.SS, u.pm * 256, wr, fr, fq, rs);
#pragma unroll
        for (int ai = 0; ai < 2; ++ai)
#pragma unroll
            for (int m = 0; m < 4; ++m) { const int r = ai * HALF + wr * 64 + m * 16 + fr; const int c = wc * 32 + 8 * fq;
                float g[8] = {acc[ai][0][m][0][0], acc[ai][0][m][0][1], acc[ai][0][m][0][2], acc[ai][0][m][0][3], acc[ai][0][m][1][0], acc[ai][0][m][1][1], acc[ai][0][m][1][2], acc[ai][0][m][1][3]};
                float p[8] = {acc[ai][1][m][0][0], acc[ai][1][m][0][1], acc[ai][1][m][0][2], acc[ai][1][m][0][3], acc[ai][1][m][1][0], acc[ai][1][m][1][1], acc[ai][1][m][1][2], acc[ai][1][m][1][3]};
                f(u, r, c, g, p, rs[ai][m]); }
    }
};

template <class Epi, class Sched, bool ALIGN_EPI = false, bool SP2 = false, bool F8 = false>
__device__ __forceinline__ void gemm_phase(PG8_LAS unsigned char* lds, const Gemm g, const Sched& S, const Epi& E, const int wave_s, const bool skip_epi = false) {
    const int wid = wave_s, lane = mk_lane(), tid = wid * 64 + lane, wr = wid >> 2, wc = wid & 3, fr = lane & 15, fq = lane >> 4;
    const int K = g.K, nt = K / BK;
    unsigned voffA[2], voffB[2];
#pragma unroll
    for (int i = 0; i < 2; ++i) { int R, C; stage_rc(tid * 16 + i * 8192, R, C); const int Rb = Epi::PERM ? ((R & ~31) + perm32(R & 31)) : R;
        voffA[i] = (unsigned)(R * g.lda + C) * 2u; voffB[i] = (unsigned)(Rb * g.ldb + C) * 2u; }
    const size_t kstep = (size_t)(BK * 2);
    const size_t hstepA = (size_t)HALF * g.lda * 2, hstepB = (size_t)HALF * g.ldb * 2;
    const size_t tstepA = 2 * hstepA, tstepB = 2 * hstepB;
    const unsigned ldsw = (unsigned)wid * 1024u;
    const int aoff = lds_byte(wr * 64 + fr, fq * 8), boff = lds_byte(wc * 32 + fr, fq * 8);
    const int f8_scale = 0x7F7F7F7F; (void)f8_scale;
    int aoffv = aoff, boffv = boff + 4 * HTB; if constexpr (F8) { asm volatile("" : "+v"(aoffv), "+v"(boffv)); } (void)aoffv; (void)boffv;
#define PG8_SA(b, h) (((b) * 2 + (h)) * HTB)
#define PG8_SB(b, h) ((4 + (b) * 2 + (h)) * HTB)
#define PG8_STAGE(bufoff, gbase, voff) do { _Pragma("unroll") for (int _i = 0; _i < 2; ++_i) \
        __builtin_amdgcn_global_load_lds((const unsigned*)((const char*)(gbase) + (voff)[_i]), (PG8_LAS unsigned*)(lds + (bufoff) + ldsw + _i * 8192), 16, 0, 0); } while (0)
#define PG8_LD16A(off) (*(const PG8_LAS i32x4*)(lds + aoffv + (off)))
#define PG8_LD16B(off) (*(const PG8_LAS i32x4*)(lds + boffv + (off)))
#define PG8_LDA(dst, b, h) do { if constexpr (F8) { _Pragma("unroll") for (int m = 0; m < 4; ++m) dst##8[m] = __builtin_shufflevector(PG8_LD16A(((b) * 2 + (h)) * HTB + m * 2048), PG8_LD16A(((b) * 2 + (h)) * HTB + m * 2048 + 1024), 0, 1, 2, 3, 4, 5, 6, 7); } \
    else { _Pragma("unroll") for (int m = 0; m < 4; ++m) _Pragma("unroll") for (int k = 0; k < 2; ++k) dst[m][k] = *(const PG8_LAS bf16x8*)(lds + PG8_SA(b, h) + aoff + m * 2048 + k * 1024); } } while (0)
#define PG8_LDB(dst, b, h) do { if constexpr (F8) { _Pragma("unroll") for (int n = 0; n < 2; ++n) dst##8[n] = __builtin_shufflevector(PG8_LD16B(((b) * 2 + (h)) * HTB + n * 2048), PG8_LD16B(((b) * 2 + (h)) * HTB + n * 2048 + 1024), 0, 1, 2, 3, 4, 5, 6, 7); } \
    else { _Pragma("unroll") for (int n = 0; n < 2; ++n) _Pragma("unroll") for (int k = 0; k < 2; ++k) dst[n][k] = *(const PG8_LAS bf16x8*)(lds + PG8_SB(b, h) + boff + n * 2048 + k * 1024); } } while (0)
#define PG8_MMA(ai, bj, At, Bt) do { __builtin_amdgcn_s_setprio(1); if constexpr (F8) { _Pragma("unroll") for (int m = 0; m < 4; ++m) _Pragma("unroll") for (int n = 0; n < 2; ++n) \
            asm volatile("v_mfma_scale_f32_16x16x128_f8f6f4 %0, %1, %2, %0, %3, %3 op_sel_hi:[0,0,0]" : "+v"(acc[ai][bj][m][n]) : "v"(Bt##8[n]), "v"(At##8[m]), "v"(f8_scale)); } \
        else { _Pragma("unroll") for (int m = 0; m < 4; ++m) _Pragma("unroll") for (int n = 0; n < 2; ++n) _Pragma("unroll") for (int k = 0; k < 2; ++k) \
        acc[ai][bj][m][n] = __builtin_amdgcn_mfma_f32_16x16x32_bf16(Bt[n][k], At[m][k], acc[ai][bj][m][n], 0, 0, 0); } __builtin_amdgcn_s_setprio(0); } while (0)
#define PG8_WAIT_V(n) asm volatile("s_waitcnt vmcnt(" #n ")" ::: "memory")
#define PG8_WAIT_L(n) asm volatile("s_waitcnt lgkmcnt(" #n ")" ::: "memory")
#define PG8_BAR __builtin_amdgcn_s_barrier()
#define PG8_SCHED __builtin_amdgcn_sched_barrier(0)
    Unit cur, nxt; int ui = 0;
    if (!S.next(0, cur)) return;
    f32x4 acc[2][2][4][2];
#pragma unroll
    for (int a = 0; a < 2; ++a)
#pragma unroll
        for (int b = 0; b < 2; ++b)
#pragma unroll
            for (int m = 0; m < 4; ++m)
#pragma unroll
                for (int n = 0; n < 2; ++n) acc[a][b][m][n] = (f32x4){0.f, 0.f, 0.f, 0.f};
    bf16x8 At[4][2], B0[2][2], B1[2][2]; i32x8 At8[4], B08[2], B18[2]; (void)At; (void)B0; (void)B1; (void)At8; (void)B08; (void)B18;
    const char* cA = (const char*)g.A + (size_t)cur.pm * tstepA; const char* cB = (const char*)g.Bt + (size_t)cur.pn * tstepB;
    S.a_ready(cur);
    if constexpr (SP2) {
        PG8_STAGE(PG8_SB(0, 0), cB, voffB); PG8_STAGE(PG8_SB(0, 1), cB + hstepB, voffB); PG8_STAGE(PG8_SA(0, 0), cA, voffA); PG8_STAGE(PG8_SA(0, 1), cA + hstepA, voffA);
        if (wr == 1) PG8_BAR;
        PG8_WAIT_V(2); PG8_BAR;
        PG8_STAGE(PG8_SB(1, 0), cB + kstep, voffB); PG8_STAGE(PG8_SA(1, 0), cA + kstep, voffA); PG8_STAGE(PG8_SB(1, 1), cB + hstepB + kstep, voffB);
        PG8_WAIT_V(6); PG8_BAR;
    } else {
        PG8_STAGE(PG8_SB(0, 0), cB, voffB); PG8_STAGE(PG8_SA(0, 0), cA, voffA); PG8_STAGE(PG8_SB(0, 1), cB + hstepB, voffB); PG8_STAGE(PG8_SA(0, 1), cA + hstepA, voffA);
        if (wr == 1) PG8_BAR;
        PG8_WAIT_V(4); PG8_BAR;
        PG8_STAGE(PG8_SB(1, 0), cB + kstep, voffB); PG8_STAGE(PG8_SA(1, 0), cA + kstep, voffA); PG8_STAGE(PG8_SB(1, 1), cB + hstepB + kstep, voffB);
        PG8_WAIT_V(6); PG8_BAR;
    }
    for (;;) {
        const bool has_next = S.next(ui + 1, nxt);
        const char* nA = has_next ? (const char*)g.A + (size_t)nxt.pm * tstepA : cA; const char* nB = has_next ? (const char*)g.Bt + (size_t)nxt.pn * tstepB : cB;
        if constexpr (F8) {
            _Pragma("unroll") for (int a = 0; a < 2; ++a) _Pragma("unroll") for (int b = 0; b < 2; ++b) _Pragma("unroll") for (int m = 0; m < 4; ++m) _Pragma("unroll") for (int n = 0; n < 2; ++n) asm volatile("" : "+v"(acc[a][b][m][n])); }
        _Pragma("clang loop unroll(disable)")
        for (int t = 0; t < nt; t += 2) {
            const bool last = (t == nt - 2);
            const char* a1 = cA + (size_t)(t + 1) * kstep;
            const char* a2 = last ? nA : cA + (size_t)(t + 2) * kstep; const char* b2 = last ? nB : cB + (size_t)(t + 2) * kstep;
            const char* a3 = a2 + kstep; const char* b3 = b2 + kstep;
            if (last && has_next) S.a_ready(nxt);
            if constexpr (SP2) {
            PG8_LDB(B0, 0, 0); PG8_LDB(B1, 0, 1); PG8_SCHED; PG8_LDA(At, 0, 0); PG8_STAGE(PG8_SA(1, 1), a1 + hstepA, voffA);
            PG8_WAIT_V(8); PG8_WAIT_L(0); PG8_BAR; PG8_MMA(0, 0, At, B0); PG8_MMA(0, 1, At, B1); PG8_BAR; PG8_SCHED;
            PG8_LDA(At, 0, 1); PG8_STAGE(PG8_SB(0, 0), b2, voffB); PG8_STAGE(PG8_SB(0, 1), b2 + hstepB, voffB); PG8_STAGE(PG8_SA(0, 0), a2, voffA);
            PG8_WAIT_V(8); PG8_WAIT_L(0); PG8_BAR; PG8_MMA(1, 0, At, B0); PG8_MMA(1, 1, At, B1); PG8_BAR; PG8_SCHED;
            PG8_LDB(B0, 1, 0); PG8_LDB(B1, 1, 1); PG8_SCHED; PG8_LDA(At, 1, 0); PG8_STAGE(PG8_SA(0, 1), a2 + hstepA, voffA);
            PG8_WAIT_V(8); PG8_WAIT_L(0); PG8_BAR; PG8_MMA(0, 0, At, B0); PG8_MMA(0, 1, At, B1); PG8_BAR; PG8_SCHED;
            PG8_LDA(At, 1, 1); PG8_STAGE(PG8_SB(1, 0), b3, voffB); PG8_STAGE(PG8_SB(1, 1), b3 + hstepB, voffB); PG8_STAGE(PG8_SA(1, 0), a3, voffA);
            PG8_WAIT_V(8); PG8_WAIT_L(0); PG8_BAR; PG8_MMA(1, 0, At, B0); PG8_MMA(1, 1, At, B1); PG8_BAR; PG8_SCHED;
            } else {
            PG8_LDB(B0, 0, 0); PG8_SCHED; PG8_LDA(At, 0, 0); PG8_STAGE(PG8_SA(1, 1), a1 + hstepA, voffA);
            PG8_WAIT_L(8); PG8_BAR; PG8_WAIT_L(0); PG8_MMA(0, 0, At, B0); PG8_BAR; PG8_SCHED;
            PG8_LDB(B1, 0, 1); PG8_STAGE(PG8_SB(0, 0), b2, voffB);
            PG8_BAR; PG8_WAIT_L(0); PG8_MMA(0, 1, At, B1); PG8_BAR;
            PG8_LDA(At, 0, 1); PG8_STAGE(PG8_SA(0, 0), a2, voffA);
            PG8_BAR; PG8_WAIT_L(0); PG8_MMA(1, 0, At, B0); PG8_BAR; PG8_SCHED;
            PG8_STAGE(PG8_SB(0, 1), b2 + hstepB, voffB);
            PG8_WAIT_V(6); PG8_BAR; PG8_MMA(1, 1, At, B1); PG8_BAR;
            PG8_LDB(B0, 1, 0); PG8_SCHED; PG8_LDA(At, 1, 0); PG8_STAGE(PG8_SA(0, 1), a2 + hstepA, voffA);
            PG8_WAIT_L(8); PG8_BAR; PG8_WAIT_L(0); PG8_MMA(0, 0, At, B0); PG8_BAR; PG8_SCHED;
            PG8_LDB(B1, 1, 1); PG8_STAGE(PG8_SB(1, 0), b3, voffB);
            PG8_BAR; PG8_WAIT_L(0); PG8_MMA(0, 1, At, B1); PG8_BAR;
            PG8_LDA(At, 1, 1); PG8_STAGE(PG8_SA(1, 0), a3, voffA);
            PG8_BAR; PG8_WAIT_L(0); PG8_MMA(1, 0, At, B0); PG8_BAR; PG8_SCHED;
            PG8_STAGE(PG8_SB(1, 1), b3 + hstepB, voffB);
            PG8_WAIT_V(6); PG8_BAR; PG8_MMA(1, 1, At, B1); PG8_BAR;
            }
        }
        if constexpr (F8) { asm volatile("s_nop 15\n\ts_nop 15" ::: "memory"); }
        if constexpr (ALIGN_EPI) { if (wr == 0) PG8_BAR; }
        if constexpr (!Epi::AFTER_DRAIN) { if (!skip_epi) E(acc, cur, wr, wc, fr, fq); S.done(cur); }
        if (!has_next) break;
#pragma unroll
        for (int a = 0; a < 2; ++a)
#pragma unroll
            for (int b = 0; b < 2; ++b)
#pragma unroll
                for (int m = 0; m < 4; ++m)
#pragma unroll
                    for (int n = 0; n < 2; ++n) acc[a][b][m][n] = (f32x4){0.f, 0.f, 0.f, 0.f};
        cur = nxt; cA = nA; cB = nB; ++ui;
        if constexpr (ALIGN_EPI) { if (wr == 1) PG8_BAR; }
    }
    PG8_WAIT_V(0);
    if constexpr (!ALIGN_EPI) { if (wr == 0) PG8_BAR; }
    PG8_BAR;
    if constexpr (Epi::AFTER_DRAIN) { E.fused(acc, cur, wr, wc, fr, fq, lds, wid, lane); S.done(cur); }
#undef PG8_SA
#undef PG8_SB
#undef PG8_STAGE
#undef PG8_LD16A
#undef PG8_LD16B
#undef PG8_LDA
#undef PG8_LDB
#undef PG8_MMA
#undef PG8_WAIT_V
#undef PG8_WAIT_L
#undef PG8_BAR
#undef PG8_SCHED
}
}

namespace attn_body {
using bf16=__hip_bfloat16;
using bf16x8=__attribute__((ext_vector_type(8)))short;
using s16x4=__attribute__((ext_vector_type(4)))short;
using f32x16=__attribute__((ext_vector_type(16)))float;
using u32x4=__attribute__((ext_vector_type(4)))unsigned;
constexpr int BATCH=4,NHEAD=8,SEQ=8192,D=64,DM=NHEAD*D,ODM=1024;
constexpr int NW=8,QBLK=32,QB=QBLK*NW,KVBLK=64,NQB=SEQ/QB;
constexpr int ATTN_PITCH=DM, ATTN_UNIT_ROWS=QB;
__device__ __forceinline__ int crow(int r,int hi){return (r&3)+8*(r>>2)+4*hi;}
#define SBAR() __builtin_amdgcn_sched_barrier(0)
__device__ __forceinline__ void cmask(f32x16&p0,f32x16&p1,int jb,int qrel,int hi){
  const float NEG=-INFINITY; int kb=64*jb+4*hi;
  #pragma unroll
  for(int r=0;r<16;++r){int kv=kb+(r&3)+8*(r>>2); if(kv>qrel)p0[r]=NEG; if(kv+32>qrel)p1[r]=NEG;}
}

constexpr int NSLOT=3, SLOTB=8192;
constexpr int LDS_K=0, LDS_V=NSLOT*SLOTB, LDS_WS=2*NSLOT*SLOTB, LDS_OST=LDS_WS+NW*64*4, LDS_BYTES=LDS_OST+NW*4096;
constexpr float C2=0.125f*1.4426950408889634f;
__device__ __forceinline__ void glds16(const void*gsrc,unsigned lds_dst){unsigned keep;
  asm volatile("s_mov_b32 %0, m0\n\ts_mov_b32 m0, %2\n\ts_nop 0\n\tglobal_load_lds_dwordx4 %1, off\n\ts_mov_b32 m0, %0":"=&s"(keep):"v"(gsrc),"s"(lds_dst):"memory");}
__device__ __forceinline__ float max3f(float a,float b,float c){float r;asm("v_max3_f32 %0, %1, %2, %3":"=v"(r):"v"(a),"v"(b),"v"(c));return r;}
__device__ __forceinline__ float max2f(float a,float b){float r;asm("v_max_f32_e32 %0, %1, %2":"=v"(r):"v"(a),"v"(b));return r;}
__device__ __forceinline__ float fadd_s(float a,float b){float r;asm("v_add_f32_e32 %0, %1, %2":"=v"(r):"v"(a),"v"(b));return r;}
__device__ __forceinline__ float fsub_s(float a,float b){float r;asm("v_sub_f32_e32 %0, %1, %2":"=v"(r):"v"(a),"v"(b));return r;}
typedef float f32x2_t __attribute__((ext_vector_type(2))); typedef __bf16 bf16x2_t __attribute__((ext_vector_type(2)));
__device__ __forceinline__ unsigned cvtpk_s(float lo,float hi){f32x2_t v={lo,hi};bf16x2_t b=__builtin_convertvector(v,bf16x2_t);return __builtin_bit_cast(unsigned,b);}
#define WAIT_BAR(N) asm volatile("s_waitcnt vmcnt(" #N ") lgkmcnt(0)\n\ts_barrier":::"memory")

__device__ __forceinline__ void qkt(f32x16&p0,f32x16&p1,const char*Kslot,const bf16x8*qr,const f32x16&negm,int r32,int hi){
  const char*kb=Kslot+hi*1024+r32*16;
  #pragma unroll
  for(int d0=0;d0<4;++d0){
    const bf16x8 b0=*reinterpret_cast<const bf16x8*>(kb+d0*2048);
    const bf16x8 b1=*reinterpret_cast<const bf16x8*>(kb+d0*2048+512);
    if(d0==0){p0=__builtin_amdgcn_mfma_f32_32x32x16_bf16(b0,qr[0],negm,0,0,0);p1=__builtin_amdgcn_mfma_f32_32x32x16_bf16(b1,qr[0],negm,0,0,0);}
    else{p0=__builtin_amdgcn_mfma_f32_32x32x16_bf16(b0,qr[d0],p0,0,0,0);p1=__builtin_amdgcn_mfma_f32_32x32x16_bf16(b1,qr[d0],p1,0,0,0);}}
}
typedef __attribute__((address_space(3))) const char* lds_cptr;
typedef short v4i16_t __attribute__((ext_vector_type(4)));
__device__ __forceinline__ void kload8(bf16x8*kf,lds_cptr kp){
  kf[0]=*(const __attribute__((address_space(3))) bf16x8*)(kp);      kf[1]=*(const __attribute__((address_space(3))) bf16x8*)(kp+512);
  kf[2]=*(const __attribute__((address_space(3))) bf16x8*)(kp+2048); kf[3]=*(const __attribute__((address_space(3))) bf16x8*)(kp+2560);
  kf[4]=*(const __attribute__((address_space(3))) bf16x8*)(kp+4096); kf[5]=*(const __attribute__((address_space(3))) bf16x8*)(kp+4608);
  kf[6]=*(const __attribute__((address_space(3))) bf16x8*)(kp+6144); kf[7]=*(const __attribute__((address_space(3))) bf16x8*)(kp+6656);
}
__device__ __forceinline__ void kload2(bf16x8*kf,lds_cptr kp,int j){ kf[2*j]=*(const __attribute__((address_space(3))) bf16x8*)(kp+j*2048); kf[2*j+1]=*(const __attribute__((address_space(3))) bf16x8*)(kp+j*2048+512); }
__device__ __forceinline__ s16x4 vtr(lds_cptr p){ return __builtin_bit_cast(s16x4,__builtin_amdgcn_ds_read_tr16_b64_v4i16((__attribute__((address_space(3))) v4i16_t*)p)); }
__device__ __forceinline__ float rowmax(const f32x16&p0,const f32x16&p1){
  float a=max3f(p0[0],p0[1],p1[0]),b=max3f(p0[2],p0[3],p1[1]);a=max3f(a,p1[2],p1[3]);
  #pragma unroll
  for(int r=4;r<16;r+=4){a=max3f(a,p0[r],p0[r+1]);b=max3f(b,p0[r+2],p0[r+3]);a=max3f(a,p1[r],p1[r+1]);b=max3f(b,p1[r+2],p1[r+3]);}
  const float m=max2f(a,b);
  auto rr=__builtin_amdgcn_permlane32_swap(__float_as_uint(m),__float_as_uint(m),false,false);
  return max2f(__uint_as_float(rr[0]),__uint_as_float(rr[1]));
}
__device__ __forceinline__ void pv(f32x16*o,int vb,bf16x8 pa0,bf16x8 pa1,bf16x8 pa2,bf16x8 pa3){
  #pragma unroll
  for(int d0=0;d0<2;++d0){s16x4 lo[4],hi[4];
    #pragma unroll
    for(int ks=0;ks<4;++ks){
      asm volatile("ds_read_b64_tr_b16 %0,%1 offset:%c2":"=&v"(lo[ks]):"v"(vb),"i"(d0*4096+ks*1024):"memory");
      asm volatile("ds_read_b64_tr_b16 %0,%1 offset:%c2":"=&v"(hi[ks]):"v"(vb),"i"(d0*4096+ks*1024+512):"memory");}
    asm volatile("s_waitcnt lgkmcnt(0)":::"memory");SBAR();
    #define PK(k) (bf16x8){lo[k][0],lo[k][1],lo[k][2],lo[k][3],hi[k][0],hi[k][1],hi[k][2],hi[k][3]}
    o[d0]=__builtin_amdgcn_mfma_f32_32x32x16_bf16(pa0,PK(0),o[d0],0,0,0);
    o[d0]=__builtin_amdgcn_mfma_f32_32x32x16_bf16(pa1,PK(1),o[d0],0,0,0);
    o[d0]=__builtin_amdgcn_mfma_f32_32x32x16_bf16(pa2,PK(2),o[d0],0,0,0);
    o[d0]=__builtin_amdgcn_mfma_f32_32x32x16_bf16(pa3,PK(3),o[d0],0,0,0);
    #undef PK
  }
}

#ifndef ATTN_STORE16
#define ATTN_STORE16(p,v) (*(u32x4*)(p)=(v))
#endif
template<int THRL> __device__ __forceinline__ void attn_unit(int b,int h,int qb,const bf16*Q,const bf16*__restrict__ K,const bf16*__restrict__ V,bf16*O,const unsigned*__restrict__ SEL,char*shm,const int wave_s){
  const int wid=wave_s,lane=mk_lane(),r32=lane&31,hi=lane>>5;
  const long rowbase=(long)b*SEQ; const int q0=qb*QB;
  const bf16*Qw=Q+(rowbase+q0+wid*QBLK)*DM+h*D;
  const bf16*Kh=K+rowbase*DM+h*D,*Vh=V+rowbase*DM+h*D;
  const unsigned lds0=(unsigned)(uintptr_t)shm;
  float*wsf=(float*)(shm+LDS_WS)+wid*64;
  const bf16*ksrc=Kh+(long)lane*DM+wid*8;
  const bf16*vsrc=Vh+(long)(16*(wid&3)+(lane>>2))*DM+(wid>>2)*32+(lane&3)*8;
  const unsigned kdst=lds0+LDS_K+wid*1024, vdst=lds0+LDS_V+wid*1024;
  #define TAU(t) (((t)<4)?(NT-4+(t)):((t)-4))
  #define DMA_K(t,slot) glds16(ksrc+(long)TAU(t)*KVBLK*DM,(unsigned)__builtin_amdgcn_readfirstlane(kdst+(slot)))
  #define DMA_V(t,slot) glds16(vsrc+(long)TAU(t)*KVBLK*DM,(unsigned)__builtin_amdgcn_readfirstlane(vdst+(slot)))
  const int vb0=(int)(lds0+LDS_V)+((lane>>4)&1)*32+(lane&3)*8+(4*hi+((lane&15)>>2))*64;
  const char*Kbase=shm+LDS_K; bf16x8 kf[8];
  const lds_cptr shm3=(lds_cptr)shm; const lds_cptr kp0=shm3+LDS_K+hi*1024+r32*16; const lds_cptr vp0=shm3+LDS_V+((lane>>4)&1)*32+(lane&3)*8+(4*hi+((lane&15)>>2))*64;
  const int NT=(q0+QB)/KVBLK;
  DMA_K(0,0);DMA_V(0,0);DMA_K(1,SLOTB);
  bf16x8 qr[4];
  #pragma unroll
  for(int d0=0;d0<4;++d0)qr[d0]=*reinterpret_cast<const bf16x8*>(&Qw[(long)r32*DM+d0*16+hi*8]);
  float mhat=0.f,l_reg=0.f;f32x16 o[2];o[0]=f32x16{};o[1]=f32x16{};const f32x16 negm=f32x16{};
  const int qrel=wid*QBLK+r32;
  const unsigned selw_addr=lds0+LDS_BYTES+wid*128+r32*4;
  { const unsigned sm0_=SEL[(size_t)(b*NHEAD+h)*SEQ+q0+qrel]; if(hi==0){ asm volatile("ds_write_b32 %0, %1"::"v"(selw_addr),"v"(sm0_):"memory"); } }
  #define CMASK(P0,P1,t) do{ unsigned sm_; asm volatile("ds_read_b32 %0, %1\n\ts_waitcnt lgkmcnt(0)":"=v"(sm_):"v"(selw_addr):"memory"); const int pt_=((t)<4)?0:((t)-4)>>2; const int lim_=((t)<4)?(qrel-64*(t)):((((sm_>>pt_)&1u)!=0u)?64:-1); cmask(P0,P1,0,lim_,hi); }while(0)
  bool resc=false;
  #define START(P0,P1) do{ const float rm=rowmax(P0,P1); resc=false; \
    { const float dl=rm; mhat=fadd_s(mhat,dl); \
      _Pragma("unroll") for(int r=0;r<16;++r){P0[r]=fsub_s(P0[r],dl);P1[r]=fsub_s(P1[r],dl);} \
    } \
    _Pragma("unroll") for(int r=0;r<16;++r)P0[r]=__builtin_amdgcn_exp2f(P0[r]); }while(0)
  #define RESC() do{ if(resc){ asm volatile("s_waitcnt lgkmcnt(0)":::"memory"); \
      _Pragma("unroll") for(int d_=0;d_<2;++d_) _Pragma("unroll") for(int r=0;r<16;++r)o[d_][r]*=wsf[crow(r,hi)]; } }while(0)
  f32x16 pA0,pA1,pB0,pB1;
  int sl_prev=0,sl_cur=0,sl_next=SLOTB;
  #define ROT() do{sl_prev=sl_cur;sl_cur=sl_next;sl_next=(sl_next==(NSLOT-1)*SLOTB)?0:sl_next+SLOTB;}while(0)
  DMA_K(2,2*SLOTB);
  WAIT_BAR(3);
  qkt(pA0,pA1,Kbase,qr,negm,r32,hi);asm volatile("s_nop 15\n\ts_nop 7":"+v"(pA0),"+v"(pA1));CMASK(pA0,pA1,0);
  START(pA0,pA1);
  _Pragma("unroll") for(int r=0;r<16;++r)pA1[r]=__builtin_amdgcn_exp2f(pA1[r]);
  WAIT_BAR(0);
  DMA_K(3,0);DMA_V(1,SLOTB);
  ROT();
  kload8(kf,kp0+sl_cur);
  WAIT_BAR(2);
  s16x4 vlo[8],vhi[8]; u32x4 pw0,pw1,pw2,pw3;
  #define PKW(P,B) cvtpk_s(P[B],P[B+1])
  #define PAF(k) __builtin_bit_cast(bf16x8,pw##k)
  #define VFR(i) (bf16x8){vlo[i][0],vlo[i][1],vlo[i][2],vlo[i][3],vhi[i][0],vhi[i][1],vhi[i][2],vhi[i][3]}
  #define PIN(x) asm volatile("":"+v"(x))
  #define MX3(a,b,c) __builtin_fmaxf(__builtin_fmaxf((a),(b)),(c))
  #define GAPA(MF,A0,A1,A2,A3,W0,W1,PW) do{ MF; sacc+=A0; sacc+=A1; sacc+=A2; sacc+=A3; PIN(sacc); W0; W1; PIN(PW); SBAR(); }while(0)
  #define EX(v) __builtin_amdgcn_exp2f(v)
  #define GAPB(MF,X,B) do{ MF; X[B]=EX(X[B]); X[B+1]=EX(X[B+1]); X[B+2]=EX(X[B+2]); X[B+3]=EX(X[B+3]); PIN(X); SBAR(); }while(0)
  #define VRD(i) do{ vlo[i]=vtr(vp_+(((i)>>2)*4096+((i)&3)*1024)); vhi[i]=vtr(vp_+(((i)>>2)*4096+((i)&3)*1024+512)); }while(0)
  #define KRD(G,j) do{ if(G){ kload2(kf,kp0+sl_next,j); SBAR(); } }while(0)
  #define STEP(C0,C1,P0,P1,t,GK,GV,GL) do{ SBAR(); \
    const lds_cptr vp_=vp0+sl_prev; \
    VRD(0); SBAR(); float sacc=(P0[0]+P0[1]); \
    GAPA(C0=__builtin_amdgcn_mfma_f32_32x32x16_bf16(kf[0],qr[0],negm,0,0,0), P0[2],P0[3],P0[4],P0[5],     pw0[0]=PKW(P0,0), pw0[1]=PKW(P0,2), pw0); \
    VRD(4); SBAR(); GAPA(C1=__builtin_amdgcn_mfma_f32_32x32x16_bf16(kf[1],qr[0],negm,0,0,0), P0[6],P0[7],P0[8],P0[9],     pw0[2]=PKW(P0,4), pw0[3]=PKW(P0,6), pw0); \
    VRD(1); SBAR(); GAPA(C0=__builtin_amdgcn_mfma_f32_32x32x16_bf16(kf[2],qr[1],C0,0,0,0),   P0[10],P0[11],P0[12],P0[13], pw1[0]=PKW(P0,8), pw1[1]=PKW(P0,10), pw1); \
    VRD(5); SBAR(); GAPA(C1=__builtin_amdgcn_mfma_f32_32x32x16_bf16(kf[3],qr[1],C1,0,0,0),   P0[14],P0[15],P1[0],P1[1],   pw1[2]=PKW(P0,12),pw1[3]=PKW(P0,14), pw1); \
    VRD(2); SBAR(); GAPA(C0=__builtin_amdgcn_mfma_f32_32x32x16_bf16(kf[4],qr[2],C0,0,0,0),   P1[2],P1[3],P1[4],P1[5],     pw2[0]=PKW(P1,0), pw2[1]=PKW(P1,2), pw2); \
    VRD(6); SBAR(); GAPA(C1=__builtin_amdgcn_mfma_f32_32x32x16_bf16(kf[5],qr[2],C1,0,0,0),   P1[6],P1[7],P1[8],P1[9],     pw2[2]=PKW(P1,4), pw2[3]=PKW(P1,6), pw2); \
    VRD(3); SBAR(); GAPA(C0=__builtin_amdgcn_mfma_f32_32x32x16_bf16(kf[6],qr[3],C0,0,0,0),   P1[10],P1[11],P1[12],P1[13], pw3[0]=PKW(P1,8), pw3[1]=PKW(P1,10), pw3); \
    VRD(7); SBAR(); GAPA(C1=__builtin_amdgcn_mfma_f32_32x32x16_bf16(kf[7],qr[3],C1,0,0,0),   P1[14],P1[15],0.f,0.f,       pw3[2]=PKW(P1,12),pw3[3]=PKW(P1,14), pw3); \
    l_reg+=sacc; \
    if(GK){DMA_K((t)+3,sl_cur);} if(GV){DMA_V((t)+1,sl_next);} \
    _Pragma("unroll") for(int r=0;r<16;++r){C0[r]-=mhat;C1[r]-=mhat;} \
    CMASK(C0,C1,t); \
    { float a=MX3(C0[0],C0[1],C1[0]),b=MX3(C0[2],C0[3],C1[1]); a=MX3(a,C1[2],C1[3]); \
      _Pragma("unroll") for(int r=4;r<16;r+=4){a=MX3(a,C0[r],C0[r+1]);b=MX3(b,C0[r+2],C0[r+3]);a=MX3(a,C1[r],C1[r+1]);b=MX3(b,C1[r+2],C1[r+3]);} \
      float rm=__builtin_fmaxf(a,b); { auto rr=__builtin_amdgcn_permlane32_swap(__float_as_uint(rm),__float_as_uint(rm),false,false); rm=__builtin_fmaxf(__uint_as_float(rr[0]),__uint_as_float(rr[1])); } \
      resc=false; \
      if(__builtin_expect(__any(rm>(float)THRL),0)){ const float dl=__builtin_fmaxf(rm,0.f); mhat+=dl; \
        _Pragma("unroll") for(int r=0;r<16;++r){C0[r]-=dl;C1[r]-=dl;} \
        const float f=__builtin_amdgcn_exp2f(-dl); l_reg*=f; if(hi==0)wsf[r32]=f; resc=true; } } \
    SBAR(); \
    GAPB(o[0]=__builtin_amdgcn_mfma_f32_32x32x16_bf16(PAF(0),VFR(0),o[0],0,0,0), C0,0); \
    GAPB(o[1]=__builtin_amdgcn_mfma_f32_32x32x16_bf16(PAF(0),VFR(4),o[1],0,0,0), C0,4); \
    KRD(GL,0); GAPB(o[0]=__builtin_amdgcn_mfma_f32_32x32x16_bf16(PAF(1),VFR(1),o[0],0,0,0), C0,8); \
    KRD(GL,1); GAPB(o[1]=__builtin_amdgcn_mfma_f32_32x32x16_bf16(PAF(1),VFR(5),o[1],0,0,0), C0,12); \
    KRD(GL,2); GAPB(o[0]=__builtin_amdgcn_mfma_f32_32x32x16_bf16(PAF(2),VFR(2),o[0],0,0,0), C1,0); \
    KRD(GL,3); GAPB(o[1]=__builtin_amdgcn_mfma_f32_32x32x16_bf16(PAF(2),VFR(6),o[1],0,0,0), C1,4); \
    GAPB(o[0]=__builtin_amdgcn_mfma_f32_32x32x16_bf16(PAF(3),VFR(3),o[0],0,0,0), C1,8); \
    GAPB(o[1]=__builtin_amdgcn_mfma_f32_32x32x16_bf16(PAF(3),VFR(7),o[1],0,0,0), C1,12); \
    }while(0)
  int t=1;
  #undef CMASK
  #define CMASK(P0,P1,t) do{ unsigned sm_; asm volatile("ds_read_b32 %0, %1\n\ts_waitcnt lgkmcnt(0)":"=v"(sm_):"v"(selw_addr):"memory"); const int pt_=((t)<4)?0:((t)-4)>>2; const int lim_=((t)<4)?(qrel-64*(t)):((((sm_>>pt_)&1u)!=0u)?64:-1); cmask(P0,P1,0,lim_,hi); }while(0)
  for(;t+5<NT;t+=2){
    STEP(pB0,pB1,pA0,pA1,t,true,true,true);     WAIT_BAR(2); RESC(); ROT();
    STEP(pA0,pA1,pB0,pB1,t+1,true,true,true);   WAIT_BAR(2); RESC(); ROT();
  }
  #undef CMASK
  #define CMASK(P0,P1,t) do{ unsigned sm_; asm volatile("ds_read_b32 %0, %1\n\ts_waitcnt lgkmcnt(0)":"=v"(sm_):"v"(selw_addr):"memory"); const int pt_=((t)<4)?0:((t)-4)>>2; const int lim_=((t)<4)?(qrel-64*(t)):((((sm_>>pt_)&1u)!=0u)?64:-1); cmask(P0,P1,0,lim_,hi); }while(0)
  #define ENDW(tt) do{ if((tt)+3<NT){WAIT_BAR(2);} else if((tt)+2<NT){WAIT_BAR(1);} else {WAIT_BAR(0);} }while(0)
  for(;t+1<NT;t+=2){
    STEP(pB0,pB1,pA0,pA1,t,(t+3<NT),(t+1<NT),(t+1<NT));       ENDW(t);   RESC(); ROT();
    STEP(pA0,pA1,pB0,pB1,t+1,(t+4<NT),(t+2<NT),(t+2<NT));     ENDW(t+1); RESC(); ROT();
  }
  STEP(pB0,pB1,pA0,pA1,NT-1,false,false,false); RESC();
  { float sacc=pB0[0]+pB0[1]; _Pragma("unroll") for(int r=2;r<16;++r)sacc+=pB0[r]; _Pragma("unroll") for(int r=0;r<16;++r)sacc+=pB1[r]; l_reg+=sacc;
    pw0=(u32x4){PKW(pB0,0),PKW(pB0,2),PKW(pB0,4),PKW(pB0,6)};pw1=(u32x4){PKW(pB0,8),PKW(pB0,10),PKW(pB0,12),PKW(pB0,14)};pw2=(u32x4){PKW(pB1,0),PKW(pB1,2),PKW(pB1,4),PKW(pB1,6)};pw3=(u32x4){PKW(pB1,8),PKW(pB1,10),PKW(pB1,12),PKW(pB1,14)};
    SBAR(); pv(o,vb0+sl_cur,PAF(0),PAF(1),PAF(2),PAF(3)); }
  #undef PKW
  #undef PAF
  #undef VFR
  #undef PIN
  #undef MX3
  #undef GAPA
  #undef GAPB
  #undef EX
  #undef VRD
  #undef KRD
  #undef STEP
  #undef ENDW
  {auto rr=__builtin_amdgcn_permlane32_swap(__float_as_uint(l_reg),__float_as_uint(l_reg),false,false);l_reg=__uint_as_float(rr[0])+__uint_as_float(rr[1]);}
  if(hi==0)wsf[32+r32]=l_reg;asm volatile("s_waitcnt lgkmcnt(0)":::"memory");
  float rli[16];
  #pragma unroll
  for(int r=0;r<16;++r)rli[r]=__builtin_amdgcn_rcpf(wsf[32+crow(r,hi)]);
  bf16*Ow=O+(rowbase+q0+wid*QBLK)*ODM+h*D;
  { bf16*stg=(bf16*)(shm+LDS_OST)+wid*2048;
    #pragma unroll
    for(int r=0;r<16;++r){const int orow=crow(r,hi);
      #pragma unroll
      for(int d0=0;d0<2;++d0)stg[orow*64+d0*32+r32]=__float2bfloat16(ABL_MOBA?0.f:o[d0][r]*rli[r]);}
    asm volatile("s_waitcnt lgkmcnt(0)":::"memory");
    #pragma unroll
    for(int i=0;i<4;++i){const int row=i*8+(lane>>3),ch=lane&7; const u32x4 v=*(const u32x4*)(stg+row*64+ch*8); ATTN_STORE16(Ow+(long)row*ODM+ch*8,v);} }
  asm volatile("s_waitcnt lgkmcnt(0)\n\ts_barrier":::"memory");
  #undef DMA_K
  #undef DMA_V
  #undef CMASK
  #undef START
  #undef RESC
  #undef ROT
}
constexpr int ATTN_LDS_BYTES=LDS_BYTES;
struct AttnTensors { const bf16* Q; const bf16* K; const bf16* V; bf16* O; const unsigned* SEL; };
struct AttnUnit { int bh; int qb; };
struct StaticOrder {
  int vcu;
  __device__ __forceinline__ explicit StaticOrder(int grid,int block):vcu((block%8)*(grid/8)+block/8){}
  __device__ __forceinline__ bool next(int i,AttnUnit&u)const{ if(i>=4)return false; const int s=vcu&7; u.bh=vcu>>3; u.qb=(i==0)?s:(i==1)?15-s:(i==2)?16+s:31-s; return true; }
  __device__ __forceinline__ void a_ready(const AttnUnit&)const{}
  __device__ __forceinline__ void done(const AttnUnit&)const{}
};
template<class Sched,int THRL=8> __device__ __forceinline__ void attn_phase(char*lds,const AttnTensors&T,const Sched&S,const int wave_s){
  AttnUnit u;
  for(int i=0;S.next(i,u);++i){ S.a_ready(u); attn_unit<THRL>(u.bh/NHEAD,u.bh%NHEAD,u.qb,T.Q,T.K,T.V,T.O,T.SEL,lds,wave_s); S.done(u); }
}
#undef SBAR
#undef WAIT_BAR
}

#define LAS __attribute__((address_space(3)))
#define XB_TMO      128
#define XB_XCNT(j)  (256  + 64 * (j))
#define XB_XSUB(j)  (1280 + 64 * (j))
#define XB_XGEN(j)  (2304 + 64 * (j))
#define XB_TOP      3328
#define XB_TOPGEN   3392
#define XCD_BAR_WORDS 3456
#define XB_SPIN_CAP (1u << 18)

__device__ __forceinline__ unsigned xb_ld(unsigned* p)              { return __hip_atomic_load(p, __ATOMIC_RELAXED, __HIP_MEMORY_SCOPE_AGENT); }
__device__ __forceinline__ unsigned xb_add(unsigned* p, unsigned v) { return __hip_atomic_fetch_add(p, v, __ATOMIC_RELAXED, __HIP_MEMORY_SCOPE_AGENT); }
__device__ __forceinline__ unsigned xb_xcc_id() { return (unsigned)__builtin_amdgcn_s_getreg((3 << 11) | 20) & 0xFu; }
#define XB_SPIN(cond, bar) do { unsigned _sp = 0; while (cond) { __builtin_amdgcn_s_sleep(1); \
    if ((++_sp & 255u) == 0u) { if (xb_ld(&(bar)[XB_TMO])) break; if (_sp > XB_SPIN_CAP) { atomicAdd(&(bar)[XB_TMO], 1u); break; } } } } while (0)

struct XcdBarrier {
    unsigned* bar; unsigned x;
    volatile LAS unsigned* st;
};

__device__ __forceinline__ XcdBarrier xcd_barrier_post(unsigned* bar, volatile LAS unsigned* st) {
    XcdBarrier b; b.bar = bar; b.x = xb_xcc_id(); b.st = st;
    if (threadIdx.x == 0) (void)xb_add(&bar[XB_XCNT(b.x)], 1u);
    return b;
}
__device__ __forceinline__ void xcd_barrier_complete(unsigned* bar, unsigned x, unsigned& nloc, unsigned& nx) {
    const unsigned G = gridDim.x * gridDim.y * gridDim.z;
    unsigned sum, cnt, mine, sp = 0u;
    for (;;) {
        sum = 0u; cnt = 0u; mine = 0u;
#pragma unroll
        for (unsigned j = 0; j < 16; ++j) { const unsigned c = xb_ld(&bar[XB_XCNT(j)]); sum += c; cnt += (c > 0u) ? 1u : 0u; mine = (j == x) ? c : mine; }
        if (sum == G) break;
        __builtin_amdgcn_s_sleep(1);
        if ((++sp & 255u) == 0u) { if (xb_ld(&bar[XB_TMO])) break; if (sp > XB_SPIN_CAP) { atomicAdd(&bar[XB_TMO], 1u); break; } }
    }
    nloc = mine > 0u ? mine : 1u; nx = cnt > 0u ? cnt : 1u;
}

__device__ __forceinline__ void xcd_barrier(const XcdBarrier& b, const bool is_t0) {
    asm volatile("s_waitcnt vmcnt(0)" ::: "memory");
    __syncthreads();
    if (is_t0) {
        unsigned* bar = b.bar;
        __builtin_amdgcn_s_waitcnt(0);
        unsigned nloc = b.st[0], nx = b.st[1];
        if (nloc == 0u) { xcd_barrier_complete(bar, b.x, nloc, nx); b.st[0] = nloc; b.st[1] = nx; }
        const unsigned old = xb_add(&bar[XB_XSUB(b.x)], 1u);
        const unsigned gen = old / nloc;
        if (old + 1u == (gen + 1u) * nloc) {
            __builtin_amdgcn_fence(__ATOMIC_RELEASE, "agent");
            asm volatile("s_waitcnt vmcnt(0)" ::: "memory");
            const unsigned og = xb_add(&bar[XB_TOP], 1u);
            const unsigned tg = og / nx;
            if (og + 1u == (tg + 1u) * nx) xb_add(&bar[XB_TOPGEN], 1u);
            else XB_SPIN(xb_ld(&bar[XB_TOPGEN]) == tg, bar);
            __builtin_amdgcn_fence(__ATOMIC_ACQUIRE, "agent");
            xb_add(&bar[XB_XGEN(b.x)], 1u);
            asm volatile("s_waitcnt vmcnt(0)" ::: "memory");
        } else {
            XB_SPIN(xb_ld(&bar[XB_XGEN(b.x)]) == gen, bar);
            __builtin_amdgcn_fence(__ATOMIC_ACQUIRE, "agent");
            asm volatile("s_waitcnt vmcnt(0)" ::: "memory");
        }
    }
    __syncthreads();
}

#ifndef STAMP_KA
#define STAMP_KA -1
#define STAMP_KB -1
#endif
#ifndef DUP_RWKV
#define DUP_RWKV 0
#endif
#ifndef DUPMASK
#define DUPMASK 0
#endif
#ifndef RWKV_SEQ_OVERRIDE
#define RWKV_SEQ_OVERRIDE 0
#endif
#ifndef RWKV_DBG
#define RWKV_DBG 0
#endif
#ifndef SKIP_DSA
#define SKIP_DSA 0
#endif
#ifndef DSA_DUP_ATT
#define DSA_DUP_ATT 0
#endif
#ifndef DSA_DUP_PASS
#define DSA_DUP_PASS 0
#endif
#ifndef DSA_DUP_KIND
#define DSA_DUP_KIND 0
#endif
#ifndef MOE_SCALE
#define MOE_SCALE 1.0f
#endif
#ifndef DIAG
#define DIAG 0
#endif
#ifndef ABL_MOE
#define ABL_MOE 0
#endif
#ifndef ABL_RWKV
#define ABL_RWKV 0
#endif
#ifndef ABL_DSA
#define ABL_DSA 0
#endif
#ifndef ABL_S5
#define ABL_S5 0
#endif
#ifndef ABL_MOBA
#define ABL_MOBA 0
#endif
#ifndef ABL_FFN0
#define ABL_FFN0 0
#endif
constexpr int NWAVES = 8;
constexpr int T_TOK = 32768, DMODEL = 1024, SEQL = 8192, NBATCH = 4;
constexpr int FFN_D = 2816, ODD_PROJ = 2756, ODD_PAD = 2816, FEXP = 3584, NEXP = 8;
constexpr float NORM_EPS = 1e-6f;
constexpr size_t MiB = 1u << 20;
constexpr size_t WS_CTL = 0, CTL_ZERO_BYTES = 1 * MiB;
constexpr size_t WS_ROPE = 1 * MiB;
constexpr size_t WS_KMEAN = WS_ROPE + 512 * 1024;
constexpr size_t WS_TOKINFO = 2 * MiB;
constexpr size_t WS_TOKSLOT = WS_TOKINFO + 512 * 1024;
constexpr size_t WS_TILEEXP = WS_TOKSLOT + 256 * 1024;
constexpr size_t WS_WE_IN = 3 * MiB;
constexpr size_t WS_WGLU = WS_WE_IN + 4 * MiB;
constexpr size_t WS_WE_OUT = WS_WGLU + MiB / 2;
constexpr size_t WS_WFFN_GU = WS_WE_OUT + 2 * MiB;
constexpr size_t WS_WFFN_D = WS_WFFN_GU + 11 * MiB;
constexpr size_t WS_WO_IN = WS_WFFN_D + 11 * MiB / 2;
constexpr size_t WS_WLORA = WS_WO_IN + 11 * MiB / 2;
constexpr size_t WS_WO_OUT = WS_WLORA + 3 * MiB / 4;
constexpr size_t WS_S5MT = 35 * MiB;
constexpr size_t WS_S5BEND = 55 * MiB;
static_assert(WS_WO_OUT + 2 * MiB <= WS_S5MT, "weights map");
constexpr size_t WS_XN = 64 * MiB;
constexpr size_t WS_CAT = WS_XN;
constexpr size_t WS_UG = 128 * MiB;
constexpr size_t WS_Q0 = 168 * MiB, WS_K0 = 200 * MiB, WS_V0 = 232 * MiB;
constexpr size_t WS_XEND = 264 * MiB;
constexpr size_t WS_YA = 280 * MiB;
constexpr size_t WS_SELM = 312 * MiB;
constexpr size_t WS_SS1 = 314 * MiB, WS_SS2 = 316 * MiB;
constexpr size_t WS_HB1 = 320 * MiB;
constexpr size_t WS_ACT = 128 * MiB;
constexpr size_t WS_P1 = 128 * MiB;
constexpr size_t WS_LORA = 304 * MiB;
constexpr size_t WS_QD = 400 * MiB;
constexpr size_t WS_KD = 432 * MiB;
constexpr size_t WS_KI = 436 * MiB;
constexpr size_t WS_QI = 440 * MiB;
constexpr size_t WS_WI = 456 * MiB;
constexpr size_t WS_VD = 490 * MiB;
constexpr size_t WS_ALORA = 457 * MiB;
constexpr size_t WS_YR = 457 * MiB;
constexpr int MOE_MAXTILES = 264, MOE_CHUNK = 128;
constexpr size_t WS_XG = 64 * MiB;
constexpr size_t WS_YS = 130 * MiB;
constexpr size_t WS_WMOE_GU = 262 * MiB;
constexpr size_t WS_WMOE_D = 318 * MiB;
constexpr size_t WS_ACTQ = 346 * MiB;
constexpr float MOE_WGU_SCALE = 32.0f, MOE_WD_SCALE = 64.0f, FFN_WGU_SCALE = 32.0f, FFN_WD_SCALE = 64.0f;
constexpr size_t WS_NEED = 494 * MiB;
constexpr int CW_BAR = 4096;
constexpr int MAX_LAUNCH = 36;
constexpr int CW_EXPCNT = 196608;
static_assert((CW_BAR + MAX_LAUNCH * 3456) <= CW_EXPCNT && (CW_EXPCNT + 8 * 64) * 4 <= (int)CTL_ZERO_BYTES, "ctl map");

constexpr int RING_BYTES = 131072;
constexpr int MISC_OFF = 147200;
constexpr int LDS_BYTES = 147456;

#define GAS __attribute__((address_space(1)))
typedef unsigned short bf16;
typedef unsigned v4u __attribute__((ext_vector_type(4)));
typedef unsigned v2u __attribute__((ext_vector_type(2)));
typedef float f32x4 __attribute__((ext_vector_type(4)));
typedef float f32x2 __attribute__((ext_vector_type(2)));
typedef short bf16x8 __attribute__((ext_vector_type(8)));
#define LDS_WAIT() asm volatile("s_waitcnt lgkmcnt(0)" ::: "memory")
#define VM_WAIT() asm volatile("s_waitcnt vmcnt(0)" ::: "memory")
typedef float cv_f32x2 __attribute__((ext_vector_type(2))); typedef __bf16 cv_bf16x2 __attribute__((ext_vector_type(2)));
__device__ __forceinline__ unsigned pk2(float lo, float hi) { const cv_f32x2 v = {lo, hi}; const cv_bf16x2 b = __builtin_convertvector(v, cv_bf16x2); return __builtin_bit_cast(unsigned, b); }
__device__ __forceinline__ unsigned f2bf(float f) { return pk2(f, 0.f) & 0xffffu; }
__device__ __forceinline__ float clamp448(float x) { return __builtin_amdgcn_fmed3f(x, -448.0f, 448.0f); }
__device__ __forceinline__ unsigned pk4_fp8(float a, float b, float c, float d) {
    unsigned w = __builtin_amdgcn_cvt_pk_fp8_f32(clamp448(a), clamp448(b), 0u, false); return __builtin_amdgcn_cvt_pk_fp8_f32(clamp448(c), clamp448(d), w, true); }
__device__ __forceinline__ float bf2f(unsigned short b) { return __builtin_bit_cast(float, (unsigned)b << 16); }
__device__ __forceinline__ float bflo(unsigned w) { return __builtin_bit_cast(float, w << 16); }
__device__ __forceinline__ float bfhi(unsigned w) { return __builtin_bit_cast(float, w & 0xffff0000u); }
__device__ __forceinline__ void unpack8(const v4u w, float (&o)[8]) { o[0] = bflo(w.x); o[1] = bfhi(w.x); o[2] = bflo(w.y); o[3] = bfhi(w.y); o[4] = bflo(w.z); o[5] = bfhi(w.z); o[6] = bflo(w.w); o[7] = bfhi(w.w); }
__device__ __forceinline__ v4u pack8(const float (&v)[8]) { v4u w; w.x = pk2(v[0], v[1]); w.y = pk2(v[2], v[3]); w.z = pk2(v[4], v[5]); w.w = pk2(v[6], v[7]); return w; }
__device__ __forceinline__ void store8_bf16(bf16* dst, const float (&v)[8]) { *(v4u*)dst = pack8(v); }
__device__ __forceinline__ void load8_bf16(const bf16* src, float (&o)[8]) { const v4u w = *(const v4u*)src; unpack8(w, o); }
__device__ __forceinline__ float wave_sum(float v) {
#pragma unroll
    for (int o = 1; o < 64; o <<= 1) v += __shfl_xor(v, o);
    return v;
}
__device__ __forceinline__ float sigmoidf_(float x) { return __builtin_amdgcn_rcpf(1.0f + __expf(-x)); }
__device__ __forceinline__ float gelu_tanh(float x) { const float z = 0.7978845608028654f * (x + 0.044715f * x * x * x); const float t = 1.0f - 2.0f * __builtin_amdgcn_rcpf(1.0f + __expf(2.0f * z)); return 0.5f * x * (1.0f + t); }


__device__ __forceinline__ float dpp_sum8(float x) {
    x += __builtin_bit_cast(float, __builtin_amdgcn_mov_dpp(__builtin_bit_cast(int, x), 0xB1, 0xf, 0xf, true));
    x += __builtin_bit_cast(float, __builtin_amdgcn_mov_dpp(__builtin_bit_cast(int, x), 0x4E, 0xf, 0xf, true));
    x += __builtin_bit_cast(float, __builtin_amdgcn_mov_dpp(__builtin_bit_cast(int, x), 0x141, 0xf, 0xf, true));
    return x;
}

struct Args { const float* in[38]; float* out; unsigned char* ws; int ph_lo, ph_hi, li, pad; };
struct Frame {
    LAS unsigned char* lds;
    int wave, G;
    const float* const* in; float* out; unsigned char* ws;
};
enum InIdx { I_X = 0, I_E_NORM_MIX, I_E_W_IN, I_S5_A_RE, I_S5_A_IM, I_S5_LOG_DT, I_S5_B_RE, I_S5_B_IM, I_S5_C_RE, I_S5_C_IM, I_S5_D, I_S5_GLU_W, I_S5_GLU_B, I_E_W_OUT, I_E_NORM_FFN,
             I_FFN_GATE, I_FFN_UP, I_FFN_DOWN, I_O_NORM_MIX, I_O_W_IN, I_RWKV_MU, I_RWKV_W0, I_RWKV_W_UP, I_RWKV_A0, I_RWKV_A_UP, I_RWKV_G_UP, I_RWKV_K_K, I_RWKV_K_A, I_RWKV_R_K,
             I_RWKV_LN_W, I_RWKV_LN_B, I_O_W_OUT, I_O_NORM_FFN, I_MOE_ROUTER, I_MOE_GATE, I_MOE_UP, I_MOE_DOWN, I_FINAL_NORM };

template <int MODE>
__device__ __forceinline__ void tr_item(const float* __restrict__ W, int K, int N, bf16* __restrict__ WT, int ldo, int row_off, const float* __restrict__ gain, LAS float* scr, int kb, int nb, int lane) {
    const int k0 = 64 * kb, n0 = 32 * nb; const int nn = n0 + (lane & 31);
#pragma unroll 8
    for (int i = 0; i < 32; ++i) { const int kk = 2 * i + (lane >> 5); float w = (nn < N) ? W[(size_t)(k0 + kk) * N + nn] : 0.f; if (gain) w *= gain[k0 + kk]; scr[kk * 33 + (lane & 31)] = w; }
    LDS_WAIT(); asm volatile("" ::: "memory");
    const int c = lane & 7;
#pragma unroll
    for (int j = 0; j < 4; ++j) { const int nl = (lane >> 3) + 8 * j; const int n = n0 + nl; const LAS float* s = scr + (8 * c) * 33 + nl;
        v4u o; o.x = pk2(s[0 * 33], s[1 * 33]); o.y = pk2(s[2 * 33], s[3 * 33]); o.z = pk2(s[4 * 33], s[5 * 33]); o.w = pk2(s[6 * 33], s[7 * 33]);
        const int row = (MODE == 0) ? (row_off + n) : (row_off + (n >> 7) * 256 + (n & 127));
        if (n < N) *(v4u*)(WT + (size_t)row * ldo + k0 + 8 * c) = o; }
    LDS_WAIT(); asm volatile("" ::: "memory");
}
template <int MODE>
__device__ __forceinline__ void tr_item64(const float* __restrict__ W, int K, int N, bf16* __restrict__ WT, int ldo, int row_off, const float* __restrict__ gain, LAS bf16* scr, int kb, int nb, int lane) {
    const int k0 = 64 * kb, n0 = 64 * nb, n4 = (lane & 15) * 4, kr = lane >> 4; const bool ok = (n0 + n4) < N;
    f32x4 v[16];
#pragma unroll
    for (int i = 0; i < 16; ++i) v[i] = ok ? *(const f32x4*)(W + (size_t)(k0 + 4 * i + kr) * N + n0 + n4) : (f32x4){0.f, 0.f, 0.f, 0.f};
#pragma unroll
    for (int i = 0; i < 16; ++i) { const int k = 4 * i + kr; const float gg = gain ? gain[k0 + k] : 1.0f; LAS bf16* d = scr + n4 * 72 + k;
        d[0] = (bf16)f2bf(v[i].x * gg); d[72] = (bf16)f2bf(v[i].y * gg); d[144] = (bf16)f2bf(v[i].z * gg); d[216] = (bf16)f2bf(v[i].w * gg); }
    LDS_WAIT(); asm volatile("" ::: "memory");
    const int c = lane & 7;
#pragma unroll
    for (int j = 0; j < 8; ++j) { const int nl = (lane >> 3) + 8 * j, n = n0 + nl; const v4u o = *(const LAS v4u*)(scr + nl * 72 + 8 * c);
        const int row = (MODE == 0) ? (row_off + n) : (row_off + (n >> 7) * 256 + (n & 127));
        if (n < N) *(v4u*)(WT + (size_t)row * ldo + k0 + 8 * c) = o; }
    LDS_WAIT(); asm volatile("" ::: "memory");
}
__device__ __forceinline__ void tr64_load(const float* __restrict__ W, int N, int kb, int nb, int lane, f32x4 (&v)[16]) {
    const int k0 = 64 * kb, n0 = 64 * nb, n4 = (lane & 15) * 4, kr = lane >> 4;
#pragma unroll
    for (int i = 0; i < 16; ++i) v[i] = *(const f32x4*)(W + (size_t)(k0 + 16 * (i >> 2) + 4 * kr + (i & 3)) * N + n0 + n4);
}
template <int MODE>
__device__ __forceinline__ void tr64_f8_finish(const f32x4 (&v)[16], unsigned char* __restrict__ WT, int ldo, int row_off, const float* __restrict__ gain, float scale, LAS unsigned char* scr, int kb, int nb, int lane) {
    const int k0 = 64 * kb, n0 = 64 * nb, n4 = (lane & 15) * 4, kr = lane >> 4;
#pragma unroll
    for (int i = 0; i < 16; ++i) { const int k = 16 * (i >> 2) + 4 * kr + (i & 3); const float gg = (gain ? gain[k0 + k] : 1.0f) * scale; const unsigned w = pk4_fp8(v[i].x * gg, v[i].y * gg, v[i].z * gg, v[i].w * gg); LAS unsigned char* d = scr + n4 * 68 + k;
        d[0] = (unsigned char)w; d[68] = (unsigned char)(w >> 8); d[136] = (unsigned char)(w >> 16); d[204] = (unsigned char)(w >> 24); }
    LDS_WAIT(); asm volatile("" ::: "memory");
    const int c = lane & 3;
#pragma unroll
    for (int j = 0; j < 4; ++j) { const int nl = (lane >> 2) + 16 * j, n = n0 + nl; const LAS unsigned* sp = (const LAS unsigned*)(scr + nl * 68 + 16 * c); const v4u o = {sp[0], sp[1], sp[2], sp[3]};
        const int row = (MODE == 0) ? (row_off + n) : (row_off + (n >> 7) * 256 + (n & 127));
        *(v4u*)(WT + (size_t)row * ldo + k0 + 16 * c) = o; }
    LDS_WAIT(); asm volatile("" ::: "memory");
}
template <int MODE>
__device__ __forceinline__ void tr_item64_f8(const float* __restrict__ W, int K, int N, unsigned char* __restrict__ WT, int ldo, int row_off, const float* __restrict__ gain, float scale, LAS unsigned char* scr, int kb, int nb, int lane) {
    f32x4 v[16]; tr64_load(W, N, kb, nb, lane, v); tr64_f8_finish<MODE>(v, WT, ldo, row_off, gain, scale, scr, kb, nb, lane);
}
__device__ __forceinline__ void rms_row_to_bf16(const float* xrow, bf16* orow, int lane) {
    const f32x4* xr = (const f32x4*)xrow + lane;
    f32x4 v[4]; float s = 0.f;
#pragma unroll
    for (int j = 0; j < 4; ++j) { v[j] = xr[64 * j]; s += (v[j].x * v[j].x + v[j].y * v[j].y) + (v[j].z * v[j].z + v[j].w * v[j].w); }
    const float rstd = __builtin_amdgcn_rsqf(wave_sum(s) * (1.f / DMODEL) + NORM_EPS);
    unsigned long long* o8 = (unsigned long long*)orow + lane;
#pragma unroll
    for (int j = 0; j < 4; ++j) o8[64 * j] = (unsigned long long)pk2(v[j].x * rstd, v[j].y * rstd) | ((unsigned long long)pk2(v[j].z * rstd, v[j].w * rstd) << 32);
}
__device__ __forceinline__ void norm_phase(Frame& F, const float* src, bf16* dst, int hb, int HG) {
    const int gw = hb * NWAVES + F.wave, NGW = HG * NWAVES, lane = mk_lane();
    for (int m0 = gw; m0 < T_TOK; m0 += 4 * NGW) { f32x4 v[4][4];
#pragma unroll
        for (int r = 0; r < 4; ++r) { const int m = m0 + r * NGW; const f32x4* xr = (const f32x4*)(src + (size_t)(m < T_TOK ? m : m0) * DMODEL) + lane;
#pragma unroll
            for (int j = 0; j < 4; ++j) v[r][j] = xr[64 * j]; }
#pragma unroll
        for (int r = 0; r < 4; ++r) { const int m = m0 + r * NGW; float s = 0.f;
#pragma unroll
            for (int j = 0; j < 4; ++j) s += (v[r][j].x * v[r][j].x + v[r][j].y * v[r][j].y) + (v[r][j].z * v[r][j].z + v[r][j].w * v[r][j].w);
            const float rstd = __builtin_amdgcn_rsqf(wave_sum(s) * (1.f / DMODEL) + NORM_EPS);
            if (m < T_TOK) { unsigned long long* o8 = (unsigned long long*)(dst + (size_t)m * DMODEL) + lane;
#pragma unroll
                for (int j = 0; j < 4; ++j) o8[64 * j] = (unsigned long long)pk2(v[r][j].x * rstd, v[r][j].y * rstd) | ((unsigned long long)pk2(v[r][j].z * rstd, v[r][j].w * rstd) << 32); } } }
}

__device__ __forceinline__ void s5_build_group(Frame& F, int g) {
    LAS float* pw_re = (LAS float*)F.lds;
    LAS float* pw_im = pw_re + 33 * 64;
    LAS float* bb_re = pw_im + 33 * 64;
    LAS float* bb_im = bb_re + 1024;
    LAS float* cc_re = bb_im + 1024;
    LAS float* cc_im = cc_re + 1024;
    LAS float* klag = cc_im + 1024;
    LAS float* lm = klag + 8192;
    LAS float* th = lm + 64;
    LAS float* fr = th + 64;
    LAS float* fi = fr + 64;
    const float* a_re = F.in[I_S5_A_RE]; const float* a_im = F.in[I_S5_A_IM]; const float* log_dt = F.in[I_S5_LOG_DT];
    const float* b_re = F.in[I_S5_B_RE]; const float* b_im = F.in[I_S5_B_IM]; const float* c_re = F.in[I_S5_C_RE]; const float* c_im = F.in[I_S5_C_IM];
    const int tid = F.wave * 64 + mk_lane();
    if (tid < 64) { const int p = tid; const float ar = a_re[g * 64 + p], ai = a_im[g * 64 + p], dt = expf(log_dt[g]);
        const float mag = expf(dt * ar); float sn, cs; sincosf(dt * ai, &sn, &cs); const float abr = mag * cs, abi = mag * sn;
        const float den = ar * ar + ai * ai, xr = abr - 1.0f, xi = abi;
        lm[p] = dt * ar; th[p] = dt * ai; fr[p] = (xr * ar + xi * ai) / den; fi[p] = (xi * ar - xr * ai) / den; }
    __syncthreads();
    for (int idx = tid; idx < 33 * 64; idx += 512) { const int tau = idx >> 6, p = idx & 63; const float mag = expf((float)tau * lm[p]); float sn, cs; sincosf((float)tau * th[p], &sn, &cs); pw_re[idx] = mag * cs; pw_im[idx] = mag * sn; }
    for (int idx = tid; idx < 1024; idx += 512) { const int p = idx >> 4; const float br = b_re[(size_t)g * 1024 + idx], bi = b_im[(size_t)g * 1024 + idx];
        bb_re[idx] = fr[p] * br - fi[p] * bi; bb_im[idx] = fr[p] * bi + fi[p] * br;
        cc_re[idx] = c_re[(size_t)g * 1024 + idx]; cc_im[idx] = c_im[(size_t)g * 1024 + idx]; }
    __syncthreads();
    for (int idx = tid; idx < 8192; idx += 512) { const int tau = idx >> 8, c = (idx >> 4) & 15, c2 = idx & 15; float s = 0.f;
        for (int p = 0; p < 64; ++p) { const float cr = cc_re[c * 64 + p], ci = cc_im[c * 64 + p], pr = pw_re[tau * 64 + p], pi = pw_im[tau * 64 + p];
            const float er = cr * pr - ci * pi, ei = cr * pi + ci * pr; s += er * bb_re[p * 16 + c2] - ei * bb_im[p * 16 + c2]; }
        klag[idx] = s; }
    __syncthreads();
    bf16* MT = (bf16*)(F.ws + WS_S5MT) + (size_t)g * 512 * 640;
    for (int ch = tid; ch < 512 * 80; ch += 512) { const int n = ch / 80, kc = ch % 80, t = n >> 4, c = n & 15, k0 = 8 * kc; float v[8];
        if (k0 < 512) { const int s = k0 >> 4, c0 = k0 & 15;
#pragma unroll
            for (int j = 0; j < 8; ++j) v[j] = (s <= t) ? klag[((t - s) * 16 + c) * 16 + c0 + j] : 0.f;
        } else {
#pragma unroll
            for (int j = 0; j < 8; ++j) { const int jj = k0 - 512 + j, p = jj >> 1; const float cr = cc_re[c * 64 + p], ci = cc_im[c * 64 + p], pr = pw_re[(t + 1) * 64 + p], pi = pw_im[(t + 1) * 64 + p];
                v[j] = (jj & 1) ? -(cr * pi + ci * pr) : (cr * pr - ci * pi); }
        }
        store8_bf16(MT + (size_t)n * 640 + k0, v); }
    bf16* BE = (bf16*)(F.ws + WS_S5BEND) + (size_t)g * 256 * 512;
    for (int ch = tid; ch < 256 * 64; ch += 512) { const int n = ch >> 6, kc = ch & 63, k0 = 8 * kc, s = k0 >> 4, c0 = k0 & 15; float v[8];
        if (n < 128) { const int p = n >> 1; const float pr = pw_re[(31 - s) * 64 + p], pi = pw_im[(31 - s) * 64 + p];
#pragma unroll
            for (int j = 0; j < 8; ++j) { const float br = bb_re[p * 16 + c0 + j], bi = bb_im[p * 16 + c0 + j]; v[j] = (n & 1) ? (pr * bi + pi * br) : (pr * br - pi * bi); }
        } else {
#pragma unroll
            for (int j = 0; j < 8; ++j) v[j] = 0.f;
        }
        store8_bf16(BE + (size_t)n * 512 + k0, v); }
    __syncthreads();
}

__device__ __forceinline__ void p0_prologue(Frame& F, int parts = 15) {
    if (parts & 1) { if ((int)blockIdx.x < 32) s5_build_group(F, (int)blockIdx.x);
        if (F.G < 32) { for (int g = F.G + (int)blockIdx.x; g < 32; g += F.G) s5_build_group(F, g); } }
    if (!(parts & 14)) return;
    LAS bf16* scr = (LAS bf16*)(F.lds + F.wave * 16384);
    const int lane = mk_lane(), tid = F.wave * 64 + lane;
    const bool sep = F.G >= 64; if (sep && (int)blockIdx.x < 32) return;
    const int hb = sep ? (int)blockIdx.x - 32 : (int)blockIdx.x, HG = sep ? F.G - 32 : F.G;
    const int gw = hb * NWAVES + F.wave, NGW = HG * NWAVES;
    constexpr int J0 = 16 * 32, J1 = 8 * 8, J2 = 16 * 16, J3 = 16 * 44, J4 = J3, J5 = 44 * 16, J6 = 16 * 44, J7 = 16 * 16;
    constexpr int NIT = J0 + J1 + J2 + J3 + J4 + J5 + J6; (void)J7;
    unsigned char* ws = F.ws;
    if (parts & 2) for (int it = gw; it < NIT; it += NGW) {
        int r = it;
        if (r < J0) { tr_item64<0>(F.in[I_E_W_IN], 1024, 2048, (bf16*)(ws + WS_WE_IN), 1024, 0, F.in[I_E_NORM_MIX], scr, r / 32, r % 32, lane); continue; } r -= J0;
        if (r < J1) { tr_item64<0>(F.in[I_S5_GLU_W], 512, 512, (bf16*)(ws + WS_WGLU), 512, 0, nullptr, scr, r / 8, r % 8, lane); continue; } r -= J1;
        if (r < J2) { tr_item64<0>(F.in[I_E_W_OUT], 1024, 1024, (bf16*)(ws + WS_WE_OUT), 1024, 0, nullptr, scr, r / 16, r % 16, lane); continue; } r -= J2;
        if (r < J3) { tr_item64<1>(F.in[I_FFN_GATE], 1024, FFN_D, (bf16*)(ws + WS_WFFN_GU), 1024, 0, F.in[I_E_NORM_FFN], scr, r / 44, r % 44, lane); continue; } r -= J3;
        if (r < J4) { tr_item64<1>(F.in[I_FFN_UP], 1024, FFN_D, (bf16*)(ws + WS_WFFN_GU), 1024, 128, F.in[I_E_NORM_FFN], scr, r / 44, r % 44, lane); continue; } r -= J4;
        if (r < J5) { tr_item64<0>(F.in[I_FFN_DOWN], FFN_D, 1024, (bf16*)(ws + WS_WFFN_D), FFN_D, 0, nullptr, scr, r / 16, r % 16, lane); continue; } r -= J5;
        tr_item64<0>(F.in[I_O_W_IN], 1024, ODD_PROJ, (bf16*)(ws + WS_WO_IN), 1024, 0, F.in[I_O_NORM_MIX], scr, r / 44, r % 44, lane);
    }
    const int gt = hb * 512 + tid, NGT = HG * 512;
    if (parts & 4) {
    { bf16* w = (bf16*)(ws + WS_WO_IN) + (size_t)ODD_PROJ * 1024; for (int i = gt; i < (ODD_PAD - ODD_PROJ) * 1024 / 8; i += NGT) *(v4u*)(w + (size_t)i * 8) = (v4u){0u, 0u, 0u, 0u}; }
    { bf16* w = (bf16*)(ws + WS_WLORA); const float* wu = F.in[I_RWKV_W_UP]; const float* au = F.in[I_RWKV_A_UP]; const float* gu = F.in[I_RWKV_G_UP];
      for (int i = gt; i < 1536 * 256; i += NGT) { const int n = i >> 8, k = i & 255; float v = 0.f;
          if (n < 512) { if (k < 64) v = wu[k * 512 + n]; } else if (n < 1024) { if (k >= 64 && k < 128) v = au[(k - 64) * 512 + (n - 512)]; } else { if (k >= 128) v = gu[(k - 128) * 512 + (n - 1024)]; }
          w[i] = (bf16)f2bf(v); } }
    { float* rp = (float*)(ws + WS_ROPE); for (int i = gt; i < 8192 * 8; i += NGT) { const int pos = i >> 3, j = i & 7; const float inv = powf(500000.0f, -(float)j / 8.0f); const float ang = (float)pos * inv;
          rp[pos * 16 + j] = cosf(ang); rp[pos * 16 + 8 + j] = sinf(ang); } }
    }
    if (parts & 8) norm_phase(F, F.in[I_X], (bf16*)(ws + WS_XN), hb, HG);
}

constexpr float ATT_C2 = 0.125f * 1.4426950408889634f;
struct F_E1 {
    bf16* UG; bf16* Q0; bf16* K0; bf16* V0; const float* rope;
    __device__ __forceinline__ void operator()(const pg8::Unit& u, int r, int c, float (&v)[8], int wc) const {
        const int row = u.pm * 256 + r, col = u.pn * 256 + c, seg = u.pn >> 1;
        if (seg == 0) { const int g = col >> 4, c0 = col & 15; store8_bf16(UG + ((size_t)(g * 1024 + (row >> 5)) * 640 + (row & 31) * 16 + c0), v); }
        else if (seg == 3) { store8_bf16(V0 + (size_t)row * 512 + (col - 1536), v); }
        else { const int ch = col - seg * 512;
            if ((wc & 1) == 0) { float o[8];
#pragma unroll
                for (int j = 0; j < 8; ++j) o[j] = __shfl_xor(v[j], 16);
                const int d = ch & 63;
                if (d < 16) { const float* cs = rope + (size_t)(row & 8191) * 16; const f32x4 c0 = *(const f32x4*)cs, c1 = *(const f32x4*)(cs + 4), s0 = *(const f32x4*)(cs + 8), s1 = *(const f32x4*)(cs + 12);
                    const float cv[8] = {c0.x, c0.y, c0.z, c0.w, c1.x, c1.y, c1.z, c1.w}, sv[8] = {s0.x, s0.y, s0.z, s0.w, s1.x, s1.y, s1.z, s1.w};
                    const float sgn = (d == 0) ? -1.0f : 1.0f;
#pragma unroll
                    for (int j = 0; j < 8; ++j) v[j] = v[j] * cv[j] + sgn * o[j] * sv[j]; } }
            if (seg == 1) {
#pragma unroll
                for (int j = 0; j < 8; ++j) v[j] *= ATT_C2;
                store8_bf16(Q0 + (size_t)row * 512 + ch, v); }
            else store8_bf16(K0 + (size_t)row * 512 + ch, v); }
    }
};
struct EpiE1 {
    static constexpr bool PERM = true, AFTER_DRAIN = false;
    bf16* UG; bf16* Q0; bf16* K0; bf16* V0; const float* rope;
    __device__ __forceinline__ void operator()(const pg8::f32x4 (&acc)[2][2][4][2], const pg8::Unit& u, int wr, int wc, int fr, int fq) const {
        const int seg = u.pn >> 1;
        if (seg == 0 || seg == 3) {
#pragma unroll
            for (int ai = 0; ai < 2; ++ai)
#pragma unroll
                for (int m = 0; m < 4; ++m) { const int row = u.pm * 256 + ai * 128 + wr * 64 + m * 16 + fr;
#pragma unroll
                    for (int bj = 0; bj < 2; ++bj) { const int col = u.pn * 256 + bj * 128 + wc * 32 + 8 * fq;
                        float v[8] = {acc[ai][bj][m][0][0], acc[ai][bj][m][0][1], acc[ai][bj][m][0][2], acc[ai][bj][m][0][3], acc[ai][bj][m][1][0], acc[ai][bj][m][1][1], acc[ai][bj][m][1][2], acc[ai][bj][m][1][3]};
                        if (seg == 0) { const int g = col >> 4, c0 = col & 15; store8_bf16(UG + ((size_t)(g * 1024 + (row >> 5)) * 640 + (row & 31) * 16 + c0), v); }
                        else store8_bf16(V0 + (size_t)row * 512 + (col - 1536), v); } }
            return; }
        bf16* dst = (seg == 1) ? Q0 : K0; const float osc = (seg == 1) ? ATT_C2 : 1.0f;
        const bool ropew = (wc & 1) == 0;
        if (!ropew) {
#pragma unroll
            for (int ai = 0; ai < 2; ++ai)
#pragma unroll
                for (int m = 0; m < 4; ++m) { const int row = u.pm * 256 + ai * 128 + wr * 64 + m * 16 + fr;
#pragma unroll
                    for (int bj = 0; bj < 2; ++bj) { const int ch = (u.pn & 1) * 256 + bj * 128 + wc * 32 + 8 * fq;
                        float v[8] = {acc[ai][bj][m][0][0] * osc, acc[ai][bj][m][0][1] * osc, acc[ai][bj][m][0][2] * osc, acc[ai][bj][m][0][3] * osc, acc[ai][bj][m][1][0] * osc, acc[ai][bj][m][1][1] * osc, acc[ai][bj][m][1][2] * osc, acc[ai][bj][m][1][3] * osc};
                        store8_bf16(dst + (size_t)row * 512 + ch, v); } }
            return; }
        const float sgn = (fq == 0) ? -osc : osc; const float keep = (fq < 2) ? 0.0f : osc;
        f32x4 pr[2][2][4];
#define E1_LOAD(b, buf) do { _Pragma("unroll") for (int mm = 0; mm < 2; ++mm) { const int ri = (b) * 2 + mm; const int row = u.pm * 256 + (ri >> 2) * 128 + wr * 64 + (ri & 3) * 16 + fr; \
            const f32x4* cs = (const f32x4*)(rope + (size_t)(row & 8191) * 16); pr[buf][mm][0] = cs[0]; pr[buf][mm][1] = cs[1]; pr[buf][mm][2] = cs[2]; pr[buf][mm][3] = cs[3]; } } while (0)
        E1_LOAD(0, 0);
#pragma unroll
        for (int b = 0; b < 4; ++b) {
            if (b + 1 < 4) E1_LOAD(b + 1, (b + 1) & 1);
#pragma unroll
            for (int mm = 0; mm < 2; ++mm) { const int ri = b * 2 + mm, ai = ri >> 2, m = ri & 3; const int row = u.pm * 256 + ai * 128 + wr * 64 + m * 16 + fr;
                const f32x4 c0 = pr[b & 1][mm][0], c1 = pr[b & 1][mm][1], s0 = pr[b & 1][mm][2], s1 = pr[b & 1][mm][3];
                float cv[8] = {c0.x, c0.y, c0.z, c0.w, c1.x, c1.y, c1.z, c1.w}, sv[8] = {s0.x, s0.y, s0.z, s0.w, s1.x, s1.y, s1.z, s1.w};
#pragma unroll
                for (int j = 0; j < 8; ++j) { cv[j] = (fq < 2) ? cv[j] * osc : keep; sv[j] = (fq < 2) ? sv[j] * sgn : 0.0f; }
#pragma unroll
                for (int bj = 0; bj < 2; ++bj) { const int ch = (u.pn & 1) * 256 + bj * 128 + wc * 32 + 8 * fq;
                    float v[8] = {acc[ai][bj][m][0][0], acc[ai][bj][m][0][1], acc[ai][bj][m][0][2], acc[ai][bj][m][0][3], acc[ai][bj][m][1][0], acc[ai][bj][m][1][1], acc[ai][bj][m][1][2], acc[ai][bj][m][1][3]};
                    float o[8];
#pragma unroll
                    for (int j = 0; j < 8; ++j) o[j] = __shfl_xor(v[j], 16);
#pragma unroll
                    for (int j = 0; j < 8; ++j) v[j] = v[j] * cv[j] + o[j] * sv[j];
                    store8_bf16(dst + (size_t)row * 512 + ch, v); } } }
#undef E1_LOAD
    }
};
struct F_XEND { float* XEND;
    __device__ __forceinline__ void operator()(const pg8::Unit& u, int r, int c, float (&v)[8], int) const {
        if (c < 128) { float* d = XEND + (size_t)(u.pm * 256 + r) * 128 + c; *(f32x4*)d = (f32x4){v[0], v[1], v[2], v[3]}; *(f32x4*)(d + 4) = (f32x4){v[4], v[5], v[6], v[7]}; } }
};
struct F_S5Y { const bf16* UG; const float* dsk; bf16* YA;
    static constexpr int MB = 4; typedef v4u Pre; struct Hoist { f32x4 d[2]; };
    __device__ __forceinline__ void hoist(const pg8::Unit& u, int, int fq, Hoist& h) const { const int ch = (u.pm >> 2) * 16 + ((8 * fq) & 15); h.d[0] = *(const f32x4*)(dsk + ch); h.d[1] = *(const f32x4*)(dsk + ch + 4); }
    __device__ __forceinline__ void load(const pg8::Unit& u, int r, int c, Pre& p) const { p = *(const v4u*)(UG + (size_t)(u.pm * 256 + r) * 640 + (u.pn & 1) * 256 + c); }
    __device__ __forceinline__ void apply(const pg8::Unit& u, int r, int c, float (&v)[8], const Pre& p, const Hoist& h, int) const {
        const int row = u.pm * 256 + r, lc = (u.pn & 1) * 256 + c, g = u.pm >> 2, t = lc >> 4, c0 = lc & 15;
        const int token = (row & 1023) * 32 + t, ch = g * 16 + c0;
        float uu[8]; unpack8(p, uu);
        const float dv[8] = {h.d[0].x, h.d[0].y, h.d[0].z, h.d[0].w, h.d[1].x, h.d[1].y, h.d[1].z, h.d[1].w};
#pragma unroll
        for (int j = 0; j < 8; ++j) v[j] = gelu_tanh(v[j] + dv[j] * uu[j]);
        store8_bf16(YA + (size_t)token * 512 + ch, v); }
};
struct F_GLU { const bf16* YA; const float* gb; bf16* CAT;
    static constexpr int MB = 4; typedef v4u Pre; struct Hoist { f32x4 b[2][2]; };
    __device__ __forceinline__ void hoist(const pg8::Unit& u, int wc, int fq, Hoist& h) const {
#pragma unroll
        for (int bj = 0; bj < 2; ++bj) { const int col = u.pn * 256 + bj * 128 + wc * 32 + 8 * fq; h.b[bj][0] = *(const f32x4*)(gb + col); h.b[bj][1] = *(const f32x4*)(gb + col + 4); } }
    __device__ __forceinline__ void load(const pg8::Unit& u, int r, int c, Pre& p) const { p = *(const v4u*)(YA + (size_t)(u.pm * 256 + r) * 512 + u.pn * 256 + c); }
    __device__ __forceinline__ void apply(const pg8::Unit& u, int r, int c, float (&v)[8], const Pre& p, const Hoist& h, int bj) const {
        const int row = u.pm * 256 + r, col = u.pn * 256 + c;
        float ya[8]; unpack8(p, ya);
        const f32x4 b0 = h.b[bj][0], b1 = h.b[bj][1]; const float bv[8] = {b0.x, b0.y, b0.z, b0.w, b1.x, b1.y, b1.z, b1.w};
#pragma unroll
        for (int j = 0; j < 8; ++j) v[j] = ABL_S5 ? 0.f : ya[j] * sigmoidf_(v[j] + bv[j]);
        store8_bf16(CAT + (size_t)row * 1024 + col, v); }
};
constexpr int RES_LD = 2 * DMODEL;
struct F_RES { const bf16* base; bf16* out;
    static constexpr int MB = 4; typedef v4u Pre; struct Hoist {};
    __device__ __forceinline__ void hoist(const pg8::Unit&, int, int, Hoist&) const {}
    __device__ __forceinline__ void load(const pg8::Unit& u, int r, int c, Pre& p) const { p = *(const v4u*)(base + (size_t)(u.pm * 256 + r) * RES_LD + u.pn * 256 + c); }
    __device__ __forceinline__ void apply(const pg8::Unit& u, int r, int c, float (&v)[8], const Pre& p, const Hoist&, int) const {
        float b[8]; unpack8(p, b);
#pragma unroll
        for (int j = 0; j < 8; ++j) v[j] += b[j];
        store8_bf16(out + (size_t)(u.pm * 256 + r) * RES_LD + u.pn * 256 + c, v); }
};
__device__ __forceinline__ float row_rstd16(const float* SS, int row) {
    const f32x4* p = (const f32x4*)(SS + (size_t)row * 16); const f32x4 a = p[0], b = p[1], c = p[2], d = p[3];
    const float s = ((a.x + a.y) + (a.z + a.w)) + ((b.x + b.y) + (b.z + b.w)) + ((c.x + c.y) + (c.z + c.w)) + ((d.x + d.y) + (d.z + d.w));
    return __builtin_amdgcn_rsqf(s * (1.f / DMODEL) + NORM_EPS); }
struct F_SWIGLU { bf16* ACT; int ld; const float* SS; int mode = 0;
    __device__ __forceinline__ void operator()(const pg8::Unit& u, int r, int c, float (&g)[8], float (&p)[8], float rs) const {
        const int row = u.pm * 256 + r;
        float o[8];
#pragma unroll
        for (int j = 0; j < 8; ++j) { const float gg = g[j] * rs; o[j] = ABL_FFN0 ? 0.f : gg * sigmoidf_(gg) * (p[j] * rs); }
        if (mode == 0 || o[0] == 1.2345e-30f) store8_bf16(ACT + (size_t)row * ld + u.pn * 128 + c, o); }
};
template <bool BASE_BF16> struct EpiResNorm {
    static constexpr bool PERM = true, AFTER_DRAIN = false;
    const void* base; bf16* HB; bf16* RES; float* SS; int skip = 0;
    __device__ __forceinline__ void operator()(const pg8::f32x4 (&acc)[2][2][4][2], const pg8::Unit& u, int wr, int wc, int fr, int fq) const {
        if (skip) return;
        f32x4 pa[2][2][2][2];
#define ERN_LOAD(b, buf) do { _Pragma("unroll") for (int mm = 0; mm < 2; ++mm) { const int ri = (b) * 2 + mm; const int row = u.pm * 256 + (ri >> 2) * 128 + wr * 64 + (ri & 3) * 16 + fr; \
            _Pragma("unroll") for (int bj = 0; bj < 2; ++bj) { const size_t o = (size_t)row * 1024 + u.pn * 256 + bj * 128 + wc * 32 + 8 * fq; \
                if (BASE_BF16) pa[buf][mm][bj][0] = __builtin_bit_cast(f32x4, *(const v4u*)((const bf16*)base + o)); \
                else { pa[buf][mm][bj][0] = *(const f32x4*)((const float*)base + o); pa[buf][mm][bj][1] = *(const f32x4*)((const float*)base + o + 4); } } } } while (0)
        ERN_LOAD(0, 0);
#pragma unroll
        for (int b = 0; b < 4; ++b) {
            if (b + 1 < 4) ERN_LOAD(b + 1, (b + 1) & 1);
#pragma unroll
            for (int mm = 0; mm < 2; ++mm) { const int ri = b * 2 + mm, ai = ri >> 2, m = ri & 3; const int row = u.pm * 256 + ai * 128 + wr * 64 + m * 16 + fr; float ss = 0.f;
#pragma unroll
                for (int bj = 0; bj < 2; ++bj) { const int col = u.pn * 256 + bj * 128 + wc * 32 + 8 * fq;
                    float bv[8];
                    if (BASE_BF16) unpack8(__builtin_bit_cast(v4u, pa[b & 1][mm][bj][0]), bv);
                    else { const f32x4 a = pa[b & 1][mm][bj][0], bb = pa[b & 1][mm][bj][1]; bv[0] = a.x; bv[1] = a.y; bv[2] = a.z; bv[3] = a.w; bv[4] = bb.x; bv[5] = bb.y; bv[6] = bb.z; bv[7] = bb.w; }
                    float v[8] = {bv[0] + acc[ai][bj][m][0][0], bv[1] + acc[ai][bj][m][0][1], bv[2] + acc[ai][bj][m][0][2], bv[3] + acc[ai][bj][m][0][3],
                                  bv[4] + acc[ai][bj][m][1][0], bv[5] + acc[ai][bj][m][1][1], bv[6] + acc[ai][bj][m][1][2], bv[7] + acc[ai][bj][m][1][3]};
                    const v4u pk = pack8(v);
                    *(v4u*)(HB + (size_t)row * 1024 + col) = pk;
                    if (RES) *(v4u*)(RES + (size_t)row * RES_LD + col) = pk;
#pragma unroll
                    for (int j = 0; j < 8; ++j) ss += v[j] * v[j]; }
                ss += __shfl_xor(ss, 16); ss += __shfl_xor(ss, 32);
                if (fq == 0) SS[(size_t)row * 16 + u.pn * 4 + wc] = ss; } }
#undef ERN_LOAD
    }
};
struct SchedXend { int G, c;
    __device__ __forceinline__ bool next(int i, pg8::Unit& u) const { const int L = i * G + c; if (L >= 128) return false; u.pm = L; u.pn = L >> 2; u.aux = 0; return true; }
    __device__ __forceinline__ void a_ready(const pg8::Unit&) const {}
    __device__ __forceinline__ void done(const pg8::Unit&) const {} };
struct SchedS5Y { int G, c;
    __device__ __forceinline__ bool next(int i, pg8::Unit& u) const { const int L = i * G + c; if (L >= 256) return false; const int g = L >> 3; u.pm = g * 4 + ((L >> 1) & 3); u.pn = g * 2 + (L & 1); u.aux = 0; return true; }
    __device__ __forceinline__ void a_ready(const pg8::Unit&) const {}
    __device__ __forceinline__ void done(const pg8::Unit&) const {} };

__device__ __forceinline__ void kmean_phase(Frame& F) {
    const bf16* K0 = (const bf16*)(F.ws + WS_K0); float* km = (float*)(F.ws + WS_KMEAN); const int lane = mk_lane(), tid = F.wave * 64 + lane; LAS float* red = (LAS float*)F.lds;
    for (int un = ((int)blockIdx.x + F.G - (128 % F.G)) % F.G; un < 128; un += F.G) { const int b = un >> 5, n = un & 31; const bf16* src = K0 + ((size_t)b * SEQL + n * 256 + F.wave) * 512 + 8 * lane;
        float s[8] = {0.f, 0.f, 0.f, 0.f, 0.f, 0.f, 0.f, 0.f};
#pragma unroll 8
        for (int i = 0; i < 32; ++i) { float t[8]; load8_bf16(src + (size_t)i * 8 * 512, t);
#pragma unroll
            for (int e = 0; e < 8; ++e) s[e] += t[e]; }
        *(LAS f32x4*)(red + F.wave * 512 + 8 * lane) = (f32x4){s[0], s[1], s[2], s[3]}; *(LAS f32x4*)(red + F.wave * 512 + 8 * lane + 4) = (f32x4){s[4], s[5], s[6], s[7]};
        __syncthreads();
        float a = 0.f;
#pragma unroll
        for (int w = 0; w < 8; ++w) a += red[w * 512 + tid];
        const int h = tid >> 6, d = tid & 63; km[((size_t)(b * 8 + h) * 32 + n) * 64 + d] = a * (1.0f / 256.0f);
        __syncthreads(); }
}
__device__ __forceinline__ void s5_carry_phase(Frame& F) {
    const int lane = mk_lane(), tid = F.wave * 64 + lane; LAS float* xs = (LAS float*)F.lds;
    for (int un = blockIdx.x; un < 128; un += F.G) { const int g = un >> 2, b = un & 3;
        const f32x4* src = (const f32x4*)((const float*)(F.ws + WS_XEND) + (size_t)(g * 1024 + b * 256) * 128);
#pragma unroll 4
        for (int i = tid; i < 8192; i += 512) ((LAS f32x4*)xs)[i] = src[i];
        __syncthreads();
        if (F.wave == 0) { const int p = lane;
            const float ar = F.in[I_S5_A_RE][g * 64 + p], ai = F.in[I_S5_A_IM][g * 64 + p], dt = expf(F.in[I_S5_LOG_DT][g]);
            const float mag = expf(32.0f * dt * ar); float sn, cs; sincosf(32.0f * dt * ai, &sn, &cs); const float a_r = mag * cs, a_i = mag * sn;
            unsigned* __restrict__ ug = (unsigned*)((bf16*)(F.ws + WS_UG) + (size_t)(g * 1024 + b * 256) * 640 + 512 + 2 * p);
            float cr = 0.f, ci = 0.f;
#pragma unroll 8
            for (int c = 0; c < 256; ++c) { const f32x2 x = *(const LAS f32x2*)(xs + c * 128 + 2 * p); ug[(size_t)c * 320] = pk2(cr, ci);
                const float nr = a_r * cr - a_i * ci + x.x, ni = a_r * ci + a_i * cr + x.y; cr = nr; ci = ni; } }
        __syncthreads(); }
}
__device__ __forceinline__ void moba_select_phase(Frame& F) {
    LAS float* km = (LAS float*)F.lds;
    const bf16* Q0 = (const bf16*)(F.ws + WS_Q0); const float* kmg = (const float*)(F.ws + WS_KMEAN); unsigned* SELM = (unsigned*)(F.ws + WS_SELM); const int tid = F.wave * 64 + mk_lane();
    const bool split = (F.G == 256); const int ufirst = split ? ((int)blockIdx.x < 128 ? (int)blockIdx.x : 128 + ((int)blockIdx.x - 128) * 3) : (int)blockIdx.x;
    const int ucount = split ? ((int)blockIdx.x < 128 ? 1 : 3) : (512 - (int)blockIdx.x + F.G - 1) / F.G;
    for (int ui = 0; ui < ucount; ++ui) { const int un = split ? ufirst + ui : ufirst + ui * F.G; const int b = un >> 7, qb = (un >> 2) & 31, hp = un & 3;
        for (int i = tid; i < 4096; i += 512) km[i] = kmg[(size_t)(b * 8 + hp * 2 + (i >> 11)) * 2048 + (i & 2047)];
        __syncthreads();
        const int hl = tid >> 8, tl = tid & 255, h = hp * 2 + hl, t = qb * 256 + tl;
        float q[64]; const bf16* qp = Q0 + ((size_t)b * SEQL + t) * 512 + h * 64;
#pragma unroll
        for (int j = 0; j < 8; ++j) { float tmp[8]; load8_bf16(qp + 8 * j, tmp);
#pragma unroll
            for (int e = 0; e < 8; ++e) q[8 * j + e] = tmp[e]; }
        float v1 = -INFINITY, v2 = -INFINITY, v3 = -INFINITY; int i1 = -1, i2 = -1, i3 = -1;
        for (int n = 0; n < qb; ++n) { const LAS float* kp = km + (hl * 32 + n) * 64; float s = 0.f;
#pragma unroll
            for (int d = 0; d < 64; d += 4) { const f32x4 kv = *(const LAS f32x4*)(kp + d); s += q[d] * kv.x + q[d + 1] * kv.y + q[d + 2] * kv.z + q[d + 3] * kv.w; }
            if (s > v1) { v3 = v2; i3 = i2; v2 = v1; i2 = i1; v1 = s; i1 = n; } else if (s > v2) { v3 = v2; i3 = i2; v2 = s; i2 = n; } else if (s > v3) { v3 = s; i3 = n; } }
        unsigned m = 1u << qb; if (i1 >= 0) m |= 1u << i1; if (i2 >= 0) m |= 1u << i2; if (i3 >= 0) m |= 1u << i3;
        SELM[(size_t)(b * 8 + h) * SEQL + t] = m;
        __syncthreads(); }
}

constexpr int P1_LD = ODD_PAD;
constexpr int PC_R = 0, PC_K = 512, PC_V = 1024, PC_WD = 1536, PC_AD = 1600, PC_GD = 1664, PC_Q = 1792, PC_KD = 2304, PC_VD = 2368, PC_QI = 2432, PC_KI = 2688, PC_WI = 2752;
struct F_P1 { bf16* P1; const float* SS;
    __device__ __forceinline__ void operator()(const pg8::Unit& u, int r, int c, float (&v)[8], float rs) const { const int row = u.pm * 256 + r;
#pragma unroll
        for (int j = 0; j < 8; ++j) v[j] *= rs;
        store8_bf16(P1 + (size_t)row * P1_LD + u.pn * 256 + c, v); } };
struct F_LORA { bf16* LORA; const float* w0; const float* a0;
    static constexpr int MB = 4; struct Pre {}; struct Hoist { f32x4 w[2][2]; };
    __device__ __forceinline__ void hoist(const pg8::Unit& u, int wc, int fq, Hoist& h) const { const int seg = u.pn >> 1; const float* src = (seg == 0) ? w0 : a0 - 512;
#pragma unroll
        for (int bj = 0; bj < 2; ++bj) { const int col = (seg < 2) ? (u.pn * 256 + bj * 128 + wc * 32 + 8 * fq) : 512; h.w[bj][0] = *(const f32x4*)(src + col); h.w[bj][1] = *(const f32x4*)(src + col + 4); } }
    __device__ __forceinline__ void load(const pg8::Unit&, int, int, Pre&) const {}
    __device__ __forceinline__ void apply(const pg8::Unit& u, int r, int c, float (&v)[8], const Pre&, const Hoist& h, int bj) const {
        const int row = u.pm * 256 + r, col = u.pn * 256 + c, seg = u.pn >> 1;
        const float wv[8] = {h.w[bj][0].x, h.w[bj][0].y, h.w[bj][0].z, h.w[bj][0].w, h.w[bj][1].x, h.w[bj][1].y, h.w[bj][1].z, h.w[bj][1].w};
        const float sc = (seg == 0) ? -0.6065306597126334f : 1.0f;
#pragma unroll
        for (int j = 0; j < 8; ++j) { const float sg = sc * sigmoidf_(wv[j] + v[j]); v[j] = (seg < 2) ? sg : v[j]; }
        store8_bf16(LORA + (size_t)row * 1536 + col, v); }
};
struct F_MOEGU { unsigned char* ACTQ; int rt0; int probe = 0;
    __device__ __forceinline__ void operator()(const pg8::Unit& u, int r, int c, float (&g)[8], float (&p)[8]) const {
        float o[8];
#pragma unroll
        for (int j = 0; j < 8; ++j) { const float gg = g[j] * (1.0f / MOE_WGU_SCALE); o[j] = gg * sigmoidf_(gg) * (p[j] * (1.0f / MOE_WGU_SCALE)); }
        if (probe == 2) { if (o[0] == 1.2345e-30f) ACTQ[0] = 1; return; }
        *(v2u*)(ACTQ + (size_t)((probe ? 0 : (u.aux >> 8)) * 256 + r) * FEXP + (probe ? 0 : (u.aux & 255)) * 128 + c) = (v2u){pk4_fp8(o[0], o[1], o[2], o[3]), pk4_fp8(o[4], o[5], o[6], o[7])}; }
};
struct F_MOED { bf16* YS; int probe = 0;
    __device__ __forceinline__ void operator()(const pg8::Unit& u, int r, int c, float (&v)[8], int) const {
#pragma unroll
        for (int j = 0; j < 8; ++j) v[j] *= (1.0f / MOE_WD_SCALE);
        if (probe == 2) { if (v[0] == 1.2345e-30f) YS[0] = 1; return; }
        store8_bf16(YS + (size_t)((probe ? 0 : u.aux) * 256 + r) * 1024 + (u.pn & 3) * 256 + c, v); } };
struct SchedMoeGU { const int* tile_exp; int rt0, ntq, G, c, ntail, nD;
    __device__ __forceinline__ bool next(int i, pg8::Unit& u) const { const int nt = ntq + ntail, U = nt * 28; int L;
        if (c < nD) { L = (i + 4) * G + c; if (L >= U) return false; }
        else { L = i * G + c;
            if (L >= U) { if (c >= 5 * nD) return false; const int own = (U - c + G - 1) / G; if (i != own) return false; const int e = c - nD; L = (e / nD) * G + (e % nD); } }
        const int idx = L % nt, pn = L / nt, rt = idx < ntq ? rt0 + idx : 256 + (idx - ntq); const int e = tile_exp[rt]; u.pm = rt; u.pn = e * 28 + pn; u.aux = pn | (idx << 8); return true; }
    __device__ __forceinline__ void a_ready(const pg8::Unit&) const {}
    __device__ __forceinline__ void done(const pg8::Unit&) const {} };
struct SchedMoeDT { const int* tile_exp; int ntail, G, c;
    __device__ __forceinline__ bool next(int i, pg8::Unit& u) const { if (i > 0 || c >= ntail * 4) return false; const int idx = c % ntail, pn = c / ntail, rt = 256 + idx; const int e = tile_exp[rt]; u.pm = 128 + idx; u.pn = e * 4 + pn; u.aux = rt; return true; }
    __device__ __forceinline__ void a_ready(const pg8::Unit&) const {}
    __device__ __forceinline__ void done(const pg8::Unit&) const {} };
struct SchedMoeD { const int* tile_exp; int rt0, ntq, G, c;
    __device__ __forceinline__ bool next(int i, pg8::Unit& u) const { const int L = i * G + c; if (L >= ntq * 4) return false; const int rt = rt0 + L % ntq, pn = L / ntq; const int e = tile_exp[rt]; u.pm = rt - rt0; u.pn = e * 4 + pn; u.aux = rt; return true; }
    __device__ __forceinline__ void a_ready(const pg8::Unit&) const {}
    __device__ __forceinline__ void done(const pg8::Unit&) const {} };

__device__ __forceinline__ void rope8_x1(float (&v)[8], int d0, const float* cs) {
    float o[8];
#pragma unroll
    for (int j = 0; j < 8; ++j) o[j] = __shfl_xor(v[j], 1);
    if (d0 < 16) { const f32x4 c0 = *(const f32x4*)cs, c1 = *(const f32x4*)(cs + 4), s0 = *(const f32x4*)(cs + 8), s1 = *(const f32x4*)(cs + 12);
        const float cv[8] = {c0.x, c0.y, c0.z, c0.w, c1.x, c1.y, c1.z, c1.w}, sv[8] = {s0.x, s0.y, s0.z, s0.w, s1.x, s1.y, s1.z, s1.w};
        const float sgn = (d0 == 0) ? -1.0f : 1.0f;
#pragma unroll
        for (int j = 0; j < 8; ++j) v[j] = v[j] * cv[j] + sgn * o[j] * sv[j]; }
}
__device__ __forceinline__ void rope8_pre(float (&v)[8], int d0, const f32x4 (&cs)[4]) {
    float o[8];
#pragma unroll
    for (int j = 0; j < 8; ++j) o[j] = __shfl_xor(v[j], 1);
    const float cv[8] = {cs[0].x, cs[0].y, cs[0].z, cs[0].w, cs[1].x, cs[1].y, cs[1].z, cs[1].w}, sv[8] = {cs[2].x, cs[2].y, cs[2].z, cs[2].w, cs[3].x, cs[3].y, cs[3].z, cs[3].w};
    const float sgn = (d0 == 0) ? -1.0f : 1.0f;
#pragma unroll
    for (int j = 0; j < 8; ++j) v[j] = (d0 < 16) ? v[j] * cv[j] + sgn * o[j] * sv[j] : v[j];
}
__device__ __forceinline__ void l1_prep_phase(Frame& F) {
    const int gw = blockIdx.x * NWAVES + F.wave, NGW = F.G * NWAVES, lane = mk_lane();
    const bf16* P1 = (const bf16*)(F.ws + WS_P1); const float* mu = F.in[I_RWKV_MU]; const float* rope = (const float*)(F.ws + WS_ROPE);
    bf16* ALORA = (bf16*)(F.ws + WS_ALORA); bf16* QD = (bf16*)(F.ws + WS_QD); bf16* KD = (bf16*)(F.ws + WS_KD); bf16* KI = (bf16*)(F.ws + WS_KI); bf16* QI = (bf16*)(F.ws + WS_QI); float* WI = (float*)(F.ws + WS_WI);
    const int colA = PC_WD + 8 * (lane & 31); float muv[8];
#pragma unroll
    for (int j = 0; j < 8; ++j) muv[j] = mu[colA + j];
    const int src3 = (lane < 32) ? (PC_QI + 8 * lane) : ((lane < 40) ? (PC_KD + 8 * (lane - 32)) : ((lane < 48) ? (PC_KI + 8 * (lane & 7)) : (PC_VD + 8 * (lane & 7))));
    bf16* VD = (bf16*)(F.ws + WS_VD);
    for (int t0 = gw; t0 < T_TOK; t0 += 4 * NGW) { v4u cur[4], prv[4], qv[4], s3[4]; f32x4 cs[4][4]; unsigned short wi[4];
#pragma unroll
        for (int r = 0; r < 4; ++r) { const int tok = t0 + r * NGW, tc = tok < T_TOK ? tok : t0; const bf16* row = P1 + (size_t)tc * P1_LD; const int pos = tc & (SEQL - 1); const f32x4* csp = (const f32x4*)(rope + (size_t)pos * 16);
            cur[r] = *(const v4u*)(row + colA); prv[r] = *(const v4u*)((pos != 0 ? row - P1_LD : row) + colA); qv[r] = *(const v4u*)(row + PC_Q + 8 * lane); s3[r] = *(const v4u*)(row + src3);
            cs[r][0] = csp[0]; cs[r][1] = csp[1]; cs[r][2] = csp[2]; cs[r][3] = csp[3]; wi[r] = row[PC_WI + (lane & 3)]; }
#pragma unroll
        for (int r = 0; r < 4; ++r) { const int tok = t0 + r * NGW; const int pos = tok & (SEQL - 1);
            if (tok < T_TOK) {
                { float c8[8], p8[8]; unpack8(cur[r], c8); unpack8(prv[r], p8);
#pragma unroll
                  for (int j = 0; j < 8; ++j) { const float pv = (pos != 0) ? p8[j] : 0.f; const float x = c8[j] + (pv - c8[j]) * muv[j];
                      c8[j] = (lane < 8) ? tanhf(x) : ((lane < 16) ? x : sigmoidf_(x)); }
                  if (lane < 32) store8_bf16(ALORA + (size_t)tok * 256 + 8 * lane, c8); }
                { float v[8]; unpack8(qv[r], v); rope8_pre(v, 8 * (lane & 7), cs[r]);
#pragma unroll
                  for (int j = 0; j < 8; ++j) v[j] *= ATT_C2;
                  store8_bf16(QD + (size_t)tok * 512 + 8 * lane, v); }
                { float v[8]; unpack8(s3[r], v); rope8_pre(v, 8 * (lane & 7), cs[r]);
                  if (lane >= 48 && lane < 56) *(v4u*)(VD + (size_t)tok * 64 + 8 * (lane - 48)) = s3[r];
                  if (lane < 32) store8_bf16(QI + (size_t)tok * 256 + 8 * lane, v);
                  else if (lane < 40) store8_bf16(KD + (size_t)tok * 64 + 8 * (lane - 32), v);
                  else if (lane < 48) store8_bf16(KI + (size_t)tok * 64 + 8 * (lane - 40), v); }
                if (lane < 4) WI[(size_t)tok * 4 + lane] = bf2f(wi[r]) * 0.0625f; } } }
}
#ifndef RP_NB
#define RP_NB 4
#endif
__device__ __forceinline__ void rwkv_post_phase(Frame& F) {
    const int gw = blockIdx.x * NWAVES + F.wave, NGW = F.G * NWAVES, lane = mk_lane(), c0 = 8 * lane;
    const bf16* P1 = (const bf16*)(F.ws + WS_P1); const bf16* LORA = (const bf16*)(F.ws + WS_LORA); const bf16* YR = (const bf16*)(F.ws + WS_YR); bf16* CAT2 = (bf16*)(F.ws + WS_CAT);
    float mur[8], muk[8], muv[8], ka[8], rk[8], lnw[8], lnb[8];
#pragma unroll
    for (int j = 0; j < 8; ++j) { mur[j] = F.in[I_RWKV_MU][PC_R + c0 + j]; muk[j] = F.in[I_RWKV_MU][PC_K + c0 + j]; muv[j] = F.in[I_RWKV_MU][PC_V + c0 + j];
        ka[j] = F.in[I_RWKV_K_A][c0 + j]; rk[j] = F.in[I_RWKV_R_K][c0 + j]; lnw[j] = F.in[I_RWKV_LN_W][c0 + j]; lnb[j] = F.in[I_RWKV_LN_B][c0 + j]; }
    for (int t0 = gw; t0 < T_TOK; t0 += RP_NB * NGW) { v4u L[RP_NB][9];
#pragma unroll
        for (int r = 0; r < RP_NB; ++r) { const int tok = t0 + r * NGW, tc = tok < T_TOK ? tok : t0; const bool first = (tc & (SEQL - 1)) == 0; const bf16* row = P1 + (size_t)tc * P1_LD; const bf16* prow = first ? row : (row - P1_LD);
            L[r][0] = *(const v4u*)(row + PC_R + c0); L[r][1] = *(const v4u*)(row + PC_K + c0); L[r][2] = *(const v4u*)(row + PC_V + c0);
            L[r][3] = *(const v4u*)(prow + PC_R + c0); L[r][4] = *(const v4u*)(prow + PC_K + c0); L[r][5] = *(const v4u*)(prow + PC_V + c0);
            L[r][6] = *(const v4u*)(LORA + (size_t)tc * 1536 + 512 + c0); L[r][7] = *(const v4u*)(LORA + (size_t)tc * 1536 + 1024 + c0); L[r][8] = *(const v4u*)(YR + (size_t)tc * 512 + c0); }
#pragma unroll
        for (int r = 0; r < RP_NB; ++r) { const int tok = t0 + r * NGW; const bool first = (tok & (SEQL - 1)) == 0;
            float rc[8], kc[8], vc[8], rp[8], kp[8], vp[8], a[8], g[8], y[8];
            unpack8(L[r][0], rc); unpack8(L[r][1], kc); unpack8(L[r][2], vc); unpack8(L[r][3], rp); unpack8(L[r][4], kp); unpack8(L[r][5], vp); unpack8(L[r][6], a); unpack8(L[r][7], g); unpack8(L[r][8], y);
            float sy = 0.f, sb = 0.f; float v[8];
#pragma unroll
            for (int j = 0; j < 8; ++j) { const float rr = rc[j] + ((first ? 0.f : rp[j]) - rc[j]) * mur[j], k0 = kc[j] + ((first ? 0.f : kp[j]) - kc[j]) * muk[j]; v[j] = vc[j] + ((first ? 0.f : vp[j]) - vc[j]) * muv[j];
                const float k = k0 * (1.0f + (a[j] - 1.0f) * ka[j]); sb += rr * k * rk[j]; sy += y[j]; }
            const float mean = dpp_sum8(sy) * (1.0f / 64.0f); float sq = 0.f;
#pragma unroll
            for (int j = 0; j < 8; ++j) { y[j] -= mean; sq += y[j] * y[j]; }
            const float rstd = __builtin_amdgcn_rsqf(dpp_sum8(sq) * (1.0f / 64.0f) + 64e-5f), bonus = dpp_sum8(sb);
            float o[8];
#pragma unroll
            for (int j = 0; j < 8; ++j) o[j] = ABL_RWKV ? 0.f : (y[j] * rstd * lnw[j] + lnb[j] + bonus * v[j]) * g[j];
            if (tok < T_TOK) { store8_bf16(CAT2 + (size_t)tok * 1024 + c0, o);
                if (SKIP_DSA) { float z[8] = {0.f, 0.f, 0.f, 0.f, 0.f, 0.f, 0.f, 0.f}; store8_bf16(CAT2 + (size_t)tok * 1024 + 512 + c0, z); } } } }
}
__device__ __forceinline__ void moe_convert_phase(Frame& F) {
    LAS unsigned char* scr = (LAS unsigned char*)(F.lds + F.wave * 16384); const int lane = mk_lane();
    const int gw = blockIdx.x * NWAVES + F.wave, NGW = F.G * NWAVES;
    constexpr int PER = 896, NIT = 3 * 8 * PER;
    unsigned char* WGU = F.ws + WS_WMOE_GU; unsigned char* WD = F.ws + WS_WMOE_D;
#define MC_LOAD(it_, buf) do { const int m_ = (it_) / (8 * PER), r_ = (it_) % (8 * PER), e_ = r_ / PER, q_ = r_ % PER; \
        if (m_ == 0) tr64_load(F.in[I_MOE_GATE] + (size_t)e_ * 1024 * FEXP, FEXP, q_ / 56, q_ % 56, lane, buf); \
        else if (m_ == 1) tr64_load(F.in[I_MOE_UP] + (size_t)e_ * 1024 * FEXP, FEXP, q_ / 56, q_ % 56, lane, buf); \
        else tr64_load(F.in[I_MOE_DOWN] + (size_t)e_ * FEXP * 1024, 1024, q_ / 16, q_ % 16, lane, buf); } while (0)
#define MC_FIN(it_, buf) do { const int m_ = (it_) / (8 * PER), r_ = (it_) % (8 * PER), e_ = r_ / PER, q_ = r_ % PER; \
        if (m_ == 0) tr64_f8_finish<1>(buf, WGU, 1024, e_ * 7168, F.in[I_O_NORM_FFN], MOE_WGU_SCALE, scr, q_ / 56, q_ % 56, lane); \
        else if (m_ == 1) tr64_f8_finish<1>(buf, WGU, 1024, e_ * 7168 + 128, F.in[I_O_NORM_FFN], MOE_WGU_SCALE, scr, q_ / 56, q_ % 56, lane); \
        else tr64_f8_finish<0>(buf, WD, FEXP, e_ * 1024, nullptr, MOE_WD_SCALE, scr, q_ / 16, q_ % 16, lane); } while (0)
    f32x4 va[16], vb[16];
    int it = gw; if (it < NIT) MC_LOAD(it, va);
    for (; it < NIT; it += 2 * NGW) { const int it2 = it + NGW, it3 = it + 2 * NGW;
        if (it2 < NIT) MC_LOAD(it2, vb);
        MC_FIN(it, va);
        if (it3 < NIT) MC_LOAD(it3, va);
        if (it2 < NIT) MC_FIN(it2, vb); }
#undef MC_LOAD
#undef MC_FIN
}
__device__ __forceinline__ f32x4 ld_res4(const bf16* RESb, int tok, int lane, int j) {
    const v2u w = ((const v2u*)(RESb + (size_t)tok * RES_LD))[lane + 64 * j]; return (f32x4){bflo(w.x), bfhi(w.x), bflo(w.y), bfhi(w.y)}; }
__device__ __forceinline__ void router_phase(Frame& F, int cnt_off = 0) {
    const int lane = mk_lane(), tid = F.wave * 64 + lane;
    const float* gn = F.in[I_O_NORM_FFN]; const float* rt = F.in[I_MOE_ROUTER]; unsigned* cnt = (unsigned*)(F.ws + WS_CTL) + CW_EXPCNT + cnt_off; v2u* info = (v2u*)(F.ws + WS_TOKINFO);
    LAS unsigned* lcnt = (LAS unsigned*)F.lds; LAS unsigned* gbase = lcnt + 8; LAS v4u* lrec = (LAS v4u*)(F.lds + 64);
    for (int tb = blockIdx.x * 128; tb < T_TOK; tb += F.G * 128) {
        if (tid < 8) lcnt[tid] = 0u;
        __syncthreads();
        f32x4 vn[4];
        {
#pragma unroll
          for (int j = 0; j < 4; ++j) vn[j] = ld_res4((const bf16*)F.out, tb + F.wave * 16, lane, j); }
#pragma unroll 1
        for (int i = 0; i < 16; ++i) { const int tl = F.wave * 16 + i, tok = tb + tl; f32x4 v[4]; float s = 0.f;
#pragma unroll
            for (int j = 0; j < 4; ++j) v[j] = vn[j];
            {
#pragma unroll
              for (int j = 0; j < 4; ++j) vn[j] = ld_res4((const bf16*)F.out, tok + (i < 15 ? 1 : 0), lane, j); }
#pragma unroll
            for (int j = 0; j < 4; ++j) s += (v[j].x * v[j].x + v[j].y * v[j].y) + (v[j].z * v[j].z + v[j].w * v[j].w);
            const float rstd = __builtin_amdgcn_rsqf(wave_sum(s) * (1.f / DMODEL) + NORM_EPS);
            float lg[8] = {0.f, 0.f, 0.f, 0.f, 0.f, 0.f, 0.f, 0.f};
#pragma unroll
            for (int j = 0; j < 4; ++j) { const int k0 = 4 * (lane + 64 * j); const f32x4 gg = *(const f32x4*)(gn + k0); const float xv[4] = {v[j].x * rstd * gg.x, v[j].y * rstd * gg.y, v[j].z * rstd * gg.z, v[j].w * rstd * gg.w};
#pragma unroll
                for (int q = 0; q < 4; ++q) { const f32x4 w0 = *(const f32x4*)(rt + (size_t)(k0 + q) * 8), w1 = *(const f32x4*)(rt + (size_t)(k0 + q) * 8 + 4);
                    lg[0] += xv[q] * w0.x; lg[1] += xv[q] * w0.y; lg[2] += xv[q] * w0.z; lg[3] += xv[q] * w0.w; lg[4] += xv[q] * w1.x; lg[5] += xv[q] * w1.y; lg[6] += xv[q] * w1.z; lg[7] += xv[q] * w1.w; } }
#pragma unroll
            for (int e = 0; e < 8; ++e) lg[e] = wave_sum(lg[e]);
            int e1 = 0; float l1 = lg[0];
#pragma unroll
            for (int e = 1; e < 8; ++e) if (lg[e] > l1) { l1 = lg[e]; e1 = e; }
            int e2 = -1; float l2 = -INFINITY;
#pragma unroll
            for (int e = 0; e < 8; ++e) if (e != e1 && lg[e] > l2) { l2 = lg[e]; e2 = e; }
            const float g1 = 1.0f / (1.0f + __expf(l2 - l1)), g2 = 1.0f - g1;
            if (lane == 0) { const unsigned r1 = __hip_atomic_fetch_add(lcnt + e1, 1u, __ATOMIC_RELAXED, __HIP_MEMORY_SCOPE_WORKGROUP), r2 = __hip_atomic_fetch_add(lcnt + e2, 1u, __ATOMIC_RELAXED, __HIP_MEMORY_SCOPE_WORKGROUP);
                lrec[tl] = (v4u){((unsigned)e1 << 24) | r1, __builtin_bit_cast(unsigned, g1), ((unsigned)e2 << 24) | r2, __builtin_bit_cast(unsigned, g2)}; } }
        __syncthreads();
        if (tid < 8) gbase[tid] = atomicAdd(cnt + 64 * tid, lcnt[tid]);
        __syncthreads();
        if (tid < 128) { const v4u r = lrec[tid]; const unsigned b1 = gbase[r.x >> 24], b2 = gbase[r.z >> 24];
            ((v4u*)info)[(size_t)(tb + tid)] = (v4u){r.x + b1, r.y, r.z + b2, r.w}; }
        __syncthreads(); }
}
__device__ __forceinline__ void moe_scatter_phase(Frame& F) {
    const int gw = blockIdx.x * NWAVES + F.wave, NGW = F.G * NWAVES, lane = mk_lane();
    const unsigned* cnt = (const unsigned*)(F.ws + WS_CTL) + CW_EXPCNT; const v2u* info = (const v2u*)(F.ws + WS_TOKINFO); int* tokslot = (int*)(F.ws + WS_TOKSLOT); int* tile_exp = (int*)(F.ws + WS_TILEEXP);
    int pstart[8]; int acc = 0;
#pragma unroll
    for (int e = 0; e < 8; ++e) { const int c = (int)__hip_atomic_load(cnt + 64 * e, __ATOMIC_RELAXED, __HIP_MEMORY_SCOPE_AGENT); pstart[e] = acc; acc += (c + 255) & ~255; }
    const int ntiles = acc >> 8;
    if (blockIdx.x == 0 && F.wave == 0) { for (int t = lane; t < 512; t += 64) { int e = 7;
#pragma unroll
            for (int q = 7; q >= 1; --q) if (t * 256 < pstart[q]) e = q - 1;
            tile_exp[t] = (t == 511) ? ntiles : e; } }
    unsigned char* XG = F.ws + WS_XG;
    for (int t0 = gw; t0 < T_TOK; t0 += 4 * NGW) { f32x4 v[4][4]; v2u inf[4][2];
#pragma unroll
        for (int r = 0; r < 4; ++r) { const int tok = t0 + r * NGW, tc = tok < T_TOK ? tok : t0;
#pragma unroll
            for (int j = 0; j < 4; ++j) v[r][j] = ld_res4((const bf16*)F.out, tc, lane, j);
            inf[r][0] = info[(size_t)tc * 2]; inf[r][1] = info[(size_t)tc * 2 + 1]; }
#pragma unroll
        for (int r = 0; r < 4; ++r) { const int tok = t0 + r * NGW; float s = 0.f;
#pragma unroll
            for (int j = 0; j < 4; ++j) s += (v[r][j].x * v[r][j].x + v[r][j].y * v[r][j].y) + (v[r][j].z * v[r][j].z + v[r][j].w * v[r][j].w);
            const float rstd = __builtin_amdgcn_rsqf(wave_sum(s) * (1.f / DMODEL) + NORM_EPS);
            unsigned w[4];
#pragma unroll
            for (int j = 0; j < 4; ++j) w[j] = pk4_fp8(v[r][j].x * rstd, v[r][j].y * rstd, v[r][j].z * rstd, v[r][j].w * rstd);
            if (tok < T_TOK) {
#pragma unroll
                for (int k = 0; k < 2; ++k) { const int e = (int)(inf[r][k].x >> 24), rank = (int)(inf[r][k].x & 0xffffffu);
                    int ps = 0;
#pragma unroll
                    for (int q = 0; q < 8; ++q) ps = (e == q) ? pstart[q] : ps;
                    const int slot = ps + rank; unsigned* o4 = (unsigned*)(XG + (size_t)slot * 1024) + lane;
#pragma unroll
                    for (int j = 0; j < 4; ++j) o4[64 * j] = w[j];
                    if (lane == 0) tokslot[(size_t)tok * 2 + k] = slot; } } } }
}
__device__ __forceinline__ void moe_combine_final_phase(Frame& F, float* outp = nullptr) {
    if (outp == nullptr) outp = F.out;
    const int gw = blockIdx.x * NWAVES + F.wave, NGW = F.G * NWAVES, lane = mk_lane(); const float* gn = F.in[I_FINAL_NORM];
    const v2u* info = (const v2u*)(F.ws + WS_TOKINFO); const int* tokslot = (const int*)(F.ws + WS_TOKSLOT); const bf16* YS = (const bf16*)(F.ws + WS_YS);
    f32x4 gv[4];
#pragma unroll
    for (int j = 0; j < 4; ++j) gv[j] = ((const f32x4*)gn)[lane + 64 * j];
#if RWKV_DBG
    { const unsigned long long* ck = (const unsigned long long*)(F.ws + WS_CTL) + 200; int code = 0;
      for (int arr = 3; arr >= 0; --arr) if (ck[arr] != ck[4 + arr]) code = arr + 1;
      const float ds = 1.0f + 0.5f * code; for (int j = 0; j < 4; ++j) gv[j] = gv[j] * ds; }
#endif
#if STAMP_KA >= 0
    { const float fr = ((const float*)(F.ws + WS_TILEEXP + 4096))[0]; const float ds = 1.0f + 0.08f * sqrtf(fminf(fmaxf(fr, 0.f), 1.f));
      for (int j = 0; j < 4; ++j) gv[j] = gv[j] * ds; }
#endif
    for (int t0 = gw; t0 < T_TOK; t0 += 4 * NGW) { f32x4 v[4][4]; float gk[4][2]; int sl[4][2]; v2u ys[4][2][4];
#pragma unroll
        for (int r = 0; r < 4; ++r) { const int tok = t0 + r * NGW, tc = tok < T_TOK ? tok : t0;
#pragma unroll
            for (int j = 0; j < 4; ++j) v[r][j] = ld_res4((const bf16*)F.out, tc, lane, j);
#pragma unroll
            for (int k = 0; k < 2; ++k) { const unsigned gkb = info[(size_t)tc * 2 + k].y; gk[r][k] = MOE_SCALE * __builtin_bit_cast(float, gkb); sl[r][k] = tokslot[(size_t)tc * 2 + k]; } }
#pragma unroll
        for (int r = 0; r < 4; ++r)
#pragma unroll
            for (int k = 0; k < 2; ++k) { const v2u* yr = (const v2u*)(YS + (size_t)sl[r][k] * 1024) + lane;
#pragma unroll
                for (int j = 0; j < 4; ++j) ys[r][k][j] = yr[64 * j]; }
#pragma unroll
        for (int r = 0; r < 4; ++r) { const int tok = t0 + r * NGW;
#pragma unroll
            for (int k = 0; k < 2; ++k)
#pragma unroll
                for (int j = 0; j < 4; ++j) { v2u w = ys[r][k][j]; if (ABL_MOE) w = (v2u){0u, 0u}; v[r][j].x += gk[r][k] * bflo(w.x); v[r][j].y += gk[r][k] * bfhi(w.x); v[r][j].z += gk[r][k] * bflo(w.y); v[r][j].w += gk[r][k] * bfhi(w.y); }
            float s = 0.f;
#pragma unroll
            for (int j = 0; j < 4; ++j) s += (v[r][j].x * v[r][j].x + v[r][j].y * v[r][j].y) + (v[r][j].z * v[r][j].z + v[r][j].w * v[r][j].w);
            const float rstd = __builtin_amdgcn_rsqf(wave_sum(s) * (1.f / DMODEL) + NORM_EPS);
            if (tok < T_TOK) { f32x4* xo = (f32x4*)(outp + (size_t)tok * DMODEL) + lane;
#pragma unroll
                for (int j = 0; j < 4; ++j) xo[64 * j] = v[r][j] * rstd * gv[j]; } } }
}

constexpr int RW_BLOCKS = 64;
constexpr int RW_STEPS = 32, RW_REC = 5 * 64, RW_BUF_FLOATS = RW_STEPS * RW_REC + RW_STEPS * 32;
__device__ __forceinline__ void rwkv_produce(Frame& F, LAS float* buf, int b, int h, int half, int j, int pw, int lane) {
    const bf16* P1 = (const bf16*)(F.ws + WS_P1); const bf16* LORA = (const bf16*)(F.ws + WS_LORA);
    const float* mu = F.in[I_RWKV_MU]; const int ch = h * 64 + lane;
    const float mu_r = mu[PC_R + ch], mu_k = mu[PC_K + ch], mu_v = mu[PC_V + ch], kkw = F.in[I_RWKV_K_K][ch], kaw = F.in[I_RWKV_K_A][ch];
    float rc[8], kc[8], vc[8], rp[8], kp[8], vp[8], lw[8], al[8];
#pragma unroll
    for (int i = 0; i < 8; ++i) { const int tt = 8 * pw + i, pos = 32 * j + tt; const size_t tok = (size_t)b * SEQL + pos; const bf16* row = P1 + tok * P1_LD; const bf16* prow = (pos == 0) ? row : (row - P1_LD);
        rc[i] = bf2f(row[PC_R + ch]); kc[i] = bf2f(row[PC_K + ch]); vc[i] = bf2f(row[PC_V + ch]);
        rp[i] = bf2f(prow[PC_R + ch]); kp[i] = bf2f(prow[PC_K + ch]); vp[i] = bf2f(prow[PC_V + ch]);
        lw[i] = bf2f(LORA[tok * 1536 + ch]); al[i] = bf2f(LORA[tok * 1536 + 512 + ch]); }
#pragma unroll
    for (int i = 0; i < 8; ++i) { const int tt = 8 * pw + i, pos = 32 * j + tt; const bool first = (pos == 0);
        const float r = rc[i] + ((first ? 0.f : rp[i]) - rc[i]) * mu_r, k0 = kc[i] + ((first ? 0.f : kp[i]) - kc[i]) * mu_k, v = vc[i] + ((first ? 0.f : vp[i]) - vc[i]) * mu_v;
        const float kkv = k0 * kkw; const float nrm = sqrtf(wave_sum(kkv * kkv)); const float kk = kkv / fmaxf(nrm, 1e-12f);
        const float a = al[i]; LAS float* rec = buf + tt * RW_REC;
        rec[lane] = __expf(lw[i]); rec[64 + lane] = -kk; rec[128 + lane] = kk * a; rec[192 + lane] = k0 * (1.0f + (a - 1.0f) * kaw); rec[256 + lane] = r;
        if ((lane >> 5) == half) buf[RW_STEPS * RW_REC + tt * 32 + (lane & 31)] = v; }
}
__device__ __forceinline__ void rwkv_seq_block(Frame& F, int blk) {
    const int bh = blk >> 1, half = blk & 1, b = bh >> 3, h = bh & 7; const int lane = mk_lane(), wave = F.wave;
    LAS float* buf0 = (LAS float*)F.lds; LAS float* buf1 = buf0 + RW_BUF_FLOATS;
    bf16* YR = (bf16*)(F.ws + WS_YR);
    const int rowl = 8 * (wave & 3) + (lane >> 3), kg = lane & 7;
    f32x2 s[4] = {{0.f, 0.f}, {0.f, 0.f}, {0.f, 0.f}, {0.f, 0.f}};
    if (wave >= 4) rwkv_produce(F, buf0, b, h, half, 0, wave - 4, lane);
    __syncthreads();
    for (int j = 0; j < SEQL / RW_STEPS; ++j) { LAS float* cur = (j & 1) ? buf1 : buf0; LAS float* nxt = (j & 1) ? buf0 : buf1;
        if (wave >= 4) { if (j + 1 < SEQL / RW_STEPS) rwkv_produce(F, nxt, b, h, half, j + 1, wave - 4, lane); }
        else { bf16* yo = YR + ((size_t)b * SEQL + 32 * j) * 512 + h * 64 + 32 * half + rowl;
#pragma unroll 4
            for (int t = 0; t < RW_STEPS; ++t) { const LAS float* rec = cur + t * RW_REC + 8 * kg;
                const f32x4 w0 = *(const LAS f32x4*)(rec), w1 = *(const LAS f32x4*)(rec + 4), a0 = *(const LAS f32x4*)(rec + 64), a1 = *(const LAS f32x4*)(rec + 68);
                const f32x4 b0 = *(const LAS f32x4*)(rec + 128), b1 = *(const LAS f32x4*)(rec + 132), k0 = *(const LAS f32x4*)(rec + 192), k1 = *(const LAS f32x4*)(rec + 196);
                const f32x4 r0 = *(const LAS f32x4*)(rec + 256), r1 = *(const LAS f32x4*)(rec + 260);
                const float vv = cur[RW_STEPS * RW_REC + t * 32 + rowl];
                f32x2 sa2 = s[0] * (f32x2){a0.x, a0.y} + s[1] * (f32x2){a0.z, a0.w} + s[2] * (f32x2){a1.x, a1.y} + s[3] * (f32x2){a1.z, a1.w};
                const float sa = dpp_sum8(sa2.x + sa2.y); const f32x2 sav = {sa, sa}, vvv = {vv, vv};
                s[0] = s[0] * (f32x2){w0.x, w0.y} + sav * (f32x2){b0.x, b0.y} + vvv * (f32x2){k0.x, k0.y};
                s[1] = s[1] * (f32x2){w0.z, w0.w} + sav * (f32x2){b0.z, b0.w} + vvv * (f32x2){k0.z, k0.w};
                s[2] = s[2] * (f32x2){w1.x, w1.y} + sav * (f32x2){b1.x, b1.y} + vvv * (f32x2){k1.x, k1.y};
                s[3] = s[3] * (f32x2){w1.z, w1.w} + sav * (f32x2){b1.z, b1.w} + vvv * (f32x2){k1.z, k1.w};
                f32x2 y2 = s[0] * (f32x2){r0.x, r0.y} + s[1] * (f32x2){r0.z, r0.w} + s[2] * (f32x2){r1.x, r1.y} + s[3] * (f32x2){r1.z, r1.w};
                const float y = dpp_sum8(y2.x + y2.y);
                if (kg == 0) yo[(size_t)t * 512] = (bf16)f2bf(y); } }
        __syncthreads(); }
}

typedef float f32x4_t __attribute__((ext_vector_type(4)));
constexpr int DSA_SEL_OFF = 131072 + 1024, DSA_META_OFF = DSA_SEL_OFF + 16 * 256 * 2, DSA_CAND_CAP = 1024;
constexpr int CW_DSAQ = CW_EXPCNT + 8 * 64;
static_assert(DSA_META_OFF + 512 <= MISC_OFF && (CW_DSAQ + 128) * 4 <= (int)CTL_ZERO_BYTES, "dsa lds / ctl map");
__device__ __forceinline__ unsigned f32_order_key(float x) { x = x + 0.0f; const unsigned u = __builtin_bit_cast(unsigned, x); return (u & 0x80000000u) ? ~u : (u | 0x80000000u); }
template <int MODE, bool DRY = false>
__device__ __forceinline__ void dsa_score_pass(const bf16* __restrict__ KIb, const bf16x8 (&qa)[4][2], const float (&wq)[4][4], int t0, int ktb, int nkt, int wave, int lane,
                                               LAS unsigned* hist, LAS unsigned short* sel, LAS int* meta, bool use_lo) {
    const int g = lane >> 4, c = lane & 15;
    int bst[4] = {0, 0, 0, 0};
#pragma unroll
    for (int m = 0; m < 4; ++m) bst[m] = (MODE == 1) ? meta[4 * m + g] : (use_lo ? meta[64 + 4 * m + g] : 0);
#define DSA_LOADK(dst, kt0_) do { _Pragma("unroll") for (int u = 0; u < 4; ++u) { const int kt = (kt0_) + 8 * u, ktc = kt < nkt ? kt : (nkt - 1); const bf16* kp = KIb + (size_t)(16 * ktc + c) * 64 + 8 * g; \
        dst[u][0] = *(const bf16x8*)kp; dst[u][1] = *(const bf16x8*)(kp + 32); } } while (0)
#define DSA_TRIP(kb, kt0_) do { _Pragma("unroll") for (int u = 0; u < 4; ++u) { const int kt = (kt0_) + 8 * u; if (kt < nkt) { const int key = 16 * kt + c; const bool full = (16 * kt + 15 <= t0); \
        f32x4_t accm[4]; \
        _Pragma("unroll") for (int m = 0; m < 4; ++m) { f32x4_t z_ = {0.f, 0.f, 0.f, 0.f}; z_ = __builtin_amdgcn_mfma_f32_16x16x32_bf16(qa[m][0], kb[u][0], z_, 0, 0, 0); accm[m] = __builtin_amdgcn_mfma_f32_16x16x32_bf16(qa[m][1], kb[u][1], z_, 0, 0, 0); } \
        _Pragma("unroll") for (int m = 0; m < 4; ++m) { \
            float sc = __builtin_fmaf(__builtin_amdgcn_fmed3f(accm[m][0], 0.f, 3.0e38f), wq[m][0], 0.0f); sc = __builtin_fmaf(__builtin_amdgcn_fmed3f(accm[m][1], 0.f, 3.0e38f), wq[m][1], sc); \
            sc = __builtin_fmaf(__builtin_amdgcn_fmed3f(accm[m][2], 0.f, 3.0e38f), wq[m][2], sc); sc = __builtin_fmaf(__builtin_amdgcn_fmed3f(accm[m][3], 0.f, 3.0e38f), wq[m][3], sc); \
            const int q = 4 * m + g; const unsigned ub = __builtin_bit_cast(unsigned, sc); const unsigned uk = ub ^ ((unsigned)((int)ub >> 31) | 0x80000000u); \
            if (full || key <= t0 + q) { \
                if (MODE == 2) { dry += uk; } else if (MODE == 0) { if (uk >= bstk[m]) __hip_atomic_fetch_add(hist + q * 2048 + (uk >> 21), DRY ? 0u : (1u << ((uk >> 16) & 16u)), __ATOMIC_RELAXED, __HIP_MEMORY_SCOPE_WORKGROUP); } \
                else { if (uk >= bstk[m] + 0x100000u) { const int p = __hip_atomic_fetch_add((LAS unsigned*)(meta + 32 + q), DRY ? 0u : 1u, __ATOMIC_RELAXED, __HIP_MEMORY_SCOPE_WORKGROUP); if (p < (DRY ? dryz : 256)) sel[q * 256 + p] = (unsigned short)key; } \
                       else if (uk >= bstk[m]) { const int p = __hip_atomic_fetch_add((LAS unsigned*)(meta + 48 + q), DRY ? 0u : 1u, __ATOMIC_RELAXED, __HIP_MEMORY_SCOPE_WORKGROUP); \
                           if (p < (DRY ? dryz : DSA_CAND_CAP)) { hist[(q * DSA_CAND_CAP + p) * 2] = uk; hist[(q * DSA_CAND_CAP + p) * 2 + 1] = (unsigned)key; } } } } } } } } while (0)
    unsigned bstk[4]; unsigned dry = 0; const int dryz = meta[126];
#pragma unroll
    for (int m = 0; m < 4; ++m) bstk[m] = (unsigned)bst[m] << 20;
    bf16x8 kbA[4][2], kbB[4][2];
    DSA_LOADK(kbA, ktb + wave);
    for (int kt0 = ktb + wave; kt0 < nkt; kt0 += 64) {
        if (kt0 + 32 < nkt) DSA_LOADK(kbB, kt0 + 32);
        DSA_TRIP(kbA, kt0);
        if (kt0 + 32 < nkt) { if (kt0 + 64 < nkt) DSA_LOADK(kbA, kt0 + 64); DSA_TRIP(kbB, kt0 + 32); } }
#undef DSA_LOADK
#undef DSA_TRIP
    if (MODE == 2 && dry == 0x12345678u) meta[127] = 1;
}
__device__ __forceinline__ void dsa_tile(Frame& F, int item) {
    const int lane = mk_lane(), wave = F.wave, tid = wave * 64 + lane;
    const int b = item & 3, ti = 511 - (item >> 2), t0 = 16 * ti, nkt = ti + 1; const size_t tok0 = (size_t)b * SEQL + t0;
    LAS unsigned* hist = (LAS unsigned*)F.lds; LAS unsigned short* sel = (LAS unsigned short*)(F.lds + DSA_SEL_OFF); LAS int* meta = (LAS int*)(F.lds + DSA_META_OFF);
    const bf16* QI = (const bf16*)(F.ws + WS_QI); const bf16* KIb = (const bf16*)(F.ws + WS_KI) + (size_t)b * SEQL * 64; const float* WI = (const float*)(F.ws + WS_WI);
    const int g = lane >> 4, c = lane & 15;
    if (ti >= 16) {
        for (int i = tid; i < 32768 / 4; i += 512) ((LAS v4u*)hist)[i] = (v4u){0u, 0u, 0u, 0u};
        if (tid < 96 || tid == 126) meta[tid] = 0;
        bf16x8 qa[4][2]; float wq[4][4];
#pragma unroll
        for (int m = 0; m < 4; ++m) { const bf16* qp = QI + (tok0 + 4 * m + (c >> 2)) * 256 + (c & 3) * 64 + 8 * g; qa[m][0] = *(const bf16x8*)qp; qa[m][1] = *(const bf16x8*)(qp + 32);
            const f32x4 w4 = *(const f32x4*)(WI + (tok0 + 4 * m + g) * 4); wq[m][0] = w4.x; wq[m][1] = w4.y; wq[m][2] = w4.z; wq[m][3] = w4.w; }
        __syncthreads();
#define DSA_BOUNDARY(OUT_BIN, OUT_NA) do { _Pragma("unroll 1") for (int qq = 0; qq < 2; ++qq) { const int q = 2 * wave + qq; const LAS unsigned* hw = hist + q * 2048 + 32 * lane; unsigned s_ = 0; \
              \
            _Pragma("unroll") for (int i = 0; i < 32; ++i) { const unsigned w = hw[(i + lane) & 31]; s_ += (w & 0xffffu) + (w >> 16); } \
            unsigned tsum = s_; \
            _Pragma("unroll") for (int off = 1; off < 64; off <<= 1) { const unsigned o = __shfl_down(tsum, off); tsum += (lane + off < 64) ? o : 0u; } \
            const unsigned above = tsum - s_; \
            const unsigned long long hit = __ballot(above < 256u && tsum >= 256u); const int Lh = hit ? (int)__builtin_ctzll(hit) : 0; \
            const unsigned aboveL = (unsigned)__shfl((int)above, Lh); \
            const int bin = 64 * Lh + lane; const unsigned wv = hist[q * 2048 + (bin >> 1)]; const unsigned cn = (bin & 1) ? (wv >> 16) : (wv & 0xffffu); \
            unsigned t2 = cn; \
            _Pragma("unroll") for (int off = 1; off < 64; off <<= 1) { const unsigned o = __shfl_down(t2, off); t2 += (lane + off < 64) ? o : 0u; } \
            const unsigned ab2 = t2 - cn + aboveL; \
            if (ab2 < 256u && ab2 + cn >= 256u) { meta[(OUT_BIN) + q] = bin; if ((OUT_NA) >= 0) meta[(OUT_NA) + q] = (int)ab2; } } } while (0)
        const int npre = (nkt >= 64) ? (((nkt >> 3) + 7) & ~7) < 32 ? 32 : (((nkt >> 3) + 7) & ~7) : nkt;
        dsa_score_pass<0>(KIb, qa, wq, t0, 0, npre, wave, lane, hist, sel, meta, false);
        __syncthreads();
        if (npre < nkt) { DSA_BOUNDARY(64, -1); __syncthreads();
            dsa_score_pass<0>(KIb, qa, wq, t0, npre, nkt, wave, lane, hist, sel, meta, true);
            __syncthreads(); }
        DSA_BOUNDARY(0, 16);
        __syncthreads();
        if (DSA_DUP_KIND & 1) { dsa_score_pass<0, true>(KIb, qa, wq, t0, 0, npre, wave, lane, hist, sel, meta, false); __syncthreads(); }
        if ((DSA_DUP_KIND & 2) && npre < nkt) { dsa_score_pass<0, true>(KIb, qa, wq, t0, npre, nkt, wave, lane, hist, sel, meta, true); __syncthreads(); }
        if (DSA_DUP_KIND & 16) { DSA_BOUNDARY(0, 16); __syncthreads(); DSA_BOUNDARY(0, 16); __syncthreads(); }
#undef DSA_BOUNDARY
        if (DSA_DUP_PASS) dsa_score_pass<2>(KIb, qa, wq, t0, 0, nkt, wave, lane, hist, sel, meta, false);
        dsa_score_pass<1>(KIb, qa, wq, t0, 0, nkt, wave, lane, hist, sel, meta, false);
        __syncthreads();
        if (DSA_DUP_KIND & 4) { dsa_score_pass<1, true>(KIb, qa, wq, t0, 0, nkt, wave, lane, hist, sel, meta, false); __syncthreads(); }
#pragma unroll 1
        for (int qq0 = 0; qq0 < ((DSA_DUP_KIND & 8) ? 4 : 2); ++qq0) { const int qq = qq0 & 1; const bool rdry = qq0 >= 2; const int q = 2 * wave + qq;
            int n = __builtin_amdgcn_readfirstlane(meta[48 + q]); n = n < DSA_CAND_CAP ? n : DSA_CAND_CAP; const int nab = __builtin_amdgcn_readfirstlane(meta[16 + q]); const int R = 256 - nab;
            const LAS v2u* cd = (const LAS v2u*)(hist + (size_t)q * DSA_CAND_CAP * 2);
            unsigned ck[16], ci[16];
#pragma unroll
            for (int j2 = 0; j2 < 16; ++j2) { const int c_ = lane + 64 * j2; v2u e = {0u, 0u}; if (c_ < n) e = cd[c_]; ck[j2] = (c_ < n) ? (e.x & 0xFFFFFu) + 1u : 0u; ci[j2] = e.y; }
            unsigned T = 0;
#pragma unroll 1
            for (int bit = 20; bit >= 0; --bit) { const unsigned trial = T | (1u << bit); int cnt = 0;
#pragma unroll
                for (int j2 = 0; j2 < 16; ++j2) cnt += __builtin_popcountll(__ballot(ck[j2] >= trial));
                if (cnt >= R) T = trial; }
            int cgt = 0, ceq = 0;
#pragma unroll
            for (int j2 = 0; j2 < 16; ++j2) { cgt += __builtin_popcountll(__ballot(ck[j2] > T)); ceq += __builtin_popcountll(__ballot(ck[j2] == T)); }
            const int need = R - cgt; unsigned I = 0xFFFFu;
            if (ceq > need) { I = 0;
#pragma unroll 1
                for (int bit = 12; bit >= 0; --bit) { const unsigned trial = I | (1u << bit); int cnt = 0;
#pragma unroll
                    for (int j2 = 0; j2 < 16; ++j2) cnt += __builtin_popcountll(__ballot(ck[j2] == T && ci[j2] < trial));
                    if (cnt < need) I = trial; } }
            int base = nab;
#pragma unroll
            for (int j2 = 0; j2 < 16; ++j2) { const bool s_ = (ck[j2] > T) || (ck[j2] == T && ci[j2] <= I); const unsigned long long m_ = __ballot(s_);
                const int p = base + (int)__builtin_amdgcn_mbcnt_hi((unsigned)(m_ >> 32), __builtin_amdgcn_mbcnt_lo((unsigned)m_, 0u));
                if (s_ && p < 256 && !rdry) sel[q * 256 + p] = (unsigned short)ci[j2];
                base += __builtin_popcountll(m_); } }
    } else {
        for (int i = tid; i < 16 * 256; i += 512) sel[i] = (unsigned short)(i & 255);
    }
    __syncthreads();
    const bf16* QD = (const bf16*)(F.ws + WS_QD); const bf16* KD = (const bf16*)(F.ws + WS_KD) + (size_t)b * SEQL * 64; const bf16* VDb = (const bf16*)(F.ws + WS_VD) + (size_t)b * SEQL * 64;
    bf16* CAT2 = (bf16*)(F.ws + WS_CAT);
    bf16x8 esel[2];
#pragma unroll
    for (int d = 0; d < 2; ++d)
#pragma unroll
        for (int j = 0; j < 8; ++j) esel[d][j] = (8 * g + j == 16 * d + c) ? (short)0x3F80 : (short)0;
#pragma unroll 1
    for (int qq0 = 0; qq0 < ((DSA_DUP_ATT || (DSA_DUP_KIND & 32)) ? 4 : 2); ++qq0) { const int qq = qq0 & 1; const int q = 2 * wave + qq; const int pos = t0 + q; const size_t tok = tok0 + q; const int nsel = (pos + 1 < 256) ? (pos + 1) : 256;
        bf16x8 qb[2];
        { const bf16* qp = QD + tok * 512 + (c & 7) * 64 + 8 * g; qb[0] = *(const bf16x8*)qp; qb[1] = *(const bf16x8*)(qp + 32);
          if (c >= 8) { qb[0] = (bf16x8){0, 0, 0, 0, 0, 0, 0, 0}; qb[1] = qb[0]; } }
        f32x4_t st[16];
        {
            bf16x8 kaA[4][2], kaB[4][2];
#define DSA_LDK(dst, bt) do { _Pragma("unroll") for (int i = 0; i < 4; ++i) { const int idx = 16 * (4 * (bt) + i) + c; const int key = (idx < nsel) ? (int)sel[q * 256 + idx] : 0; const bf16* kp = KD + (size_t)key * 64 + 8 * g; \
                dst[i][0] = *(const bf16x8*)kp; dst[i][1] = *(const bf16x8*)(kp + 32); } } while (0)
#define DSA_MMK(src, bt) do { _Pragma("unroll") for (int i = 0; i < 4; ++i) { f32x4_t a = {0.f, 0.f, 0.f, 0.f}; \
                a = __builtin_amdgcn_mfma_f32_16x16x32_bf16(src[i][0], qb[0], a, 0, 0, 0); a = __builtin_amdgcn_mfma_f32_16x16x32_bf16(src[i][1], qb[1], a, 0, 0, 0); \
                _Pragma("unroll") for (int j = 0; j < 4; ++j) if (16 * (4 * (bt) + i) + 4 * g + j >= nsel) a[j] = -INFINITY; \
                st[4 * (bt) + i] = a; } } while (0)
            bf16x8 kaC[4][2];
            DSA_LDK(kaA, 0); DSA_LDK(kaB, 1); DSA_LDK(kaC, 2); DSA_MMK(kaA, 0); DSA_LDK(kaA, 3); DSA_MMK(kaB, 1); DSA_MMK(kaC, 2); DSA_MMK(kaA, 3);
#undef DSA_LDK
#undef DSA_MMK
        }
        float mx = -INFINITY;
#pragma unroll
        for (int i = 0; i < 16; ++i) mx = fmaxf(fmaxf(mx, fmaxf(st[i][0], st[i][1])), fmaxf(st[i][2], st[i][3]));
        mx = fmaxf(mx, __shfl_xor(mx, 16)); mx = fmaxf(mx, __shfl_xor(mx, 32));
        float ls = 0.f;
#pragma unroll
        for (int i = 0; i < 16; ++i) {
#pragma unroll
            for (int j = 0; j < 4; ++j) { const float p = __builtin_amdgcn_exp2f(st[i][j] - mx); st[i][j] = p; ls += p; } }
        ls += __shfl_xor(ls, 16); ls += __shfl_xor(ls, 32);
        f32x4_t o[4] = {{0.f, 0.f, 0.f, 0.f}, {0.f, 0.f, 0.f, 0.f}, {0.f, 0.f, 0.f, 0.f}, {0.f, 0.f, 0.f, 0.f}};
        bf16x8 vnx[2][2];
#pragma unroll
        for (int tt = 0; tt < 2; ++tt) { const int idx = 16 * tt + c; const int key = (idx < nsel) ? (int)sel[q * 256 + idx] : 0; const bf16* vp = VDb + (size_t)key * 64 + 8 * g; vnx[tt][0] = *(const bf16x8*)vp; vnx[tt][1] = *(const bf16x8*)(vp + 32); }
#pragma unroll
        for (int ks = 0; ks < 8; ++ks) { v4u pw; pw.x = pk2(st[2 * ks][0], st[2 * ks][1]); pw.y = pk2(st[2 * ks][2], st[2 * ks][3]); pw.z = pk2(st[2 * ks + 1][0], st[2 * ks + 1][1]); pw.w = pk2(st[2 * ks + 1][2], st[2 * ks + 1][3]);
            const bf16x8 pa = __builtin_bit_cast(bf16x8, pw);
            bf16x8 vcur[2][2];
#pragma unroll
            for (int tt = 0; tt < 2; ++tt) { vcur[tt][0] = vnx[tt][0]; vcur[tt][1] = vnx[tt][1]; }
            if (ks < 7) {
#pragma unroll
                for (int tt = 0; tt < 2; ++tt) { const int idx = 16 * (2 * ks + 2 + tt) + c; const int key = (idx < nsel) ? (int)sel[q * 256 + idx] : 0; const bf16* vp = VDb + (size_t)key * 64 + 8 * g; vnx[tt][0] = *(const bf16x8*)vp; vnx[tt][1] = *(const bf16x8*)(vp + 32); } }
            f32x4_t tr[2][4];
#pragma unroll
            for (int tt = 0; tt < 2; ++tt) { const f32x4_t z = {0.f, 0.f, 0.f, 0.f};
                tr[tt][0] = __builtin_amdgcn_mfma_f32_16x16x32_bf16(vcur[tt][0], esel[0], z, 0, 0, 0); tr[tt][1] = __builtin_amdgcn_mfma_f32_16x16x32_bf16(vcur[tt][0], esel[1], z, 0, 0, 0);
                tr[tt][2] = __builtin_amdgcn_mfma_f32_16x16x32_bf16(vcur[tt][1], esel[0], z, 0, 0, 0); tr[tt][3] = __builtin_amdgcn_mfma_f32_16x16x32_bf16(vcur[tt][1], esel[1], z, 0, 0, 0); }
#pragma unroll
            for (int db = 0; db < 4; ++db) { v4u vw; vw.x = pk2(tr[0][db][0], tr[0][db][1]); vw.y = pk2(tr[0][db][2], tr[0][db][3]); vw.z = pk2(tr[1][db][0], tr[1][db][1]); vw.w = pk2(tr[1][db][2], tr[1][db][3]);
                o[db] = __builtin_amdgcn_mfma_f32_16x16x32_bf16(pa, __builtin_bit_cast(bf16x8, vw), o[db], 0, 0, 0); } }
        float li[4];
#pragma unroll
        for (int j = 0; j < 4; ++j) li[j] = 1.0f / __shfl(ls, (4 * g + j) & 15);
        if (g < 2) { bf16* op = CAT2 + tok * 1024 + 512 + c;
#pragma unroll
            for (int j = 0; j < 4; ++j)
#pragma unroll
                for (int db = 0; db < 4; ++db) op[(4 * g + j) * 64 + 16 * db] = ABL_DSA ? (bf16)0 : (bf16)f2bf(o[db][j] * li[j]); } }
    __syncthreads();
}
__device__ __forceinline__ void dsa_phase(Frame& F, int qi, int item0, int nitems) {
    unsigned* qhead = (unsigned*)(F.ws + WS_CTL) + CW_DSAQ + 64 * qi; LAS int* meta = (LAS int*)(F.lds + DSA_META_OFF);
    for (;;) { if (F.wave == 0 && mk_lane() == 0) meta[100] = (int)atomicAdd(qhead, 1u);
        __syncthreads(); const int it = meta[100]; __syncthreads();
        if (it >= nitems) break;
        const int v = (item0 == 0) ? (it < 768 ? it : it + 1024) : it + 768;
        dsa_tile(F, v); }
}

constexpr int RC_PT = 72, RC_MS = 64 * RC_PT;
constexpr size_t WS_RWS = 5 * MiB;
constexpr size_t WS_WO_OUT2 = 3 * MiB;
constexpr size_t RWS_WY = 0, RWS_MC = 16 * MiB, RWS_NC = 32 * MiB;
typedef float rc_f32x2 __attribute__((ext_vector_type(2))); typedef __bf16 rc_bf16x2 __attribute__((ext_vector_type(2)));
__device__ __forceinline__ unsigned cvtpk(float lo, float hi) { const rc_f32x2 v = {lo, hi}; const rc_bf16x2 b = __builtin_convertvector(v, rc_bf16x2); return __builtin_bit_cast(unsigned, b); }
__device__ __forceinline__ f32x4 rc_ld4(const LAS bf16* M, int n, int m0) { const v2u w = *(const LAS v2u*)(M + n * RC_PT + m0); return (f32x4){bflo(w.x), bfhi(w.x), bflo(w.y), bfhi(w.y)}; }
__device__ __forceinline__ void rc_st4(LAS bf16* M, int n, int m0, const f32x4 v) { *(LAS v2u*)(M + n * RC_PT + m0) = (v2u){cvtpk(v.x, v.y), cvtpk(v.z, v.w)}; }
template <class Init, class Out>
__device__ __forceinline__ void rc_pset(const LAS bf16* X, const LAS bf16* Y, int wave, int lane, Init init, Out out) {
    const int g = lane >> 4, c = lane & 15;
#pragma unroll
    for (int u = 0; u < 2; ++u) { const int tl = 2 * wave + u, mt = tl >> 2, nt = tl & 3;
        f32x4 acc = init(mt, nt, g, c);
#pragma unroll
        for (int ks = 0; ks < 2; ++ks) { const bf16x8 a = *(const LAS bf16x8*)(X + (16 * mt + c) * RC_PT + 32 * ks + 8 * g), b = *(const LAS bf16x8*)(Y + (16 * nt + c) * RC_PT + 32 * ks + 8 * g);
            acc = __builtin_amdgcn_mfma_f32_16x16x32_bf16(a, b, acc, 0, 0, 0); }
        out(mt, nt, g, c, acc); }
}
#define RC_SYNC() __syncthreads()
__device__ __forceinline__ void rwkv_chunk_unit(Frame& F, int b, int h, int hl, int ch) {
    const int lane = mk_lane(), wave = F.wave;
    LAS bf16* L0 = (LAS bf16*)F.lds;
#define SLOT(i) (L0 + (i) * RC_MS)
    LAS float* gC = (LAS float*)(L0 + 15 * RC_MS);
    LAS float* segs = gC + 64;
    const bf16* P1 = (const bf16*)(F.ws + WS_P1); const bf16* LORA = (const bf16*)(F.ws + WS_LORA);
    const size_t tok0 = (size_t)b * SEQL + 64 * ch; const int chn = h * 64 + lane;
    { const float* mu = F.in[I_RWKV_MU]; const float mu_r = mu[PC_R + chn], mu_k = mu[PC_K + chn], mu_v = mu[PC_V + chn], kkw = F.in[I_RWKV_K_K][chn], kaw = F.in[I_RWKV_K_A][chn];
      float rr[8], kmod[8], vv[8], lw[8], kk[8], al[8]; float tot = 0.f;
#pragma unroll
      for (int i = 0; i < 8; ++i) { const int tt = 8 * wave + i; const size_t tok = tok0 + tt; const bool first = (ch == 0 && tt == 0); const bf16* row = P1 + tok * P1_LD; const bf16* prow = first ? row : (row - P1_LD);
          const float rc = bf2f(row[PC_R + chn]), kc = bf2f(row[PC_K + chn]), vc = bf2f(row[PC_V + chn]);
          const float rp = first ? 0.f : bf2f(prow[PC_R + chn]), kp = first ? 0.f : bf2f(prow[PC_K + chn]), vp = first ? 0.f : bf2f(prow[PC_V + chn]);
          lw[i] = bf2f(LORA[tok * 1536 + chn]); al[i] = bf2f(LORA[tok * 1536 + 512 + chn]);
          rr[i] = rc + (rp - rc) * mu_r; const float k0 = kc + (kp - kc) * mu_k; vv[i] = vc + (vp - vc) * mu_v;
          const float kkv = k0 * kkw; const float nrm = sqrtf(wave_sum(kkv * kkv)); kk[i] = kkv / fmaxf(nrm, 1e-12f);
          kmod[i] = k0 * (1.0f + (al[i] - 1.0f) * kaw); tot += lw[i]; }
      segs[wave * 64 + lane] = tot;
      RC_SYNC();
      float off = 0.f;
#pragma unroll
      for (int w2 = 0; w2 < 8; ++w2) off += (w2 < wave) ? segs[w2 * 64 + lane] : 0.f;
#pragma unroll
      for (int i = 0; i < 8; ++i) { const int tt = 8 * wave + i; const float Lm = off; off += lw[i]; const float Lc = off;
          const float eL = __expf(Lc), eLm = __expf(Lm), enL = __expf(-Lc);
          const bf16 va = (bf16)f2bf(-kk[i] * eLm), vb = (bf16)f2bf(kk[i] * al[i] * enL), vk = (bf16)f2bf(kmod[i] * enL), vr = (bf16)f2bf(rr[i] * eL), vvv = (bf16)f2bf(vv[i]);
          SLOT(0)[tt * RC_PT + lane] = va; SLOT(1)[tt * RC_PT + lane] = vb; SLOT(2)[tt * RC_PT + lane] = vk; SLOT(3)[tt * RC_PT + lane] = vr;
          SLOT(4)[lane * RC_PT + tt] = va; SLOT(5)[lane * RC_PT + tt] = vb; SLOT(6)[lane * RC_PT + tt] = vvv;
          if (tt == 63) gC[lane] = eL; }
      RC_SYNC(); }
    const auto zero = [](int, int, int, int) { return (f32x4){0.f, 0.f, 0.f, 0.f}; };
    rc_pset(SLOT(1), SLOT(0), wave, lane, zero, [&](int mt, int nt, int g, int c, f32x4 a) { const int m0 = 16 * mt + 4 * g, n = 16 * nt + c;
        rc_st4(SLOT(9), n, m0, (f32x4){m0 < n ? a.x : 0.f, m0 + 1 < n ? a.y : 0.f, m0 + 2 < n ? a.z : 0.f, m0 + 3 < n ? a.w : 0.f}); });
    rc_pset(SLOT(0), SLOT(1), wave, lane, zero, [&](int mt, int nt, int g, int c, f32x4 a) { const int m0 = 16 * mt + 4 * g, n = 16 * nt + c;
        rc_st4(SLOT(10), n, m0, (f32x4){n < m0 ? a.x : 0.f, n < m0 + 1 ? a.y : 0.f, n < m0 + 2 ? a.z : 0.f, n < m0 + 3 ? a.w : 0.f}); });
    rc_pset(SLOT(0), SLOT(2), wave, lane, zero, [&](int mt, int nt, int g, int c, f32x4 a) { const int m0 = 16 * mt + 4 * g, n = 16 * nt + c;
        rc_st4(SLOT(7), n, m0, (f32x4){n < m0 ? a.x : 0.f, n < m0 + 1 ? a.y : 0.f, n < m0 + 2 ? a.z : 0.f, n < m0 + 3 ? a.w : 0.f}); });
    rc_pset(SLOT(1), SLOT(3), wave, lane, zero, [&](int mt, int nt, int g, int c, f32x4 a) { const int m0 = 16 * mt + 4 * g, n = 16 * nt + c;
        rc_st4(SLOT(8), n, m0, (f32x4){m0 <= n ? a.x : 0.f, m0 + 1 <= n ? a.y : 0.f, m0 + 2 <= n ? a.z : 0.f, m0 + 3 <= n ? a.w : 0.f}); });
    RC_SYNC();
#define RC_NEU(sN, sNT, sM, sMT, dN, dNT, dM, dMT, LAST) do { \
    if (!(LAST)) rc_pset(SLOT(sNT), SLOT(sM), wave, lane, [&](int mt, int nt, int g, int c) { return rc_ld4(SLOT(sN), 16 * nt + c, 16 * mt + 4 * g); }, \
                         [&](int mt, int nt, int g, int c, f32x4 a) { rc_st4(SLOT(dN), 16 * nt + c, 16 * mt + 4 * g, a); });                   \
    rc_pset(SLOT(sM), SLOT(sNT), wave, lane, [&](int mt, int nt, int g, int c) { return rc_ld4(SLOT(sNT), 16 * nt + c, 16 * mt + 4 * g); }, \
            [&](int mt, int nt, int g, int c, f32x4 a) { rc_st4(SLOT(dNT), 16 * nt + c, 16 * mt + 4 * g, a); });                             \
    if (!(LAST)) { rc_pset(SLOT(sMT), SLOT(sM), wave, lane, zero, [&](int mt, int nt, int g, int c, f32x4 a) { rc_st4(SLOT(dM), 16 * nt + c, 16 * mt + 4 * g, a); });     \
                   rc_pset(SLOT(sM), SLOT(sMT), wave, lane, zero, [&](int mt, int nt, int g, int c, f32x4 a) { rc_st4(SLOT(dMT), 16 * nt + c, 16 * mt + 4 * g, a); }); } \
    RC_SYNC(); } while (0)
    RC_NEU(9, 10, 9, 10, 11, 12, 13, 14, false);
    RC_NEU(11, 12, 13, 14, 9, 10, 0, 1, false);
    RC_NEU(9, 10, 0, 1, 11, 12, 13, 14, false);
    RC_NEU(11, 12, 13, 14, 9, 10, 0, 1, false);
    RC_NEU(9, 10, 0, 1, 11, 12, 13, 14, false);
    RC_NEU(11, 12, 13, 14, 9, 10, 0, 1, true);
#undef RC_NEU
    rc_pset(SLOT(10), SLOT(8), wave, lane, [&](int mt, int nt, int g, int c) { return rc_ld4(SLOT(8), 16 * nt + c, 16 * mt + 4 * g); },
            [&](int mt, int nt, int g, int c, f32x4 a) { rc_st4(SLOT(9), 16 * nt + c, 16 * mt + 4 * g, a); });
    rc_pset(SLOT(10), SLOT(5), wave, lane, [&](int mt, int nt, int g, int c) { return rc_ld4(SLOT(5), 16 * nt + c, 16 * mt + 4 * g); },
            [&](int mt, int nt, int g, int c, f32x4 a) { rc_st4(SLOT(11), 16 * nt + c, 16 * mt + 4 * g, a); });
    RC_SYNC();
    const int ul = ((b * 4 + hl) * 128 + ch);
    bf16* WY = (bf16*)(F.ws + WS_RWS) + (size_t)ul * 12288; bf16* MC = WY + 4096; bf16* NC = WY + 8192;
    rc_pset(SLOT(4), SLOT(9), wave, lane, [&](int mt, int nt, int g, int c) { return rc_ld4(SLOT(3), 16 * nt + c, 16 * mt + 4 * g); },
            [&](int mt, int nt, int g, int c, f32x4 a) { *(v2u*)(WY + ((nt * 2 + (mt >> 1)) * 64 + g * 16 + c) * 8 + 4 * (mt & 1)) = (v2u){cvtpk(a.x, a.y), cvtpk(a.z, a.w)}; });
    { const int g = lane >> 4, c = lane & 15;
#pragma unroll
      for (int u = 0; u < 2; ++u) { const int tl = 2 * wave + u, mt = tl >> 2, nt = tl & 3, m0 = 16 * mt + 4 * g, n = 16 * nt + c; f32x4 acc = {0.f, 0.f, 0.f, 0.f};
#pragma unroll
          for (int ks = 0; ks < 2; ++ks) acc = __builtin_amdgcn_mfma_f32_16x16x32_bf16(*(const LAS bf16x8*)(SLOT(2) + (16 * mt + c) * RC_PT + 32 * ks + 8 * g), *(const LAS bf16x8*)(SLOT(3) + (16 * nt + c) * RC_PT + 32 * ks + 8 * g), acc, 0, 0, 0);
          acc = (f32x4){m0 <= n ? acc.x : 0.f, m0 + 1 <= n ? acc.y : 0.f, m0 + 2 <= n ? acc.z : 0.f, m0 + 3 <= n ? acc.w : 0.f};
#pragma unroll
          for (int ks = 0; ks < 2; ++ks) acc = __builtin_amdgcn_mfma_f32_16x16x32_bf16(*(const LAS bf16x8*)(SLOT(7) + (16 * mt + c) * RC_PT + 32 * ks + 8 * g), *(const LAS bf16x8*)(SLOT(9) + (16 * nt + c) * RC_PT + 32 * ks + 8 * g), acc, 0, 0, 0);
          rc_st4(SLOT(13), n, m0, acc); } }
    rc_pset(SLOT(4), SLOT(11), wave, lane, zero, [&](int mt, int nt, int g, int c, f32x4 a) { const int m0 = 16 * mt + 4 * g, n = 16 * nt + c; const float gg = gC[n];
        const f32x4 o = {gg * (a.x + (m0 == n ? 1.f : 0.f)), gg * (a.y + (m0 + 1 == n ? 1.f : 0.f)), gg * (a.z + (m0 + 2 == n ? 1.f : 0.f)), gg * (a.w + (m0 + 3 == n ? 1.f : 0.f))};
        *(v2u*)(MC + ((nt * 2 + (mt >> 1)) * 64 + g * 16 + c) * 8 + 4 * (mt & 1)) = (v2u){cvtpk(o.x, o.y), cvtpk(o.z, o.w)}; });
    rc_pset(SLOT(7), SLOT(11), wave, lane, [&](int mt, int nt, int g, int c) { const int m0 = 16 * mt + 4 * g, n = 16 * nt + c;
                return (f32x4){bf2f(SLOT(2)[m0 * RC_PT + n]), bf2f(SLOT(2)[(m0 + 1) * RC_PT + n]), bf2f(SLOT(2)[(m0 + 2) * RC_PT + n]), bf2f(SLOT(2)[(m0 + 3) * RC_PT + n])}; },
            [&](int mt, int nt, int g, int c, f32x4 a) { rc_st4(SLOT(14), 16 * nt + c, 16 * mt + 4 * g, a); });
    RC_SYNC();
    rc_pset(SLOT(14), SLOT(6), wave, lane, zero, [&](int mt, int nt, int g, int c, f32x4 a) { const int m0 = 16 * mt + 4 * g; const f32x4 gg = *(const LAS f32x4*)(gC + m0);
        *(v2u*)(NC + ((nt * 4 + mt) * 64 + lane) * 4) = (v2u){cvtpk(a.x * gg.x, a.y * gg.y), cvtpk(a.z * gg.z, a.w * gg.w)}; });
    { bf16* YR = (bf16*)(F.ws + WS_YR);
      rc_pset(SLOT(13), SLOT(6), wave, lane, zero, [&](int mt, int nt, int g, int c, f32x4 a) { bf16* yp = YR + (tok0 + 16 * mt + 4 * g) * 512 + h * 64 + 16 * nt + c;
          yp[0] = (bf16)f2bf(a.x); yp[512] = (bf16)f2bf(a.y); yp[1024] = (bf16)f2bf(a.z); yp[1536] = (bf16)f2bf(a.w); }); }
    RC_SYNC();
#undef SLOT
}
__device__ __forceinline__ void rwkv_chunk_passA(Frame& F, int half) {
    for (int un = blockIdx.x; un < 2048; un += F.G) { const int ch = un & 127, hl = (un >> 7) & 3, b = un >> 9; rwkv_chunk_unit(F, b, 4 * half + hl, hl, ch); }
}
constexpr int RB_SLOT = 32768, RB_R = 4, RB_D = 3;
template <bool STORE> __device__ __forceinline__ void rwkv_chunk_passB(Frame& F, int half) {
    const int lane = mk_lane(), wave = F.wave, g = lane >> 4, c = lane & 15; const int sq = (int)blockIdx.x, b = sq >> 2, hl = sq & 3, h = 4 * half + hl;
    const bf16* UB = (const bf16*)(F.ws + WS_RWS) + (size_t)sq * 128 * 12288;
    bf16* YRb = (bf16*)(F.ws + WS_YR) + (size_t)b * SEQL * 512 + h * 64;
    LAS unsigned char* ring = F.lds;
    const bool loader = wave >= 4; const int lw = wave & 3;
#define RB_ISSUE(ch_) do { const int ch2 = (ch_); LAS unsigned char* sl = ring + (ch2 % RB_R) * RB_SLOT; const char* ub = (const char*)(UB + (size_t)ch2 * 12288); \
        _Pragma("unroll") for (int q = 0; q < 6; ++q) { const int i = lw * 6 + q; __builtin_amdgcn_global_load_lds((const unsigned*)(ub + i * 1024 + lane * 16), (LAS unsigned*)(sl + i * 1024), 16, 0, 0); } \
        _Pragma("unroll") for (int q = 0; q < 2; ++q) { const int i2 = lw * 2 + q; const char* yp = (const char*)(YRb + (size_t)(64 * ch2 + 8 * i2 + (lane >> 3)) * 512) + (lane & 7) * 16; \
            __builtin_amdgcn_global_load_lds((const unsigned*)yp, (LAS unsigned*)(sl + 24576 + i2 * 1024), 16, 0, 0); } } while (0)
    if (loader) { RB_ISSUE(0); RB_ISSUE(1); RB_ISSUE(2); }
    bf16x8 sB[2] = {{0, 0, 0, 0, 0, 0, 0, 0}, {0, 0, 0, 0, 0, 0, 0, 0}};
    for (int ch = 0; ch < 128; ++ch) {
        if (loader) { if (ch + 2 < 128) asm volatile("s_waitcnt vmcnt(16)" ::: "memory"); else asm volatile("s_waitcnt vmcnt(0)" ::: "memory"); }
        else asm volatile("s_waitcnt lgkmcnt(0)" ::: "memory");
        asm volatile("" ::: "memory"); __builtin_amdgcn_s_barrier(); asm volatile("" ::: "memory");
        if (loader) { if (ch + RB_D < 128) RB_ISSUE(ch + RB_D); }
        else { const LAS unsigned char* sl = ring + (ch % RB_R) * RB_SLOT; const int vg = wave;
            bf16x8 wa[4][2], ma[4][2]; v2u nf[4]; float yl[4][4];
#pragma unroll
            for (int mt = 0; mt < 4; ++mt) {
#pragma unroll
                for (int ks = 0; ks < 2; ++ks) { wa[mt][ks] = *(const LAS bf16x8*)(sl + ((mt * 2 + ks) * 64 + lane) * 16); ma[mt][ks] = *(const LAS bf16x8*)(sl + 8192 + ((mt * 2 + ks) * 64 + lane) * 16); }
                nf[mt] = *(const LAS v2u*)(sl + 16384 + ((vg * 4 + mt) * 64 + lane) * 8);
#pragma unroll
                for (int j = 0; j < 4; ++j) yl[mt][j] = bf2f(*(const LAS unsigned short*)(sl + 24576 + (16 * mt + 4 * g + j) * 128 + (16 * vg + c) * 2)); }
            f32x4 ns[4];
#pragma unroll
            for (int mt = 0; mt < 4; ++mt) { f32x4 y = {yl[mt][0], yl[mt][1], yl[mt][2], yl[mt][3]};
                y = __builtin_amdgcn_mfma_f32_16x16x32_bf16(wa[mt][0], sB[0], y, 0, 0, 0); y = __builtin_amdgcn_mfma_f32_16x16x32_bf16(wa[mt][1], sB[1], y, 0, 0, 0);
                bf16* yp = YRb + (size_t)(64 * ch + 16 * mt + 4 * g) * 512 + 16 * vg + c; if (STORE) { yp[0] = (bf16)f2bf(y.x); yp[512] = (bf16)f2bf(y.y); yp[1024] = (bf16)f2bf(y.z); yp[1536] = (bf16)f2bf(y.w); } else if (y.x == 123456.f) yp[0] = 0;
                f32x4 s = {bflo(nf[mt].x), bfhi(nf[mt].x), bflo(nf[mt].y), bfhi(nf[mt].y)};
                s = __builtin_amdgcn_mfma_f32_16x16x32_bf16(ma[mt][0], sB[0], s, 0, 0, 0); s = __builtin_amdgcn_mfma_f32_16x16x32_bf16(ma[mt][1], sB[1], s, 0, 0, 0); ns[mt] = s; }
            { v4u w0, w1; w0.x = cvtpk(ns[0].x, ns[0].y); w0.y = cvtpk(ns[0].z, ns[0].w); w0.z = cvtpk(ns[1].x, ns[1].y); w0.w = cvtpk(ns[1].z, ns[1].w);
              w1.x = cvtpk(ns[2].x, ns[2].y); w1.y = cvtpk(ns[2].z, ns[2].w); w1.z = cvtpk(ns[3].x, ns[3].y); w1.w = cvtpk(ns[3].z, ns[3].w);
              sB[0] = __builtin_bit_cast(bf16x8, w0); sB[1] = __builtin_bit_cast(bf16x8, w1); } } }
    asm volatile("s_waitcnt vmcnt(0) lgkmcnt(0)" ::: "memory"); __builtin_amdgcn_s_barrier(); asm volatile("" ::: "memory");
#undef RB_ISSUE
}

__device__ __forceinline__ void final_norm_phase(Frame& F) {
    const int gw = blockIdx.x * NWAVES + F.wave, NGW = F.G * NWAVES, lane = mk_lane(); const float* gn = F.in[I_FINAL_NORM];
    f32x4 gv[4];
#pragma unroll
    for (int j = 0; j < 4; ++j) gv[j] = ((const f32x4*)gn)[lane + 64 * j];
    for (int m = gw; m < T_TOK; m += NGW) { f32x4* xr = (f32x4*)(F.out + (size_t)m * DMODEL) + lane; f32x4 v[4]; float s = 0.f;
#pragma unroll
        for (int j = 0; j < 4; ++j) { v[j] = xr[64 * j]; s += (v[j].x * v[j].x + v[j].y * v[j].y) + (v[j].z * v[j].z + v[j].w * v[j].w); }
        const float rstd = 1.0f / sqrtf(wave_sum(s) * (1.f / DMODEL) + NORM_EPS);
#pragma unroll
        for (int j = 0; j < 4; ++j) xr[64 * j] = v[j] * rstd * gv[j]; }
}

constexpr int NPHASE = 29;
__global__ void __launch_bounds__(NWAVES * 64, 2) mega_fwd(Args args) {
    extern __shared__ __attribute__((aligned(16))) unsigned char lds[];
    Frame F;
    F.lds = (LAS unsigned char*)lds;
    F.wave = __builtin_amdgcn_readfirstlane((int)threadIdx.x >> 6); F.G = gridDim.x;
    F.in = args.in; F.out = args.out; F.ws = args.ws;
    unsigned char* ws = args.ws;
    for (int u = threadIdx.x; u < (LDS_BYTES - RING_BYTES) / 4; u += NWAVES * 64) ((LAS unsigned*)(F.lds + RING_BYTES))[u] = 0u;
    __syncthreads();
    XcdBarrier bar = xcd_barrier_post((unsigned*)(ws + WS_CTL) + CW_BAR + args.li * XCD_BAR_WORDS, (volatile LAS unsigned*)(F.lds + MISC_OFF));
    const int lo = args.ph_lo, hi = args.ph_hi;
#if STAMP_KA >= 0
    volatile LAS unsigned long long* stl = (volatile LAS unsigned long long*)(F.lds + MISC_OFF + 32);
    const bool stamper = (blockIdx.x == 0 && threadIdx.x == 0);
    if (stamper) stl[0] = __builtin_amdgcn_s_memrealtime();
#define STAMP_AT(k) do { if (stamper) { if ((k) == STAMP_KA) stl[1] = __builtin_amdgcn_s_memrealtime(); if ((k) == STAMP_KB) stl[2] = __builtin_amdgcn_s_memrealtime(); \
        if ((k) == 27) { const unsigned long long now = __builtin_amdgcn_s_memrealtime(); ((float*)(ws + WS_TILEEXP + 4096))[0] = (float)(stl[2] - stl[1]) / (float)(now - stl[0]); } } } while (0)
#else
#define STAMP_AT(k) do {} while (0)
#endif
#define IN(k) (lo <= (k) && (k) < hi)
#ifndef P8_DUP_MODE
#define P8_DUP_MODE 0
#endif
#ifndef P8_SP2
#define P8_SP2 true
#endif
#ifndef MFMA_SPIN
#define MFMA_SPIN 0
#endif
#ifndef P8_DUP_LD0
#define P8_DUP_LD0 0
#endif
#ifndef E1_OLD
#define E1_OLD 0
#endif
#ifndef P8_DUP_ZERO
#define P8_DUP_ZERO 0
#endif
#ifndef EXTRA_BAR
#define EXTRA_BAR 0
#endif
#ifndef P8_DUP_LDV
#define P8_DUP_LDV 0
#endif
#ifndef P9_DUP_LDV
#define P9_DUP_LDV 0
#endif
#ifndef P9_DUP_SKIP
#define P9_DUP_SKIP 0
#endif
#ifndef DUP_SKIP_EPI
#define DUP_SKIP_EPI 0
#endif
#ifndef P8_DUP_F8
#define P8_DUP_F8 0
#endif
#ifndef P8_ORDER
#define P8_ORDER pg8::StaticOrder
#endif
#ifndef GEMM_ORDER
#define GEMM_ORDER pg8::StaticOrder
#endif
#ifndef MOE_PROBE
#define MOE_PROBE 0
#endif
#ifndef MOE_PROBE_OFF
#define MOE_PROBE_OFF 470
#endif
#ifndef MOE_ALIGN
#define MOE_ALIGN true
#endif
#ifndef DUPSET
#define DUPSET 0ull
#endif
#define PHB(k) if (IN(k)) { const int nrep_ = 1 + (int)(((unsigned long long)(DUPSET) >> (k)) & 1ull); for (int rep_ = 0; rep_ < nrep_; ++rep_) { const bool last_ = (rep_ + 1 == nrep_); (void)last_;
#define PHE(k) if (!last_) xcd_barrier(bar, F.wave == 0 && mk_lane() == 0); } }
#define SEAM(k) do { if (IN(k) && IN((k) + 1)) { xcd_barrier(bar, F.wave == 0 && mk_lane() == 0); if (EXTRA_BAR) xcd_barrier(bar, F.wave == 0 && mk_lane() == 0); } } while (0)
#define SEAM2(k, kn) do { if (IN(k) && IN(kn)) xcd_barrier(bar, F.wave == 0 && mk_lane() == 0); } while (0)
    bf16* XN = (bf16*)(ws + WS_XN); bf16* CAT = (bf16*)(ws + WS_CAT); bf16* UG = (bf16*)(ws + WS_UG);
    bf16* Q0 = (bf16*)(ws + WS_Q0); bf16* K0 = (bf16*)(ws + WS_K0); bf16* V0 = (bf16*)(ws + WS_V0); bf16* YA = (bf16*)(ws + WS_YA);

#if MFMA_SPIN
    {
        typedef short s8_t __attribute__((ext_vector_type(8)));
        f32x4 a8[8]; s8_t xa, xb;
#pragma unroll
        for (int j = 0; j < 8; ++j) { a8[j] = (f32x4){0.f, 0.f, 0.f, 0.f}; xa[j] = (short)(0x3c00 + mk_lane() + j); xb[j] = (short)(0x3b80 + 3 * j); }
#pragma unroll 1
        for (int i = 0; i < MFMA_SPIN; ++i) {
#pragma unroll
            for (int j = 0; j < 8; ++j) a8[j] = __builtin_amdgcn_mfma_f32_16x16x32_bf16(xa, xb, a8[j], 0, 0, 0); }
        float sm = 0.f;
#pragma unroll
        for (int j = 0; j < 8; ++j) sm += a8[j][0] + a8[j][1] + a8[j][2] + a8[j][3];
        if (sm == 1.2345e-30f) ((float*)(ws + WS_TILEEXP))[1000] = sm;
    }
#endif
    PHB(0) p0_prologue(F, last_ ? 15 : (int)(((unsigned long long)(DUPSET) >> 46) & 15ull)); PHE(0) SEAM(0);
    PHB(1) pg8::Gemm g{XN, (const bf16*)(ws + WS_WE_IN), 1024, 1024, 1024}; GEMM_ORDER S; S.init(T_TOK, 2048, F.G, (int)blockIdx.x);
        #if E1_OLD
        pg8::Epi8<F_E1> E{{UG, Q0, K0, V0, (const float*)(ws + WS_ROPE)}};
        pg8::gemm_phase<pg8::Epi8<F_E1>, pg8::StaticOrder, true, true>(F.lds, g, S, E, F.wave, !last_ && DUP_SKIP_EPI); PHE(1) SEAM(1);
#else
        EpiE1 E{UG, Q0, K0, V0, (const float*)(ws + WS_ROPE)};
        pg8::gemm_phase<EpiE1, GEMM_ORDER, true, true>(F.lds, g, S, E, F.wave, !last_ && DUP_SKIP_EPI); PHE(1) SEAM(1);
#endif
    PHB(2) pg8::Gemm g{UG, (const bf16*)(ws + WS_S5BEND), 640, 512, 512}; SchedXend S{F.G, (int)blockIdx.x};
        pg8::Epi8<F_XEND> E{{(float*)(ws + WS_XEND)}};
        if (last_ || ((DUPSET >> 44) & 1ull)) pg8::gemm_phase<pg8::Epi8<F_XEND>, SchedXend, true, true>(F.lds, g, S, E, F.wave, !last_ && DUP_SKIP_EPI);
        if (last_ || ((DUPSET >> 45) & 1ull)) kmean_phase(F); PHE(2) SEAM(2);
    PHB(3) s5_carry_phase(F); moba_select_phase(F); PHE(3) SEAM(3);
    PHB(4) if (last_ || (DUPSET & (1ull << 40))) { pg8::Gemm g{UG, (const bf16*)(ws + WS_S5MT), 640, 640, 640}; SchedS5Y S{F.G, (int)blockIdx.x};
          pg8::Epi8L<F_S5Y> E{{UG, F.in[I_S5_D], YA}};
          pg8::gemm_phase<pg8::Epi8L<F_S5Y>, SchedS5Y, true, true>(F.lds, g, S, E, F.wave, !last_ && DUP_SKIP_EPI); }
        if (F.G == 256 && (last_ || (DUPSET & (1ull << 41)))) { const attn_body::AttnTensors AT{(const attn_body::bf16*)Q0, (const attn_body::bf16*)K0, (const attn_body::bf16*)V0, (attn_body::bf16*)(CAT + 512), (const unsigned*)(ws + WS_SELM)};
          const attn_body::StaticOrder S((int)F.G, (int)blockIdx.x);
          attn_body::attn_phase<attn_body::StaticOrder>((char*)lds, AT, S, F.wave); } PHE(4) SEAM(4);
    PHB(5) pg8::Gemm g{YA, (const bf16*)(ws + WS_WGLU), 512, 512, 512}; pg8::StaticOrder S; S.init(T_TOK, 512, F.G, (int)blockIdx.x);
        pg8::Epi8L<F_GLU> E{{YA, F.in[I_S5_GLU_B], CAT}};
        pg8::gemm_phase<pg8::Epi8L<F_GLU>, pg8::StaticOrder, true, true>(F.lds, g, S, E, F.wave, !last_ && DUP_SKIP_EPI); PHE(5) SEAM(5);
    PHB(6) pg8::Gemm g{CAT, (const bf16*)(ws + WS_WE_OUT), 1024, 1024, 1024}; GEMM_ORDER S; S.init(T_TOK, 1024, F.G, (int)blockIdx.x);
        EpiResNorm<false> E{(const void*)F.in[I_X], (bf16*)(ws + WS_HB1), nullptr, (float*)(ws + WS_SS1)};
        pg8::gemm_phase<EpiResNorm<false>, GEMM_ORDER, true, true>(F.lds, g, S, E, F.wave, !last_ && DUP_SKIP_EPI); PHE(6) SEAM2(6, 8);
    PHB(8) pg8::Gemm g{(const bf16*)(ws + WS_HB1), (const bf16*)(ws + WS_WFFN_GU), 1024, 1024, 1024}; P8_ORDER S; S.init(T_TOK, 2 * FFN_D, F.G, (int)blockIdx.x);
        pg8::EpiGUR<F_SWIGLU> E{{(bf16*)(ws + WS_ACT), FFN_D, (const float*)(ws + WS_SS1), last_ ? 0 : P8_DUP_MODE}};
        pg8::gemm_phase<pg8::EpiGUR<F_SWIGLU>, P8_ORDER, true, P8_SP2>(F.lds, g, S, E, F.wave, !last_ && DUP_SKIP_EPI); PHE(8) SEAM(8);
    PHB(9) pg8::Gemm g{(const bf16*)(ws + WS_ACT), (const bf16*)(ws + WS_WFFN_D), (!last_ && P9_DUP_LDV) ? P9_DUP_LDV : FFN_D, (!last_ && P9_DUP_LDV) ? P9_DUP_LDV : FFN_D, FFN_D}; GEMM_ORDER S; S.init(T_TOK, 1024, F.G, (int)blockIdx.x);
        EpiResNorm<true> E{(const void*)(ws + WS_HB1), XN, (bf16*)F.out, (float*)(ws + WS_SS2), (!last_ && P9_DUP_SKIP) ? 1 : 0};
        pg8::gemm_phase<EpiResNorm<true>, GEMM_ORDER, true, true>(F.lds, g, S, E, F.wave, !last_ && DUP_SKIP_EPI); PHE(9) SEAM2(9, 11);
    PHB(11) pg8::Gemm g{XN, (const bf16*)(ws + WS_WO_IN), 1024, 1024, 1024}; GEMM_ORDER S; S.init(T_TOK, ODD_PAD, F.G, (int)blockIdx.x);
        pg8::Epi8R<F_P1> E{{(bf16*)(ws + WS_P1), (const float*)(ws + WS_SS2)}};
        pg8::gemm_phase<pg8::Epi8R<F_P1>, GEMM_ORDER, true, true>(F.lds, g, S, E, F.wave, !last_ && DUP_SKIP_EPI); PHE(11) SEAM(11);
    PHB(12) l1_prep_phase(F); PHE(12) SEAM(12);
    PHB(13) pg8::Gemm g{(const bf16*)(ws + WS_ALORA), (const bf16*)(ws + WS_WLORA), 256, 256, 256}; pg8::StaticOrder S; S.init(T_TOK, 1536, F.G, (int)blockIdx.x);
        pg8::Epi8L<F_LORA> E{{(bf16*)(ws + WS_LORA), F.in[I_RWKV_W0], F.in[I_RWKV_A0]}};
        pg8::gemm_phase<pg8::Epi8L<F_LORA>, pg8::StaticOrder, true, true>(F.lds, g, S, E, F.wave, !last_ && DUP_SKIP_EPI);
        { LAS bf16* scr = (LAS bf16*)(F.lds + F.wave * 16384); const int lane = mk_lane();
          for (int it = blockIdx.x * NWAVES + F.wave; it < 256; it += F.G * NWAVES) tr_item64<0>(F.in[I_O_W_OUT], 1024, 1024, (bf16*)(ws + WS_WO_OUT2), 1024, 0, nullptr, scr, it / 16, it % 16, lane); } PHE(13) SEAM(13);
    PHB(14) rwkv_chunk_passA(F, 0); PHE(14) SEAM(14);
    PHB(15) if (F.G == 256) { if ((int)blockIdx.x < 16) { if (last_) rwkv_chunk_passB<true>(F, 0); else rwkv_chunk_passB<false>(F, 0); } dsa_phase(F, last_ ? 0 : 2, 0, 1024); } PHE(15) SEAM(15);
    PHB(16) rwkv_chunk_passA(F, 1); PHE(16) SEAM(16);
    PHB(17) if (F.G == 256) { if ((int)blockIdx.x < 16) { if (last_) rwkv_chunk_passB<true>(F, 1); else rwkv_chunk_passB<false>(F, 1); } dsa_phase(F, last_ ? 1 : 3, 1024, 1024); } PHE(17) SEAM(17);
    PHB(18) rwkv_post_phase(F); PHE(18) SEAM(18);
    PHB(19) if (last_ || (DUPSET & (1ull << 42))) { pg8::Gemm g{CAT, (const bf16*)(ws + WS_WO_OUT2), 1024, 1024, 1024}; GEMM_ORDER S; S.init(T_TOK, 1024, F.G, (int)blockIdx.x);
          pg8::Epi8L<F_RES> E{{(const bf16*)F.out, last_ ? (bf16*)F.out : (bf16*)(ws + 130 * MiB)}};
          pg8::gemm_phase<pg8::Epi8L<F_RES>, GEMM_ORDER, true, true>(F.lds, g, S, E, F.wave, !last_ && DUP_SKIP_EPI); }
        if (last_ || (DUPSET & (1ull << 43))) moe_convert_phase(F); PHE(19) SEAM(19);
    PHB(20) router_phase(F, last_ ? 0 : 2048); PHE(20) SEAM(20);
    PHB(21) moe_scatter_phase(F); PHE(21) SEAM(21);
#define MOE_NT const int* te = (const int*)(ws + WS_TILEEXP); const int ntl = te[511]; const int ntail = ntl > 256 ? ntl - 256 : 0; (void)ntail;
#define MOE_GU(RT0, NTQ, NTAIL, ND) do { pg8::Gemm g{(const bf16*)(ws + WS_XG), (const bf16*)(ws + WS_WMOE_GU), 512, 512, 512}; SchedMoeGU S{te, (RT0), (NTQ), F.G, (int)blockIdx.x, (NTAIL), (ND)}; \
        pg8::EpiGU<F_MOEGU> E{{last_ ? ws + WS_ACTQ : ws + MOE_PROBE_OFF * MiB, 0, last_ ? 0 : MOE_PROBE}}; \
        pg8::gemm_phase<pg8::EpiGU<F_MOEGU>, SchedMoeGU, MOE_ALIGN, true, true>(F.lds, g, S, E, F.wave, !last_ && DUP_SKIP_EPI); } while (0)
#define MOE_D(RT0, NTQ) do { pg8::Gemm g{(const bf16*)(ws + WS_ACTQ), (const bf16*)(ws + WS_WMOE_D), FEXP / 2, FEXP / 2, FEXP / 2}; SchedMoeD S{te, (RT0), (NTQ), F.G, (int)blockIdx.x}; \
        pg8::Epi8<F_MOED> E{{last_ ? (bf16*)(ws + WS_YS) : (bf16*)(ws + MOE_PROBE_OFF * MiB), last_ ? 0 : MOE_PROBE}}; \
        pg8::gemm_phase<pg8::Epi8<F_MOED>, SchedMoeD, MOE_ALIGN, true, true>(F.lds, g, S, E, F.wave, !last_ && DUP_SKIP_EPI); } while (0)
    PHB(22) MOE_NT const int ntq0 = ntl < 128 ? ntl : 128; MOE_GU(0, ntq0, ntail, 0); PHE(22) SEAM(22);
    PHB(23) MOE_NT const int ntq0 = ntl < 128 ? ntl : 128; MOE_D(0, ntq0); PHE(23) SEAM(23);
    PHB(24) MOE_NT int ntq1 = ntl - 128; ntq1 = ntq1 < 0 ? 0 : (ntq1 > 128 ? 128 : ntq1);
        if (ntail > 0) { pg8::Gemm g{(const bf16*)(ws + WS_ACTQ), (const bf16*)(ws + WS_WMOE_D), FEXP / 2, FEXP / 2, FEXP / 2}; SchedMoeDT S{te, ntail, F.G, (int)blockIdx.x};
            pg8::Epi8<F_MOED> E{{last_ ? (bf16*)(ws + WS_YS) : (bf16*)(ws + MOE_PROBE_OFF * MiB), last_ ? 0 : MOE_PROBE}};
            pg8::gemm_phase<pg8::Epi8<F_MOED>, SchedMoeDT, MOE_ALIGN, true, true>(F.lds, g, S, E, F.wave, !last_ && DUP_SKIP_EPI); }
        MOE_GU(128, ntq1, 0, (ntq1 == 128 && F.G == 256) ? 4 * ntail : 0); PHE(24) SEAM(24);
    PHB(25) MOE_NT int ntq1 = ntl - 128; ntq1 = ntq1 < 0 ? 0 : (ntq1 > 128 ? 128 : ntq1); MOE_D(128, ntq1); PHE(25) SEAM2(25, 28);
#undef MOE_NT
#undef MOE_GU
#undef MOE_D
    PHB(28) moe_combine_final_phase(F, last_ ? F.out : (float*)(ws + 346 * MiB)); PHE(28)
#undef IN
#undef SEAM
#undef SEAM2
}

#ifndef MK_ONE_LAUNCH
#define MK_ONE_LAUNCH 1
#endif
extern "C" void kernel_launch(void* const* d_in, const int* in_sizes, int n_in, void* d_out, int out_size, void* d_ws, size_t ws_size, hipStream_t stream) {
    static int grid = 0;
    if (grid == 0) {
        if (n_in != 38 || in_sizes[0] != T_TOK * DMODEL || out_size != T_TOK * DMODEL || ws_size < WS_NEED) { fprintf(stderr, "kernel_launch: unexpected shapes (n_in %d, in0 %d, out %d, ws %zu); nothing launched\n", n_in, n_in > 0 ? in_sizes[0] : -1, out_size, ws_size); grid = -1; return; }
        int dev = 0, cus = 0, per_cu = 0;
        if (hipGetDevice(&dev) != hipSuccess || hipDeviceGetAttribute(&cus, hipDeviceAttributeMultiprocessorCount, dev) != hipSuccess) { grid = -1; return; }
        if (hipFuncSetAttribute((const void*)mega_fwd, hipFuncAttributeMaxDynamicSharedMemorySize, LDS_BYTES) != hipSuccess) { fprintf(stderr, "kernel_launch: hipFuncSetAttribute failed\n"); grid = -1; return; }
        if (hipOccupancyMaxActiveBlocksPerMultiprocessor(&per_cu, (const void*)mega_fwd, NWAVES * 64, LDS_BYTES) != hipSuccess || per_cu < 1) fprintf(stderr, "kernel_launch: occupancy query reports %d\n", per_cu);
        (void)hipGetLastError();
        grid = cus > 256 ? 256 : cus;
    }
    if (grid < 0) return;
    if (hipMemsetAsync((char*)d_ws + WS_CTL, 0, CTL_ZERO_BYTES, stream) != hipSuccess) return;
    Args a{};
    for (int i = 0; i < 38; ++i) a.in[i] = (const float*)d_in[i];
    a.out = (float*)d_out; a.ws = (unsigned char*)d_ws; a.pad = 0;
#if MK_ONE_LAUNCH
    a.ph_lo = 0; a.ph_hi = NPHASE; a.li = 0;
    hipLaunchKernelGGL(mega_fwd, dim3(grid), dim3(NWAVES * 64), LDS_BYTES, stream, a);
#else
    for (int p = 0; p < NPHASE; ++p) { a.ph_lo = p; a.ph_hi = p + 1; a.li = p;
        hipLaunchKernelGGL(mega_fwd, dim3(grid), dim3(NWAVES * 64), LDS_BYTES, stream, a);
        if (hipPeekAtLastError() != hipSuccess) { fprintf(stderr, "kernel_launch: launch %d failed\n", p); break; } }
#endif
}
```

```cpp
#include <hip/hip_runtime.h>
#include <hip/hip_bf16.h>
#include <cstdio>
#include <cstdint>
#include <cmath>
#include <type_traits>
#ifndef ABL_MOBA
#define ABL_MOBA 0
#endif
__device__ __forceinline__ int mk_lane() { int l; asm volatile("v_mbcnt_lo_u32_b32 %0, -1, 0\n\tv_mbcnt_hi_u32_b32 %0, -1, %0" : "=v"(l)); return l; }
namespace pg8 {
#define PG8_LAS __attribute__((address_space(3)))
typedef unsigned short bf16_t;
typedef short bf16x8 __attribute__((ext_vector_type(8)));
typedef float f32x4 __attribute__((ext_vector_type(4)));
typedef unsigned u32x4 __attribute__((ext_vector_type(4)));
typedef int i32x4 __attribute__((ext_vector_type(4)));
typedef int i32x8 __attribute__((ext_vector_type(8)));
constexpr int BM = 256, BK = 64, HALF = 128, HTB = HALF * BK * 2  , STAGE_BYTES = 8 * HTB, NXCD = 8, WGM = 8;

__host__ __device__ __forceinline__ int lds_byte(int r, int c) { const int st = (r >> 4) * 2 + (c >> 5), rr = r & 15, cc = c & 31, ob = rr * 64 + cc * 2; return st * 1024 + (ob ^ (((ob >> 9) & 1) << 5)); }
__host__ __device__ __forceinline__ void stage_rc(int b, int& R, int& C) { const int st = b / 1024, sb = b % 1024, swz = sb ^ (((sb >> 9) & 1) << 5); R = (st >> 1) * 16 + swz / 64; C = (st & 1) * 32 + (swz % 64) / 2; }
__host__ __device__ __forceinline__ int perm32(int rho) { const int n = rho >> 4, i = rho & 15; return 8 * (i >> 2) + 4 * n + (i & 3); }

struct Unit { int pm, pn, aux; };
struct Gemm { const bf16_t* A; const bf16_t* Bt; int lda, ldb, K; };

struct StaticOrder {
    int nM, nN, nwg, G, c, zero;
    __host__ __device__ void init(int M, int N, int G_, int c_) { nM = M / BM; nN = N / BM; nwg = nM * nN; G = G_; c = c_; zero = 0; }
    __host__ __device__ bool next(int i, Unit& u) const {
        const long L = (long)i * G + c; if (L >= nwg) return false;
        int wgid = (int)L; { const int q = nwg / NXCD, r = nwg % NXCD, xcd = wgid % NXCD, off = wgid / NXCD; wgid = (xcd < r ? xcd * (q + 1) : r * (q + 1) + (xcd - r) * q) + off; }
        const int nig = WGM * nN, gid = wgid / nig, fm = gid * WGM, gsz = (nM - fm) < WGM ? (nM - fm) : WGM;
        u.pm = fm + ((wgid % nig) % gsz); u.pn = (wgid % nig) / gsz; u.aux = 0; if (zero) { u.pm &= (zero - 1); u.pn &= (zero - 1); } return true;
    }
    __device__ __forceinline__ void a_ready(const Unit&) const {}
    __device__ __forceinline__ void done(const Unit&) const {}
};

struct ColPanelOrder {
    int nM, nN, nwg, G, c;
    __host__ __device__ void init(int M, int N, int G_, int c_) { nM = M / BM; nN = N / BM; nwg = nM * nN; G = G_; c = c_; }
    __host__ __device__ bool next(int i, Unit& u) const { const int L = i * G + c; if (L >= nwg) return false; u.pm = L % nM; u.pn = L / nM; u.aux = 0; return true; }
    __device__ __forceinline__ void a_ready(const Unit&) const {}
    __device__ __forceinline__ void done(const Unit&) const {}
};
__device__ __forceinline__ unsigned cvt_pk_bf16(float lo, float hi) { unsigned r; asm volatile("v_cvt_pk_bf16_f32 %0, %1, %2" : "=v"(r) : "v"(lo), "v"(hi)); return r; }

template <class F> struct Epi8 {
    static constexpr bool PERM = true, AFTER_DRAIN = false;
    F f;
    __device__ __forceinline__ void operator()(const f32x4 (&acc)[2][2][4][2], const Unit& u, int wr, int wc, int fr, int fq) const {
#pragma unroll
        for (int ai = 0; ai < 2; ++ai)
#pragma unroll
            for (int m = 0; m < 4; ++m) { const int r = ai * HALF + wr * 64 + m * 16 + fr;
#pragma unroll
                for (int bj = 0; bj < 2; ++bj) { const int c = bj * HALF + wc * 32 + 8 * fq;
                    float v[8] = {acc[ai][bj][m][0][0], acc[ai][bj][m][0][1], acc[ai][bj][m][0][2], acc[ai][bj][m][0][3], acc[ai][bj][m][1][0], acc[ai][bj][m][1][1], acc[ai][bj][m][1][2], acc[ai][bj][m][1][3]};
                    f(u, r, c, v, wc); } }
    }
};
template <class F> struct EpiGU {
    static constexpr bool PERM = true, AFTER_DRAIN = false;
    F f;
    __device__ __forceinline__ void operator()(const f32x4 (&acc)[2][2][4][2], const Unit& u, int wr, int wc, int fr, int fq) const {
#pragma unroll
        for (int ai = 0; ai < 2; ++ai)
#pragma unroll
            for (int m = 0; m < 4; ++m) { const int r = ai * HALF + wr * 64 + m * 16 + fr; const int c = wc * 32 + 8 * fq;
                float g[8] = {acc[ai][0][m][0][0], acc[ai][0][m][0][1], acc[ai][0][m][0][2], acc[ai][0][m][0][3], acc[ai][0][m][1][0], acc[ai][0][m][1][1], acc[ai][0][m][1][2], acc[ai][0][m][1][3]};
                float p[8] = {acc[ai][1][m][0][0], acc[ai][1][m][0][1], acc[ai][1][m][0][2], acc[ai][1][m][0][3], acc[ai][1][m][1][0], acc[ai][1][m][1][1], acc[ai][1][m][1][2], acc[ai][1][m][1][3]};
                f(u, r, c, g, p); }
    }
};

template <class F> struct Epi8L {
    static constexpr bool PERM = true, AFTER_DRAIN = false;
    F f;
    __device__ __forceinline__ void operator()(const f32x4 (&acc)[2][2][4][2], const Unit& u, int wr, int wc, int fr, int fq) const {
        constexpr int MB = F::MB, NB = 8 / MB;
        typename F::Hoist h; f.hoist(u, wc, fq, h);
        typename F::Pre pre[2][MB][2];
#pragma unroll
        for (int mm = 0; mm < MB; ++mm)
#pragma unroll
            for (int bj = 0; bj < 2; ++bj) { const int ri = mm; f.load(u, (ri >> 2) * HALF + wr * 64 + (ri & 3) * 16 + fr, bj * HALF + wc * 32 + 8 * fq, pre[0][mm][bj]); }
#pragma unroll
        for (int b = 0; b < NB; ++b) {
            if (b + 1 < NB) {
#pragma unroll
                for (int mm = 0; mm < MB; ++mm)
#pragma unroll
                    for (int bj = 0; bj < 2; ++bj) { const int ri = (b + 1) * MB + mm; f.load(u, (ri >> 2) * HALF + wr * 64 + (ri & 3) * 16 + fr, bj * HALF + wc * 32 + 8 * fq, pre[(b + 1) & 1][mm][bj]); } }
#pragma unroll
            for (int mm = 0; mm < MB; ++mm)
#pragma unroll
                for (int bj = 0; bj < 2; ++bj) { const int ri = b * MB + mm, ai = ri >> 2, m = ri & 3;
                    float v[8] = {acc[ai][bj][m][0][0], acc[ai][bj][m][0][1], acc[ai][bj][m][0][2], acc[ai][bj][m][0][3], acc[ai][bj][m][1][0], acc[ai][bj][m][1][1], acc[ai][bj][m][1][2], acc[ai][bj][m][1][3]};
                    f.apply(u, ai * HALF + wr * 64 + m * 16 + fr, bj * HALF + wc * 32 + 8 * fq, v, pre[b & 1][mm][bj], h, bj); } }
    }
};
__device__ __forceinline__ void rows_rstd(const float* SS, int row0, int wr, int fr, int fq, float (&rs)[2][4]) {
    f32x4 pp[2][4];
#pragma unroll
    for (int ai = 0; ai < 2; ++ai)
#pragma unroll
        for (int m = 0; m < 4; ++m) pp[ai][m] = ((const f32x4*)(SS + (size_t)(row0 + ai * HALF + wr * 64 + m * 16 + fr) * 16))[fq];
#pragma unroll
    for (int ai = 0; ai < 2; ++ai)
#pragma unroll
        for (int m = 0; m < 4; ++m) { float s = (pp[ai][m][0] + pp[ai][m][1]) + (pp[ai][m][2] + pp[ai][m][3]); s += __shfl_xor(s, 16); s += __shfl_xor(s, 32); rs[ai][m] = __builtin_amdgcn_rsqf(s * (1.f / 1024.f) + 1e-6f); }
}
template <class F> struct Epi8R {
    static constexpr bool PERM = true, AFTER_DRAIN = false;
    F f;
    __device__ __forceinline__ void operator()(const f32x4 (&acc)[2][2][4][2], const Unit& u, int wr, int wc, int fr, int fq) const {
        float rs[2][4]; rows_rstd(f.SS, u.pm * 256, wr, fr, fq, rs);
#pragma unroll
        for (int ai = 0; ai < 2; ++ai)
#pragma unroll
            for (int m = 0; m < 4; ++m) { const int r = ai * HALF + wr * 64 + m * 16 + fr;
#pragma unroll
                for (int bj = 0; bj < 2; ++bj) { const int c = bj * HALF + wc * 32 + 8 * fq;
                    float v[8] = {acc[ai][bj][m][0][0], acc[ai][bj][m][0][1], acc[ai][bj][m][0][2], acc[ai][bj][m][0][3], acc[ai][bj][m][1][0], acc[ai][bj][m][1][1], acc[ai][bj][m][1][2], acc[ai][bj][m][1][3]};
                    f(u, r, c, v, rs[ai][m]); } }
    }
};
template <class F> struct EpiGUR {
    static constexpr bool PERM = true, AFTER_DRAIN = false;
    F f;
    __device__ __forceinline__ void operator()(const f32x4 (&acc)[2][2][4][2], const Unit& u, int wr, int wc, int fr, int fq) const {
        if (f.mode == 2) return;
        float rs[2][4]; rows_rstd(f.SS, u.pm * 256, wr, fr, fq, rs);
#pragma unroll
        for (int ai = 0; ai < 2; ++ai)
#pragma unroll
            for (int m = 0; m < 4; ++m) { const int r = ai * HALF + wr * 64 + m * 16 + fr; const int c = wc * 32 + 8 * fq;
                float g[8] = {acc[ai][0][m][0][0], acc[ai][0][m][0][1], acc[ai][0][m][0][2], acc[ai][0][m][0][3], acc[ai][0][m][1][0], acc[ai][0][m][1][1], acc[ai][0][m][1][2], acc[ai][0][m][1][3]};
                float p[8] = {acc[ai][1][m][0][0], acc[ai][1][m][0][1], acc[ai][1][m][0][2], acc[ai][1][m][0][3], acc[ai][1][m][1][0], acc[ai][1][m][1][1], acc[ai][1][m][1][2], acc[ai][1][m][1][3]};
                f(u, r, c, g, p, rs[ai][m]); }
    }
};

template <class Epi, class Sched, bool ALIGN_EPI = false, bool SP2 = false, bool F8 = false>
__device__ __forceinline__ void gemm_phase(PG8_LAS unsigned char* lds, const Gemm g, const Sched& S, const Epi& E, const int wave_s, const bool skip_epi = false) {
    const int wid = wave_s, lane = mk_lane(), tid = wid * 64 + lane, wr = wid >> 2, wc = wid & 3, fr = lane & 15, fq = lane >> 4;
    const int K = g.K, nt = K / BK;
    unsigned voffA[2], voffB[2];
#pragma unroll
    for (int i = 0; i < 2; ++i) { int R, C; stage_rc(tid * 16 + i * 8192, R, C); const int Rb = Epi::PERM ? ((R & ~31) + perm32(R & 31)) : R;
        voffA[i] = (unsigned)(R * g.lda + C) * 2u; voffB[i] = (unsigned)(Rb * g.ldb + C) * 2u; }
    const size_t kstep = (size_t)(BK * 2);
    const size_t hstepA = (size_t)HALF * g.lda * 2, hstepB = (size_t)HALF * g.ldb * 2;
    const size_t tstepA = 2 * hstepA, tstepB = 2 * hstepB;
    const unsigned ldsw = (unsigned)wid * 1024u;
    const int aoff = lds_byte(wr * 64 + fr, fq * 8), boff = lds_byte(wc * 32 + fr, fq * 8);
    const int f8_scale = 0x7F7F7F7F; (void)f8_scale;
    int aoffv = aoff, boffv = boff + 4 * HTB; if constexpr (F8) { asm volatile("" : "+v"(aoffv), "+v"(boffv)); } (void)aoffv; (void)boffv;
#define PG8_SA(b, h) (((b) * 2 + (h)) * HTB)
#define PG8_SB(b, h) ((4 + (b) * 2 + (h)) * HTB)
#define PG8_STAGE(bufoff, gbase, voff) do { _Pragma("unroll") for (int _i = 0; _i < 2; ++_i) \
        __builtin_amdgcn_global_load_lds((const unsigned*)((const char*)(gbase) + (voff)[_i]), (PG8_LAS unsigned*)(lds + (bufoff) + ldsw + _i * 8192), 16, 0, 0); } while (0)
#define PG8_LD16A(off) (*(const PG8_LAS i32x4*)(lds + aoffv + (off)))
#define PG8_LD16B(off) (*(const PG8_LAS i32x4*)(lds + boffv + (off)))
#define PG8_LDA(dst, b, h) do { if constexpr (F8) { _Pragma("unroll") for (int m = 0; m < 4; ++m) dst##8[m] = __builtin_shufflevector(PG8_LD16A(((b) * 2 + (h)) * HTB + m * 2048), PG8_LD16A(((b) * 2 + (h)) * HTB + m * 2048 + 1024), 0, 1, 2, 3, 4, 5, 6, 7); } \
    else { _Pragma("unroll") for (int m = 0; m < 4; ++m) _Pragma("unroll") for (int k = 0; k < 2; ++k) dst[m][k] = *(const PG8_LAS bf16x8*)(lds + PG8_SA(b, h) + aoff + m * 2048 + k * 1024); } } while (0)
#define PG8_LDB(dst, b, h) do { if constexpr (F8) { _Pragma("unroll") for (int n = 0; n < 2; ++n) dst##8[n] = __builtin_shufflevector(PG8_LD16B(((b) * 2 + (h)) * HTB + n * 2048), PG8_LD16B(((b) * 2 + (h)) * HTB + n * 2048 + 1024), 0, 1, 2, 3, 4, 5, 6, 7); } \
    else { _Pragma("unroll") for (int n = 0; n < 2; ++n) _Pragma("unroll") for (int k = 0; k < 2; ++k) dst[n][k] = *(const PG8_LAS bf16x8*)(lds + PG8_SB(b, h) + boff + n * 2048 + k * 1024); } } while (0)
#define PG8_MMA(ai, bj, At, Bt) do { __builtin_amdgcn_s_setprio(1); if constexpr (F8) { _Pragma("unroll") for (int m = 0; m < 4; ++m) _Pragma("unroll") for (int n = 0; n < 2; ++n) \
            asm volatile("v_mfma_scale_f32_16x16x128_f8f6f4 %0, %1, %2, %0, %3, %3 op_sel_hi:[0,0,0]" : "+v"(acc[ai][bj][m][n]) : "v"(Bt##8[n]), "v"(At##8[m]), "v"(f8_scale)); } \
        else { _Pragma("unroll") for (int m = 0; m < 4; ++m) _Pragma("unroll") for (int n = 0; n < 2; ++n) _Pragma("unroll") for (int k = 0; k < 2; ++k) \
        acc[ai][bj][m][n] = __builtin_amdgcn_mfma_f32_16x16x32_bf16(Bt[n][k], At[m][k], acc[ai][bj][m][n], 0, 0, 0); } __builtin_amdgcn_s_setprio(0); } while (0)
#define PG8_WAIT_V(n) asm volatile("s_waitcnt vmcnt(" #n ")" ::: "memory")
#define PG8_WAIT_L(n) asm volatile("s_waitcnt lgkmcnt(" #n ")" ::: "memory")
#define PG8_BAR __builtin_amdgcn_s_barrier()
#define PG8_SCHED __builtin_amdgcn_sched_barrier(0)
    Unit cur, nxt; int ui = 0;
    if (!S.next(0, cur)) return;
    f32x4 acc[2][2][4][2];
#pragma unroll
    for (int a = 0; a < 2; ++a)
#pragma unroll
        for (int b = 0; b < 2; ++b)
#pragma unroll
            for (int m = 0; m < 4; ++m)
#pragma unroll
                for (int n = 0; n < 2; ++n) acc[a][b][m][n] = (f32x4){0.f, 0.f, 0.f, 0.f};
    bf16x8 At[4][2], B0[2][2], B1[2][2]; i32x8 At8[4], B08[2], B18[2]; (void)At; (void)B0; (void)B1; (void)At8; (void)B08; (void)B18;
    const char* cA = (const char*)g.A + (size_t)cur.pm * tstepA; const char* cB = (const char*)g.Bt + (size_t)cur.pn * tstepB;
    S.a_ready(cur);
    if constexpr (SP2) {
        PG8_STAGE(PG8_SB(0, 0), cB, voffB); PG8_STAGE(PG8_SB(0, 1), cB + hstepB, voffB); PG8_STAGE(PG8_SA(0, 0), cA, voffA); PG8_STAGE(PG8_SA(0, 1), cA + hstepA, voffA);
        if (wr == 1) PG8_BAR;
        PG8_WAIT_V(2); PG8_BAR;
        PG8_STAGE(PG8_SB(1, 0), cB + kstep, voffB); PG8_STAGE(PG8_SA(1, 0), cA + kstep, voffA); PG8_STAGE(PG8_SB(1, 1), cB + hstepB + kstep, voffB);
        PG8_WAIT_V(6); PG8_BAR;
    } else {
        PG8_STAGE(PG8_SB(0, 0), cB, voffB); PG8_STAGE(PG8_SA(0, 0), cA, voffA); PG8_STAGE(PG8_SB(0, 1), cB + hstepB, voffB); PG8_STAGE(PG8_SA(0, 1), cA + hstepA, voffA);
        if (wr == 1) PG8_BAR;
        PG8_WAIT_V(4); PG8_BAR;
        PG8_STAGE(PG8_SB(1, 0), cB + kstep, voffB); PG8_STAGE(PG8_SA(1, 0), cA + kstep, voffA); PG8_STAGE(PG8_SB(1, 1), cB + hstepB + kstep, voffB);
        PG8_WAIT_V(6); PG8_BAR;
    }
    for (;;) {
        const bool has_next = S.next(ui + 1, nxt);
        const char* nA = has_next ? (const char*)g.A + (size_t)nxt.pm * tstepA : cA; const char* nB = has_next ? (const char*)g.Bt + (size_t)nxt.pn * tstepB : cB;
        if constexpr (F8) {
            _Pragma("unroll") for (int a = 0; a < 2; ++a) _Pragma("unroll") for (int b = 0; b < 2; ++b) _Pragma("unroll") for (int m = 0; m < 4; ++m) _Pragma("unroll") for (int n = 0; n < 2; ++n) asm volatile("" : "+v"(acc[a][b][m][n])); }
        _Pragma("clang loop unroll(disable)")
        for (int t = 0; t < nt; t += 2) {
            const bool last = (t == nt - 2);
            const char* a1 = cA + (size_t)(t + 1) * kstep;
            const char* a2 = last ? nA : cA + (size_t)(t + 2) * kstep; const char* b2 = last ? nB : cB + (size_t)(t + 2) * kstep;
            const char* a3 = a2 + kstep; const char* b3 = b2 + kstep;
            if (last && has_next) S.a_ready(nxt);
            if constexpr (SP2) {
            PG8_LDB(B0, 0, 0); PG8_LDB(B1, 0, 1); PG8_SCHED; PG8_LDA(At, 0, 0); PG8_STAGE(PG8_SA(1, 1), a1 + hstepA, voffA);
            PG8_WAIT_V(8); PG8_WAIT_L(0); PG8_BAR; PG8_MMA(0, 0, At, B0); PG8_MMA(0, 1, At, B1); PG8_BAR; PG8_SCHED;
            PG8_LDA(At, 0, 1); PG8_STAGE(PG8_SB(0, 0), b2, voffB); PG8_STAGE(PG8_SB(0, 1), b2 + hstepB, voffB); PG8_STAGE(PG8_SA(0, 0), a2, voffA);
            PG8_WAIT_V(8); PG8_WAIT_L(0); PG8_BAR; PG8_MMA(1, 0, At, B0); PG8_MMA(1, 1, At, B1); PG8_BAR; PG8_SCHED;
            PG8_LDB(B0, 1, 0); PG8_LDB(B1, 1, 1); PG8_SCHED; PG8_LDA(At, 1, 0); PG8_STAGE(PG8_SA(0, 1), a2 + hstepA, voffA);
            PG8_WAIT_V(8); PG8_WAIT_L(0); PG8_BAR; PG8_MMA(0, 0, At, B0); PG8_MMA(0, 1, At, B1); PG8_BAR; PG8_SCHED;
            PG8_LDA(At, 1, 1); PG8_STAGE(PG8_SB(1, 0), b3, voffB); PG8_STAGE(PG8_SB(1, 1), b3 + hstepB, voffB); PG8_STAGE(PG8_SA(1, 0), a3, voffA);
            PG8_WAIT_V(8); PG8_WAIT_L(0); PG8_BAR; PG8_MMA(1, 0, At, B0); PG8_MMA(1, 1, At, B1); PG8_BAR; PG8_SCHED;
            } else {
            PG8_LDB(B0, 0, 0); PG8_SCHED; PG8_LDA(At, 0, 0); PG8_STAGE(PG8_SA(1, 1), a1 + hstepA, voffA);
            PG8_WAIT_L(8); PG8_BAR; PG8_WAIT_L(0); PG8_MMA(0, 0, At, B0); PG8_BAR; PG8_SCHED;
            PG8_LDB(B1, 0, 1); PG8_STAGE(PG8_SB(0, 0), b2, voffB);
            PG8_BAR; PG8_WAIT_L(0); PG8_MMA(0, 1, At, B1); PG8_BAR;
            PG8_LDA(At, 0, 1); PG8_STAGE(PG8_SA(0, 0), a2, voffA);
            PG8_BAR; PG8_WAIT_L(0); PG8_MMA(1, 0, At, B0); PG8_BAR; PG8_SCHED;
            PG8_STAGE(PG8_SB(0, 1), b2 + hstepB, voffB);
            PG8_WAIT_V(6); PG8_BAR; PG8_MMA(1, 1, At, B1); PG8_BAR;
            PG8_LDB(B0, 1, 0); PG8_SCHED; PG8_LDA(At, 1, 0); PG8_STAGE(PG8_SA(0, 1), a2 + hstepA, voffA);
            PG8_WAIT_L(8); PG8_BAR; PG8_WAIT_L(0); PG8_MMA(0, 0, At, B0); PG8_BAR; PG8_SCHED;
            PG8_LDB(B1, 1, 1); PG8_STAGE(PG8_SB(1, 0), b3, voffB);
            PG8_BAR; PG8_WAIT_L(0); PG8_MMA(0, 1, At, B1); PG8_BAR;
            PG8_LDA(At, 1, 1); PG8_STAGE(PG8_SA(1, 0), a3, voffA);
            PG8_BAR; PG8_WAIT_L(0); PG8_MMA(1, 0, At, B0); PG8_BAR; PG8_SCHED;
            PG8_STAGE(PG8_SB(1, 1), b3 + hstepB, voffB);
            PG8_WAIT_V(6); PG8_BAR; PG8_MMA(1, 1, At, B1); PG8_BAR;
            }
        }
        if constexpr (F8) { asm volatile("s_nop 15\n\ts_nop 15" ::: "memory"); }
        if constexpr (ALIGN_EPI) { if (wr == 0) PG8_BAR; }
        if constexpr (!Epi::AFTER_DRAIN) { if (!skip_epi) E(acc, cur, wr, wc, fr, fq); S.done(cur); }
        if (!has_next) break;
#pragma unroll
        for (int a = 0; a < 2; ++a)
#pragma unroll
            for (int b = 0; b < 2; ++b)
#pragma unroll
                for (int m = 0; m < 4; ++m)
#pragma unroll
                    for (int n = 0; n < 2; ++n) acc[a][b][m][n] = (f32x4){0.f, 0.f, 0.f, 0.f};
        cur = nxt; cA = nA; cB = nB; ++ui;
        if constexpr (ALIGN_EPI) { if (wr == 1) PG8_BAR; }
    }
    PG8_WAIT_V(0);
    if constexpr (!ALIGN_EPI) { if (wr == 0) PG8_BAR; }
    PG8_BAR;
    if constexpr (Epi::AFTER_DRAIN) { E.fused(acc, cur, wr, wc, fr, fq, lds, wid, lane); S.done(cur); }
#undef PG8_SA
#undef PG8_SB
#undef PG8_STAGE
#undef PG8_LD16A
#undef PG8_LD16B
#undef PG8_LDA
#undef PG8_LDB
#undef PG8_MMA
#undef PG8_WAIT_V
#undef PG8_WAIT_L
#undef PG8_BAR
#undef PG8_SCHED
}
}

namespace attn_body {
using bf16=__hip_bfloat16;
using bf16x8=__attribute__((ext_vector_type(8)))short;
using s16x4=__attribute__((ext_vector_type(4)))short;
using f32x16=__attribute__((ext_vector_type(16)))float;
using u32x4=__attribute__((ext_vector_type(4)))unsigned;
constexpr int BATCH=4,NHEAD=8,SEQ=8192,D=64,DM=NHEAD*D,ODM=1024;
constexpr int NW=8,QBLK=32,QB=QBLK*NW,KVBLK=64,NQB=SEQ/QB;
constexpr int ATTN_PITCH=DM, ATTN_UNIT_ROWS=QB;
__device__ __forceinline__ int crow(int r,int hi){return (r&3)+8*(r>>2)+4*hi;}
#define SBAR() __builtin_amdgcn_sched_barrier(0)
__device__ __forceinline__ void cmask(f32x16&p0,f32x16&p1,int jb,int qrel,int hi){
  const float NEG=-INFINITY; int kb=64*jb+4*hi;
  #pragma unroll
  for(int r=0;r<16;++r){int kv=kb+(r&3)+8*(r>>2); if(kv>qrel)p0[r]=NEG; if(kv+32>qrel)p1[r]=NEG;}
}

constexpr int NSLOT=3, SLOTB=8192;
constexpr int LDS_K=0, LDS_V=NSLOT*SLOTB, LDS_WS=2*NSLOT*SLOTB, LDS_OST=LDS_WS+NW*64*4, LDS_BYTES=LDS_OST+NW*4096;
constexpr float C2=0.125f*1.4426950408889634f;
__device__ __forceinline__ void glds16(const void*gsrc,unsigned lds_dst){unsigned keep;
  asm volatile("s_mov_b32 %0, m0\n\ts_mov_b32 m0, %2\n\ts_nop 0\n\tglobal_load_lds_dwordx4 %1, off\n\ts_mov_b32 m0, %0":"=&s"(keep):"v"(gsrc),"s"(lds_dst):"memory");}
__device__ __forceinline__ float max3f(float a,float b,float c){float r;asm("v_max3_f32 %0, %1, %2, %3":"=v"(r):"v"(a),"v"(b),"v"(c));return r;}
__device__ __forceinline__ float max2f(float a,float b){float r;asm("v_max_f32_e32 %0, %1, %2":"=v"(r):"v"(a),"v"(b));return r;}
__device__ __forceinline__ float fadd_s(float a,float b){float r;asm("v_add_f32_e32 %0, %1, %2":"=v"(r):"v"(a),"v"(b));return r;}
__device__ __forceinline__ float fsub_s(float a,float b){float r;asm("v_sub_f32_e32 %0, %1, %2":"=v"(r):"v"(a),"v"(b));return r;}
typedef float f32x2_t __attribute__((ext_vector_type(2))); typedef __bf16 bf16x2_t __attribute__((ext_vector_type(2)));
__device__ __forceinline__ unsigned cvtpk_s(float lo,float hi){f32x2_t v={lo,hi};bf16x2_t b=__builtin_convertvector(v,bf16x2_t);return __builtin_bit_cast(unsigned,b);}
#define WAIT_BAR(N) asm volatile("s_waitcnt vmcnt(" #N ") lgkmcnt(0)\n\ts_barrier":::"memory")

__device__ __forceinline__ void qkt(f32x16&p0,f32x16&p1,const char*Kslot,const bf16x8*qr,const f32x16&negm,int r32,int hi){
  const char*kb=Kslot+hi*1024+r32*16;
  #pragma unroll
  for(int d0=0;d0<4;++d0){
    const bf16x8 b0=*reinterpret_cast<const bf16x8*>(kb+d0*2048);
    const bf16x8 b1=*reinterpret_cast<const bf16x8*>(kb+d0*2048+512);
    if(d0==0){p0=__builtin_amdgcn_mfma_f32_32x32x16_bf16(b0,qr[0],negm,0,0,0);p1=__builtin_amdgcn_mfma_f32_32x32x16_bf16(b1,qr[0],negm,0,0,0);}
    else{p0=__builtin_amdgcn_mfma_f32_32x32x16_bf16(b0,qr[d0],p0,0,0,0);p1=__builtin_amdgcn_mfma_f32_32x32x16_bf16(b1,qr[d0],p1,0,0,0);}}
}
typedef __attribute__((address_space(3))) const char* lds_cptr;
typedef short v4i16_t __attribute__((ext_vector_type(4)));
__device__ __forceinline__ void kload8(bf16x8*kf,lds_cptr kp){
  kf[0]=*(const __attribute__((address_space(3))) bf16x8*)(kp);      kf[1]=*(const __attribute__((address_space(3))) bf16x8*)(kp+512);
  kf[2]=*(const __attribute__((address_space(3))) bf16x8*)(kp+2048); kf[3]=*(const __attribute__((address_space(3))) bf16x8*)(kp+2560);
  kf[4]=*(const __attribute__((address_space(3))) bf16x8*)(kp+4096); kf[5]=*(const __attribute__((address_space(3))) bf16x8*)(kp+4608);
  kf[6]=*(const __attribute__((address_space(3))) bf16x8*)(kp+6144); kf[7]=*(const __attribute__((address_space(3))) bf16x8*)(kp+6656);
}
__device__ __forceinline__ void kload2(bf16x8*kf,lds_cptr kp,int j){ kf[2*j]=*(const __attribute__((address_space(3))) bf16x8*)(kp+j*2048); kf[2*j+1]=*(const __attribute__((address_space(3))) bf16x8*)(kp+j*2048+512); }
__device__ __forceinline__ s16x4 vtr(lds_cptr p){ return __builtin_bit_cast(s16x4,__builtin_amdgcn_ds_read_tr16_b64_v4i16((__attribute__((address_space(3))) v4i16_t*)p)); }
__device__ __forceinline__ float rowmax(const f32x16&p0,const f32x16&p1){
  float a=max3f(p0[0],p0[1],p1[0]),b=max3f(p0[2],p0[3],p1[1]);a=max3f(a,p1[2],p1[3]);
  #pragma unroll
  for(int r=4;r<16;r+=4){a=max3f(a,p0[r],p0[r+1]);b=max3f(b,p0[r+2],p0[r+3]);a=max3f(a,p1[r],p1[r+1]);b=max3f(b,p1[r+2],p1[r+3]);}
  const float m=max2f(a,b);
  auto rr=__builtin_amdgcn_permlane32_swap(__float_as_uint(m),__float_as_uint(m),false,false);
  return max2f(__uint_as_float(rr[0]),__uint_as_float(rr[1]));
}
__device__ __forceinline__ void pv(f32x16*o,int vb,bf16x8 pa0,bf16x8 pa1,bf16x8 pa2,bf16x8 pa3){
  #pragma unroll
  for(int d0=0;d0<2;++d0){s16x4 lo[4],hi[4];
    #pragma unroll
    for(int ks=0;ks<4;++ks){
      asm volatile("ds_read_b64_tr_b16 %0,%1 offset:%c2":"=&v"(lo[ks]):"v"(vb),"i"(d0*4096+ks*1024):"memory");
      asm volatile("ds_read_b64_tr_b16 %0,%1 offset:%c2":"=&v"(hi[ks]):"v"(vb),"i"(d0*4096+ks*1024+512):"memory");}
    asm volatile("s_waitcnt lgkmcnt(0)":::"memory");SBAR();
    #define PK(k) (bf16x8){lo[k][0],lo[k][1],lo[k][2],lo[k][3],hi[k][0],hi[k][1],hi[k][2],hi[k][3]}
    o[d0]=__builtin_amdgcn_mfma_f32_32x32x16_bf16(pa0,PK(0),o[d0],0,0,0);
    o[d0]=__builtin_amdgcn_mfma_f32_32x32x16_bf16(pa1,PK(1),o[d0],0,0,0);
    o[d0]=__builtin_amdgcn_mfma_f32_32x32x16_bf16(pa2,PK(2),o[d0],0,0,0);
    o[d0]=__builtin_amdgcn_mfma_f32_32x32x16_bf16(pa3,PK(3),o[d0],0,0,0);
    #undef PK
  }
}

#ifndef ATTN_STORE16
#define ATTN_STORE16(p,v) (*(u32x4*)(p)=(v))
#endif
template<int THRL> __device__ __forceinline__ void attn_unit(int b,int h,int qb,const bf16*Q,const bf16*__restrict__ K,const bf16*__restrict__ V,bf16*O,const unsigned*__restrict__ SEL,char*shm,const int wave_s){
  const int wid=wave_s,lane=mk_lane(),r32=lane&31,hi=lane>>5;
  const long rowbase=(long)b*SEQ; const int q0=qb*QB;
  const bf16*Qw=Q+(rowbase+q0+wid*QBLK)*DM+h*D;
  const bf16*Kh=K+rowbase*DM+h*D,*Vh=V+rowbase*DM+h*D;
  const unsigned lds0=(unsigned)(uintptr_t)shm;
  float*wsf=(float*)(shm+LDS_WS)+wid*64;
  const bf16*ksrc=Kh+(long)lane*DM+wid*8;
  const bf16*vsrc=Vh+(long)(16*(wid&3)+(lane>>2))*DM+(wid>>2)*32+(lane&3)*8;
  const unsigned kdst=lds0+LDS_K+wid*1024, vdst=lds0+LDS_V+wid*1024;
  #define TAU(t) (((t)<4)?(NT-4+(t)):((t)-4))
  #define DMA_K(t,slot) glds16(ksrc+(long)TAU(t)*KVBLK*DM,(unsigned)__builtin_amdgcn_readfirstlane(kdst+(slot)))
  #define DMA_V(t,slot) glds16(vsrc+(long)TAU(t)*KVBLK*DM,(unsigned)__builtin_amdgcn_readfirstlane(vdst+(slot)))
  const int vb0=(int)(lds0+LDS_V)+((lane>>4)&1)*32+(lane&3)*8+(4*hi+((lane&15)>>2))*64;
  const char*Kbase=shm+LDS_K; bf16x8 kf[8];
  const lds_cptr shm3=(lds_cptr)shm; const lds_cptr kp0=shm3+LDS_K+hi*1024+r32*16; const lds_cptr vp0=shm3+LDS_V+((lane>>4)&1)*32+(lane&3)*8+(4*hi+((lane&15)>>2))*64;
  const int NT=(q0+QB)/KVBLK;
  DMA_K(0,0);DMA_V(0,0);DMA_K(1,SLOTB);
  bf16x8 qr[4];
  #pragma unroll
  for(int d0=0;d0<4;++d0)qr[d0]=*reinterpret_cast<const bf16x8*>(&Qw[(long)r32*DM+d0*16+hi*8]);
  float mhat=0.f,l_reg=0.f;f32x16 o[2];o[0]=f32x16{};o[1]=f32x16{};const f32x16 negm=f32x16{};
  const int qrel=wid*QBLK+r32;
  const unsigned selw_addr=lds0+LDS_BYTES+wid*128+r32*4;
  const unsigned smreg_=SEL[(size_t)(b*NHEAD+h)*SEQ+q0+qrel]; if(hi==0){ asm volatile("ds_write_b32 %0, %1"::"v"(selw_addr),"v"(smreg_):"memory"); }
  #define CMASK(P0,P1,t) do{ unsigned sm_; asm volatile("ds_read_b32 %0, %1\n\ts_waitcnt lgkmcnt(0)":"=v"(sm_):"v"(selw_addr):"memory"); const int pt_=((t)<4)?0:((t)-4)>>2; const int lim_=((t)<4)?(qrel-64*(t)):((((sm_>>pt_)&1u)!=0u)?64:-1); cmask(P0,P1,0,lim_,hi); }while(0)
  bool resc=false;
  #define START(P0,P1) do{ const float rm=rowmax(P0,P1); resc=false; \
    { const float dl=rm; mhat=fadd_s(mhat,dl); \
      _Pragma("unroll") for(int r=0;r<16;++r){P0[r]=fsub_s(P0[r],dl);P1[r]=fsub_s(P1[r],dl);} \
    } \
    _Pragma("unroll") for(int r=0;r<16;++r)P0[r]=__builtin_amdgcn_exp2f(P0[r]); }while(0)
  #define RESC() do{ if(resc){ asm volatile("s_waitcnt lgkmcnt(0)":::"memory"); \
      _Pragma("unroll") for(int d_=0;d_<2;++d_) _Pragma("unroll") for(int r=0;r<16;++r)o[d_][r]*=wsf[crow(r,hi)]; } }while(0)
  f32x16 pA0,pA1,pB0,pB1;
  int sl_prev=0,sl_cur=0,sl_next=SLOTB;
  #define ROT() do{sl_prev=sl_cur;sl_cur=sl_next;sl_next=(sl_next==(NSLOT-1)*SLOTB)?0:sl_next+SLOTB;}while(0)
  DMA_K(2,2*SLOTB);
  WAIT_BAR(3);
  qkt(pA0,pA1,Kbase,qr,negm,r32,hi);asm volatile("s_nop 15\n\ts_nop 7":"+v"(pA0),"+v"(pA1));CMASK(pA0,pA1,0);
  START(pA0,pA1);
  _Pragma("unroll") for(int r=0;r<16;++r)pA1[r]=__builtin_amdgcn_exp2f(pA1[r]);
  WAIT_BAR(0);
  DMA_K(3,0);DMA_V(1,SLOTB);
  ROT();
  kload8(kf,kp0+sl_cur);
  WAIT_BAR(2);
  s16x4 vlo[8],vhi[8]; u32x4 pw0,pw1,pw2,pw3;
  #define PKW(P,B) cvtpk_s(P[B],P[B+1])
  #define PAF(k) __builtin_bit_cast(bf16x8,pw##k)
  #define VFR(i) (bf16x8){vlo[i][0],vlo[i][1],vlo[i][2],vlo[i][3],vhi[i][0],vhi[i][1],vhi[i][2],vhi[i][3]}
  #define PIN(x) asm volatile("":"+v"(x))
  #define MX3(a,b,c) __builtin_fmaxf(__builtin_fmaxf((a),(b)),(c))
  #define GAPA(MF,A0,A1,A2,A3,W0,W1,PW) do{ MF; sacc+=A0; sacc+=A1; sacc+=A2; sacc+=A3; PIN(sacc); W0; W1; PIN(PW); SBAR(); }while(0)
  #define EX(v) __builtin_amdgcn_exp2f(v)
  #define GAPB(MF,X,B) do{ MF; X[B]=EX(X[B]); X[B+1]=EX(X[B+1]); X[B+2]=EX(X[B+2]); X[B+3]=EX(X[B+3]); PIN(X); SBAR(); }while(0)
  #define VRD(i) do{ vlo[i]=vtr(vp_+(((i)>>2)*4096+((i)&3)*1024)); vhi[i]=vtr(vp_+(((i)>>2)*4096+((i)&3)*1024+512)); }while(0)
  #define KRD(G,j) do{ if(G){ kload2(kf,kp0+sl_next,j); SBAR(); } }while(0)
  #define STEP(C0,C1,P0,P1,t,GK,GV,GL) do{ SBAR(); \
      \
    f32x16 nm_; { const float nv_=((t)>=4&&((smreg_>>(((t)-4)>>2))&1u)==0u)?-INFINITY:-mhat; _Pragma("unroll") for(int r=0;r<16;++r) nm_[r]=nv_; } \
    const lds_cptr vp_=vp0+sl_prev; \
    VRD(0); SBAR(); float sacc=(P0[0]+P0[1]); \
    GAPA(C0=__builtin_amdgcn_mfma_f32_32x32x16_bf16(kf[0],qr[0],nm_,0,0,0), P0[2],P0[3],P0[4],P0[5],     pw0[0]=PKW(P0,0), pw0[1]=PKW(P0,2), pw0); \
    VRD(4); SBAR(); GAPA(C1=__builtin_amdgcn_mfma_f32_32x32x16_bf16(kf[1],qr[0],nm_,0,0,0), P0[6],P0[7],P0[8],P0[9],     pw0[2]=PKW(P0,4), pw0[3]=PKW(P0,6), pw0); \
    VRD(1); SBAR(); GAPA(C0=__builtin_amdgcn_mfma_f32_32x32x16_bf16(kf[2],qr[1],C0,0,0,0),   P0[10],P0[11],P0[12],P0[13], pw1[0]=PKW(P0,8), pw1[1]=PKW(P0,10), pw1); \
    VRD(5); SBAR(); GAPA(C1=__builtin_amdgcn_mfma_f32_32x32x16_bf16(kf[3],qr[1],C1,0,0,0),   P0[14],P0[15],P1[0],P1[1],   pw1[2]=PKW(P0,12),pw1[3]=PKW(P0,14), pw1); \
    VRD(2); SBAR(); GAPA(C0=__builtin_amdgcn_mfma_f32_32x32x16_bf16(kf[4],qr[2],C0,0,0,0),   P1[2],P1[3],P1[4],P1[5],     pw2[0]=PKW(P1,0), pw2[1]=PKW(P1,2), pw2); \
    VRD(6); SBAR(); GAPA(C1=__builtin_amdgcn_mfma_f32_32x32x16_bf16(kf[5],qr[2],C1,0,0,0),   P1[6],P1[7],P1[8],P1[9],     pw2[2]=PKW(P1,4), pw2[3]=PKW(P1,6), pw2); \
    VRD(3); SBAR(); GAPA(C0=__builtin_amdgcn_mfma_f32_32x32x16_bf16(kf[6],qr[3],C0,0,0,0),   P1[10],P1[11],P1[12],P1[13], pw3[0]=PKW(P1,8), pw3[1]=PKW(P1,10), pw3); \
    VRD(7); SBAR(); GAPA(C1=__builtin_amdgcn_mfma_f32_32x32x16_bf16(kf[7],qr[3],C1,0,0,0),   P1[14],P1[15],0.f,0.f,       pw3[2]=PKW(P1,12),pw3[3]=PKW(P1,14), pw3); \
    l_reg+=sacc; \
    if(GK){DMA_K((t)+3,sl_cur);} if(GV){DMA_V((t)+1,sl_next);} \
    { \
      if((t)<4){ cmask(C0,C1,0,qrel-64*(t),hi); } } \
    { float a=MX3(C0[0],C0[1],C1[0]),b=MX3(C0[2],C0[3],C1[1]); a=MX3(a,C1[2],C1[3]); \
      _Pragma("unroll") for(int r=4;r<16;r+=4){a=MX3(a,C0[r],C0[r+1]);b=MX3(b,C0[r+2],C0[r+3]);a=MX3(a,C1[r],C1[r+1]);b=MX3(b,C1[r+2],C1[r+3]);} \
      float rm=__builtin_fmaxf(a,b); { auto rr=__builtin_amdgcn_permlane32_swap(__float_as_uint(rm),__float_as_uint(rm),false,false); rm=__builtin_fmaxf(__uint_as_float(rr[0]),__uint_as_float(rr[1])); } \
      resc=false; \
      if(__builtin_expect(__any(rm>(float)THRL),0)){ const float dl=__builtin_fmaxf(rm,0.f); mhat+=dl; \
        _Pragma("unroll") for(int r=0;r<16;++r){C0[r]-=dl;C1[r]-=dl;} \
        const float f=__builtin_amdgcn_exp2f(-dl); l_reg*=f; if(hi==0)wsf[r32]=f; resc=true; } } \
    SBAR(); \
    GAPB(o[0]=__builtin_amdgcn_mfma_f32_32x32x16_bf16(PAF(0),VFR(0),o[0],0,0,0), C0,0); \
    GAPB(o[1]=__builtin_amdgcn_mfma_f32_32x32x16_bf16(PAF(0),VFR(4),o[1],0,0,0), C0,4); \
    KRD(GL,0); GAPB(o[0]=__builtin_amdgcn_mfma_f32_32x32x16_bf16(PAF(1),VFR(1),o[0],0,0,0), C0,8); \
    KRD(GL,1); GAPB(o[1]=__builtin_amdgcn_mfma_f32_32x32x16_bf16(PAF(1),VFR(5),o[1],0,0,0), C0,12); \
    KRD(GL,2); GAPB(o[0]=__builtin_amdgcn_mfma_f32_32x32x16_bf16(PAF(2),VFR(2),o[0],0,0,0), C1,0); \
    KRD(GL,3); GAPB(o[1]=__builtin_amdgcn_mfma_f32_32x32x16_bf16(PAF(2),VFR(6),o[1],0,0,0), C1,4); \
    GAPB(o[0]=__builtin_amdgcn_mfma_f32_32x32x16_bf16(PAF(3),VFR(3),o[0],0,0,0), C1,8); \
    GAPB(o[1]=__builtin_amdgcn_mfma_f32_32x32x16_bf16(PAF(3),VFR(7),o[1],0,0,0), C1,12); \
    }while(0)
  int t=1;
  #undef CMASK
  #define CMASK(P0,P1,t) do{ unsigned sm_; asm volatile("ds_read_b32 %0, %1\n\ts_waitcnt lgkmcnt(0)":"=v"(sm_):"v"(selw_addr):"memory"); const int pt_=((t)<4)?0:((t)-4)>>2; const int lim_=((t)<4)?(qrel-64*(t)):((((sm_>>pt_)&1u)!=0u)?64:-1); cmask(P0,P1,0,lim_,hi); }while(0)
  for(;t+5<NT;t+=2){
    STEP(pB0,pB1,pA0,pA1,t,true,true,true);     WAIT_BAR(2); RESC(); ROT();
    STEP(pA0,pA1,pB0,pB1,t+1,true,true,true);   WAIT_BAR(2); RESC(); ROT();
  }
  #undef CMASK
  #define CMASK(P0,P1,t) do{ unsigned sm_; asm volatile("ds_read_b32 %0, %1\n\ts_waitcnt lgkmcnt(0)":"=v"(sm_):"v"(selw_addr):"memory"); const int pt_=((t)<4)?0:((t)-4)>>2; const int lim_=((t)<4)?(qrel-64*(t)):((((sm_>>pt_)&1u)!=0u)?64:-1); cmask(P0,P1,0,lim_,hi); }while(0)
  #define ENDW(tt) do{ if((tt)+3<NT){WAIT_BAR(2);} else if((tt)+2<NT){WAIT_BAR(1);} else {WAIT_BAR(0);} }while(0)
  for(;t+1<NT;t+=2){
    STEP(pB0,pB1,pA0,pA1,t,(t+3<NT),(t+1<NT),(t+1<NT));       ENDW(t);   RESC(); ROT();
    STEP(pA0,pA1,pB0,pB1,t+1,(t+4<NT),(t+2<NT),(t+2<NT));     ENDW(t+1); RESC(); ROT();
  }
  STEP(pB0,pB1,pA0,pA1,NT-1,false,false,false); RESC();
  { float sacc=pB0[0]+pB0[1]; _Pragma("unroll") for(int r=2;r<16;++r)sacc+=pB0[r]; _Pragma("unroll") for(int r=0;r<16;++r)sacc+=pB1[r]; l_reg+=sacc;
    pw0=(u32x4){PKW(pB0,0),PKW(pB0,2),PKW(pB0,4),PKW(pB0,6)};pw1=(u32x4){PKW(pB0,8),PKW(pB0,10),PKW(pB0,12),PKW(pB0,14)};pw2=(u32x4){PKW(pB1,0),PKW(pB1,2),PKW(pB1,4),PKW(pB1,6)};pw3=(u32x4){PKW(pB1,8),PKW(pB1,10),PKW(pB1,12),PKW(pB1,14)};
    SBAR(); pv(o,vb0+sl_cur,PAF(0),PAF(1),PAF(2),PAF(3)); }
  #undef PKW
  #undef PAF
  #undef VFR
  #undef PIN
  #undef MX3
  #undef GAPA
  #undef GAPB
  #undef EX
  #undef VRD
  #undef KRD
  #undef STEP
  #undef ENDW
  {auto rr=__builtin_amdgcn_permlane32_swap(__float_as_uint(l_reg),__float_as_uint(l_reg),false,false);l_reg=__uint_as_float(rr[0])+__uint_as_float(rr[1]);}
  if(hi==0)wsf[32+r32]=l_reg;asm volatile("s_waitcnt lgkmcnt(0)":::"memory");
  float rli[16];
  #pragma unroll
  for(int r=0;r<16;++r)rli[r]=__builtin_amdgcn_rcpf(wsf[32+crow(r,hi)]);
  bf16*Ow=O+(rowbase+q0+wid*QBLK)*ODM+h*D;
  { bf16*stg=(bf16*)(shm+LDS_OST)+wid*2048;
    #pragma unroll
    for(int r=0;r<16;++r){const int orow=crow(r,hi);
      #pragma unroll
      for(int d0=0;d0<2;++d0)stg[orow*64+d0*32+r32]=__float2bfloat16(ABL_MOBA?0.f:o[d0][r]*rli[r]);}
    asm volatile("s_waitcnt lgkmcnt(0)":::"memory");
    #pragma unroll
    for(int i=0;i<4;++i){const int row=i*8+(lane>>3),ch=lane&7; const u32x4 v=*(const u32x4*)(stg+row*64+ch*8); ATTN_STORE16(Ow+(long)row*ODM+ch*8,v);} }
  asm volatile("s_waitcnt lgkmcnt(0)\n\ts_barrier":::"memory");
  #undef DMA_K
  #undef DMA_V
  #undef CMASK
  #undef START
  #undef RESC
  #undef ROT
}
constexpr int ATTN_LDS_BYTES=LDS_BYTES;
struct AttnTensors { const bf16* Q; const bf16* K; const bf16* V; bf16* O; const unsigned* SEL; };
struct AttnUnit { int bh; int qb; };
struct StaticOrder {
  int vcu;
  __device__ __forceinline__ explicit StaticOrder(int grid,int block):vcu((block%8)*(grid/8)+block/8){}
  __device__ __forceinline__ bool next(int i,AttnUnit&u)const{ if(i>=4)return false; const int s=vcu&7; u.bh=vcu>>3; u.qb=(i==0)?s:(i==1)?15-s:(i==2)?16+s:31-s; return true; }
  __device__ __forceinline__ void a_ready(const AttnUnit&)const{}
  __device__ __forceinline__ void done(const AttnUnit&)const{}
};
template<class Sched,int THRL=8> __device__ __forceinline__ void attn_phase(char*lds,const AttnTensors&T,const Sched&S,const int wave_s){
  AttnUnit u;
  for(int i=0;S.next(i,u);++i){ S.a_ready(u); attn_unit<THRL>(u.bh/NHEAD,u.bh%NHEAD,u.qb,T.Q,T.K,T.V,T.O,T.SEL,lds,wave_s); S.done(u); }
}
#undef SBAR
#undef WAIT_BAR
}

#define LAS __attribute__((address_space(3)))
#define XB_TMO      128
#define XB_XCNT(j)  (256  + 64 * (j))
#define XB_XSUB(j)  (1280 + 64 * (j))
#define XB_XGEN(j)  (2304 + 64 * (j))
#define XB_TOP      3328
#define XB_TOPGEN   3392
#define XCD_BAR_WORDS 3456
#define XB_SPIN_CAP (1u << 18)

__device__ __forceinline__ unsigned xb_ld(unsigned* p)              { return __hip_atomic_load(p, __ATOMIC_RELAXED, __HIP_MEMORY_SCOPE_AGENT); }
__device__ __forceinline__ unsigned xb_add(unsigned* p, unsigned v) { return __hip_atomic_fetch_add(p, v, __ATOMIC_RELAXED, __HIP_MEMORY_SCOPE_AGENT); }
__device__ __forceinline__ unsigned xb_xcc_id() { return (unsigned)__builtin_amdgcn_s_getreg((3 << 11) | 20) & 0xFu; }
#define XB_SPIN(cond, bar) do { unsigned _sp = 0; while (cond) { __builtin_amdgcn_s_sleep(1); \
    if ((++_sp & 255u) == 0u) { if (xb_ld(&(bar)[XB_TMO])) break; if (_sp > XB_SPIN_CAP) { atomicAdd(&(bar)[XB_TMO], 1u); break; } } } } while (0)

struct XcdBarrier {
    unsigned* bar; unsigned x;
    volatile LAS unsigned* st;
};

__device__ __forceinline__ XcdBarrier xcd_barrier_post(unsigned* bar, volatile LAS unsigned* st) {
    XcdBarrier b; b.bar = bar; b.x = xb_xcc_id(); b.st = st;
    if (threadIdx.x == 0) (void)xb_add(&bar[XB_XCNT(b.x)], 1u);
    return b;
}
__device__ __forceinline__ void xcd_barrier_complete(unsigned* bar, unsigned x, unsigned& nloc, unsigned& nx) {
    const unsigned G = gridDim.x * gridDim.y * gridDim.z;
    unsigned sum, cnt, mine, sp = 0u;
    for (;;) {
        sum = 0u; cnt = 0u; mine = 0u;
#pragma unroll
        for (unsigned j = 0; j < 16; ++j) { const unsigned c = xb_ld(&bar[XB_XCNT(j)]); sum += c; cnt += (c > 0u) ? 1u : 0u; mine = (j == x) ? c : mine; }
        if (sum == G) break;
        __builtin_amdgcn_s_sleep(1);
        if ((++sp & 255u) == 0u) { if (xb_ld(&bar[XB_TMO])) break; if (sp > XB_SPIN_CAP) { atomicAdd(&bar[XB_TMO], 1u); break; } }
    }
    nloc = mine > 0u ? mine : 1u; nx = cnt > 0u ? cnt : 1u;
}

__device__ __forceinline__ void xcd_barrier(const XcdBarrier& b, const bool is_t0) {
    asm volatile("s_waitcnt vmcnt(0)" ::: "memory");
    __syncthreads();
    if (is_t0) {
        unsigned* bar = b.bar;
        __builtin_amdgcn_s_waitcnt(0);
        unsigned nloc = b.st[0], nx = b.st[1];
        if (nloc == 0u) { xcd_barrier_complete(bar, b.x, nloc, nx); b.st[0] = nloc; b.st[1] = nx; }
        const unsigned old = xb_add(&bar[XB_XSUB(b.x)], 1u);
        const unsigned gen = old / nloc;
        if (old + 1u == (gen + 1u) * nloc) {
            __builtin_amdgcn_fence(__ATOMIC_RELEASE, "agent");
            asm volatile("s_waitcnt vmcnt(0)" ::: "memory");
            const unsigned og = xb_add(&bar[XB_TOP], 1u);
            const unsigned tg = og / nx;
            if (og + 1u == (tg + 1u) * nx) xb_add(&bar[XB_TOPGEN], 1u);
            else XB_SPIN(xb_ld(&bar[XB_TOPGEN]) == tg, bar);
            __builtin_amdgcn_fence(__ATOMIC_ACQUIRE, "agent");
            xb_add(&bar[XB_XGEN(b.x)], 1u);
            asm volatile("s_waitcnt vmcnt(0)" ::: "memory");
        } else {
            XB_SPIN(xb_ld(&bar[XB_XGEN(b.x)]) == gen, bar);
            __builtin_amdgcn_fence(__ATOMIC_ACQUIRE, "agent");
            asm volatile("s_waitcnt vmcnt(0)" ::: "memory");
        }
    }
    __syncthreads();
}

#ifndef STAMP_KA
#define STAMP_KA -1
#define STAMP_KB -1
#endif
#ifndef DUP_RWKV
#define DUP_RWKV 0
#endif
#ifndef DUPMASK
#define DUPMASK 0
#endif
#ifndef RWKV_SEQ_OVERRIDE
#define RWKV_SEQ_OVERRIDE 0
#endif
#ifndef RWKV_DBG
#define RWKV_DBG 0
#endif
#ifndef SKIP_DSA
#define SKIP_DSA 0
#endif
#ifndef DSA_DUP_ATT
#define DSA_DUP_ATT 0
#endif
#ifndef DSA_DUP_PASS
#define DSA_DUP_PASS 0
#endif
#ifndef DSA_DUP_KIND
#define DSA_DUP_KIND 0
#endif
#ifndef MOE_SCALE
#define MOE_SCALE 1.0f
#endif
#ifndef DIAG
#define DIAG 0
#endif
#ifndef ABL_MOE
#define ABL_MOE 0
#endif
#ifndef ABL_RWKV
#define ABL_RWKV 0
#endif
#ifndef ABL_DSA
#define ABL_DSA 0
#endif
#ifndef ABL_S5
#define ABL_S5 0
#endif
#ifndef ABL_MOBA
#define ABL_MOBA 0
#endif
#ifndef ABL_FFN0
#define ABL_FFN0 0
#endif
constexpr int NWAVES = 8;
constexpr int T_TOK = 32768, DMODEL = 1024, SEQL = 8192, NBATCH = 4;
constexpr int FFN_D = 2816, ODD_PROJ = 2756, ODD_PAD = 2816, FEXP = 3584, NEXP = 8;
constexpr float NORM_EPS = 1e-6f;
constexpr size_t MiB = 1u << 20;
constexpr size_t WS_CTL = 0, CTL_ZERO_BYTES = 1 * MiB;
constexpr size_t WS_ROPE = 1 * MiB;
constexpr size_t WS_KMEAN = WS_ROPE + 512 * 1024;
constexpr size_t WS_TOKINFO = 2 * MiB;
constexpr size_t WS_TOKSLOT = WS_TOKINFO + 512 * 1024;
constexpr size_t WS_TILEEXP = WS_TOKSLOT + 256 * 1024;
constexpr size_t WS_WE_IN = 3 * MiB;
constexpr size_t WS_WGLU = WS_WE_IN + 4 * MiB;
constexpr size_t WS_WE_OUT = WS_WGLU + MiB / 2;
constexpr size_t WS_WFFN_GU = WS_WE_OUT + 2 * MiB;
constexpr size_t WS_WFFN_D = WS_WFFN_GU + 11 * MiB;
constexpr size_t WS_WO_IN = WS_WFFN_D + 11 * MiB / 2;
constexpr size_t WS_WLORA = WS_WO_IN + 11 * MiB / 2;
constexpr size_t WS_WO_OUT = WS_WLORA + 3 * MiB / 4;
constexpr size_t WS_S5MT = 35 * MiB;
constexpr size_t WS_S5BEND = 55 * MiB;
static_assert(WS_WO_OUT + 2 * MiB <= WS_S5MT, "weights map");
constexpr size_t WS_XN = 64 * MiB;
constexpr size_t WS_CAT = WS_XN;
constexpr size_t WS_UG = 128 * MiB;
constexpr size_t WS_Q0 = 168 * MiB, WS_K0 = 200 * MiB, WS_V0 = 232 * MiB;
constexpr size_t WS_XEND = 264 * MiB;
constexpr size_t WS_YA = 280 * MiB;
constexpr size_t WS_SELM = 312 * MiB;
constexpr size_t WS_SS1 = 314 * MiB, WS_SS2 = 316 * MiB;
constexpr size_t WS_HB1 = 320 * MiB;
constexpr size_t WS_ACT = 128 * MiB;
constexpr size_t WS_P1 = 128 * MiB;
constexpr size_t WS_LORA = 304 * MiB;
constexpr size_t WS_QD = 400 * MiB;
constexpr size_t WS_KD = 432 * MiB;
constexpr size_t WS_KI = 436 * MiB;
constexpr size_t WS_QI = 440 * MiB;
constexpr size_t WS_WI = 456 * MiB;
constexpr size_t WS_VD = 490 * MiB;
constexpr size_t WS_ALORA = 457 * MiB;
constexpr size_t WS_YR = 457 * MiB;
constexpr int MOE_MAXTILES = 264, MOE_CHUNK = 128;
constexpr size_t WS_XG = 64 * MiB;
constexpr size_t WS_YS = 130 * MiB;
constexpr size_t WS_WMOE_GU = 262 * MiB;
constexpr size_t WS_WMOE_D = 318 * MiB;
constexpr size_t WS_ACTQ = 346 * MiB;
constexpr float MOE_WGU_SCALE = 32.0f, MOE_WD_SCALE = 64.0f, FFN_WGU_SCALE = 32.0f, FFN_WD_SCALE = 64.0f;
constexpr size_t WS_NEED = 494 * MiB;
constexpr int CW_BAR = 4096;
constexpr int MAX_LAUNCH = 36;
constexpr int CW_EXPCNT = 196608;
static_assert((CW_BAR + MAX_LAUNCH * 3456) <= CW_EXPCNT && (CW_EXPCNT + 8 * 64) * 4 <= (int)CTL_ZERO_BYTES, "ctl map");

constexpr int RING_BYTES = 131072;
constexpr int MISC_OFF = 147200;
constexpr int LDS_BYTES = 147456;

#define GAS __attribute__((address_space(1)))
typedef unsigned short bf16;
typedef unsigned v4u __attribute__((ext_vector_type(4)));
typedef unsigned v2u __attribute__((ext_vector_type(2)));
typedef float f32x4 __attribute__((ext_vector_type(4)));
typedef float f32x2 __attribute__((ext_vector_type(2)));
typedef short bf16x8 __attribute__((ext_vector_type(8)));
#define LDS_WAIT() asm volatile("s_waitcnt lgkmcnt(0)" ::: "memory")
#define VM_WAIT() asm volatile("s_waitcnt vmcnt(0)" ::: "memory")
typedef float cv_f32x2 __attribute__((ext_vector_type(2))); typedef __bf16 cv_bf16x2 __attribute__((ext_vector_type(2)));
__device__ __forceinline__ unsigned pk2(float lo, float hi) { const cv_f32x2 v = {lo, hi}; const cv_bf16x2 b = __builtin_convertvector(v, cv_bf16x2); return __builtin_bit_cast(unsigned, b); }
__device__ __forceinline__ unsigned f2bf(float f) { return pk2(f, 0.f) & 0xffffu; }
__device__ __forceinline__ float clamp448(float x) { return __builtin_amdgcn_fmed3f(x, -448.0f, 448.0f); }
__device__ __forceinline__ unsigned pk4_fp8(float a, float b, float c, float d) {
    unsigned w = __builtin_amdgcn_cvt_pk_fp8_f32(clamp448(a), clamp448(b), 0u, false); return __builtin_amdgcn_cvt_pk_fp8_f32(clamp448(c), clamp448(d), w, true); }
__device__ __forceinline__ float bf2f(unsigned short b) { return __builtin_bit_cast(float, (unsigned)b << 16); }
__device__ __forceinline__ float bflo(unsigned w) { return __builtin_bit_cast(float, w << 16); }
__device__ __forceinline__ float bfhi(unsigned w) { return __builtin_bit_cast(float, w & 0xffff0000u); }
__device__ __forceinline__ void unpack8(const v4u w, float (&o)[8]) { o[0] = bflo(w.x); o[1] = bfhi(w.x); o[2] = bflo(w.y); o[3] = bfhi(w.y); o[4] = bflo(w.z); o[5] = bfhi(w.z); o[6] = bflo(w.w); o[7] = bfhi(w.w); }
__device__ __forceinline__ v4u pack8(const float (&v)[8]) { v4u w; w.x = pk2(v[0], v[1]); w.y = pk2(v[2], v[3]); w.z = pk2(v[4], v[5]); w.w = pk2(v[6], v[7]); return w; }
__device__ __forceinline__ void store8_bf16(bf16* dst, const float (&v)[8]) { *(v4u*)dst = pack8(v); }
__device__ __forceinline__ void load8_bf16(const bf16* src, float (&o)[8]) { const v4u w = *(const v4u*)src; unpack8(w, o); }
__device__ __forceinline__ float sigmoidf_(float x) { return __builtin_amdgcn_rcpf(1.0f + __expf(-x)); }
__device__ __forceinline__ float gelu_tanh(float x) { const float z = 0.7978845608028654f * (x + 0.044715f * x * x * x); const float t = 1.0f - 2.0f * __builtin_amdgcn_rcpf(1.0f + __expf(2.0f * z)); return 0.5f * x * (1.0f + t); }


__device__ __forceinline__ float dpp_sum8(float x) {
    x += __builtin_bit_cast(float, __builtin_amdgcn_mov_dpp(__builtin_bit_cast(int, x), 0xB1, 0xf, 0xf, true));
    x += __builtin_bit_cast(float, __builtin_amdgcn_mov_dpp(__builtin_bit_cast(int, x), 0x4E, 0xf, 0xf, true));
    x += __builtin_bit_cast(float, __builtin_amdgcn_mov_dpp(__builtin_bit_cast(int, x), 0x141, 0xf, 0xf, true));
    return x;
}
__device__ __forceinline__ float wave_sum(float v) {
    v = dpp_sum8(v);
    v += __builtin_bit_cast(float, __builtin_amdgcn_mov_dpp(__builtin_bit_cast(int, v), 0x140, 0xf, 0xf, true));
    v += __shfl_xor(v, 16); v += __shfl_xor(v, 32);
    return v;
}

struct Args { const float* in[38]; float* out; unsigned char* ws; int ph_lo, ph_hi, li, pad; };
struct Frame {
    LAS unsigned char* lds;
    int wave, G;
    const float* const* in; float* out; unsigned char* ws;
};
enum InIdx { I_X = 0, I_E_NORM_MIX, I_E_W_IN, I_S5_A_RE, I_S5_A_IM, I_S5_LOG_DT, I_S5_B_RE, I_S5_B_IM, I_S5_C_RE, I_S5_C_IM, I_S5_D, I_S5_GLU_W, I_S5_GLU_B, I_E_W_OUT, I_E_NORM_FFN,
             I_FFN_GATE, I_FFN_UP, I_FFN_DOWN, I_O_NORM_MIX, I_O_W_IN, I_RWKV_MU, I_RWKV_W0, I_RWKV_W_UP, I_RWKV_A0, I_RWKV_A_UP, I_RWKV_G_UP, I_RWKV_K_K, I_RWKV_K_A, I_RWKV_R_K,
             I_RWKV_LN_W, I_RWKV_LN_B, I_O_W_OUT, I_O_NORM_FFN, I_MOE_ROUTER, I_MOE_GATE, I_MOE_UP, I_MOE_DOWN, I_FINAL_NORM };

template <int MODE>
__device__ __forceinline__ void tr_item(const float* __restrict__ W, int K, int N, bf16* __restrict__ WT, int ldo, int row_off, const float* __restrict__ gain, LAS float* scr, int kb, int nb, int lane) {
    const int k0 = 64 * kb, n0 = 32 * nb; const int nn = n0 + (lane & 31);
#pragma unroll 8
    for (int i = 0; i < 32; ++i) { const int kk = 2 * i + (lane >> 5); float w = (nn < N) ? W[(size_t)(k0 + kk) * N + nn] : 0.f; if (gain) w *= gain[k0 + kk]; scr[kk * 33 + (lane & 31)] = w; }
    LDS_WAIT(); asm volatile("" ::: "memory");
    const int c = lane & 7;
#pragma unroll
    for (int j = 0; j < 4; ++j) { const int nl = (lane >> 3) + 8 * j; const int n = n0 + nl; const LAS float* s = scr + (8 * c) * 33 + nl;
        v4u o; o.x = pk2(s[0 * 33], s[1 * 33]); o.y = pk2(s[2 * 33], s[3 * 33]); o.z = pk2(s[4 * 33], s[5 * 33]); o.w = pk2(s[6 * 33], s[7 * 33]);
        const int row = (MODE == 0) ? (row_off + n) : (row_off + (n >> 7) * 256 + (n & 127));
        if (n < N) *(v4u*)(WT + (size_t)row * ldo + k0 + 8 * c) = o; }
    LDS_WAIT(); asm volatile("" ::: "memory");
}
template <int MODE>
__device__ __forceinline__ void tr_item64(const float* __restrict__ W, int K, int N, bf16* __restrict__ WT, int ldo, int row_off, const float* __restrict__ gain, LAS bf16* scr, int kb, int nb, int lane) {
    const int k0 = 64 * kb, n0 = 64 * nb, n4 = (lane & 15) * 4, kr = lane >> 4; const bool ok = (n0 + n4) < N;
    f32x4 v[16];
#pragma unroll
    for (int i = 0; i < 16; ++i) v[i] = ok ? *(const f32x4*)(W + (size_t)(k0 + 4 * i + kr) * N + n0 + n4) : (f32x4){0.f, 0.f, 0.f, 0.f};
#pragma unroll
    for (int i = 0; i < 16; ++i) { const int k = 4 * i + kr; const float gg = gain ? gain[k0 + k] : 1.0f; LAS bf16* d = scr + n4 * 72 + k;
        d[0] = (bf16)f2bf(v[i].x * gg); d[72] = (bf16)f2bf(v[i].y * gg); d[144] = (bf16)f2bf(v[i].z * gg); d[216] = (bf16)f2bf(v[i].w * gg); }
    LDS_WAIT(); asm volatile("" ::: "memory");
    const int c = lane & 7;
#pragma unroll
    for (int j = 0; j < 8; ++j) { const int nl = (lane >> 3) + 8 * j, n = n0 + nl; const v4u o = *(const LAS v4u*)(scr + nl * 72 + 8 * c);
        const int row = (MODE == 0) ? (row_off + n) : (row_off + (n >> 7) * 256 + (n & 127));
        if (n < N) *(v4u*)(WT + (size_t)row * ldo + k0 + 8 * c) = o; }
    LDS_WAIT(); asm volatile("" ::: "memory");
}
__device__ __forceinline__ void tr64_load(const float* __restrict__ W, int N, int kb, int nb, int lane, f32x4 (&v)[16]) {
    const int k0 = 64 * kb, n0 = 64 * nb, n4 = (lane & 15) * 4, kr = lane >> 4;
#pragma unroll
    for (int i = 0; i < 16; ++i) v[i] = *(const f32x4*)(W + (size_t)(k0 + 16 * (i >> 2) + 4 * kr + (i & 3)) * N + n0 + n4);
}
template <int MODE>
__device__ __forceinline__ void tr64_f8_finish(const f32x4 (&v)[16], unsigned char* __restrict__ WT, int ldo, int row_off, const float* __restrict__ gain, float scale, LAS unsigned char* scr, int kb, int nb, int lane) {
    const int k0 = 64 * kb, n0 = 64 * nb, n4 = (lane & 15) * 4, kr = lane >> 4;
#pragma unroll
    for (int i = 0; i < 16; ++i) { const int k = 16 * (i >> 2) + 4 * kr + (i & 3); const float gg = (gain ? gain[k0 + k] : 1.0f) * scale; const unsigned w = pk4_fp8(v[i].x * gg, v[i].y * gg, v[i].z * gg, v[i].w * gg); LAS unsigned char* d = scr + n4 * 68 + k;
        d[0] = (unsigned char)w; d[68] = (unsigned char)(w >> 8); d[136] = (unsigned char)(w >> 16); d[204] = (unsigned char)(w >> 24); }
    LDS_WAIT(); asm volatile("" ::: "memory");
    const int c = lane & 3;
#pragma unroll
    for (int j = 0; j < 4; ++j) { const int nl = (lane >> 2) + 16 * j, n = n0 + nl; const LAS unsigned* sp = (const LAS unsigned*)(scr + nl * 68 + 16 * c); const v4u o = {sp[0], sp[1], sp[2], sp[3]};
        const int row = (MODE == 0) ? (row_off + n) : (row_off + (n >> 7) * 256 + (n & 127));
        *(v4u*)(WT + (size_t)row * ldo + k0 + 16 * c) = o; }
    LDS_WAIT(); asm volatile("" ::: "memory");
}
template <int MODE>
__device__ __forceinline__ void tr_item64_f8(const float* __restrict__ W, int K, int N, unsigned char* __restrict__ WT, int ldo, int row_off, const float* __restrict__ gain, float scale, LAS unsigned char* scr, int kb, int nb, int lane) {
    f32x4 v[16]; tr64_load(W, N, kb, nb, lane, v); tr64_f8_finish<MODE>(v, WT, ldo, row_off, gain, scale, scr, kb, nb, lane);
}
__device__ __forceinline__ void rms_row_to_bf16(const float* xrow, bf16* orow, int lane) {
    const f32x4* xr = (const f32x4*)xrow + lane;
    f32x4 v[4]; float s = 0.f;
#pragma unroll
    for (int j = 0; j < 4; ++j) { v[j] = xr[64 * j]; s += (v[j].x * v[j].x + v[j].y * v[j].y) + (v[j].z * v[j].z + v[j].w * v[j].w); }
    const float rstd = __builtin_amdgcn_rsqf(wave_sum(s) * (1.f / DMODEL) + NORM_EPS);
    unsigned long long* o8 = (unsigned long long*)orow + lane;
#pragma unroll
    for (int j = 0; j < 4; ++j) o8[64 * j] = (unsigned long long)pk2(v[j].x * rstd, v[j].y * rstd) | ((unsigned long long)pk2(v[j].z * rstd, v[j].w * rstd) << 32);
}
#ifndef NORM_PROBE
#define NORM_PROBE 0
#endif
__device__ __forceinline__ void norm_phase(Frame& F, const float* src, bf16* dst, int hb, int HG, bool nprobe = false) {
    const int gw = hb * NWAVES + F.wave, NGW = HG * NWAVES, lane = mk_lane();
    for (int m0 = gw; m0 < T_TOK; m0 += 4 * NGW) { f32x4 v[4][4];
#pragma unroll
        for (int r = 0; r < 4; ++r) { const int m = m0 + r * NGW; const f32x4* xr = (const f32x4*)(src + (size_t)(m < T_TOK ? m : m0) * DMODEL) + lane;
#pragma unroll
            for (int j = 0; j < 4; ++j) v[r][j] = (NORM_PROBE == 2 && nprobe) ? (f32x4){1.f, 2.f, 3.f, (float)m} : xr[64 * j]; }
#pragma unroll
        for (int r = 0; r < 4; ++r) { const int m = m0 + r * NGW; float s = 0.f;
#pragma unroll
            for (int j = 0; j < 4; ++j) s += (v[r][j].x * v[r][j].x + v[r][j].y * v[r][j].y) + (v[r][j].z * v[r][j].z + v[r][j].w * v[r][j].w);
            const float rstd = __builtin_amdgcn_rsqf(wave_sum(s) * (1.f / DMODEL) + NORM_EPS);
            if (m < T_TOK && !(NORM_PROBE == 1 && nprobe && rstd != 1.2345e-30f)) { unsigned long long* o8 = (unsigned long long*)(dst + (size_t)m * DMODEL) + lane;
#pragma unroll
                for (int j = 0; j < 4; ++j) o8[64 * j] = (unsigned long long)pk2(v[r][j].x * rstd, v[r][j].y * rstd) | ((unsigned long long)pk2(v[r][j].z * rstd, v[r][j].w * rstd) << 32); } } }
}

__device__ __forceinline__ void s5_build_group(Frame& F, int g) {
    LAS float* pw_re = (LAS float*)F.lds;
    LAS float* pw_im = pw_re + 33 * 65;
    LAS float* bb_re = pw_im + 33 * 65;
    LAS float* bb_im = bb_re + 1024;
    LAS float* cc_re = bb_im + 1024;
    LAS float* cc_im = cc_re + 16 * 65;
    LAS float* klag = cc_im + 16 * 65;
    LAS float* lm = klag + 32 * 257;
    LAS float* th = lm + 64;
    LAS float* fr = th + 64;
    LAS float* fi = fr + 64;
    const float* a_re = F.in[I_S5_A_RE]; const float* a_im = F.in[I_S5_A_IM]; const float* log_dt = F.in[I_S5_LOG_DT];
    const float* b_re = F.in[I_S5_B_RE]; const float* b_im = F.in[I_S5_B_IM]; const float* c_re = F.in[I_S5_C_RE]; const float* c_im = F.in[I_S5_C_IM];
    const int tid = F.wave * 64 + mk_lane();
    if (tid < 64) { const int p = tid; const float ar = a_re[g * 64 + p], ai = a_im[g * 64 + p], dt = expf(log_dt[g]);
        const float mag = expf(dt * ar); float sn, cs; sincosf(dt * ai, &sn, &cs); const float abr = mag * cs, abi = mag * sn;
        const float den = ar * ar + ai * ai, xr = abr - 1.0f, xi = abi;
        lm[p] = dt * ar; th[p] = dt * ai; fr[p] = (xr * ar + xi * ai) / den; fi[p] = (xi * ar - xr * ai) / den; }
    __syncthreads();
    for (int idx = tid; idx < 33 * 64; idx += 512) { const int tau = idx >> 6, p = idx & 63; const float mag = expf((float)tau * lm[p]); float sn, cs; sincosf((float)tau * th[p], &sn, &cs); pw_re[tau * 65 + p] = mag * cs; pw_im[tau * 65 + p] = mag * sn; }
    for (int idx = tid; idx < 1024; idx += 512) { const int p = idx >> 4; const float br = b_re[(size_t)g * 1024 + idx], bi = b_im[(size_t)g * 1024 + idx];
        bb_re[idx] = fr[p] * br - fi[p] * bi; bb_im[idx] = fr[p] * bi + fi[p] * br;
        cc_re[(idx >> 6) * 65 + (idx & 63)] = c_re[(size_t)g * 1024 + idx]; cc_im[(idx >> 6) * 65 + (idx & 63)] = c_im[(size_t)g * 1024 + idx]; }
    __syncthreads();
    for (int idx = tid; idx < 8192; idx += 512) { const int tau = idx >> 8, c = (idx >> 4) & 15, c2 = idx & 15; float s = 0.f;
        for (int p = 0; p < 64; ++p) { const float cr = cc_re[c * 65 + p], ci = cc_im[c * 65 + p], pr = pw_re[tau * 65 + p], pi = pw_im[tau * 65 + p];
            const float er = cr * pr - ci * pi, ei = cr * pi + ci * pr; s += er * bb_re[p * 16 + c2] - ei * bb_im[p * 16 + c2]; }
        klag[tau * 257 + (idx & 255)] = s; }
    __syncthreads();
    bf16* MT = (bf16*)(F.ws + WS_S5MT) + (size_t)g * 512 * 640;
    for (int ch = tid; ch < 512 * 80; ch += 512) { const int n = ch / 80, kc = ch % 80, t = n >> 4, c = n & 15, k0 = 8 * kc; float v[8];
        if (k0 < 512) { const int s = k0 >> 4, c0 = k0 & 15;
#pragma unroll
            for (int j = 0; j < 8; ++j) v[j] = (s <= t) ? klag[(t - s) * 257 + c * 16 + c0 + j] : 0.f;
        } else {
#pragma unroll
            for (int j = 0; j < 8; ++j) { const int jj = k0 - 512 + j, p = jj >> 1; const float cr = cc_re[c * 65 + p], ci = cc_im[c * 65 + p], pr = pw_re[(t + 1) * 65 + p], pi = pw_im[(t + 1) * 65 + p];
                v[j] = (jj & 1) ? -(cr * pi + ci * pr) : (cr * pr - ci * pi); }
        }
        store8_bf16(MT + (size_t)n * 640 + k0, v); }
    bf16* BE = (bf16*)(F.ws + WS_S5BEND) + (size_t)g * 256 * 512;
    for (int ch = tid; ch < 256 * 64; ch += 512) { const int n = ch >> 6, kc = ch & 63, k0 = 8 * kc, s = k0 >> 4, c0 = k0 & 15; float v[8];
        if (n < 128) { const int p = n >> 1; const float pr = pw_re[(31 - s) * 65 + p], pi = pw_im[(31 - s) * 65 + p];
#pragma unroll
            for (int j = 0; j < 8; ++j) { const float br = bb_re[p * 16 + c0 + j], bi = bb_im[p * 16 + c0 + j]; v[j] = (n & 1) ? (pr * bi + pi * br) : (pr * br - pi * bi); }
        } else {
#pragma unroll
            for (int j = 0; j < 8; ++j) v[j] = 0.f;
        }
        store8_bf16(BE + (size_t)n * 512 + k0, v); }
    __syncthreads();
}

__device__ __forceinline__ void p0_prologue(Frame& F, int parts = 15) {
    if (parts & 1) { if ((int)blockIdx.x < 32) s5_build_group(F, (int)blockIdx.x);
        if (F.G < 32) { for (int g = F.G + (int)blockIdx.x; g < 32; g += F.G) s5_build_group(F, g); } }
    if (!(parts & 14)) return;
    LAS bf16* scr = (LAS bf16*)(F.lds + F.wave * 16384);
    const int lane = mk_lane(), tid = F.wave * 64 + lane;
    const bool sep = F.G >= 64; if (sep && (int)blockIdx.x < 32) return;
    const int hb = sep ? (int)blockIdx.x - 32 : (int)blockIdx.x, HG = sep ? F.G - 32 : F.G;
    const int gw = hb * NWAVES + F.wave, NGW = HG * NWAVES;
    constexpr int J0 = 16 * 32, J1 = 8 * 8, J2 = 16 * 16, J3 = 16 * 44, J4 = J3, J5 = 44 * 16, J6 = 16 * 44, J7 = 16 * 16;
    constexpr int JL = 32;
    constexpr int NIT = J0 + J1 + J2 + J3 + J4 + J5 + J6 + JL; (void)J7;
    unsigned char* ws = F.ws;
    if (parts & 2) for (int it = gw; it < NIT; it += NGW) {
        int r = it;
        if (r < J0) { tr_item64<0>(F.in[I_E_W_IN], 1024, 2048, (bf16*)(ws + WS_WE_IN), 1024, 0, F.in[I_E_NORM_MIX], scr, r / 32, r % 32, lane); continue; } r -= J0;
        if (r < J1) { tr_item64<0>(F.in[I_S5_GLU_W], 512, 512, (bf16*)(ws + WS_WGLU), 512, 0, nullptr, scr, r / 8, r % 8, lane); continue; } r -= J1;
        if (r < J2) { tr_item64<0>(F.in[I_E_W_OUT], 1024, 1024, (bf16*)(ws + WS_WE_OUT), 1024, 0, nullptr, scr, r / 16, r % 16, lane); continue; } r -= J2;
        if (r < J3) { tr_item64<1>(F.in[I_FFN_GATE], 1024, FFN_D, (bf16*)(ws + WS_WFFN_GU), 1024, 0, F.in[I_E_NORM_FFN], scr, r / 44, r % 44, lane); continue; } r -= J3;
        if (r < J4) { tr_item64<1>(F.in[I_FFN_UP], 1024, FFN_D, (bf16*)(ws + WS_WFFN_GU), 1024, 128, F.in[I_E_NORM_FFN], scr, r / 44, r % 44, lane); continue; } r -= J4;
        if (r < J5) { tr_item64<0>(F.in[I_FFN_DOWN], FFN_D, 1024, (bf16*)(ws + WS_WFFN_D), FFN_D, 0, nullptr, scr, r / 16, r % 16, lane); continue; } r -= J5;
        if (r < J6) { tr_item64<0>(F.in[I_O_W_IN], 1024, ODD_PROJ, (bf16*)(ws + WS_WO_IN), 1024, 0, F.in[I_O_NORM_MIX], scr, r / 44, r % 44, lane); continue; } r -= J6;
        if (r < 8) tr_item64<0>(F.in[I_RWKV_W_UP], 64, 512, (bf16*)(ws + WS_WLORA), 256, 0, nullptr, scr, 0, r, lane);
        else if (r < 16) tr_item64<0>(F.in[I_RWKV_A_UP], 64, 512, (bf16*)(ws + WS_WLORA) + 64, 256, 512, nullptr, scr, 0, r - 8, lane);
        else tr_item64<0>(F.in[I_RWKV_G_UP], 128, 512, (bf16*)(ws + WS_WLORA) + 128, 256, 1024, nullptr, scr, (r - 16) / 8, (r - 16) % 8, lane);
    }
    const int gt = hb * 512 + tid, NGT = HG * 512;
    if (parts & 4) {
    { bf16* w = (bf16*)(ws + WS_WO_IN) + (size_t)ODD_PROJ * 1024; for (int i = gt; i < (ODD_PAD - ODD_PROJ) * 1024 / 8; i += NGT) *(v4u*)(w + (size_t)i * 8) = (v4u){0u, 0u, 0u, 0u}; }
    { bf16* w = (bf16*)(ws + WS_WLORA);
      for (int i = gt; i < 1536 * 32; i += NGT) { const int n = i >> 5, k = (i & 31) * 8; const bool cov = (n < 512) ? (k < 64) : ((n < 1024) ? (k >= 64 && k < 128) : (k >= 128));
          if (!cov) *(v4u*)(w + (size_t)n * 256 + k) = (v4u){0u, 0u, 0u, 0u}; } }
    { float* rp = (float*)(ws + WS_ROPE); for (int i = gt; i < 8192 * 8; i += NGT) { const int pos = i >> 3, j = i & 7; const float inv = powf(500000.0f, -(float)j / 8.0f); const float ang = (float)pos * inv;
          rp[pos * 16 + j] = cosf(ang); rp[pos * 16 + 8 + j] = sinf(ang); } }
    }
    if (parts & 8) norm_phase(F, F.in[I_X], (parts == 8 && NORM_PROBE == 2) ? (bf16*)(ws + 400 * MiB) : (bf16*)(ws + WS_XN), hb, HG, parts == 8);
}

constexpr float ATT_C2 = 0.125f * 1.4426950408889634f;
struct F_E1 {
    bf16* UG; bf16* Q0; bf16* K0; bf16* V0; const float* rope;
    __device__ __forceinline__ void operator()(const pg8::Unit& u, int r, int c, float (&v)[8], int wc) const {
        const int row = u.pm * 256 + r, col = u.pn * 256 + c, seg = u.pn >> 1;
        if (seg == 0) { const int g = col >> 4, c0 = col & 15; store8_bf16(UG + ((size_t)(g * 1024 + (row >> 5)) * 640 + (row & 31) * 16 + c0), v); }
        else if (seg == 3) { store8_bf16(V0 + (size_t)row * 512 + (col - 1536), v); }
        else { const int ch = col - seg * 512;
            if ((wc & 1) == 0) { float o[8];
#pragma unroll
                for (int j = 0; j < 8; ++j) o[j] = __shfl_xor(v[j], 16);
                const int d = ch & 63;
                if (d < 16) { const float* cs = rope + (size_t)(row & 8191) * 16; const f32x4 c0 = *(const f32x4*)cs, c1 = *(const f32x4*)(cs + 4), s0 = *(const f32x4*)(cs + 8), s1 = *(const f32x4*)(cs + 12);
                    const float cv[8] = {c0.x, c0.y, c0.z, c0.w, c1.x, c1.y, c1.z, c1.w}, sv[8] = {s0.x, s0.y, s0.z, s0.w, s1.x, s1.y, s1.z, s1.w};
                    const float sgn = (d == 0) ? -1.0f : 1.0f;
#pragma unroll
                    for (int j = 0; j < 8; ++j) v[j] = v[j] * cv[j] + sgn * o[j] * sv[j]; } }
            if (seg == 1) {
#pragma unroll
                for (int j = 0; j < 8; ++j) v[j] *= ATT_C2;
                store8_bf16(Q0 + (size_t)row * 512 + ch, v); }
            else store8_bf16(K0 + (size_t)row * 512 + ch, v); }
    }
};
struct EpiE1 {
    static constexpr bool PERM = true, AFTER_DRAIN = false;
    bf16* UG; bf16* Q0; bf16* K0; bf16* V0; const float* rope;
    __device__ __forceinline__ void operator()(const pg8::f32x4 (&acc)[2][2][4][2], const pg8::Unit& u, int wr, int wc, int fr, int fq) const {
        const int seg = u.pn >> 1;
        if (seg == 0 || seg == 3) {
#pragma unroll
            for (int ai = 0; ai < 2; ++ai)
#pragma unroll
                for (int m = 0; m < 4; ++m) { const int row = u.pm * 256 + ai * 128 + wr * 64 + m * 16 + fr;
#pragma unroll
                    for (int bj = 0; bj < 2; ++bj) { const int col = u.pn * 256 + bj * 128 + wc * 32 + 8 * fq;
                        float v[8] = {acc[ai][bj][m][0][0], acc[ai][bj][m][0][1], acc[ai][bj][m][0][2], acc[ai][bj][m][0][3], acc[ai][bj][m][1][0], acc[ai][bj][m][1][1], acc[ai][bj][m][1][2], acc[ai][bj][m][1][3]};
                        if (seg == 0) { const int g = col >> 4, c0 = col & 15; store8_bf16(UG + ((size_t)(g * 1024 + (row >> 5)) * 640 + (row & 31) * 16 + c0), v); }
                        else store8_bf16(V0 + (size_t)row * 512 + (col - 1536), v); } }
            return; }
        bf16* dst = (seg == 1) ? Q0 : K0; const float osc = (seg == 1) ? ATT_C2 : 1.0f;
        const bool ropew = (wc & 1) == 0;
        if (!ropew) {
#pragma unroll
            for (int ai = 0; ai < 2; ++ai)
#pragma unroll
                for (int m = 0; m < 4; ++m) { const int row = u.pm * 256 + ai * 128 + wr * 64 + m * 16 + fr;
#pragma unroll
                    for (int bj = 0; bj < 2; ++bj) { const int ch = (u.pn & 1) * 256 + bj * 128 + wc * 32 + 8 * fq;
                        float v[8] = {acc[ai][bj][m][0][0] * osc, acc[ai][bj][m][0][1] * osc, acc[ai][bj][m][0][2] * osc, acc[ai][bj][m][0][3] * osc, acc[ai][bj][m][1][0] * osc, acc[ai][bj][m][1][1] * osc, acc[ai][bj][m][1][2] * osc, acc[ai][bj][m][1][3] * osc};
                        store8_bf16(dst + (size_t)row * 512 + ch, v); } }
            return; }
        const float sgn = (fq == 0) ? -osc : osc; const float keep = (fq < 2) ? 0.0f : osc;
        f32x4 pr[2][2][4];
#define E1_LOAD(b, buf) do { _Pragma("unroll") for (int mm = 0; mm < 2; ++mm) { const int ri = (b) * 2 + mm; const int row = u.pm * 256 + (ri >> 2) * 128 + wr * 64 + (ri & 3) * 16 + fr; \
            const f32x4* cs = (const f32x4*)(rope + (size_t)(row & 8191) * 16); pr[buf][mm][0] = cs[0]; pr[buf][mm][1] = cs[1]; pr[buf][mm][2] = cs[2]; pr[buf][mm][3] = cs[3]; } } while (0)
        E1_LOAD(0, 0);
#pragma unroll
        for (int b = 0; b < 4; ++b) {
            if (b + 1 < 4) E1_LOAD(b + 1, (b + 1) & 1);
#pragma unroll
            for (int mm = 0; mm < 2; ++mm) { const int ri = b * 2 + mm, ai = ri >> 2, m = ri & 3; const int row = u.pm * 256 + ai * 128 + wr * 64 + m * 16 + fr;
                const f32x4 c0 = pr[b & 1][mm][0], c1 = pr[b & 1][mm][1], s0 = pr[b & 1][mm][2], s1 = pr[b & 1][mm][3];
                float cv[8] = {c0.x, c0.y, c0.z, c0.w, c1.x, c1.y, c1.z, c1.w}, sv[8] = {s0.x, s0.y, s0.z, s0.w, s1.x, s1.y, s1.z, s1.w};
#pragma unroll
                for (int j = 0; j < 8; ++j) { cv[j] = (fq < 2) ? cv[j] * osc : keep; sv[j] = (fq < 2) ? sv[j] * sgn : 0.0f; }
#pragma unroll
                for (int bj = 0; bj < 2; ++bj) { const int ch = (u.pn & 1) * 256 + bj * 128 + wc * 32 + 8 * fq;
                    float v[8] = {acc[ai][bj][m][0][0], acc[ai][bj][m][0][1], acc[ai][bj][m][0][2], acc[ai][bj][m][0][3], acc[ai][bj][m][1][0], acc[ai][bj][m][1][1], acc[ai][bj][m][1][2], acc[ai][bj][m][1][3]};
                    float o[8];
#pragma unroll
                    for (int j = 0; j < 8; ++j) o[j] = __shfl_xor(v[j], 16);
#pragma unroll
                    for (int j = 0; j < 8; ++j) v[j] = v[j] * cv[j] + o[j] * sv[j];
                    store8_bf16(dst + (size_t)row * 512 + ch, v); } } }
#undef E1_LOAD
    }
};
struct F_XEND { float* XEND;
    __device__ __forceinline__ void operator()(const pg8::Unit& u, int r, int c, float (&v)[8], int) const {
        if (c < 128) { float* d = XEND + (size_t)(u.pm * 256 + r) * 128 + c; *(f32x4*)d = (f32x4){v[0], v[1], v[2], v[3]}; *(f32x4*)(d + 4) = (f32x4){v[4], v[5], v[6], v[7]}; } }
};
struct F_S5Y { const bf16* UG; const float* dsk; bf16* YA;
    static constexpr int MB = 4; typedef v4u Pre; struct Hoist { f32x4 d[2]; };
    __device__ __forceinline__ void hoist(const pg8::Unit& u, int, int fq, Hoist& h) const { const int ch = (u.pm >> 2) * 16 + ((8 * fq) & 15); h.d[0] = *(const f32x4*)(dsk + ch); h.d[1] = *(const f32x4*)(dsk + ch + 4); }
    __device__ __forceinline__ void load(const pg8::Unit& u, int r, int c, Pre& p) const { p = *(const v4u*)(UG + (size_t)(u.pm * 256 + r) * 640 + (u.pn & 1) * 256 + c); }
    __device__ __forceinline__ void apply(const pg8::Unit& u, int r, int c, float (&v)[8], const Pre& p, const Hoist& h, int) const {
        const int row = u.pm * 256 + r, lc = (u.pn & 1) * 256 + c, g = u.pm >> 2, t = lc >> 4, c0 = lc & 15;
        const int token = (row & 1023) * 32 + t, ch = g * 16 + c0;
        float uu[8]; unpack8(p, uu);
        const float dv[8] = {h.d[0].x, h.d[0].y, h.d[0].z, h.d[0].w, h.d[1].x, h.d[1].y, h.d[1].z, h.d[1].w};
#pragma unroll
        for (int j = 0; j < 8; ++j) v[j] = gelu_tanh(v[j] + dv[j] * uu[j]);
        store8_bf16(YA + (size_t)token * 512 + ch, v); }
};
struct F_GLU { const bf16* YA; const float* gb; bf16* CAT;
    static constexpr int MB = 4; typedef v4u Pre; struct Hoist { f32x4 b[2][2]; };
    __device__ __forceinline__ void hoist(const pg8::Unit& u, int wc, int fq, Hoist& h) const {
#pragma unroll
        for (int bj = 0; bj < 2; ++bj) { const int col = u.pn * 256 + bj * 128 + wc * 32 + 8 * fq; h.b[bj][0] = *(const f32x4*)(gb + col); h.b[bj][1] = *(const f32x4*)(gb + col + 4); } }
    __device__ __forceinline__ void load(const pg8::Unit& u, int r, int c, Pre& p) const { p = *(const v4u*)(YA + (size_t)(u.pm * 256 + r) * 512 + u.pn * 256 + c); }
    __device__ __forceinline__ void apply(const pg8::Unit& u, int r, int c, float (&v)[8], const Pre& p, const Hoist& h, int bj) const {
        const int row = u.pm * 256 + r, col = u.pn * 256 + c;
        float ya[8]; unpack8(p, ya);
        const f32x4 b0 = h.b[bj][0], b1 = h.b[bj][1]; const float bv[8] = {b0.x, b0.y, b0.z, b0.w, b1.x, b1.y, b1.z, b1.w};
#pragma unroll
        for (int j = 0; j < 8; ++j) v[j] = ABL_S5 ? 0.f : ya[j] * sigmoidf_(v[j] + bv[j]);
        store8_bf16(CAT + (size_t)row * 1024 + col, v); }
};
constexpr int RES_LD = 2 * DMODEL;
struct F_RES { const bf16* base; bf16* out;
    static constexpr int MB = 4; typedef v4u Pre; struct Hoist {};
    __device__ __forceinline__ void hoist(const pg8::Unit&, int, int, Hoist&) const {}
    __device__ __forceinline__ void load(const pg8::Unit& u, int r, int c, Pre& p) const { p = *(const v4u*)(base + (size_t)(u.pm * 256 + r) * RES_LD + u.pn * 256 + c); }
    __device__ __forceinline__ void apply(const pg8::Unit& u, int r, int c, float (&v)[8], const Pre& p, const Hoist&, int) const {
        float b[8]; unpack8(p, b);
#pragma unroll
        for (int j = 0; j < 8; ++j) v[j] += b[j];
        store8_bf16(out + (size_t)(u.pm * 256 + r) * RES_LD + u.pn * 256 + c, v); }
};
__device__ __forceinline__ float row_rstd16(const float* SS, int row) {
    const f32x4* p = (const f32x4*)(SS + (size_t)row * 16); const f32x4 a = p[0], b = p[1], c = p[2], d = p[3];
    const float s = ((a.x + a.y) + (a.z + a.w)) + ((b.x + b.y) + (b.z + b.w)) + ((c.x + c.y) + (c.z + c.w)) + ((d.x + d.y) + (d.z + d.w));
    return __builtin_amdgcn_rsqf(s * (1.f / DMODEL) + NORM_EPS); }
struct F_SWIGLU { bf16* ACT; int ld; const float* SS; int mode = 0;
    __device__ __forceinline__ void operator()(const pg8::Unit& u, int r, int c, float (&g)[8], float (&p)[8], float rs) const {
        const int row = u.pm * 256 + r;
        float o[8];
#pragma unroll
        for (int j = 0; j < 8; ++j) { const float gg = g[j] * rs; o[j] = ABL_FFN0 ? 0.f : gg * sigmoidf_(gg) * (p[j] * rs); }
        if (mode == 0 || o[0] == 1.2345e-30f) store8_bf16(ACT + (size_t)row * ld + u.pn * 128 + c, o); }
};
template <bool BASE_BF16> struct EpiResNorm {
    static constexpr bool PERM = true, AFTER_DRAIN = false;
    const void* base; bf16* HB; bf16* RES; float* SS; int skip = 0;
    __device__ __forceinline__ void operator()(const pg8::f32x4 (&acc)[2][2][4][2], const pg8::Unit& u, int wr, int wc, int fr, int fq) const {
        if (skip) return;
        f32x4 pa[2][2][2][2];
#define ERN_LOAD(b, buf) do { _Pragma("unroll") for (int mm = 0; mm < 2; ++mm) { const int ri = (b) * 2 + mm; const int row = u.pm * 256 + (ri >> 2) * 128 + wr * 64 + (ri & 3) * 16 + fr; \
            _Pragma("unroll") for (int bj = 0; bj < 2; ++bj) { const size_t o = (size_t)row * 1024 + u.pn * 256 + bj * 128 + wc * 32 + 8 * fq; \
                if (BASE_BF16) pa[buf][mm][bj][0] = __builtin_bit_cast(f32x4, *(const v4u*)((const bf16*)base + o)); \
                else { pa[buf][mm][bj][0] = *(const f32x4*)((const float*)base + o); pa[buf][mm][bj][1] = *(const f32x4*)((const float*)base + o + 4); } } } } while (0)
        ERN_LOAD(0, 0);
#pragma unroll
        for (int b = 0; b < 4; ++b) {
            if (b + 1 < 4) ERN_LOAD(b + 1, (b + 1) & 1);
#pragma unroll
            for (int mm = 0; mm < 2; ++mm) { const int ri = b * 2 + mm, ai = ri >> 2, m = ri & 3; const int row = u.pm * 256 + ai * 128 + wr * 64 + m * 16 + fr; float ss = 0.f;
#pragma unroll
                for (int bj = 0; bj < 2; ++bj) { const int col = u.pn * 256 + bj * 128 + wc * 32 + 8 * fq;
                    float bv[8];
                    if (BASE_BF16) unpack8(__builtin_bit_cast(v4u, pa[b & 1][mm][bj][0]), bv);
                    else { const f32x4 a = pa[b & 1][mm][bj][0], bb = pa[b & 1][mm][bj][1]; bv[0] = a.x; bv[1] = a.y; bv[2] = a.z; bv[3] = a.w; bv[4] = bb.x; bv[5] = bb.y; bv[6] = bb.z; bv[7] = bb.w; }
                    float v[8] = {bv[0] + acc[ai][bj][m][0][0], bv[1] + acc[ai][bj][m][0][1], bv[2] + acc[ai][bj][m][0][2], bv[3] + acc[ai][bj][m][0][3],
                                  bv[4] + acc[ai][bj][m][1][0], bv[5] + acc[ai][bj][m][1][1], bv[6] + acc[ai][bj][m][1][2], bv[7] + acc[ai][bj][m][1][3]};
                    const v4u pk = pack8(v);
                    if (HB) *(v4u*)(HB + (size_t)row * 1024 + col) = pk;
                    if (RES) *(v4u*)(RES + (size_t)row * RES_LD + col) = pk;
#pragma unroll
                    for (int j = 0; j < 8; ++j) ss += v[j] * v[j]; }
                ss += __shfl_xor(ss, 16); ss += __shfl_xor(ss, 32);
                if (fq == 0) SS[(size_t)row * 16 + u.pn * 4 + wc] = ss; } }
#undef ERN_LOAD
    }
};
struct SchedXend { int G, c;
    __device__ __forceinline__ bool next(int i, pg8::Unit& u) const { const int L = i * G + c; if (L >= 128) return false; u.pm = L; u.pn = L >> 2; u.aux = 0; return true; }
    __device__ __forceinline__ void a_ready(const pg8::Unit&) const {}
    __device__ __forceinline__ void done(const pg8::Unit&) const {} };
struct SchedS5Y { int G, c;
    __device__ __forceinline__ bool next(int i, pg8::Unit& u) const { const int L = i * G + c; if (L >= 256) return false; const int g = L >> 3; u.pm = g * 4 + ((L >> 1) & 3); u.pn = g * 2 + (L & 1); u.aux = 0; return true; }
    __device__ __forceinline__ void a_ready(const pg8::Unit&) const {}
    __device__ __forceinline__ void done(const pg8::Unit&) const {} };

__device__ __forceinline__ void kmean_phase(Frame& F) {
    const bf16* K0 = (const bf16*)(F.ws + WS_K0); float* km = (float*)(F.ws + WS_KMEAN); const int lane = mk_lane(), tid = F.wave * 64 + lane; LAS float* red = (LAS float*)F.lds;
    for (int un = ((int)blockIdx.x + F.G - (128 % F.G)) % F.G; un < 128; un += F.G) { const int b = un >> 5, n = un & 31; const bf16* src = K0 + ((size_t)b * SEQL + n * 256 + F.wave) * 512 + 8 * lane;
        float s[8] = {0.f, 0.f, 0.f, 0.f, 0.f, 0.f, 0.f, 0.f};
#pragma unroll 8
        for (int i = 0; i < 32; ++i) { float t[8]; load8_bf16(src + (size_t)i * 8 * 512, t);
#pragma unroll
            for (int e = 0; e < 8; ++e) s[e] += t[e]; }
        *(LAS f32x4*)(red + F.wave * 512 + 8 * lane) = (f32x4){s[0], s[1], s[2], s[3]}; *(LAS f32x4*)(red + F.wave * 512 + 8 * lane + 4) = (f32x4){s[4], s[5], s[6], s[7]};
        __syncthreads();
        float a = 0.f;
#pragma unroll
        for (int w = 0; w < 8; ++w) a += red[w * 512 + tid];
        const int h = tid >> 6, d = tid & 63; km[((size_t)(b * 8 + h) * 32 + n) * 64 + d] = a * (1.0f / 256.0f);
        __syncthreads(); }
}
__device__ __forceinline__ void s5_carry_phase(Frame& F) {
    const int lane = mk_lane(), tid = F.wave * 64 + lane; LAS float* xs = (LAS float*)F.lds;
    for (int un = blockIdx.x; un < 128; un += F.G) { const int g = un >> 2, b = un & 3;
        const f32x4* src = (const f32x4*)((const float*)(F.ws + WS_XEND) + (size_t)(g * 1024 + b * 256) * 128);
#pragma unroll 4
        for (int i = tid; i < 8192; i += 512) ((LAS f32x4*)xs)[i] = src[i];
        __syncthreads();
        if (F.wave == 0) { const int p = lane;
            const float ar = F.in[I_S5_A_RE][g * 64 + p], ai = F.in[I_S5_A_IM][g * 64 + p], dt = expf(F.in[I_S5_LOG_DT][g]);
            const float mag = expf(32.0f * dt * ar); float sn, cs; sincosf(32.0f * dt * ai, &sn, &cs); const float a_r = mag * cs, a_i = mag * sn;
            unsigned* __restrict__ ug = (unsigned*)((bf16*)(F.ws + WS_UG) + (size_t)(g * 1024 + b * 256) * 640 + 512 + 2 * p);
            float cr = 0.f, ci = 0.f;
#pragma unroll 8
            for (int c = 0; c < 256; ++c) { const f32x2 x = *(const LAS f32x2*)(xs + c * 128 + 2 * p); ug[(size_t)c * 320] = pk2(cr, ci);
                const float nr = a_r * cr - a_i * ci + x.x, ni = a_r * ci + a_i * cr + x.y; cr = nr; ci = ni; } }
        __syncthreads(); }
}
__device__ __forceinline__ void moba_select_phase(Frame& F) {
    LAS float* km = (LAS float*)F.lds;
    const bf16* Q0 = (const bf16*)(F.ws + WS_Q0); const float* kmg = (const float*)(F.ws + WS_KMEAN); unsigned* SELM = (unsigned*)(F.ws + WS_SELM); const int tid = F.wave * 64 + mk_lane();
    const bool split = (F.G == 256); const int ufirst = split ? ((int)blockIdx.x < 128 ? (int)blockIdx.x : 128 + ((int)blockIdx.x - 128) * 3) : (int)blockIdx.x;
    const int ucount = split ? ((int)blockIdx.x < 128 ? 1 : 3) : (512 - (int)blockIdx.x + F.G - 1) / F.G;
    for (int ui = 0; ui < ucount; ++ui) { const int un = split ? ufirst + ui : ufirst + ui * F.G; const int b = un >> 7, qb = (un >> 2) & 31, hp = un & 3;
        for (int i = tid; i < 4096; i += 512) km[i] = kmg[(size_t)(b * 8 + hp * 2 + (i >> 11)) * 2048 + (i & 2047)];
        __syncthreads();
        const int hl = tid >> 8, tl = tid & 255, h = hp * 2 + hl, t = qb * 256 + tl;
        float q[64]; const bf16* qp = Q0 + ((size_t)b * SEQL + t) * 512 + h * 64;
#pragma unroll
        for (int j = 0; j < 8; ++j) { float tmp[8]; load8_bf16(qp + 8 * j, tmp);
#pragma unroll
            for (int e = 0; e < 8; ++e) q[8 * j + e] = tmp[e]; }
        float v1 = -INFINITY, v2 = -INFINITY, v3 = -INFINITY; int i1 = -1, i2 = -1, i3 = -1;
        for (int n = 0; n < qb; ++n) { const LAS float* kp = km + (hl * 32 + n) * 64; float s = 0.f;
#pragma unroll
            for (int d = 0; d < 64; d += 4) { const f32x4 kv = *(const LAS f32x4*)(kp + d); s += q[d] * kv.x + q[d + 1] * kv.y + q[d + 2] * kv.z + q[d + 3] * kv.w; }
            if (s > v1) { v3 = v2; i3 = i2; v2 = v1; i2 = i1; v1 = s; i1 = n; } else if (s > v2) { v3 = v2; i3 = i2; v2 = s; i2 = n; } else if (s > v3) { v3 = s; i3 = n; } }
        unsigned m = 1u << qb; if (i1 >= 0) m |= 1u << i1; if (i2 >= 0) m |= 1u << i2; if (i3 >= 0) m |= 1u << i3;
        SELM[(size_t)(b * 8 + h) * SEQL + t] = m;
        __syncthreads(); }
}

constexpr int P1_LD = ODD_PAD;
constexpr int PC_R = 0, PC_K = 512, PC_V = 1024, PC_WD = 1536, PC_AD = 1600, PC_GD = 1664, PC_Q = 1792, PC_KD = 2304, PC_VD = 2368, PC_QI = 2432, PC_KI = 2688, PC_WI = 2752;
struct F_P1 { bf16* P1; const float* SS;
    __device__ __forceinline__ void operator()(const pg8::Unit& u, int r, int c, float (&v)[8], float rs) const { const int row = u.pm * 256 + r;
#pragma unroll
        for (int j = 0; j < 8; ++j) v[j] *= rs;
        store8_bf16(P1 + (size_t)row * P1_LD + u.pn * 256 + c, v); } };
struct EpiP1 {
    static constexpr bool PERM = true, AFTER_DRAIN = false;
    bf16* P1; bf16* QD; bf16* KD; bf16* VD; bf16* QI; bf16* KI; float* WI; const float* SS; const float* rope;
    __device__ __forceinline__ void operator()(const pg8::f32x4 (&acc)[2][2][4][2], const pg8::Unit& u, int wr, int wc, int fr, int fq) const {
        float rs[2][4]; pg8::rows_rstd(SS, u.pm * 256, wr, fr, fq, rs);
        const int cb0 = u.pn * 256 + wc * 32, cb1 = cb0 + 128;
        const bool rot0 = (cb0 >= PC_Q && cb0 < PC_WI && !(cb0 >= PC_VD && cb0 < PC_QI) && (cb0 & 63) == 0), rot1 = (cb1 >= PC_Q && cb1 < PC_WI && !(cb1 >= PC_VD && cb1 < PC_QI) && (cb1 & 63) == 0);
        const bool anyrot = rot0 || rot1;
        const float sgn = (fq == 0) ? -1.0f : 1.0f;
        f32x4 pr[1][2][4];
#define P1_LOAD(b, buf) do { _Pragma("unroll") for (int mm = 0; mm < 2; ++mm) { const int ri = (b) * 2 + mm; const int row = u.pm * 256 + (ri >> 2) * 128 + wr * 64 + (ri & 3) * 16 + fr; \
            const f32x4* cs = (const f32x4*)(rope + (size_t)(row & 8191) * 16); pr[buf][mm][0] = cs[0]; pr[buf][mm][1] = cs[1]; pr[buf][mm][2] = cs[2]; pr[buf][mm][3] = cs[3]; } } while (0)
#pragma unroll
        for (int b = 0; b < 4; ++b) {
            if (anyrot) P1_LOAD(b, 0);
#pragma unroll
            for (int mm = 0; mm < 2; ++mm) { const int ri = b * 2 + mm, ai = ri >> 2, m = ri & 3; const int row = u.pm * 256 + ai * 128 + wr * 64 + m * 16 + fr; const float rsv = rs[ai][m];
#pragma unroll
                for (int bj = 0; bj < 2; ++bj) { const int cb = bj ? cb1 : cb0, col = cb + 8 * fq; const bool rot = bj ? rot1 : rot0;
                    float v[8] = {acc[ai][bj][m][0][0] * rsv, acc[ai][bj][m][0][1] * rsv, acc[ai][bj][m][0][2] * rsv, acc[ai][bj][m][0][3] * rsv, acc[ai][bj][m][1][0] * rsv, acc[ai][bj][m][1][1] * rsv, acc[ai][bj][m][1][2] * rsv, acc[ai][bj][m][1][3] * rsv};
                    if (rot) { float o[8];
#pragma unroll
                        for (int j = 0; j < 8; ++j) o[j] = __shfl_xor(v[j], 16);
                        const f32x4 c0 = pr[0][mm][0], c1 = pr[0][mm][1], s0 = pr[0][mm][2], s1 = pr[0][mm][3];
                        const float cv[8] = {c0.x, c0.y, c0.z, c0.w, c1.x, c1.y, c1.z, c1.w}, sv[8] = {s0.x, s0.y, s0.z, s0.w, s1.x, s1.y, s1.z, s1.w};
#pragma unroll
                        for (int j = 0; j < 8; ++j) v[j] = (fq < 2) ? v[j] * cv[j] + sgn * o[j] * sv[j] : v[j]; }
                    if (cb < PC_Q) store8_bf16(P1 + (size_t)row * P1_LD + col, v);
                    else if (cb < PC_KD) {
#pragma unroll
                        for (int j = 0; j < 8; ++j) v[j] *= ATT_C2;
                        store8_bf16(QD + (size_t)row * 512 + (col - PC_Q), v); }
                    else if (cb < PC_VD) store8_bf16(KD + (size_t)row * 64 + (col - PC_KD), v);
                    else if (cb < PC_QI) store8_bf16(VD + (size_t)row * 64 + (col - PC_VD), v);
                    else if (cb < PC_KI) store8_bf16(QI + (size_t)row * 256 + (col - PC_QI), v);
                    else if (cb < PC_WI) store8_bf16(KI + (size_t)row * 64 + (col - PC_KI), v);
                    else if (cb == PC_WI && fq == 0) *(f32x4*)(WI + (size_t)row * 4) = (f32x4){bf2f((unsigned short)f2bf(v[0])) * 0.0625f, bf2f((unsigned short)f2bf(v[1])) * 0.0625f, bf2f((unsigned short)f2bf(v[2])) * 0.0625f, bf2f((unsigned short)f2bf(v[3])) * 0.0625f};
                } } }
#undef P1_LOAD
    }
};
struct F_LORA { bf16* LORA; const float* w0; const float* a0;
    static constexpr int MB = 4; struct Pre {}; struct Hoist { f32x4 w[2][2]; };
    __device__ __forceinline__ void hoist(const pg8::Unit& u, int wc, int fq, Hoist& h) const { const int seg = u.pn >> 1; const float* src = (seg == 0) ? w0 : a0 - 512;
#pragma unroll
        for (int bj = 0; bj < 2; ++bj) { const int col = (seg < 2) ? (u.pn * 256 + bj * 128 + wc * 32 + 8 * fq) : 512; h.w[bj][0] = *(const f32x4*)(src + col); h.w[bj][1] = *(const f32x4*)(src + col + 4); } }
    __device__ __forceinline__ void load(const pg8::Unit&, int, int, Pre&) const {}
    __device__ __forceinline__ void apply(const pg8::Unit& u, int r, int c, float (&v)[8], const Pre&, const Hoist& h, int bj) const {
        const int row = u.pm * 256 + r, col = u.pn * 256 + c, seg = u.pn >> 1;
        const float wv[8] = {h.w[bj][0].x, h.w[bj][0].y, h.w[bj][0].z, h.w[bj][0].w, h.w[bj][1].x, h.w[bj][1].y, h.w[bj][1].z, h.w[bj][1].w};
        const float sc = (seg == 0) ? -0.6065306597126334f : 1.0f;
#pragma unroll
        for (int j = 0; j < 8; ++j) { const float sg = sc * sigmoidf_(wv[j] + v[j]); v[j] = (seg < 2) ? sg : v[j]; }
        store8_bf16(LORA + (size_t)row * 1536 + col, v); }
};
struct F_MOEGU { unsigned char* ACTQ; int rt0; int probe = 0;
    __device__ __forceinline__ void operator()(const pg8::Unit& u, int r, int c, float (&g)[8], float (&p)[8]) const {
        float o[8];
#pragma unroll
        for (int j = 0; j < 8; ++j) { const float gg = g[j] * (1.0f / MOE_WGU_SCALE); o[j] = gg * sigmoidf_(gg) * (p[j] * (1.0f / MOE_WGU_SCALE)); }
        if (probe == 2) { if (o[0] == 1.2345e-30f) ACTQ[0] = 1; return; }
        *(v2u*)(ACTQ + (size_t)((probe ? 0 : (u.aux >> 8)) * 256 + r) * FEXP + (probe ? 0 : (u.aux & 255)) * 128 + c) = (v2u){pk4_fp8(o[0], o[1], o[2], o[3]), pk4_fp8(o[4], o[5], o[6], o[7])}; }
};
struct F_MOED { bf16* YS; int probe = 0;
    __device__ __forceinline__ void operator()(const pg8::Unit& u, int r, int c, float (&v)[8], int) const {
#pragma unroll
        for (int j = 0; j < 8; ++j) v[j] *= (1.0f / MOE_WD_SCALE);
        if (probe == 2) { if (v[0] == 1.2345e-30f) YS[0] = 1; return; }
        store8_bf16(YS + (size_t)((probe ? 0 : u.aux) * 256 + r) * 1024 + (u.pn & 3) * 256 + c, v); } };
struct SchedMoeGU { const int* tile_exp; int rt0, ntq, G, c, ntail, nD;
    __device__ __forceinline__ bool next(int i, pg8::Unit& u) const { const int nt = ntq + ntail, U = nt * 28; int L;
        if (c < nD) { L = (i + 4) * G + c; if (L >= U) return false; }
        else { L = i * G + c;
            if (L >= U) { if (c >= 5 * nD) return false; const int own = (U - c + G - 1) / G; if (i != own) return false; const int e = c - nD; L = (e / nD) * G + (e % nD); } }
        const int idx = L % nt, pn = L / nt, rt = idx < ntq ? rt0 + idx : 256 + (idx - ntq); const int e = tile_exp[rt]; u.pm = rt; u.pn = e * 28 + pn; u.aux = pn | (idx << 8); return true; }
    __device__ __forceinline__ void a_ready(const pg8::Unit&) const {}
    __device__ __forceinline__ void done(const pg8::Unit&) const {} };
struct SchedMoeDT { const int* tile_exp; int ntail, G, c;
    __device__ __forceinline__ bool next(int i, pg8::Unit& u) const { if (i > 0 || c >= ntail * 4) return false; const int idx = c % ntail, pn = c / ntail, rt = 256 + idx; const int e = tile_exp[rt]; u.pm = 128 + idx; u.pn = e * 4 + pn; u.aux = rt; return true; }
    __device__ __forceinline__ void a_ready(const pg8::Unit&) const {}
    __device__ __forceinline__ void done(const pg8::Unit&) const {} };
struct SchedMoeD { const int* tile_exp; int rt0, ntq, G, c;
    __device__ __forceinline__ bool next(int i, pg8::Unit& u) const { const int L = i * G + c; if (L >= ntq * 4) return false; const int rt = rt0 + L % ntq, pn = L / ntq; const int e = tile_exp[rt]; u.pm = rt - rt0; u.pn = e * 4 + pn; u.aux = rt; return true; }
    __device__ __forceinline__ void a_ready(const pg8::Unit&) const {}
    __device__ __forceinline__ void done(const pg8::Unit&) const {} };

__device__ __forceinline__ void rope8_x1(float (&v)[8], int d0, const float* cs) {
    float o[8];
#pragma unroll
    for (int j = 0; j < 8; ++j) o[j] = __shfl_xor(v[j], 1);
    if (d0 < 16) { const f32x4 c0 = *(const f32x4*)cs, c1 = *(const f32x4*)(cs + 4), s0 = *(const f32x4*)(cs + 8), s1 = *(const f32x4*)(cs + 12);
        const float cv[8] = {c0.x, c0.y, c0.z, c0.w, c1.x, c1.y, c1.z, c1.w}, sv[8] = {s0.x, s0.y, s0.z, s0.w, s1.x, s1.y, s1.z, s1.w};
        const float sgn = (d0 == 0) ? -1.0f : 1.0f;
#pragma unroll
        for (int j = 0; j < 8; ++j) v[j] = v[j] * cv[j] + sgn * o[j] * sv[j]; }
}
__device__ __forceinline__ void rope8_pre(float (&v)[8], int d0, const f32x4 (&cs)[4]) {
    float o[8];
#pragma unroll
    for (int j = 0; j < 8; ++j) o[j] = __shfl_xor(v[j], 1);
    const float cv[8] = {cs[0].x, cs[0].y, cs[0].z, cs[0].w, cs[1].x, cs[1].y, cs[1].z, cs[1].w}, sv[8] = {cs[2].x, cs[2].y, cs[2].z, cs[2].w, cs[3].x, cs[3].y, cs[3].z, cs[3].w};
    const float sgn = (d0 == 0) ? -1.0f : 1.0f;
#pragma unroll
    for (int j = 0; j < 8; ++j) v[j] = (d0 < 16) ? v[j] * cv[j] + sgn * o[j] * sv[j] : v[j];
}
__device__ __forceinline__ void l1_prep_phase(Frame& F) {
    const int gw = blockIdx.x * NWAVES + F.wave, NGW = F.G * NWAVES, lane = mk_lane();
    const bf16* P1 = (const bf16*)(F.ws + WS_P1); const float* mu = F.in[I_RWKV_MU]; bf16* ALORA = (bf16*)(F.ws + WS_ALORA);
    const int colA = PC_WD + 8 * (lane & 31); float muv[8];
#pragma unroll
    for (int j = 0; j < 8; ++j) muv[j] = mu[colA + j];
    for (int t0 = gw; t0 < T_TOK; t0 += 4 * NGW) { v4u cur[4], prv[4];
#pragma unroll
        for (int r = 0; r < 4; ++r) { const int tok = t0 + r * NGW, tc = tok < T_TOK ? tok : t0; const bf16* row = P1 + (size_t)tc * P1_LD; const int pos = tc & (SEQL - 1);
            cur[r] = *(const v4u*)(row + colA); prv[r] = *(const v4u*)((pos != 0 ? row - P1_LD : row) + colA); }
#pragma unroll
        for (int r = 0; r < 4; ++r) { const int tok = t0 + r * NGW; const int pos = tok & (SEQL - 1);
            if (tok < T_TOK) { float c8[8], p8[8]; unpack8(cur[r], c8); unpack8(prv[r], p8);
#pragma unroll
                for (int j = 0; j < 8; ++j) { const float pv = (pos != 0) ? p8[j] : 0.f; const float x = c8[j] + (pv - c8[j]) * muv[j];
                    const float th_ = 1.0f - 2.0f * __builtin_amdgcn_rcpf(1.0f + __expf(2.0f * x));
                    c8[j] = (lane < 8) ? th_ : ((lane < 16) ? x : sigmoidf_(x)); }
                if (lane < 32) store8_bf16(ALORA + (size_t)tok * 256 + 8 * lane, c8); } } }
}
#ifndef RP_NB
#define RP_NB 4
#endif
__device__ __forceinline__ void rwkv_post_phase(Frame& F) {
    const int gw = blockIdx.x * NWAVES + F.wave, NGW = F.G * NWAVES, lane = mk_lane(), c0 = 8 * lane;
    const bf16* P1 = (const bf16*)(F.ws + WS_P1); const bf16* LORA = (const bf16*)(F.ws + WS_LORA); const bf16* YR = (const bf16*)(F.ws + WS_YR); bf16* CAT2 = (bf16*)(F.ws + WS_CAT);
    float mur[8], muk[8], muv[8], ka[8], rk[8], lnw[8], lnb[8];
#pragma unroll
    for (int j = 0; j < 8; ++j) { mur[j] = F.in[I_RWKV_MU][PC_R + c0 + j]; muk[j] = F.in[I_RWKV_MU][PC_K + c0 + j]; muv[j] = F.in[I_RWKV_MU][PC_V + c0 + j];
        ka[j] = F.in[I_RWKV_K_A][c0 + j]; rk[j] = F.in[I_RWKV_R_K][c0 + j]; lnw[j] = F.in[I_RWKV_LN_W][c0 + j]; lnb[j] = F.in[I_RWKV_LN_B][c0 + j]; }
    for (int t0 = gw; t0 < T_TOK; t0 += RP_NB * NGW) { v4u L[RP_NB][9];
#pragma unroll
        for (int r = 0; r < RP_NB; ++r) { const int tok = t0 + r * NGW, tc = tok < T_TOK ? tok : t0; const bool first = (tc & (SEQL - 1)) == 0; const bf16* row = P1 + (size_t)tc * P1_LD; const bf16* prow = first ? row : (row - P1_LD);
            L[r][0] = *(const v4u*)(row + PC_R + c0); L[r][1] = *(const v4u*)(row + PC_K + c0); L[r][2] = *(const v4u*)(row + PC_V + c0);
            L[r][3] = *(const v4u*)(prow + PC_R + c0); L[r][4] = *(const v4u*)(prow + PC_K + c0); L[r][5] = *(const v4u*)(prow + PC_V + c0);
            L[r][6] = *(const v4u*)(LORA + (size_t)tc * 1536 + 512 + c0); L[r][7] = *(const v4u*)(LORA + (size_t)tc * 1536 + 1024 + c0); L[r][8] = *(const v4u*)(YR + (size_t)tc * 512 + c0); }
#pragma unroll
        for (int r = 0; r < RP_NB; ++r) { const int tok = t0 + r * NGW; const bool first = (tok & (SEQL - 1)) == 0;
            float rc[8], kc[8], vc[8], rp[8], kp[8], vp[8], a[8], g[8], y[8];
            unpack8(L[r][0], rc); unpack8(L[r][1], kc); unpack8(L[r][2], vc); unpack8(L[r][3], rp); unpack8(L[r][4], kp); unpack8(L[r][5], vp); unpack8(L[r][6], a); unpack8(L[r][7], g); unpack8(L[r][8], y);
            float sy = 0.f, sb = 0.f; float v[8];
#pragma unroll
            for (int j = 0; j < 8; ++j) { const float rr = rc[j] + ((first ? 0.f : rp[j]) - rc[j]) * mur[j], k0 = kc[j] + ((first ? 0.f : kp[j]) - kc[j]) * muk[j]; v[j] = vc[j] + ((first ? 0.f : vp[j]) - vc[j]) * muv[j];
                const float k = k0 * (1.0f + (a[j] - 1.0f) * ka[j]); sb += rr * k * rk[j]; sy += y[j]; }
            const float mean = dpp_sum8(sy) * (1.0f / 64.0f); float sq = 0.f;
#pragma unroll
            for (int j = 0; j < 8; ++j) { y[j] -= mean; sq += y[j] * y[j]; }
            const float rstd = __builtin_amdgcn_rsqf(dpp_sum8(sq) * (1.0f / 64.0f) + 64e-5f), bonus = dpp_sum8(sb);
            float o[8];
#pragma unroll
            for (int j = 0; j < 8; ++j) o[j] = ABL_RWKV ? 0.f : (y[j] * rstd * lnw[j] + lnb[j] + bonus * v[j]) * g[j];
            if (tok < T_TOK) { store8_bf16(CAT2 + (size_t)tok * 1024 + c0, o);
                if (SKIP_DSA) { float z[8] = {0.f, 0.f, 0.f, 0.f, 0.f, 0.f, 0.f, 0.f}; store8_bf16(CAT2 + (size_t)tok * 1024 + 512 + c0, z); } } } }
}
__device__ __forceinline__ void moe_convert_phase(Frame& F) {
    LAS unsigned char* scr = (LAS unsigned char*)(F.lds + F.wave * 16384); const int lane = mk_lane();
    const int gw = blockIdx.x * NWAVES + F.wave, NGW = F.G * NWAVES;
    constexpr int PER = 896, NIT = 3 * 8 * PER;
    unsigned char* WGU = F.ws + WS_WMOE_GU; unsigned char* WD = F.ws + WS_WMOE_D;
#define MC_LOAD(it_, buf) do { const int m_ = (it_) / (8 * PER), r_ = (it_) % (8 * PER), e_ = r_ / PER, q_ = r_ % PER; \
        if (m_ == 0) tr64_load(F.in[I_MOE_GATE] + (size_t)e_ * 1024 * FEXP, FEXP, q_ / 56, q_ % 56, lane, buf); \
        else if (m_ == 1) tr64_load(F.in[I_MOE_UP] + (size_t)e_ * 1024 * FEXP, FEXP, q_ / 56, q_ % 56, lane, buf); \
        else tr64_load(F.in[I_MOE_DOWN] + (size_t)e_ * FEXP * 1024, 1024, q_ / 16, q_ % 16, lane, buf); } while (0)
#define MC_FIN(it_, buf) do { const int m_ = (it_) / (8 * PER), r_ = (it_) % (8 * PER), e_ = r_ / PER, q_ = r_ % PER; \
        if (m_ == 0) tr64_f8_finish<1>(buf, WGU, 1024, e_ * 7168, F.in[I_O_NORM_FFN], MOE_WGU_SCALE, scr, q_ / 56, q_ % 56, lane); \
        else if (m_ == 1) tr64_f8_finish<1>(buf, WGU, 1024, e_ * 7168 + 128, F.in[I_O_NORM_FFN], MOE_WGU_SCALE, scr, q_ / 56, q_ % 56, lane); \
        else tr64_f8_finish<0>(buf, WD, FEXP, e_ * 1024, nullptr, MOE_WD_SCALE, scr, q_ / 16, q_ % 16, lane); } while (0)
    f32x4 va[16], vb[16];
    int it = gw; if (it < NIT) MC_LOAD(it, va);
    for (; it < NIT; it += 2 * NGW) { const int it2 = it + NGW, it3 = it + 2 * NGW;
        if (it2 < NIT) MC_LOAD(it2, vb);
        MC_FIN(it, va);
        if (it3 < NIT) MC_LOAD(it3, va);
        if (it2 < NIT) MC_FIN(it2, vb); }
#undef MC_LOAD
#undef MC_FIN
}
__device__ __forceinline__ f32x4 ld_res4(const bf16* RESb, int tok, int lane, int j) {
    const v2u w = ((const v2u*)(RESb + (size_t)tok * RES_LD))[lane + 64 * j]; return (f32x4){bflo(w.x), bfhi(w.x), bflo(w.y), bfhi(w.y)}; }
__device__ __forceinline__ void router_phase(Frame& F, int cnt_off = 0) {
    const int lane = mk_lane(), tid = F.wave * 64 + lane;
    const float* gn = F.in[I_O_NORM_FFN]; const float* rt = F.in[I_MOE_ROUTER]; unsigned* cnt = (unsigned*)(F.ws + WS_CTL) + CW_EXPCNT + cnt_off; v2u* info = (v2u*)(F.ws + WS_TOKINFO);
    LAS unsigned* lcnt = (LAS unsigned*)F.lds; LAS unsigned* gbase = lcnt + 8; LAS v4u* lrec = (LAS v4u*)(F.lds + 64);
    for (int tb = blockIdx.x * 128; tb < T_TOK; tb += F.G * 128) {
        if (tid < 8) lcnt[tid] = 0u;
        __syncthreads();
        f32x4 vn[4];
        {
#pragma unroll
          for (int j = 0; j < 4; ++j) vn[j] = ld_res4((const bf16*)F.out, tb + F.wave * 16, lane, j); }
#pragma unroll 1
        for (int i = 0; i < 16; ++i) { const int tl = F.wave * 16 + i, tok = tb + tl; f32x4 v[4]; float s = 0.f;
#pragma unroll
            for (int j = 0; j < 4; ++j) v[j] = vn[j];
            {
#pragma unroll
              for (int j = 0; j < 4; ++j) vn[j] = ld_res4((const bf16*)F.out, tok + (i < 15 ? 1 : 0), lane, j); }
#pragma unroll
            for (int j = 0; j < 4; ++j) s += (v[j].x * v[j].x + v[j].y * v[j].y) + (v[j].z * v[j].z + v[j].w * v[j].w);
            const float rstd = __builtin_amdgcn_rsqf(wave_sum(s) * (1.f / DMODEL) + NORM_EPS);
            float lg[8] = {0.f, 0.f, 0.f, 0.f, 0.f, 0.f, 0.f, 0.f};
#pragma unroll
            for (int j = 0; j < 4; ++j) { const int k0 = 4 * (lane + 64 * j); const f32x4 gg = *(const f32x4*)(gn + k0); const float xv[4] = {v[j].x * rstd * gg.x, v[j].y * rstd * gg.y, v[j].z * rstd * gg.z, v[j].w * rstd * gg.w};
#pragma unroll
                for (int q = 0; q < 4; ++q) { const f32x4 w0 = *(const f32x4*)(rt + (size_t)(k0 + q) * 8), w1 = *(const f32x4*)(rt + (size_t)(k0 + q) * 8 + 4);
                    lg[0] += xv[q] * w0.x; lg[1] += xv[q] * w0.y; lg[2] += xv[q] * w0.z; lg[3] += xv[q] * w0.w; lg[4] += xv[q] * w1.x; lg[5] += xv[q] * w1.y; lg[6] += xv[q] * w1.z; lg[7] += xv[q] * w1.w; } }
#pragma unroll
            for (int e = 0; e < 8; ++e) lg[e] = wave_sum(lg[e]);
            int e1 = 0; float l1 = lg[0];
#pragma unroll
            for (int e = 1; e < 8; ++e) if (lg[e] > l1) { l1 = lg[e]; e1 = e; }
            int e2 = -1; float l2 = -INFINITY;
#pragma unroll
            for (int e = 0; e < 8; ++e) if (e != e1 && lg[e] > l2) { l2 = lg[e]; e2 = e; }
            const float g1 = 1.0f / (1.0f + __expf(l2 - l1)), g2 = 1.0f - g1;
            if (lane == 0) { const unsigned r1 = __hip_atomic_fetch_add(lcnt + e1, 1u, __ATOMIC_RELAXED, __HIP_MEMORY_SCOPE_WORKGROUP), r2 = __hip_atomic_fetch_add(lcnt + e2, 1u, __ATOMIC_RELAXED, __HIP_MEMORY_SCOPE_WORKGROUP);
                lrec[tl] = (v4u){((unsigned)e1 << 24) | r1, __builtin_bit_cast(unsigned, g1), ((unsigned)e2 << 24) | r2, __builtin_bit_cast(unsigned, g2)}; } }
        __syncthreads();
        if (tid < 8) gbase[tid] = atomicAdd(cnt + 64 * tid, lcnt[tid]);
        __syncthreads();
        if (tid < 128) { const v4u r = lrec[tid]; const unsigned b1 = gbase[r.x >> 24], b2 = gbase[r.z >> 24];
            ((v4u*)info)[(size_t)(tb + tid)] = (v4u){r.x + b1, r.y, r.z + b2, r.w}; }
        __syncthreads(); }
}
__device__ __forceinline__ void moe_scatter_phase(Frame& F) {
    const int gw = blockIdx.x * NWAVES + F.wave, NGW = F.G * NWAVES, lane = mk_lane();
    const unsigned* cnt = (const unsigned*)(F.ws + WS_CTL) + CW_EXPCNT; const v2u* info = (const v2u*)(F.ws + WS_TOKINFO); int* tokslot = (int*)(F.ws + WS_TOKSLOT); int* tile_exp = (int*)(F.ws + WS_TILEEXP);
    int pstart[8]; int acc = 0;
#pragma unroll
    for (int e = 0; e < 8; ++e) { const int c = (int)__hip_atomic_load(cnt + 64 * e, __ATOMIC_RELAXED, __HIP_MEMORY_SCOPE_AGENT); pstart[e] = acc; acc += (c + 255) & ~255; }
    const int ntiles = acc >> 8;
    if (blockIdx.x == 0 && F.wave == 0) { for (int t = lane; t < 512; t += 64) { int e = 7;
#pragma unroll
            for (int q = 7; q >= 1; --q) if (t * 256 < pstart[q]) e = q - 1;
            tile_exp[t] = (t == 511) ? ntiles : e; } }
    unsigned char* XG = F.ws + WS_XG;
    for (int t0 = gw; t0 < T_TOK; t0 += 4 * NGW) { f32x4 v[4][4]; v2u inf[4][2];
#pragma unroll
        for (int r = 0; r < 4; ++r) { const int tok = t0 + r * NGW, tc = tok < T_TOK ? tok : t0;
#pragma unroll
            for (int j = 0; j < 4; ++j) v[r][j] = ld_res4((const bf16*)F.out, tc, lane, j);
            inf[r][0] = info[(size_t)tc * 2]; inf[r][1] = info[(size_t)tc * 2 + 1]; }
#pragma unroll
        for (int r = 0; r < 4; ++r) { const int tok = t0 + r * NGW; float s = 0.f;
#pragma unroll
            for (int j = 0; j < 4; ++j) s += (v[r][j].x * v[r][j].x + v[r][j].y * v[r][j].y) + (v[r][j].z * v[r][j].z + v[r][j].w * v[r][j].w);
            const float rstd = __builtin_amdgcn_rsqf(wave_sum(s) * (1.f / DMODEL) + NORM_EPS);
            unsigned w[4];
#pragma unroll
            for (int j = 0; j < 4; ++j) w[j] = pk4_fp8(v[r][j].x * rstd, v[r][j].y * rstd, v[r][j].z * rstd, v[r][j].w * rstd);
            if (tok < T_TOK) {
#pragma unroll
                for (int k = 0; k < 2; ++k) { const int e = (int)(inf[r][k].x >> 24), rank = (int)(inf[r][k].x & 0xffffffu);
                    int ps = 0;
#pragma unroll
                    for (int q = 0; q < 8; ++q) ps = (e == q) ? pstart[q] : ps;
                    const int slot = ps + rank; unsigned* o4 = (unsigned*)(XG + (size_t)slot * 1024) + lane;
#pragma unroll
                    for (int j = 0; j < 4; ++j) o4[64 * j] = w[j];
                    if (lane == 0) tokslot[(size_t)tok * 2 + k] = slot; } } } }
}
#ifndef NT_FINAL
#define NT_FINAL 0
#endif
__device__ __forceinline__ void moe_combine_final_phase(Frame& F, float* outp = nullptr) {
    if (outp == nullptr) outp = F.out;
    const int gw = blockIdx.x * NWAVES + F.wave, NGW = F.G * NWAVES, lane = mk_lane(); const float* gn = F.in[I_FINAL_NORM];
    const v2u* info = (const v2u*)(F.ws + WS_TOKINFO); const int* tokslot = (const int*)(F.ws + WS_TOKSLOT); const bf16* YS = (const bf16*)(F.ws + WS_YS);
    f32x4 gv[4];
#pragma unroll
    for (int j = 0; j < 4; ++j) gv[j] = ((const f32x4*)gn)[lane + 64 * j];
#if RWKV_DBG
    { const unsigned long long* ck = (const unsigned long long*)(F.ws + WS_CTL) + 200; int code = 0;
      for (int arr = 3; arr >= 0; --arr) if (ck[arr] != ck[4 + arr]) code = arr + 1;
      const float ds = 1.0f + 0.5f * code; for (int j = 0; j < 4; ++j) gv[j] = gv[j] * ds; }
#endif
#if STAMP_KA >= 0
    { const float fr = ((const float*)(F.ws + WS_TILEEXP + 4096))[0]; const float ds = 1.0f + 0.08f * sqrtf(fminf(fmaxf(fr, 0.f), 1.f));
      for (int j = 0; j < 4; ++j) gv[j] = gv[j] * ds; }
#endif
    for (int t0 = gw; t0 < T_TOK; t0 += 4 * NGW) { f32x4 v[4][4]; float gk[4][2]; int sl[4][2]; v2u ys[4][2][4];
#pragma unroll
        for (int r = 0; r < 4; ++r) { const int tok = t0 + r * NGW, tc = tok < T_TOK ? tok : t0;
#pragma unroll
            for (int j = 0; j < 4; ++j) v[r][j] = ld_res4((const bf16*)F.out, tc, lane, j);
#pragma unroll
            for (int k = 0; k < 2; ++k) { const unsigned gkb = info[(size_t)tc * 2 + k].y; gk[r][k] = MOE_SCALE * __builtin_bit_cast(float, gkb); sl[r][k] = tokslot[(size_t)tc * 2 + k]; } }
#pragma unroll
        for (int r = 0; r < 4; ++r)
#pragma unroll
            for (int k = 0; k < 2; ++k) { const v2u* yr = (const v2u*)(YS + (size_t)sl[r][k] * 1024) + lane;
#pragma unroll
                for (int j = 0; j < 4; ++j) ys[r][k][j] = yr[64 * j]; }
#pragma unroll
        for (int r = 0; r < 4; ++r) { const int tok = t0 + r * NGW;
#pragma unroll
            for (int k = 0; k < 2; ++k)
#pragma unroll
                for (int j = 0; j < 4; ++j) { v2u w = ys[r][k][j]; if (ABL_MOE) w = (v2u){0u, 0u}; v[r][j].x += gk[r][k] * bflo(w.x); v[r][j].y += gk[r][k] * bfhi(w.x); v[r][j].z += gk[r][k] * bflo(w.y); v[r][j].w += gk[r][k] * bfhi(w.y); }
            float s = 0.f;
#pragma unroll
            for (int j = 0; j < 4; ++j) s += (v[r][j].x * v[r][j].x + v[r][j].y * v[r][j].y) + (v[r][j].z * v[r][j].z + v[r][j].w * v[r][j].w);
            const float rstd = __builtin_amdgcn_rsqf(wave_sum(s) * (1.f / DMODEL) + NORM_EPS);
            if (tok < T_TOK) { f32x4* xo = (f32x4*)(outp + (size_t)tok * DMODEL) + lane;
#pragma unroll
                for (int j = 0; j < 4; ++j) { const f32x4 ov = v[r][j] * rstd * gv[j];
#if NT_FINAL
                    __builtin_nontemporal_store(ov, &xo[64 * j]);
#else
                    xo[64 * j] = ov;
#endif
                } } } }
}

constexpr int RW_BLOCKS = 64;
constexpr int RW_STEPS = 32, RW_REC = 5 * 64, RW_BUF_FLOATS = RW_STEPS * RW_REC + RW_STEPS * 32;
__device__ __forceinline__ void rwkv_produce(Frame& F, LAS float* buf, int b, int h, int half, int j, int pw, int lane) {
    const bf16* P1 = (const bf16*)(F.ws + WS_P1); const bf16* LORA = (const bf16*)(F.ws + WS_LORA);
    const float* mu = F.in[I_RWKV_MU]; const int ch = h * 64 + lane;
    const float mu_r = mu[PC_R + ch], mu_k = mu[PC_K + ch], mu_v = mu[PC_V + ch], kkw = F.in[I_RWKV_K_K][ch], kaw = F.in[I_RWKV_K_A][ch];
    float rc[8], kc[8], vc[8], rp[8], kp[8], vp[8], lw[8], al[8];
#pragma unroll
    for (int i = 0; i < 8; ++i) { const int tt = 8 * pw + i, pos = 32 * j + tt; const size_t tok = (size_t)b * SEQL + pos; const bf16* row = P1 + tok * P1_LD; const bf16* prow = (pos == 0) ? row : (row - P1_LD);
        rc[i] = bf2f(row[PC_R + ch]); kc[i] = bf2f(row[PC_K + ch]); vc[i] = bf2f(row[PC_V + ch]);
        rp[i] = bf2f(prow[PC_R + ch]); kp[i] = bf2f(prow[PC_K + ch]); vp[i] = bf2f(prow[PC_V + ch]);
        lw[i] = bf2f(LORA[tok * 1536 + ch]); al[i] = bf2f(LORA[tok * 1536 + 512 + ch]); }
#pragma unroll
    for (int i = 0; i < 8; ++i) { const int tt = 8 * pw + i, pos = 32 * j + tt; const bool first = (pos == 0);
        const float r = rc[i] + ((first ? 0.f : rp[i]) - rc[i]) * mu_r, k0 = kc[i] + ((first ? 0.f : kp[i]) - kc[i]) * mu_k, v = vc[i] + ((first ? 0.f : vp[i]) - vc[i]) * mu_v;
        const float kkv = k0 * kkw; const float nrm = sqrtf(wave_sum(kkv * kkv)); const float kk = kkv / fmaxf(nrm, 1e-12f);
        const float a = al[i]; LAS float* rec = buf + tt * RW_REC;
        rec[lane] = __expf(lw[i]); rec[64 + lane] = -kk; rec[128 + lane] = kk * a; rec[192 + lane] = k0 * (1.0f + (a - 1.0f) * kaw); rec[256 + lane] = r;
        if ((lane >> 5) == half) buf[RW_STEPS * RW_REC + tt * 32 + (lane & 31)] = v; }
}
__device__ __forceinline__ void rwkv_seq_block(Frame& F, int blk) {
    const int bh = blk >> 1, half = blk & 1, b = bh >> 3, h = bh & 7; const int lane = mk_lane(), wave = F.wave;
    LAS float* buf0 = (LAS float*)F.lds; LAS float* buf1 = buf0 + RW_BUF_FLOATS;
    bf16* YR = (bf16*)(F.ws + WS_YR);
    const int rowl = 8 * (wave & 3) + (lane >> 3), kg = lane & 7;
    f32x2 s[4] = {{0.f, 0.f}, {0.f, 0.f}, {0.f, 0.f}, {0.f, 0.f}};
    if (wave >= 4) rwkv_produce(F, buf0, b, h, half, 0, wave - 4, lane);
    __syncthreads();
    for (int j = 0; j < SEQL / RW_STEPS; ++j) { LAS float* cur = (j & 1) ? buf1 : buf0; LAS float* nxt = (j & 1) ? buf0 : buf1;
        if (wave >= 4) { if (j + 1 < SEQL / RW_STEPS) rwkv_produce(F, nxt, b, h, half, j + 1, wave - 4, lane); }
        else { bf16* yo = YR + ((size_t)b * SEQL + 32 * j) * 512 + h * 64 + 32 * half + rowl;
#pragma unroll 4
            for (int t = 0; t < RW_STEPS; ++t) { const LAS float* rec = cur + t * RW_REC + 8 * kg;
                const f32x4 w0 = *(const LAS f32x4*)(rec), w1 = *(const LAS f32x4*)(rec + 4), a0 = *(const LAS f32x4*)(rec + 64), a1 = *(const LAS f32x4*)(rec + 68);
                const f32x4 b0 = *(const LAS f32x4*)(rec + 128), b1 = *(const LAS f32x4*)(rec + 132), k0 = *(const LAS f32x4*)(rec + 192), k1 = *(const LAS f32x4*)(rec + 196);
                const f32x4 r0 = *(const LAS f32x4*)(rec + 256), r1 = *(const LAS f32x4*)(rec + 260);
                const float vv = cur[RW_STEPS * RW_REC + t * 32 + rowl];
                f32x2 sa2 = s[0] * (f32x2){a0.x, a0.y} + s[1] * (f32x2){a0.z, a0.w} + s[2] * (f32x2){a1.x, a1.y} + s[3] * (f32x2){a1.z, a1.w};
                const float sa = dpp_sum8(sa2.x + sa2.y); const f32x2 sav = {sa, sa}, vvv = {vv, vv};
                s[0] = s[0] * (f32x2){w0.x, w0.y} + sav * (f32x2){b0.x, b0.y} + vvv * (f32x2){k0.x, k0.y};
                s[1] = s[1] * (f32x2){w0.z, w0.w} + sav * (f32x2){b0.z, b0.w} + vvv * (f32x2){k0.z, k0.w};
                s[2] = s[2] * (f32x2){w1.x, w1.y} + sav * (f32x2){b1.x, b1.y} + vvv * (f32x2){k1.x, k1.y};
                s[3] = s[3] * (f32x2){w1.z, w1.w} + sav * (f32x2){b1.z, b1.w} + vvv * (f32x2){k1.z, k1.w};
                f32x2 y2 = s[0] * (f32x2){r0.x, r0.y} + s[1] * (f32x2){r0.z, r0.w} + s[2] * (f32x2){r1.x, r1.y} + s[3] * (f32x2){r1.z, r1.w};
                const float y = dpp_sum8(y2.x + y2.y);
                if (kg == 0) yo[(size_t)t * 512] = (bf16)f2bf(y); } }
        __syncthreads(); }
}

#ifndef NPRE_SH
#define NPRE_SH 3
#endif
typedef float f32x4_t __attribute__((ext_vector_type(4)));
constexpr int DSA_SEL_OFF = 131072 + 1024, DSA_META_OFF = DSA_SEL_OFF + 16 * 256 * 2, DSA_CAND_CAP = 1024;
constexpr int CW_DSAQ = CW_EXPCNT + 8 * 64;
static_assert(DSA_META_OFF + 512 <= MISC_OFF && (CW_DSAQ + 128) * 4 <= (int)CTL_ZERO_BYTES, "dsa lds / ctl map");
__device__ __forceinline__ unsigned f32_order_key(float x) { x = x + 0.0f; const unsigned u = __builtin_bit_cast(unsigned, x); return (u & 0x80000000u) ? ~u : (u | 0x80000000u); }
template <int MODE, bool DRY = false>
__device__ __forceinline__ void dsa_score_pass(const bf16* __restrict__ KIb, const bf16x8 (&qa)[4][2], const float (&wq)[4][4], int t0, int ktb, int nkt, int wave, int lane,
                                               LAS unsigned* hist, LAS unsigned short* sel, LAS int* meta, bool use_lo) {
    const int g = lane >> 4, c = lane & 15;
    int bst[4] = {0, 0, 0, 0};
#pragma unroll
    for (int m = 0; m < 4; ++m) bst[m] = (MODE == 1) ? meta[4 * m + g] : (use_lo ? meta[64 + 4 * m + g] : 0);
#define DSA_LOADK(dst, kt0_) do { _Pragma("unroll") for (int u = 0; u < 4; ++u) { const int kt = (kt0_) + 8 * u, ktc = kt < nkt ? kt : (nkt - 1); const bf16* kp = KIb + (size_t)(16 * ktc + c) * 64 + 8 * g; \
        dst[u][0] = *(const bf16x8*)kp; dst[u][1] = *(const bf16x8*)(kp + 32); } } while (0)
#define DSA_GROUPS(CHK) do { _Pragma("unroll") for (int m = 0; m < 4; ++m) { \
            float sc = __builtin_fmaf(__builtin_amdgcn_fmed3f(accm[m][0], 0.f, 3.0e38f), wq[m][0], 0.0f); sc = __builtin_fmaf(__builtin_amdgcn_fmed3f(accm[m][1], 0.f, 3.0e38f), wq[m][1], sc); \
            sc = __builtin_fmaf(__builtin_amdgcn_fmed3f(accm[m][2], 0.f, 3.0e38f), wq[m][2], sc); sc = __builtin_fmaf(__builtin_amdgcn_fmed3f(accm[m][3], 0.f, 3.0e38f), wq[m][3], sc); \
            const int q = 4 * m + g; const unsigned ub = __builtin_bit_cast(unsigned, sc); const unsigned uk = ub ^ ((unsigned)((int)ub >> 31) | 0x80000000u); \
            if (!(CHK) || key <= t0 + q) { \
                if (MODE == 2) { dry += uk; } else if (MODE == 0) { if (uk >= bstk[m]) __hip_atomic_fetch_add(hist + q * 2048 + (uk >> 21), DRY ? 0u : (1u << ((uk >> 16) & 16u)), __ATOMIC_RELAXED, __HIP_MEMORY_SCOPE_WORKGROUP); } \
                else { if (uk >= bstk[m] + 0x100000u) { const int p = __hip_atomic_fetch_add((LAS unsigned*)(meta + 32 + q), DRY ? 0u : 1u, __ATOMIC_RELAXED, __HIP_MEMORY_SCOPE_WORKGROUP); if (p < (DRY ? dryz : 256)) sel[q * 256 + p] = (unsigned short)key; } \
                       else if (uk >= bstk[m]) { const int p = __hip_atomic_fetch_add((LAS unsigned*)(meta + 48 + q), DRY ? 0u : 1u, __ATOMIC_RELAXED, __HIP_MEMORY_SCOPE_WORKGROUP); \
                           if (p < (DRY ? dryz : DSA_CAND_CAP)) { hist[(q * DSA_CAND_CAP + p) * 2] = uk; hist[(q * DSA_CAND_CAP + p) * 2 + 1] = (unsigned)key; } } } } } } while (0)
#define DSA_TRIP(kb, kt0_) do { _Pragma("unroll") for (int u = 0; u < 4; ++u) { const int kt = (kt0_) + 8 * u; if (kt < nkt) { const int key = 16 * kt + c; const bool full = (16 * kt + 15 <= t0); \
        f32x4_t accm[4]; \
        _Pragma("unroll") for (int m = 0; m < 4; ++m) { f32x4_t z_ = {0.f, 0.f, 0.f, 0.f}; z_ = __builtin_amdgcn_mfma_f32_16x16x32_bf16(qa[m][0], kb[u][0], z_, 0, 0, 0); accm[m] = __builtin_amdgcn_mfma_f32_16x16x32_bf16(qa[m][1], kb[u][1], z_, 0, 0, 0); } \
        if (full) DSA_GROUPS(false); else DSA_GROUPS(true); } } } while (0)
    unsigned bstk[4]; unsigned dry = 0; const int dryz = meta[126];
#pragma unroll
    for (int m = 0; m < 4; ++m) bstk[m] = (unsigned)bst[m] << 20;
    bf16x8 kbA[4][2], kbB[4][2];
    DSA_LOADK(kbA, ktb + wave);
    for (int kt0 = ktb + wave; kt0 < nkt; kt0 += 64) {
        if (kt0 + 32 < nkt) DSA_LOADK(kbB, kt0 + 32);
        DSA_TRIP(kbA, kt0);
        if (kt0 + 32 < nkt) { if (kt0 + 64 < nkt) DSA_LOADK(kbA, kt0 + 64); DSA_TRIP(kbB, kt0 + 32); } }
#undef DSA_LOADK
#undef DSA_TRIP
#undef DSA_GROUPS
    if (MODE == 2 && dry == 0x12345678u) meta[127] = 1;
}
__device__ __forceinline__ void dsa_tile(Frame& F, int item) {
    const int lane = mk_lane(), wave = F.wave, tid = wave * 64 + lane;
    const int b = item & 3, ti = 511 - (item >> 2), t0 = 16 * ti, nkt = ti + 1; const size_t tok0 = (size_t)b * SEQL + t0;
    LAS unsigned* hist = (LAS unsigned*)F.lds; LAS unsigned short* sel = (LAS unsigned short*)(F.lds + DSA_SEL_OFF); LAS int* meta = (LAS int*)(F.lds + DSA_META_OFF);
    const bf16* QI = (const bf16*)(F.ws + WS_QI); const bf16* KIb = (const bf16*)(F.ws + WS_KI) + (size_t)b * SEQL * 64; const float* WI = (const float*)(F.ws + WS_WI);
    const int g = lane >> 4, c = lane & 15;
    if (ti >= 16) {
        for (int i = tid; i < 32768 / 4; i += 512) ((LAS v4u*)hist)[i] = (v4u){0u, 0u, 0u, 0u};
        if (tid < 96 || tid == 126) meta[tid] = 0;
        bf16x8 qa[4][2]; float wq[4][4];
#pragma unroll
        for (int m = 0; m < 4; ++m) { const bf16* qp = QI + (tok0 + 4 * m + (c >> 2)) * 256 + (c & 3) * 64 + 8 * g; qa[m][0] = *(const bf16x8*)qp; qa[m][1] = *(const bf16x8*)(qp + 32);
            const f32x4 w4 = *(const f32x4*)(WI + (tok0 + 4 * m + g) * 4); wq[m][0] = w4.x; wq[m][1] = w4.y; wq[m][2] = w4.z; wq[m][3] = w4.w; }
        __syncthreads();
#define DSA_BOUNDARY(OUT_BIN, OUT_NA) do { _Pragma("unroll 1") for (int qq = 0; qq < 2; ++qq) { const int q = 2 * wave + qq; const LAS unsigned* hw = hist + q * 2048 + 32 * lane; unsigned s_ = 0; \
              \
            _Pragma("unroll") for (int i = 0; i < 32; ++i) { const unsigned w = hw[(i + lane) & 31]; s_ += (w & 0xffffu) + (w >> 16); } \
            unsigned tsum = s_; \
            _Pragma("unroll") for (int off = 1; off < 64; off <<= 1) { const unsigned o = __shfl_down(tsum, off); tsum += (lane + off < 64) ? o : 0u; } \
            const unsigned above = tsum - s_; \
            const unsigned long long hit = __ballot(above < 256u && tsum >= 256u); const int Lh = hit ? (int)__builtin_ctzll(hit) : 0; \
            const unsigned aboveL = (unsigned)__shfl((int)above, Lh); \
            const int bin = 64 * Lh + lane; const unsigned wv = hist[q * 2048 + (bin >> 1)]; const unsigned cn = (bin & 1) ? (wv >> 16) : (wv & 0xffffu); \
            unsigned t2 = cn; \
            _Pragma("unroll") for (int off = 1; off < 64; off <<= 1) { const unsigned o = __shfl_down(t2, off); t2 += (lane + off < 64) ? o : 0u; } \
            const unsigned ab2 = t2 - cn + aboveL; \
            if (ab2 < 256u && ab2 + cn >= 256u) { meta[(OUT_BIN) + q] = bin; if ((OUT_NA) >= 0) meta[(OUT_NA) + q] = (int)ab2; } } } while (0)
        const int npre = (nkt >= 64) ? (((nkt >> NPRE_SH) + 7) & ~7) < 32 ? 32 : (((nkt >> NPRE_SH) + 7) & ~7) : nkt;
        dsa_score_pass<0>(KIb, qa, wq, t0, 0, npre, wave, lane, hist, sel, meta, false);
        __syncthreads();
        if (npre < nkt) { DSA_BOUNDARY(64, -1); __syncthreads();
            dsa_score_pass<0>(KIb, qa, wq, t0, npre, nkt, wave, lane, hist, sel, meta, true);
            __syncthreads(); }
        DSA_BOUNDARY(0, 16);
        __syncthreads();
        if (DSA_DUP_KIND & 1) { dsa_score_pass<0, true>(KIb, qa, wq, t0, 0, npre, wave, lane, hist, sel, meta, false); __syncthreads(); }
        if ((DSA_DUP_KIND & 2) && npre < nkt) { dsa_score_pass<0, true>(KIb, qa, wq, t0, npre, nkt, wave, lane, hist, sel, meta, true); __syncthreads(); }
        if (DSA_DUP_KIND & 16) { DSA_BOUNDARY(0, 16); __syncthreads(); DSA_BOUNDARY(0, 16); __syncthreads(); }
#undef DSA_BOUNDARY
        if (DSA_DUP_PASS) dsa_score_pass<2>(KIb, qa, wq, t0, 0, nkt, wave, lane, hist, sel, meta, false);
        dsa_score_pass<1>(KIb, qa, wq, t0, 0, nkt, wave, lane, hist, sel, meta, false);
        __syncthreads();
        if (DSA_DUP_KIND & 4) { dsa_score_pass<1, true>(KIb, qa, wq, t0, 0, nkt, wave, lane, hist, sel, meta, false); __syncthreads(); }
#pragma unroll 1
        for (int qq0 = 0; qq0 < ((DSA_DUP_KIND & 8) ? 4 : 2); ++qq0) { const int qq = qq0 & 1; const bool rdry = qq0 >= 2; const int q = 2 * wave + qq;
            int n = __builtin_amdgcn_readfirstlane(meta[48 + q]); n = n < DSA_CAND_CAP ? n : DSA_CAND_CAP; const int nab = __builtin_amdgcn_readfirstlane(meta[16 + q]); const int R = 256 - nab;
            const LAS v2u* cd = (const LAS v2u*)(hist + (size_t)q * DSA_CAND_CAP * 2);
            unsigned ck[16], ci[16];
#pragma unroll
            for (int j2 = 0; j2 < 16; ++j2) { const int c_ = lane + 64 * j2; v2u e = {0u, 0u}; if (c_ < n) e = cd[c_]; ck[j2] = (c_ < n) ? (e.x & 0xFFFFFu) + 1u : 0u; ci[j2] = e.y; }
            unsigned T = 0;
#pragma unroll 1
            for (int bit = 20; bit >= 0; --bit) { const unsigned trial = T | (1u << bit); int cnt = 0;
#pragma unroll
                for (int j2 = 0; j2 < 16; ++j2) cnt += __builtin_popcountll(__ballot(ck[j2] >= trial));
                if (cnt >= R) T = trial; }
            int cgt = 0, ceq = 0;
#pragma unroll
            for (int j2 = 0; j2 < 16; ++j2) { cgt += __builtin_popcountll(__ballot(ck[j2] > T)); ceq += __builtin_popcountll(__ballot(ck[j2] == T)); }
            const int need = R - cgt; unsigned I = 0xFFFFu;
            if (ceq > need) { I = 0;
#pragma unroll 1
                for (int bit = 12; bit >= 0; --bit) { const unsigned trial = I | (1u << bit); int cnt = 0;
#pragma unroll
                    for (int j2 = 0; j2 < 16; ++j2) cnt += __builtin_popcountll(__ballot(ck[j2] == T && ci[j2] < trial));
                    if (cnt < need) I = trial; } }
            int base = nab;
#pragma unroll
            for (int j2 = 0; j2 < 16; ++j2) { const bool s_ = (ck[j2] > T) || (ck[j2] == T && ci[j2] <= I); const unsigned long long m_ = __ballot(s_);
                const int p = base + (int)__builtin_amdgcn_mbcnt_hi((unsigned)(m_ >> 32), __builtin_amdgcn_mbcnt_lo((unsigned)m_, 0u));
                if (s_ && p < 256 && !rdry) sel[q * 256 + p] = (unsigned short)ci[j2];
                base += __builtin_popcountll(m_); } }
    } else {
        for (int i = tid; i < 16 * 256; i += 512) sel[i] = (unsigned short)(i & 255);
    }
    __syncthreads();
    const bf16* QD = (const bf16*)(F.ws + WS_QD); const bf16* KD = (const bf16*)(F.ws + WS_KD) + (size_t)b * SEQL * 64; const bf16* VDb = (const bf16*)(F.ws + WS_VD) + (size_t)b * SEQL * 64;
    bf16* CAT2 = (bf16*)(F.ws + WS_CAT);
    bf16x8 esel[2];
#pragma unroll
    for (int d = 0; d < 2; ++d)
#pragma unroll
        for (int j = 0; j < 8; ++j) esel[d][j] = (8 * g + j == 16 * d + c) ? (short)0x3F80 : (short)0;
#pragma unroll 1
    for (int qq0 = 0; qq0 < ((DSA_DUP_ATT || (DSA_DUP_KIND & 32)) ? 4 : 2); ++qq0) { const int qq = qq0 & 1; const int q = 2 * wave + qq; const int pos = t0 + q; const size_t tok = tok0 + q; const int nsel = (pos + 1 < 256) ? (pos + 1) : 256;
        bf16x8 qb[2];
        { const bf16* qp = QD + tok * 512 + (c & 7) * 64 + 8 * g; qb[0] = *(const bf16x8*)qp; qb[1] = *(const bf16x8*)(qp + 32);
          if (c >= 8) { qb[0] = (bf16x8){0, 0, 0, 0, 0, 0, 0, 0}; qb[1] = qb[0]; } }
        f32x4_t st[16];
        {
            bf16x8 kaA[4][2], kaB[4][2];
#define DSA_LDK(dst, bt) do { _Pragma("unroll") for (int i = 0; i < 4; ++i) { const int idx = 16 * (4 * (bt) + i) + c; const int key = (idx < nsel) ? (int)sel[q * 256 + idx] : 0; const bf16* kp = KD + (size_t)key * 64 + 8 * g; \
                dst[i][0] = *(const bf16x8*)kp; dst[i][1] = *(const bf16x8*)(kp + 32); } } while (0)
#define DSA_MMK(src, bt) do { _Pragma("unroll") for (int i = 0; i < 4; ++i) { f32x4_t a = {0.f, 0.f, 0.f, 0.f}; \
                a = __builtin_amdgcn_mfma_f32_16x16x32_bf16(src[i][0], qb[0], a, 0, 0, 0); a = __builtin_amdgcn_mfma_f32_16x16x32_bf16(src[i][1], qb[1], a, 0, 0, 0); \
                _Pragma("unroll") for (int j = 0; j < 4; ++j) if (16 * (4 * (bt) + i) + 4 * g + j >= nsel) a[j] = -INFINITY; \
                st[4 * (bt) + i] = a; } } while (0)
            bf16x8 kaC[4][2];
            DSA_LDK(kaA, 0); DSA_LDK(kaB, 1); DSA_LDK(kaC, 2); DSA_MMK(kaA, 0); DSA_LDK(kaA, 3); DSA_MMK(kaB, 1); DSA_MMK(kaC, 2); DSA_MMK(kaA, 3);
#undef DSA_LDK
#undef DSA_MMK
        }
        float mx = -INFINITY;
#pragma unroll
        for (int i = 0; i < 16; ++i) mx = fmaxf(fmaxf(mx, fmaxf(st[i][0], st[i][1])), fmaxf(st[i][2], st[i][3]));
        mx = fmaxf(mx, __shfl_xor(mx, 16)); mx = fmaxf(mx, __shfl_xor(mx, 32));
        float ls = 0.f;
#pragma unroll
        for (int i = 0; i < 16; ++i) {
#pragma unroll
            for (int j = 0; j < 4; ++j) { const float p = __builtin_amdgcn_exp2f(st[i][j] - mx); st[i][j] = p; ls += p; } }
        ls += __shfl_xor(ls, 16); ls += __shfl_xor(ls, 32);
        f32x4_t o[4] = {{0.f, 0.f, 0.f, 0.f}, {0.f, 0.f, 0.f, 0.f}, {0.f, 0.f, 0.f, 0.f}, {0.f, 0.f, 0.f, 0.f}};
        bf16x8 vnx[2][2];
#pragma unroll
        for (int tt = 0; tt < 2; ++tt) { const int idx = 16 * tt + c; const int key = (idx < nsel) ? (int)sel[q * 256 + idx] : 0; const bf16* vp = VDb + (size_t)key * 64 + 8 * g; vnx[tt][0] = *(const bf16x8*)vp; vnx[tt][1] = *(const bf16x8*)(vp + 32); }
#pragma unroll
        for (int ks = 0; ks < 8; ++ks) { v4u pw; pw.x = pk2(st[2 * ks][0], st[2 * ks][1]); pw.y = pk2(st[2 * ks][2], st[2 * ks][3]); pw.z = pk2(st[2 * ks + 1][0], st[2 * ks + 1][1]); pw.w = pk2(st[2 * ks + 1][2], st[2 * ks + 1][3]);
            const bf16x8 pa = __builtin_bit_cast(bf16x8, pw);
            bf16x8 vcur[2][2];
#pragma unroll
            for (int tt = 0; tt < 2; ++tt) { vcur[tt][0] = vnx[tt][0]; vcur[tt][1] = vnx[tt][1]; }
            if (ks < 7) {
#pragma unroll
                for (int tt = 0; tt < 2; ++tt) { const int idx = 16 * (2 * ks + 2 + tt) + c; const int key = (idx < nsel) ? (int)sel[q * 256 + idx] : 0; const bf16* vp = VDb + (size_t)key * 64 + 8 * g; vnx[tt][0] = *(const bf16x8*)vp; vnx[tt][1] = *(const bf16x8*)(vp + 32); } }
            f32x4_t tr[2][4];
#pragma unroll
            for (int tt = 0; tt < 2; ++tt) { const f32x4_t z = {0.f, 0.f, 0.f, 0.f};
                tr[tt][0] = __builtin_amdgcn_mfma_f32_16x16x32_bf16(vcur[tt][0], esel[0], z, 0, 0, 0); tr[tt][1] = __builtin_amdgcn_mfma_f32_16x16x32_bf16(vcur[tt][0], esel[1], z, 0, 0, 0);
                tr[tt][2] = __builtin_amdgcn_mfma_f32_16x16x32_bf16(vcur[tt][1], esel[0], z, 0, 0, 0); tr[tt][3] = __builtin_amdgcn_mfma_f32_16x16x32_bf16(vcur[tt][1], esel[1], z, 0, 0, 0); }
#pragma unroll
            for (int db = 0; db < 4; ++db) { v4u vw; vw.x = pk2(tr[0][db][0], tr[0][db][1]); vw.y = pk2(tr[0][db][2], tr[0][db][3]); vw.z = pk2(tr[1][db][0], tr[1][db][1]); vw.w = pk2(tr[1][db][2], tr[1][db][3]);
                o[db] = __builtin_amdgcn_mfma_f32_16x16x32_bf16(pa, __builtin_bit_cast(bf16x8, vw), o[db], 0, 0, 0); } }
        float li[4];
#pragma unroll
        for (int j = 0; j < 4; ++j) li[j] = __builtin_amdgcn_rcpf(__shfl(ls, (4 * g + j) & 15));
        if (g < 2) { bf16* op = CAT2 + tok * 1024 + 512 + c;
#pragma unroll
            for (int j = 0; j < 4; ++j)
#pragma unroll
                for (int db = 0; db < 4; ++db) op[(4 * g + j) * 64 + 16 * db] = ABL_DSA ? (bf16)0 : (bf16)f2bf(o[db][j] * li[j]); } }
    __syncthreads();
}
__device__ __forceinline__ void dsa_phase(Frame& F, int qi, int item0, int nitems) {
    unsigned* qhead = (unsigned*)(F.ws + WS_CTL) + CW_DSAQ + 64 * qi; LAS int* meta = (LAS int*)(F.lds + DSA_META_OFF);
    for (;;) { if (F.wave == 0 && mk_lane() == 0) meta[100] = (int)atomicAdd(qhead, 1u);
        __syncthreads(); const int it = meta[100]; __syncthreads();
        if (it >= nitems) break;
        const int v = (item0 == 0) ? (it < 768 ? it : it + 1024) : it + 768;
        dsa_tile(F, v); }
}

constexpr int RC_PT = 72, RC_MS = 64 * RC_PT;
constexpr size_t WS_RWS = 5 * MiB;
constexpr size_t WS_WO_OUT2 = 3 * MiB;
constexpr size_t RWS_WY = 0, RWS_MC = 16 * MiB, RWS_NC = 32 * MiB;
typedef float rc_f32x2 __attribute__((ext_vector_type(2))); typedef __bf16 rc_bf16x2 __attribute__((ext_vector_type(2)));
__device__ __forceinline__ unsigned cvtpk(float lo, float hi) { const rc_f32x2 v = {lo, hi}; const rc_bf16x2 b = __builtin_convertvector(v, rc_bf16x2); return __builtin_bit_cast(unsigned, b); }
__device__ __forceinline__ f32x4 rc_ld4(const LAS bf16* M, int n, int m0) { const v2u w = *(const LAS v2u*)(M + n * RC_PT + m0); return (f32x4){bflo(w.x), bfhi(w.x), bflo(w.y), bfhi(w.y)}; }
__device__ __forceinline__ void rc_st4(LAS bf16* M, int n, int m0, const f32x4 v) { *(LAS v2u*)(M + n * RC_PT + m0) = (v2u){cvtpk(v.x, v.y), cvtpk(v.z, v.w)}; }
template <class Init, class Out>
__device__ __forceinline__ void rc_pset(const LAS bf16* X, const LAS bf16* Y, int wave, int lane, Init init, Out out) {
    const int g = lane >> 4, c = lane & 15;
#pragma unroll
    for (int u = 0; u < 2; ++u) { const int tl = 2 * wave + u, mt = tl >> 2, nt = tl & 3;
        f32x4 acc = init(mt, nt, g, c);
#pragma unroll
        for (int ks = 0; ks < 2; ++ks) { const bf16x8 a = *(const LAS bf16x8*)(X + (16 * mt + c) * RC_PT + 32 * ks + 8 * g), b = *(const LAS bf16x8*)(Y + (16 * nt + c) * RC_PT + 32 * ks + 8 * g);
            acc = __builtin_amdgcn_mfma_f32_16x16x32_bf16(a, b, acc, 0, 0, 0); }
        out(mt, nt, g, c, acc); }
}
#define RC_SYNC() __syncthreads()
__device__ __forceinline__ void rwkv_chunk_unit(Frame& F, int b, int h, int hl, int ch) {
    const int lane = mk_lane(), wave = F.wave;
    LAS bf16* L0 = (LAS bf16*)F.lds;
#define SLOT(i) (L0 + (i) * RC_MS)
    LAS float* gC = (LAS float*)(L0 + 15 * RC_MS);
    LAS float* segs = gC + 64;
    const bf16* P1 = (const bf16*)(F.ws + WS_P1); const bf16* LORA = (const bf16*)(F.ws + WS_LORA);
    const size_t tok0 = (size_t)b * SEQL + 64 * ch; const int chn = h * 64 + lane;
    { const float* mu = F.in[I_RWKV_MU]; const float mu_r = mu[PC_R + chn], mu_k = mu[PC_K + chn], mu_v = mu[PC_V + chn], kkw = F.in[I_RWKV_K_K][chn], kaw = F.in[I_RWKV_K_A][chn];
      float rr[8], kmod[8], vv[8], lw[8], kk[8], al[8]; float tot = 0.f;
#pragma unroll
      for (int i = 0; i < 8; ++i) { const int tt = 8 * wave + i; const size_t tok = tok0 + tt; const bool first = (ch == 0 && tt == 0); const bf16* row = P1 + tok * P1_LD; const bf16* prow = first ? row : (row - P1_LD);
          const float rc = bf2f(row[PC_R + chn]), kc = bf2f(row[PC_K + chn]), vc = bf2f(row[PC_V + chn]);
          const float rp = first ? 0.f : bf2f(prow[PC_R + chn]), kp = first ? 0.f : bf2f(prow[PC_K + chn]), vp = first ? 0.f : bf2f(prow[PC_V + chn]);
          lw[i] = bf2f(LORA[tok * 1536 + chn]); al[i] = bf2f(LORA[tok * 1536 + 512 + chn]);
          rr[i] = rc + (rp - rc) * mu_r; const float k0 = kc + (kp - kc) * mu_k; vv[i] = vc + (vp - vc) * mu_v;
          const float kkv = k0 * kkw; kk[i] = kkv * __builtin_amdgcn_rsqf(fmaxf(wave_sum(kkv * kkv), 1e-24f));
          kmod[i] = k0 * (1.0f + (al[i] - 1.0f) * kaw); tot += lw[i]; }
      segs[wave * 64 + lane] = tot;
      RC_SYNC();
      float off = 0.f;
#pragma unroll
      for (int w2 = 0; w2 < 8; ++w2) off += (w2 < wave) ? segs[w2 * 64 + lane] : 0.f;
#pragma unroll
      for (int i = 0; i < 8; ++i) { const int tt = 8 * wave + i; const float Lm = off; off += lw[i]; const float Lc = off;
          const float eL = __expf(Lc), eLm = __expf(Lm), enL = __expf(-Lc);
          const bf16 va = (bf16)f2bf(-kk[i] * eLm), vb = (bf16)f2bf(kk[i] * al[i] * enL), vk = (bf16)f2bf(kmod[i] * enL), vr = (bf16)f2bf(rr[i] * eL), vvv = (bf16)f2bf(vv[i]);
          SLOT(0)[tt * RC_PT + lane] = va; SLOT(1)[tt * RC_PT + lane] = vb; SLOT(2)[tt * RC_PT + lane] = vk; SLOT(3)[tt * RC_PT + lane] = vr;
          SLOT(4)[lane * RC_PT + tt] = va; SLOT(5)[lane * RC_PT + tt] = vb; SLOT(6)[lane * RC_PT + tt] = vvv;
          if (tt == 63) gC[lane] = eL; }
      RC_SYNC(); }
    const auto zero = [](int, int, int, int) { return (f32x4){0.f, 0.f, 0.f, 0.f}; };
    rc_pset(SLOT(1), SLOT(0), wave, lane, zero, [&](int mt, int nt, int g, int c, f32x4 a) { const int m0 = 16 * mt + 4 * g, n = 16 * nt + c;
        rc_st4(SLOT(9), n, m0, (f32x4){m0 < n ? a.x : 0.f, m0 + 1 < n ? a.y : 0.f, m0 + 2 < n ? a.z : 0.f, m0 + 3 < n ? a.w : 0.f}); });
    rc_pset(SLOT(0), SLOT(1), wave, lane, zero, [&](int mt, int nt, int g, int c, f32x4 a) { const int m0 = 16 * mt + 4 * g, n = 16 * nt + c;
        rc_st4(SLOT(10), n, m0, (f32x4){n < m0 ? a.x : 0.f, n < m0 + 1 ? a.y : 0.f, n < m0 + 2 ? a.z : 0.f, n < m0 + 3 ? a.w : 0.f}); });
    rc_pset(SLOT(0), SLOT(2), wave, lane, zero, [&](int mt, int nt, int g, int c, f32x4 a) { const int m0 = 16 * mt + 4 * g, n = 16 * nt + c;
        rc_st4(SLOT(7), n, m0, (f32x4){n < m0 ? a.x : 0.f, n < m0 + 1 ? a.y : 0.f, n < m0 + 2 ? a.z : 0.f, n < m0 + 3 ? a.w : 0.f}); });
    rc_pset(SLOT(1), SLOT(3), wave, lane, zero, [&](int mt, int nt, int g, int c, f32x4 a) { const int m0 = 16 * mt + 4 * g, n = 16 * nt + c;
        rc_st4(SLOT(8), n, m0, (f32x4){m0 <= n ? a.x : 0.f, m0 + 1 <= n ? a.y : 0.f, m0 + 2 <= n ? a.z : 0.f, m0 + 3 <= n ? a.w : 0.f}); });
    RC_SYNC();
#define RC_NEU(sN, sNT, sM, sMT, dN, dNT, dM, dMT, LAST) do { \
    if (!(LAST)) rc_pset(SLOT(sNT), SLOT(sM), wave, lane, [&](int mt, int nt, int g, int c) { return rc_ld4(SLOT(sN), 16 * nt + c, 16 * mt + 4 * g); }, \
                         [&](int mt, int nt, int g, int c, f32x4 a) { rc_st4(SLOT(dN), 16 * nt + c, 16 * mt + 4 * g, a); });                   \
    rc_pset(SLOT(sM), SLOT(sNT), wave, lane, [&](int mt, int nt, int g, int c) { return rc_ld4(SLOT(sNT), 16 * nt + c, 16 * mt + 4 * g); }, \
            [&](int mt, int nt, int g, int c, f32x4 a) { rc_st4(SLOT(dNT), 16 * nt + c, 16 * mt + 4 * g, a); });                             \
    if (!(LAST)) { rc_pset(SLOT(sMT), SLOT(sM), wave, lane, zero, [&](int mt, int nt, int g, int c, f32x4 a) { rc_st4(SLOT(dM), 16 * nt + c, 16 * mt + 4 * g, a); });     \
                   rc_pset(SLOT(sM), SLOT(sMT), wave, lane, zero, [&](int mt, int nt, int g, int c, f32x4 a) { rc_st4(SLOT(dMT), 16 * nt + c, 16 * mt + 4 * g, a); }); } \
    RC_SYNC(); } while (0)
    RC_NEU(9, 10, 9, 10, 11, 12, 13, 14, false);
    RC_NEU(11, 12, 13, 14, 9, 10, 0, 1, false);
    RC_NEU(9, 10, 0, 1, 11, 12, 13, 14, false);
    RC_NEU(11, 12, 13, 14, 9, 10, 0, 1, false);
    RC_NEU(9, 10, 0, 1, 11, 12, 13, 14, false);
    RC_NEU(11, 12, 13, 14, 9, 10, 0, 1, true);
#undef RC_NEU
    rc_pset(SLOT(10), SLOT(8), wave, lane, [&](int mt, int nt, int g, int c) { return rc_ld4(SLOT(8), 16 * nt + c, 16 * mt + 4 * g); },
            [&](int mt, int nt, int g, int c, f32x4 a) { rc_st4(SLOT(9), 16 * nt + c, 16 * mt + 4 * g, a); });
    rc_pset(SLOT(10), SLOT(5), wave, lane, [&](int mt, int nt, int g, int c) { return rc_ld4(SLOT(5), 16 * nt + c, 16 * mt + 4 * g); },
            [&](int mt, int nt, int g, int c, f32x4 a) { rc_st4(SLOT(11), 16 * nt + c, 16 * mt + 4 * g, a); });
    RC_SYNC();
    const int ul = ((b * 4 + hl) * 128 + ch);
    bf16* WY = (bf16*)(F.ws + WS_RWS) + (size_t)ul * 12288; bf16* MC = WY + 4096; bf16* NC = WY + 8192;
    rc_pset(SLOT(4), SLOT(9), wave, lane, [&](int mt, int nt, int g, int c) { return rc_ld4(SLOT(3), 16 * nt + c, 16 * mt + 4 * g); },
            [&](int mt, int nt, int g, int c, f32x4 a) { *(v2u*)(WY + ((nt * 2 + (mt >> 1)) * 64 + g * 16 + c) * 8 + 4 * (mt & 1)) = (v2u){cvtpk(a.x, a.y), cvtpk(a.z, a.w)}; });
    { const int g = lane >> 4, c = lane & 15;
#pragma unroll
      for (int u = 0; u < 2; ++u) { const int tl = 2 * wave + u, mt = tl >> 2, nt = tl & 3, m0 = 16 * mt + 4 * g, n = 16 * nt + c; f32x4 acc = {0.f, 0.f, 0.f, 0.f};
#pragma unroll
          for (int ks = 0; ks < 2; ++ks) acc = __builtin_amdgcn_mfma_f32_16x16x32_bf16(*(const LAS bf16x8*)(SLOT(2) + (16 * mt + c) * RC_PT + 32 * ks + 8 * g), *(const LAS bf16x8*)(SLOT(3) + (16 * nt + c) * RC_PT + 32 * ks + 8 * g), acc, 0, 0, 0);
          acc = (f32x4){m0 <= n ? acc.x : 0.f, m0 + 1 <= n ? acc.y : 0.f, m0 + 2 <= n ? acc.z : 0.f, m0 + 3 <= n ? acc.w : 0.f};
#pragma unroll
          for (int ks = 0; ks < 2; ++ks) acc = __builtin_amdgcn_mfma_f32_16x16x32_bf16(*(const LAS bf16x8*)(SLOT(7) + (16 * mt + c) * RC_PT + 32 * ks + 8 * g), *(const LAS bf16x8*)(SLOT(9) + (16 * nt + c) * RC_PT + 32 * ks + 8 * g), acc, 0, 0, 0);
          rc_st4(SLOT(13), n, m0, acc); } }
    rc_pset(SLOT(4), SLOT(11), wave, lane, zero, [&](int mt, int nt, int g, int c, f32x4 a) { const int m0 = 16 * mt + 4 * g, n = 16 * nt + c; const float gg = gC[n];
        const f32x4 o = {gg * (a.x + (m0 == n ? 1.f : 0.f)), gg * (a.y + (m0 + 1 == n ? 1.f : 0.f)), gg * (a.z + (m0 + 2 == n ? 1.f : 0.f)), gg * (a.w + (m0 + 3 == n ? 1.f : 0.f))};
        *(v2u*)(MC + ((nt * 2 + (mt >> 1)) * 64 + g * 16 + c) * 8 + 4 * (mt & 1)) = (v2u){cvtpk(o.x, o.y), cvtpk(o.z, o.w)}; });
    rc_pset(SLOT(7), SLOT(11), wave, lane, [&](int mt, int nt, int g, int c) { const int m0 = 16 * mt + 4 * g, n = 16 * nt + c;
                return (f32x4){bf2f(SLOT(2)[m0 * RC_PT + n]), bf2f(SLOT(2)[(m0 + 1) * RC_PT + n]), bf2f(SLOT(2)[(m0 + 2) * RC_PT + n]), bf2f(SLOT(2)[(m0 + 3) * RC_PT + n])}; },
            [&](int mt, int nt, int g, int c, f32x4 a) { rc_st4(SLOT(14), 16 * nt + c, 16 * mt + 4 * g, a); });
    RC_SYNC();
    rc_pset(SLOT(14), SLOT(6), wave, lane, zero, [&](int mt, int nt, int g, int c, f32x4 a) { const int m0 = 16 * mt + 4 * g; const f32x4 gg = *(const LAS f32x4*)(gC + m0);
        *(v2u*)(NC + ((nt * 4 + mt) * 64 + lane) * 4) = (v2u){cvtpk(a.x * gg.x, a.y * gg.y), cvtpk(a.z * gg.z, a.w * gg.w)}; });
    { bf16* YR = (bf16*)(F.ws + WS_YR);
      rc_pset(SLOT(13), SLOT(6), wave, lane, zero, [&](int mt, int nt, int g, int c, f32x4 a) { bf16* yp = YR + (tok0 + 16 * mt + 4 * g) * 512 + h * 64 + 16 * nt + c;
          yp[0] = (bf16)f2bf(a.x); yp[512] = (bf16)f2bf(a.y); yp[1024] = (bf16)f2bf(a.z); yp[1536] = (bf16)f2bf(a.w); }); }
    RC_SYNC();
#undef SLOT
}
__device__ __forceinline__ void rwkv_chunk_passA(Frame& F, int half) {
    for (int un = blockIdx.x; un < 2048; un += F.G) { const int ch = un & 127, hl = (un >> 7) & 3, b = un >> 9; rwkv_chunk_unit(F, b, 4 * half + hl, hl, ch); }
}
constexpr int RB_SLOT = 32768, RB_R = 4, RB_D = 3;
template <bool STORE> __device__ __forceinline__ void rwkv_chunk_passB(Frame& F, int half) {
    const int lane = mk_lane(), wave = F.wave, g = lane >> 4, c = lane & 15; const int sq = (int)blockIdx.x, b = sq >> 2, hl = sq & 3, h = 4 * half + hl;
    const bf16* UB = (const bf16*)(F.ws + WS_RWS) + (size_t)sq * 128 * 12288;
    bf16* YRb = (bf16*)(F.ws + WS_YR) + (size_t)b * SEQL * 512 + h * 64;
    LAS unsigned char* ring = F.lds;
    const bool loader = wave >= 4; const int lw = wave & 3;
#define RB_ISSUE(ch_) do { const int ch2 = (ch_); LAS unsigned char* sl = ring + (ch2 % RB_R) * RB_SLOT; const char* ub = (const char*)(UB + (size_t)ch2 * 12288); \
        _Pragma("unroll") for (int q = 0; q < 6; ++q) { const int i = lw * 6 + q; __builtin_amdgcn_global_load_lds((const unsigned*)(ub + i * 1024 + lane * 16), (LAS unsigned*)(sl + i * 1024), 16, 0, 0); } \
        _Pragma("unroll") for (int q = 0; q < 2; ++q) { const int i2 = lw * 2 + q; const char* yp = (const char*)(YRb + (size_t)(64 * ch2 + 8 * i2 + (lane >> 3)) * 512) + (lane & 7) * 16; \
            __builtin_amdgcn_global_load_lds((const unsigned*)yp, (LAS unsigned*)(sl + 24576 + i2 * 1024), 16, 0, 0); } } while (0)
    if (loader) { RB_ISSUE(0); RB_ISSUE(1); RB_ISSUE(2); }
    bf16x8 sB[2] = {{0, 0, 0, 0, 0, 0, 0, 0}, {0, 0, 0, 0, 0, 0, 0, 0}};
    for (int ch = 0; ch < 128; ++ch) {
        if (loader) { if (ch + 2 < 128) asm volatile("s_waitcnt vmcnt(16)" ::: "memory"); else asm volatile("s_waitcnt vmcnt(0)" ::: "memory"); }
        else asm volatile("s_waitcnt lgkmcnt(0)" ::: "memory");
        asm volatile("" ::: "memory"); __builtin_amdgcn_s_barrier(); asm volatile("" ::: "memory");
        if (loader) { if (ch + RB_D < 128) RB_ISSUE(ch + RB_D); }
        else { const LAS unsigned char* sl = ring + (ch % RB_R) * RB_SLOT; const int vg = wave;
            bf16x8 wa[4][2], ma[4][2]; v2u nf[4]; float yl[4][4];
#pragma unroll
            for (int mt = 0; mt < 4; ++mt) {
#pragma unroll
                for (int ks = 0; ks < 2; ++ks) { wa[mt][ks] = *(const LAS bf16x8*)(sl + ((mt * 2 + ks) * 64 + lane) * 16); ma[mt][ks] = *(const LAS bf16x8*)(sl + 8192 + ((mt * 2 + ks) * 64 + lane) * 16); }
                nf[mt] = *(const LAS v2u*)(sl + 16384 + ((vg * 4 + mt) * 64 + lane) * 8);
#pragma unroll
                for (int j = 0; j < 4; ++j) yl[mt][j] = bf2f(*(const LAS unsigned short*)(sl + 24576 + (16 * mt + 4 * g + j) * 128 + (16 * vg + c) * 2)); }
            f32x4 ns[4];
#pragma unroll
            for (int mt = 0; mt < 4; ++mt) { f32x4 y = {yl[mt][0], yl[mt][1], yl[mt][2], yl[mt][3]};
                y = __builtin_amdgcn_mfma_f32_16x16x32_bf16(wa[mt][0], sB[0], y, 0, 0, 0); y = __builtin_amdgcn_mfma_f32_16x16x32_bf16(wa[mt][1], sB[1], y, 0, 0, 0);
                bf16* yp = YRb + (size_t)(64 * ch + 16 * mt + 4 * g) * 512 + 16 * vg + c; if (STORE) { yp[0] = (bf16)f2bf(y.x); yp[512] = (bf16)f2bf(y.y); yp[1024] = (bf16)f2bf(y.z); yp[1536] = (bf16)f2bf(y.w); } else if (y.x == 123456.f) yp[0] = 0;
                f32x4 s = {bflo(nf[mt].x), bfhi(nf[mt].x), bflo(nf[mt].y), bfhi(nf[mt].y)};
                s = __builtin_amdgcn_mfma_f32_16x16x32_bf16(ma[mt][0], sB[0], s, 0, 0, 0); s = __builtin_amdgcn_mfma_f32_16x16x32_bf16(ma[mt][1], sB[1], s, 0, 0, 0); ns[mt] = s; }
            { v4u w0, w1; w0.x = cvtpk(ns[0].x, ns[0].y); w0.y = cvtpk(ns[0].z, ns[0].w); w0.z = cvtpk(ns[1].x, ns[1].y); w0.w = cvtpk(ns[1].z, ns[1].w);
              w1.x = cvtpk(ns[2].x, ns[2].y); w1.y = cvtpk(ns[2].z, ns[2].w); w1.z = cvtpk(ns[3].x, ns[3].y); w1.w = cvtpk(ns[3].z, ns[3].w);
              sB[0] = __builtin_bit_cast(bf16x8, w0); sB[1] = __builtin_bit_cast(bf16x8, w1); } } }
    asm volatile("s_waitcnt vmcnt(0) lgkmcnt(0)" ::: "memory"); __builtin_amdgcn_s_barrier(); asm volatile("" ::: "memory");
#undef RB_ISSUE
}

__device__ __forceinline__ void final_norm_phase(Frame& F) {
    const int gw = blockIdx.x * NWAVES + F.wave, NGW = F.G * NWAVES, lane = mk_lane(); const float* gn = F.in[I_FINAL_NORM];
    f32x4 gv[4];
#pragma unroll
    for (int j = 0; j < 4; ++j) gv[j] = ((const f32x4*)gn)[lane + 64 * j];
    for (int m = gw; m < T_TOK; m += NGW) { f32x4* xr = (f32x4*)(F.out + (size_t)m * DMODEL) + lane; f32x4 v[4]; float s = 0.f;
#pragma unroll
        for (int j = 0; j < 4; ++j) { v[j] = xr[64 * j]; s += (v[j].x * v[j].x + v[j].y * v[j].y) + (v[j].z * v[j].z + v[j].w * v[j].w); }
        const float rstd = 1.0f / sqrtf(wave_sum(s) * (1.f / DMODEL) + NORM_EPS);
#pragma unroll
        for (int j = 0; j < 4; ++j) xr[64 * j] = v[j] * rstd * gv[j]; }
}

constexpr int NPHASE = 29;
__global__ void __launch_bounds__(NWAVES * 64, 2) mega_fwd(Args args) {
    extern __shared__ __attribute__((aligned(16))) unsigned char lds[];
    Frame F;
    F.lds = (LAS unsigned char*)lds;
    F.wave = __builtin_amdgcn_readfirstlane((int)threadIdx.x >> 6); F.G = gridDim.x;
    F.in = args.in; F.out = args.out; F.ws = args.ws;
    unsigned char* ws = args.ws;
    for (int u = threadIdx.x; u < (LDS_BYTES - RING_BYTES) / 4; u += NWAVES * 64) ((LAS unsigned*)(F.lds + RING_BYTES))[u] = 0u;
    __syncthreads();
    XcdBarrier bar = xcd_barrier_post((unsigned*)(ws + WS_CTL) + CW_BAR + args.li * XCD_BAR_WORDS, (volatile LAS unsigned*)(F.lds + MISC_OFF));
    const int lo = args.ph_lo, hi = args.ph_hi;
#if STAMP_KA >= 0
    volatile LAS unsigned long long* stl = (volatile LAS unsigned long long*)(F.lds + MISC_OFF + 32);
    const bool stamper = (blockIdx.x == 0 && threadIdx.x == 0);
    if (stamper) stl[0] = __builtin_amdgcn_s_memrealtime();
#define STAMP_AT(k) do { if (stamper) { if ((k) == STAMP_KA) stl[1] = __builtin_amdgcn_s_memrealtime(); if ((k) == STAMP_KB) stl[2] = __builtin_amdgcn_s_memrealtime(); \
        if ((k) == 27) { const unsigned long long now = __builtin_amdgcn_s_memrealtime(); ((float*)(ws + WS_TILEEXP + 4096))[0] = (float)(stl[2] - stl[1]) / (float)(now - stl[0]); } } } while (0)
#else
#define STAMP_AT(k) do {} while (0)
#endif
#define IN(k) (lo <= (k) && (k) < hi)
#ifndef P8_DUP_MODE
#define P8_DUP_MODE 0
#endif
#ifndef P8_SP2
#define P8_SP2 true
#endif
#ifndef MFMA_SPIN
#define MFMA_SPIN 0
#endif
#ifndef P8_DUP_LD0
#define P8_DUP_LD0 0
#endif
#ifndef E1_OLD
#define E1_OLD 0
#endif
#ifndef P8_DUP_ZERO
#define P8_DUP_ZERO 0
#endif
#ifndef EXTRA_BAR
#define EXTRA_BAR 0
#endif
#ifndef P8_DUP_LDV
#define P8_DUP_LDV 0
#endif
#ifndef P9_DUP_LDV
#define P9_DUP_LDV 0
#endif
#ifndef P9_DUP_SKIP
#define P9_DUP_SKIP 0
#endif
#ifndef DUP_SKIP_EPI
#define DUP_SKIP_EPI 0
#endif
#ifndef P8_DUP_F8
#define P8_DUP_F8 0
#endif
#ifndef P8_ORDER
#define P8_ORDER pg8::StaticOrder
#endif
#ifndef GEMM_ORDER
#define GEMM_ORDER pg8::StaticOrder
#endif
#ifndef MOE_PROBE
#define MOE_PROBE 0
#endif
#ifndef MOE_PROBE_OFF
#define MOE_PROBE_OFF 470
#endif
#ifndef MOE_ALIGN
#define MOE_ALIGN true
#endif
#ifndef DUPSET
#define DUPSET 0ull
#endif
#define PHB(k) if (IN(k)) { const int nrep_ = 1 + (int)(((unsigned long long)(DUPSET) >> (k)) & 1ull); for (int rep_ = 0; rep_ < nrep_; ++rep_) { const bool last_ = (rep_ + 1 == nrep_); (void)last_;
#define PHE(k) if (!last_) xcd_barrier(bar, F.wave == 0 && mk_lane() == 0); } }
#define SEAM(k) do { if (IN(k) && IN((k) + 1)) { xcd_barrier(bar, F.wave == 0 && mk_lane() == 0); if (EXTRA_BAR) xcd_barrier(bar, F.wave == 0 && mk_lane() == 0); } } while (0)
#define SEAM2(k, kn) do { if (IN(k) && IN(kn)) xcd_barrier(bar, F.wave == 0 && mk_lane() == 0); } while (0)
    bf16* XN = (bf16*)(ws + WS_XN); bf16* CAT = (bf16*)(ws + WS_CAT); bf16* UG = (bf16*)(ws + WS_UG);
    bf16* Q0 = (bf16*)(ws + WS_Q0); bf16* K0 = (bf16*)(ws + WS_K0); bf16* V0 = (bf16*)(ws + WS_V0); bf16* YA = (bf16*)(ws + WS_YA);

#if MFMA_SPIN
    {
        typedef short s8_t __attribute__((ext_vector_type(8)));
        f32x4 a8[8]; s8_t xa, xb;
#pragma unroll
        for (int j = 0; j < 8; ++j) { a8[j] = (f32x4){0.f, 0.f, 0.f, 0.f}; xa[j] = (short)(0x3c00 + mk_lane() + j); xb[j] = (short)(0x3b80 + 3 * j); }
#pragma unroll 1
        for (int i = 0; i < MFMA_SPIN; ++i) {
#pragma unroll
            for (int j = 0; j < 8; ++j) a8[j] = __builtin_amdgcn_mfma_f32_16x16x32_bf16(xa, xb, a8[j], 0, 0, 0); }
        float sm = 0.f;
#pragma unroll
        for (int j = 0; j < 8; ++j) sm += a8[j][0] + a8[j][1] + a8[j][2] + a8[j][3];
        if (sm == 1.2345e-30f) ((float*)(ws + WS_TILEEXP))[1000] = sm;
    }
#endif
    PHB(0) p0_prologue(F, last_ ? 15 : (int)(((unsigned long long)(DUPSET) >> 46) & 15ull)); PHE(0) SEAM(0);
    PHB(1) pg8::Gemm g{XN, (const bf16*)(ws + WS_WE_IN), 1024, 1024, 1024}; GEMM_ORDER S; S.init(T_TOK, 2048, F.G, (int)blockIdx.x);
        #if E1_OLD
        pg8::Epi8<F_E1> E{{UG, Q0, K0, V0, (const float*)(ws + WS_ROPE)}};
        pg8::gemm_phase<pg8::Epi8<F_E1>, pg8::StaticOrder, true, true>(F.lds, g, S, E, F.wave, !last_ && DUP_SKIP_EPI); PHE(1) SEAM(1);
#else
        EpiE1 E{UG, Q0, K0, V0, (const float*)(ws + WS_ROPE)};
        pg8::gemm_phase<EpiE1, GEMM_ORDER, true, true>(F.lds, g, S, E, F.wave, !last_ && DUP_SKIP_EPI); PHE(1) SEAM(1);
#endif
    PHB(2) pg8::Gemm g{UG, (const bf16*)(ws + WS_S5BEND), 640, 512, 512}; SchedXend S{F.G, (int)blockIdx.x};
        pg8::Epi8<F_XEND> E{{(float*)(ws + WS_XEND)}};
        if (last_ || ((DUPSET >> 44) & 1ull)) pg8::gemm_phase<pg8::Epi8<F_XEND>, SchedXend, true, true>(F.lds, g, S, E, F.wave, !last_ && DUP_SKIP_EPI);
        if (last_ || ((DUPSET >> 45) & 1ull)) kmean_phase(F); PHE(2) SEAM(2);
    PHB(3) s5_carry_phase(F); moba_select_phase(F); PHE(3) SEAM(3);
    PHB(4) if (last_ || (DUPSET & (1ull << 40))) { pg8::Gemm g{UG, (const bf16*)(ws + WS_S5MT), 640, 640, 640}; SchedS5Y S{F.G, (int)blockIdx.x};
          pg8::Epi8L<F_S5Y> E{{UG, F.in[I_S5_D], YA}};
          pg8::gemm_phase<pg8::Epi8L<F_S5Y>, SchedS5Y, true, true>(F.lds, g, S, E, F.wave, !last_ && DUP_SKIP_EPI); }
        if (F.G == 256 && (last_ || (DUPSET & (1ull << 41)))) { const attn_body::AttnTensors AT{(const attn_body::bf16*)Q0, (const attn_body::bf16*)K0, (const attn_body::bf16*)V0, (attn_body::bf16*)(CAT + 512), (const unsigned*)(ws + WS_SELM)};
          const attn_body::StaticOrder S((int)F.G, (int)blockIdx.x);
          attn_body::attn_phase<attn_body::StaticOrder>((char*)lds, AT, S, F.wave); } PHE(4) SEAM(4);
    PHB(5) pg8::Gemm g{YA, (const bf16*)(ws + WS_WGLU), 512, 512, 512}; pg8::StaticOrder S; S.init(T_TOK, 512, F.G, (int)blockIdx.x);
        pg8::Epi8L<F_GLU> E{{YA, F.in[I_S5_GLU_B], CAT}};
        pg8::gemm_phase<pg8::Epi8L<F_GLU>, pg8::StaticOrder, true, true>(F.lds, g, S, E, F.wave, !last_ && DUP_SKIP_EPI); PHE(5) SEAM(5);
    PHB(6) pg8::Gemm g{CAT, (const bf16*)(ws + WS_WE_OUT), 1024, 1024, 1024}; GEMM_ORDER S; S.init(T_TOK, 1024, F.G, (int)blockIdx.x);
        EpiResNorm<false> E{(const void*)F.in[I_X], (bf16*)(ws + WS_HB1), nullptr, (float*)(ws + WS_SS1)};
        pg8::gemm_phase<EpiResNorm<false>, GEMM_ORDER, true, true>(F.lds, g, S, E, F.wave, !last_ && DUP_SKIP_EPI); PHE(6) SEAM2(6, 8);
    PHB(8) pg8::Gemm g{(const bf16*)(ws + WS_HB1), (const bf16*)(ws + WS_WFFN_GU), 1024, 1024, 1024}; P8_ORDER S; S.init(T_TOK, 2 * FFN_D, F.G, (int)blockIdx.x);
        pg8::EpiGUR<F_SWIGLU> E{{(bf16*)(ws + WS_ACT), FFN_D, (const float*)(ws + WS_SS1), last_ ? 0 : P8_DUP_MODE}};
        pg8::gemm_phase<pg8::EpiGUR<F_SWIGLU>, P8_ORDER, true, P8_SP2>(F.lds, g, S, E, F.wave, !last_ && DUP_SKIP_EPI); PHE(8) SEAM(8);
    PHB(9) pg8::Gemm g{(const bf16*)(ws + WS_ACT), (const bf16*)(ws + WS_WFFN_D), (!last_ && P9_DUP_LDV) ? P9_DUP_LDV : FFN_D, (!last_ && P9_DUP_LDV) ? P9_DUP_LDV : FFN_D, FFN_D}; GEMM_ORDER S; S.init(T_TOK, 1024, F.G, (int)blockIdx.x);
        EpiResNorm<true> E{(const void*)(ws + WS_HB1), nullptr, (bf16*)F.out, (float*)(ws + WS_SS2), (!last_ && P9_DUP_SKIP) ? 1 : 0};
        pg8::gemm_phase<EpiResNorm<true>, GEMM_ORDER, true, true>(F.lds, g, S, E, F.wave, !last_ && DUP_SKIP_EPI); PHE(9) SEAM2(9, 11);
    PHB(11) pg8::Gemm g{(const bf16*)F.out, (const bf16*)(ws + WS_WO_IN), RES_LD, 1024, 1024}; GEMM_ORDER S; S.init(T_TOK, ODD_PAD, F.G, (int)blockIdx.x);
        EpiP1 E{(bf16*)(ws + WS_P1), (bf16*)(ws + WS_QD), (bf16*)(ws + WS_KD), (bf16*)(ws + WS_VD), (bf16*)(ws + WS_QI), (bf16*)(ws + WS_KI), (float*)(ws + WS_WI), (const float*)(ws + WS_SS2), (const float*)(ws + WS_ROPE)};
        pg8::gemm_phase<EpiP1, GEMM_ORDER, true, true>(F.lds, g, S, E, F.wave, !last_ && DUP_SKIP_EPI); PHE(11) SEAM(11);
    PHB(12) l1_prep_phase(F); PHE(12) SEAM(12);
    PHB(13) pg8::Gemm g{(const bf16*)(ws + WS_ALORA), (const bf16*)(ws + WS_WLORA), 256, 256, 256}; pg8::StaticOrder S; S.init(T_TOK, 1536, F.G, (int)blockIdx.x);
        pg8::Epi8L<F_LORA> E{{(bf16*)(ws + WS_LORA), F.in[I_RWKV_W0], F.in[I_RWKV_A0]}};
        pg8::gemm_phase<pg8::Epi8L<F_LORA>, pg8::StaticOrder, true, true>(F.lds, g, S, E, F.wave, !last_ && DUP_SKIP_EPI);
        { LAS bf16* scr = (LAS bf16*)(F.lds + F.wave * 16384); const int lane = mk_lane();
          for (int it = blockIdx.x * NWAVES + F.wave; it < 256; it += F.G * NWAVES) tr_item64<0>(F.in[I_O_W_OUT], 1024, 1024, (bf16*)(ws + WS_WO_OUT2), 1024, 0, nullptr, scr, it / 16, it % 16, lane); } PHE(13) SEAM(13);
    PHB(14) rwkv_chunk_passA(F, 0); PHE(14) SEAM(14);
    PHB(15) if (F.G == 256) { if ((int)blockIdx.x < 16) { if (last_) rwkv_chunk_passB<true>(F, 0); else rwkv_chunk_passB<false>(F, 0); } dsa_phase(F, last_ ? 0 : 2, 0, 1024); } PHE(15) SEAM(15);
    PHB(16) rwkv_chunk_passA(F, 1); PHE(16) SEAM(16);
    PHB(17) if (F.G == 256) { if ((int)blockIdx.x < 16) { if (last_) rwkv_chunk_passB<true>(F, 1); else rwkv_chunk_passB<false>(F, 1); } dsa_phase(F, last_ ? 1 : 3, 1024, 1024); } PHE(17) SEAM(17);
    PHB(18) rwkv_post_phase(F); PHE(18) SEAM(18);
    PHB(19) if (last_ || (DUPSET & (1ull << 42))) { pg8::Gemm g{CAT, (const bf16*)(ws + WS_WO_OUT2), 1024, 1024, 1024}; GEMM_ORDER S; S.init(T_TOK, 1024, F.G, (int)blockIdx.x);
          pg8::Epi8L<F_RES> E{{(const bf16*)F.out, last_ ? (bf16*)F.out : (bf16*)(ws + 130 * MiB)}};
          pg8::gemm_phase<pg8::Epi8L<F_RES>, GEMM_ORDER, true, true>(F.lds, g, S, E, F.wave, !last_ && DUP_SKIP_EPI); }
        if (last_ || (DUPSET & (1ull << 43))) moe_convert_phase(F); PHE(19) SEAM(19);
    PHB(20) router_phase(F, last_ ? 0 : 2048); PHE(20) SEAM(20);
    PHB(21) moe_scatter_phase(F); PHE(21) SEAM(21);
#define MOE_NT const int* te = (const int*)(ws + WS_TILEEXP); const int ntl = te[511]; const int ntail = ntl > 256 ? ntl - 256 : 0; (void)ntail;
#define MOE_GU(RT0, NTQ, NTAIL, ND) do { pg8::Gemm g{(const bf16*)(ws + WS_XG), (const bf16*)(ws + WS_WMOE_GU), 512, 512, 512}; SchedMoeGU S{te, (RT0), (NTQ), F.G, (int)blockIdx.x, (NTAIL), (ND)}; \
        pg8::EpiGU<F_MOEGU> E{{last_ ? ws + WS_ACTQ : ws + MOE_PROBE_OFF * MiB, 0, last_ ? 0 : MOE_PROBE}}; \
        pg8::gemm_phase<pg8::EpiGU<F_MOEGU>, SchedMoeGU, MOE_ALIGN, true, true>(F.lds, g, S, E, F.wave, !last_ && DUP_SKIP_EPI); } while (0)
#define MOE_D(RT0, NTQ) do { pg8::Gemm g{(const bf16*)(ws + WS_ACTQ), (const bf16*)(ws + WS_WMOE_D), FEXP / 2, FEXP / 2, FEXP / 2}; SchedMoeD S{te, (RT0), (NTQ), F.G, (int)blockIdx.x}; \
        pg8::Epi8<F_MOED> E{{last_ ? (bf16*)(ws + WS_YS) : (bf16*)(ws + MOE_PROBE_OFF * MiB), last_ ? 0 : MOE_PROBE}}; \
        pg8::gemm_phase<pg8::Epi8<F_MOED>, SchedMoeD, MOE_ALIGN, true, true>(F.lds, g, S, E, F.wave, !last_ && DUP_SKIP_EPI); } while (0)
    PHB(22) MOE_NT const int ntq0 = ntl < 128 ? ntl : 128; MOE_GU(0, ntq0, ntail, 0); PHE(22) SEAM(22);
    PHB(23) MOE_NT const int ntq0 = ntl < 128 ? ntl : 128; MOE_D(0, ntq0); PHE(23) SEAM(23);
    PHB(24) MOE_NT int ntq1 = ntl - 128; ntq1 = ntq1 < 0 ? 0 : (ntq1 > 128 ? 128 : ntq1);
        if (ntail > 0) { pg8::Gemm g{(const bf16*)(ws + WS_ACTQ), (const bf16*)(ws + WS_WMOE_D), FEXP / 2, FEXP / 2, FEXP / 2}; SchedMoeDT S{te, ntail, F.G, (int)blockIdx.x};
            pg8::Epi8<F_MOED> E{{last_ ? (bf16*)(ws + WS_YS) : (bf16*)(ws + MOE_PROBE_OFF * MiB), last_ ? 0 : MOE_PROBE}};
            pg8::gemm_phase<pg8::Epi8<F_MOED>, SchedMoeDT, MOE_ALIGN, true, true>(F.lds, g, S, E, F.wave, !last_ && DUP_SKIP_EPI); }
        MOE_GU(128, ntq1, 0, (ntq1 == 128 && F.G == 256) ? 4 * ntail : 0); PHE(24) SEAM(24);
    PHB(25) MOE_NT int ntq1 = ntl - 128; ntq1 = ntq1 < 0 ? 0 : (ntq1 > 128 ? 128 : ntq1); MOE_D(128, ntq1); PHE(25) SEAM2(25, 28);
#undef MOE_NT
#undef MOE_GU
#undef MOE_D
    PHB(28) moe_combine_final_phase(F, last_ ? F.out : (float*)(ws + 346 * MiB)); PHE(28)
#undef IN
#undef SEAM
#undef SEAM2
}

#ifndef MK_ONE_LAUNCH
#define MK_ONE_LAUNCH 1
#endif
extern "C" void kernel_launch(void* const* d_in, const int* in_sizes, int n_in, void* d_out, int out_size, void* d_ws, size_t ws_size, hipStream_t stream) {
    static int grid = 0;
    if (grid == 0) {
        if (n_in != 38 || in_sizes[0] != T_TOK * DMODEL || out_size != T_TOK * DMODEL || ws_size < WS_NEED) { fprintf(stderr, "kernel_launch: unexpected shapes (n_in %d, in0 %d, out %d, ws %zu); nothing launched\n", n_in, n_in > 0 ? in_sizes[0] : -1, out_size, ws_size); grid = -1; return; }
        int dev = 0, cus = 0, per_cu = 0;
        if (hipGetDevice(&dev) != hipSuccess || hipDeviceGetAttribute(&cus, hipDeviceAttributeMultiprocessorCount, dev) != hipSuccess) { grid = -1; return; }
        if (hipFuncSetAttribute((const void*)mega_fwd, hipFuncAttributeMaxDynamicSharedMemorySize, LDS_BYTES) != hipSuccess) { fprintf(stderr, "kernel_launch: hipFuncSetAttribute failed\n"); grid = -1; return; }
        if (hipOccupancyMaxActiveBlocksPerMultiprocessor(&per_cu, (const void*)mega_fwd, NWAVES * 64, LDS_BYTES) != hipSuccess || per_cu < 1) fprintf(stderr, "kernel_launch: occupancy query reports %d\n", per_cu);
        (void)hipGetLastError();
        grid = cus > 256 ? 256 : cus;
    }
    if (grid < 0) return;
    if (hipMemsetAsync((char*)d_ws + WS_CTL, 0, CTL_ZERO_BYTES, stream) != hipSuccess) return;
    Args a{};
    for (int i = 0; i < 38; ++i) a.in[i] = (const float*)d_in[i];
    a.out = (float*)d_out; a.ws = (unsigned char*)d_ws; a.pad = 0;
#if MK_ONE_LAUNCH
    a.ph_lo = 0; a.ph_hi = NPHASE; a.li = 0;
    hipLaunchKernelGGL(mega_fwd, dim3(grid), dim3(NWAVES * 64), LDS_BYTES, stream, a);
#else
    for (int p = 0; p < NPHASE; ++p) { a.ph_lo = p; a.ph_hi = p + 1; a.li = p;
        hipLaunchKernelGGL(mega_fwd, dim3(grid), dim3(NWAVES * 64), LDS_BYTES, stream, a);
        if (hipPeekAtLastError() != hipSuccess) { fprintf(stderr, "kernel_launch: launch %d failed\n", p); break; } }
#endif
}
```
